# Optimizing an MI355X kernel written in HIP

```python
import math, functools
import jax, jax.numpy as jnp
from jax import lax
import numpy as np

D_MODEL = 1024
BATCH = 4
SEQ = 4096
DEPTH = 1

N_META = 16
MIX_WIDTH = D_MODEL
MIX_A = MIX_WIDTH // 2
MIX_B = MIX_WIDTH - MIX_A
N_POOL_GROUPS = 4
POOL_GROUP_DIM = MIX_A // N_POOL_GROUPS
POOL_WINDOWS = (2, 4, 8, 16)
N_CONV_HEADS = 8
CONV_WIDTH = 3
MIX_IN = MIX_A + 3 * MIX_B
N_PEER_HEADS = 8
N_KEYS = 128
N_EXPERTS = N_KEYS * N_KEYS
D_QUERY = 256
D_QUERY_HALF = D_QUERY // 2
PEER_TOPK = 16
TOKEN_BLOCK = 128
EPS = 1e-6

kernel_name = "hymba_pool_shortconv_peer_layer"


def rmsnorm(x, g):
    xf = x.astype(jnp.float32)
    y = xf * lax.rsqrt(jnp.mean(xf * xf, axis=-1, keepdims=True) + EPS)
    return (y * g.astype(jnp.float32)).astype(x.dtype)


def causal_pool_minus_self(u, window):
    L = u.shape[1]
    uf = u.astype(jnp.float32)
    c = jnp.cumsum(uf, axis=1)
    c_shift = jnp.pad(c, ((0, 0), (window, 0), (0, 0)))[:, :L]
    count = jnp.minimum(jnp.arange(1, L + 1), window).astype(jnp.float32)
    mean = (c - c_shift) / count[None, :, None]
    return (mean - uf).astype(u.dtype)


def pool_mixer(a, pool_w, pool_scale):
    B, L, _ = a.shape
    groups = a.reshape(B, L, N_POOL_GROUPS, POOL_GROUP_DIM)
    pooled = jnp.stack([causal_pool_minus_self(groups[:, :, g], POOL_WINDOWS[g])
                        for g in range(N_POOL_GROUPS)], axis=2)
    y = jnp.einsum('blgc,gcd->blgd', pooled, pool_w)
    return y.reshape(B, L, MIX_A) * pool_scale


def short_conv_mixer(b_gate, c_gate, val, conv_w):
    u = c_gate * val
    L = u.shape[1]
    up = jnp.pad(u, ((0, 0), (CONV_WIDTH - 1, 0), (0, 0)))
    conv = up[:, 0:L] * conv_w[0]
    for k in range(1, CONV_WIDTH):
        conv = conv + up[:, k:k + L] * conv_w[k]
    return b_gate * conv


def peer_retrieve(xn, w_query, sub_keys):
    T = xn.shape[0]
    q = (xn @ w_query).reshape(T, N_PEER_HEADS, 2, D_QUERY_HALF)
    s = jnp.einsum('thpc,hpkc->thpk', q.astype(jnp.float32), sub_keys.astype(jnp.float32))
    s1, i1 = lax.top_k(s[:, :, 0], PEER_TOPK)
    s2, i2 = lax.top_k(s[:, :, 1], PEER_TOPK)
    cand_s = (s1[..., :, None] + s2[..., None, :]).reshape(T, N_PEER_HEADS, PEER_TOPK * PEER_TOPK)
    cand_i = (i1[..., :, None] * N_KEYS + i2[..., None, :]).reshape(T, N_PEER_HEADS, PEER_TOPK * PEER_TOPK)
    top_s, pos = lax.top_k(cand_s, PEER_TOPK)
    idx = jnp.take_along_axis(cand_i, pos, axis=-1)
    gates = jax.nn.softmax(top_s, axis=-1)
    return idx, gates


def peer_experts(xn, idx, gates, expert_u, expert_v):
    T, D = xn.shape
    HK = N_PEER_HEADS * PEER_TOPK
    pad = (-T) % TOKEN_BLOCK
    xb = jnp.pad(xn, ((0, pad), (0, 0))).reshape(-1, TOKEN_BLOCK, D)
    ib = jnp.pad(idx.reshape(T, HK), ((0, pad), (0, 0))).reshape(-1, TOKEN_BLOCK, HK)
    gb = jnp.pad(gates.reshape(T, HK), ((0, pad), (0, 0))).reshape(-1, TOKEN_BLOCK, HK)

    def block(args):
        xblk, iblk, gblk = args
        u = expert_u[iblk]
        v = expert_v[iblk]
        act = jax.nn.gelu(jnp.einsum('tkd,td->tk', u, xblk).astype(jnp.float32), approximate=False)
        return jnp.einsum('tk,tkd->td', (gblk * act).astype(v.dtype), v)

    out = lax.map(block, (xb, ib, gb))
    return out.reshape(-1, D)[:T].astype(xn.dtype)


def setup_inputs(seed: int = 0) -> dict:
    key = jax.random.key(seed)
    ks = jax.random.split(key, 16)
    f32 = jnp.float32
    nrm = lambda k, shape, scale: jax.random.normal(k, shape, f32) * scale
    gain = lambda k, shape: 1.0 + 0.02 * jax.random.normal(k, shape, f32)
    return {
        "x": jax.random.normal(ks[0], (BATCH, SEQ, D_MODEL), f32),
        "meta_tokens": nrm(ks[1], (N_META, D_MODEL), 1.0),
        "norm_mix_g": gain(ks[2], (DEPTH, D_MODEL)),
        "w_in": nrm(ks[3], (DEPTH, D_MODEL, MIX_IN), D_MODEL ** -0.5),
        "pool_w": nrm(ks[4], (DEPTH, N_POOL_GROUPS, POOL_GROUP_DIM, POOL_GROUP_DIM), POOL_GROUP_DIM ** -0.5),
        "pool_scale": 1.0 + 0.1 * jax.random.normal(ks[5], (DEPTH, MIX_A), f32),
        "conv_w": nrm(ks[6], (DEPTH, CONV_WIDTH, MIX_B), CONV_WIDTH ** -0.5),
        "norm_a_g": gain(ks[7], (DEPTH, MIX_A)),
        "norm_b_g": gain(ks[8], (DEPTH, MIX_B)),
        "w_out": nrm(ks[9], (DEPTH, MIX_WIDTH, D_MODEL), MIX_WIDTH ** -0.5),
        "norm_ffn_g": gain(ks[10], (DEPTH, D_MODEL)),
        "w_query": nrm(ks[11], (DEPTH, D_MODEL, N_PEER_HEADS * D_QUERY), D_MODEL ** -0.5),
        "sub_keys": nrm(ks[12], (DEPTH, N_PEER_HEADS, 2, N_KEYS, D_QUERY_HALF), D_QUERY_HALF ** -0.5),
        "expert_u": nrm(ks[13], (DEPTH, N_EXPERTS, D_MODEL), D_MODEL ** -0.5),
        "expert_v": nrm(ks[14], (DEPTH, N_EXPERTS, D_MODEL), 0.5),
        "norm_final_g": gain(ks[15], (D_MODEL,)),
    }


def reference(x, meta_tokens, norm_mix_g, w_in, pool_w, pool_scale, conv_w, norm_a_g, norm_b_g,
              w_out, norm_ffn_g, w_query, sub_keys, expert_u, expert_v, norm_final_g):
    B = x.shape[0]
    meta = jnp.broadcast_to(meta_tokens.astype(x.dtype)[None], (B, N_META, D_MODEL))
    h = jnp.concatenate([meta, x], axis=1)
    for layer in range(DEPTH):
        xn = rmsnorm(h, norm_mix_g[layer])
        proj = xn @ w_in[layer]
        a = proj[..., :MIX_A]
        b_gate = proj[..., MIX_A:MIX_A + MIX_B]
        c_gate = proj[..., MIX_A + MIX_B:MIX_A + 2 * MIX_B]
        val = proj[..., MIX_A + 2 * MIX_B:]
        ya = rmsnorm(pool_mixer(a, pool_w[layer], pool_scale[layer]), norm_a_g[layer])
        yb = rmsnorm(short_conv_mixer(b_gate, c_gate, val, conv_w[layer]), norm_b_g[layer])
        h = h + jnp.concatenate([ya, yb], axis=-1) @ w_out[layer]
        if layer == DEPTH - 1:
            h = h[:, N_META:]
        Bh, Lh, _ = h.shape
        xf = rmsnorm(h, norm_ffn_g[layer]).reshape(Bh * Lh, D_MODEL)
        idx, gates = peer_retrieve(xf, w_query[layer], sub_keys[layer])
        h = h + peer_experts(xf, idx, gates, expert_u[layer], expert_v[layer]).reshape(Bh, Lh, D_MODEL)
    return rmsnorm(h, norm_final_g)
```

```cpp
#include <hip/hip_runtime.h>
#include <cstdio>
#include <cstdint>
#include <math.h>

namespace {
constexpr int D = 1024, BATCH = 4, SEQ = 4096, NMETA = 16, L = SEQ + NMETA;
constexpr int MIXA = 512, MIXB = 512, MIXIN = 2048;
constexpr int NH = 8, NKEYS = 128, DQH = 128, TOPK = 16, HK = 128;
constexpr int T = BATCH * SEQ;
constexpr int TL = BATCH * L;
constexpr float EPS = 1e-6f;

constexpr size_t OFF_A = 0;
constexpr size_t OFF_B = OFF_A + (size_t)TL * D * 4;
constexpr size_t OFF_IDX = OFF_B + (size_t)TL * MIXIN * 4;
constexpr size_t OFF_GATE = OFF_IDX + (size_t)T * HK * 4;
constexpr size_t WS_END = OFF_GATE + (size_t)T * HK * 4;

__device__ __forceinline__ float wave_sum(float v) {
#pragma unroll
    for (int o = 32; o > 0; o >>= 1) v += __shfl_xor(v, o);
    return v;
}
__device__ __forceinline__ float block_sum256(float v, float* red) {
    v = wave_sum(v);
    __syncthreads();
    if ((threadIdx.x & 63) == 0) red[threadIdx.x >> 6] = v;
    __syncthreads();
    return red[0] + red[1] + red[2] + red[3];
}

__global__ void __launch_bounds__(256) k_norm_in(const float* __restrict__ x, const float* __restrict__ meta, const float* __restrict__ g, float* __restrict__ xn) {
    __shared__ float red[4];
    const int r = blockIdx.x, b = r / L, pos = r % L;
    const float* src = pos < NMETA ? meta + (size_t)pos * D : x + ((size_t)b * SEQ + (pos - NMETA)) * D;
    const float4 v = ((const float4*)src)[threadIdx.x];
    const float ss = block_sum256(v.x * v.x + v.y * v.y + v.z * v.z + v.w * v.w, red);
    const float rs = rsqrtf(ss * (1.0f / D) + EPS);
    const float4 gg = ((const float4*)g)[threadIdx.x];
    float4 o; o.x = v.x * rs * gg.x; o.y = v.y * rs * gg.y; o.z = v.z * rs * gg.z; o.w = v.w * rs * gg.w;
    ((float4*)(xn + (size_t)r * D))[threadIdx.x] = o;
}

__global__ void __launch_bounds__(256) k_norm_rows(const float* __restrict__ in, const float* __restrict__ g, float* __restrict__ out) {
    __shared__ float red[4];
    const size_t r = blockIdx.x;
    const float4 v = ((const float4*)(in + r * D))[threadIdx.x];
    const float ss = block_sum256(v.x * v.x + v.y * v.y + v.z * v.z + v.w * v.w, red);
    const float rs = rsqrtf(ss * (1.0f / D) + EPS);
    const float4 gg = ((const float4*)g)[threadIdx.x];
    float4 o; o.x = v.x * rs * gg.x; o.y = v.y * rs * gg.y; o.z = v.z * rs * gg.z; o.w = v.w * rs * gg.w;
    ((float4*)(out + r * D))[threadIdx.x] = o;
}

__global__ void __launch_bounds__(256) k_gemm(const float* __restrict__ A, const float* __restrict__ W, float* __restrict__ C, const float* __restrict__ R, int M, int N, int K) {
    __shared__ float As[16][68];
    __shared__ float Ws[16][68];
    const int tid = threadIdx.x, tx = tid & 15, ty = tid >> 4;
    const int m0 = blockIdx.y * 64, n0 = blockIdx.x * 64;
    float acc[4][4];
#pragma unroll
    for (int i = 0; i < 4; ++i)
#pragma unroll
        for (int j = 0; j < 4; ++j) acc[i][j] = 0.f;
    for (int k0 = 0; k0 < K; k0 += 16) {
        const float4 av = *(const float4*)(A + (size_t)(m0 + (tid >> 2)) * K + k0 + (tid & 3) * 4);
        const float4 wv = *(const float4*)(W + (size_t)(k0 + (tid >> 4)) * N + n0 + (tid & 15) * 4);
        __syncthreads();
        As[(tid & 3) * 4 + 0][tid >> 2] = av.x; As[(tid & 3) * 4 + 1][tid >> 2] = av.y; As[(tid & 3) * 4 + 2][tid >> 2] = av.z; As[(tid & 3) * 4 + 3][tid >> 2] = av.w;
        *(float4*)&Ws[tid >> 4][(tid & 15) * 4] = wv;
        __syncthreads();
#pragma unroll
        for (int kk = 0; kk < 16; ++kk) {
            const float4 a = *(const float4*)&As[kk][ty * 4];
            const float4 w = *(const float4*)&Ws[kk][tx * 4];
            const float aa[4] = {a.x, a.y, a.z, a.w}, ww[4] = {w.x, w.y, w.z, w.w};
#pragma unroll
            for (int i = 0; i < 4; ++i)
#pragma unroll
                for (int j = 0; j < 4; ++j) acc[i][j] += aa[i] * ww[j];
        }
    }
#pragma unroll
    for (int i = 0; i < 4; ++i) {
        const size_t o = (size_t)(m0 + ty * 4 + i) * N + n0 + tx * 4;
        float4 v = make_float4(acc[i][0], acc[i][1], acc[i][2], acc[i][3]);
        if (R) { const float4 r = *(const float4*)(R + o); v.x += r.x; v.y += r.y; v.z += r.z; v.w += r.w; }
        *(float4*)(C + o) = v;
    }
}

__global__ void __launch_bounds__(256) k_mix(const float* __restrict__ proj, const float* __restrict__ pool_w, const float* __restrict__ pool_scale,
                                             const float* __restrict__ conv_w, const float* __restrict__ ga, const float* __restrict__ gb, float* __restrict__ ycat) {
    __shared__ float pooled[MIXA];
    __shared__ float red[4];
    const int t = blockIdx.x, b = t / SEQ, s = t % SEQ, pos = s + NMETA, tid = threadIdx.x;
    const float* prow = proj + ((size_t)b * L + pos) * MIXIN;
    for (int c = tid; c < MIXA; c += 256) {
        const int g = c >> 7, w = 2 << g;
        float sum = 0.f; int cnt = 0;
        for (int j = 0; j < w; ++j) if (pos - j >= 0) { sum += prow[-(ptrdiff_t)j * MIXIN + c]; ++cnt; }
        pooled[c] = sum / (float)cnt - prow[c];
    }
    __syncthreads();
    float y[2]; float ss = 0.f;
#pragma unroll
    for (int q = 0; q < 2; ++q) {
        const int d = tid + q * 256, g = d >> 7, dd = d & 127;
        const float* pw = pool_w + (size_t)g * 128 * 128 + dd;
        float acc = 0.f;
        for (int c = 0; c < 128; ++c) acc += pooled[g * 128 + c] * pw[(size_t)c * 128];
        y[q] = acc * pool_scale[d]; ss += y[q] * y[q];
    }
    ss = block_sum256(ss, red);
    const float rsa = rsqrtf(ss * (1.0f / MIXA) + EPS);
#pragma unroll
    for (int q = 0; q < 2; ++q) { const int d = tid + q * 256; ycat[(size_t)t * D + d] = y[q] * rsa * ga[d]; }
    float z[2]; float s2 = 0.f;
#pragma unroll
    for (int q = 0; q < 2; ++q) {
        const int ch = tid + q * 256;
        float conv = 0.f;
#pragma unroll
        for (int k = 0; k < 3; ++k) {
            const int pp = pos + k - 2;
            if (pp >= 0) { const float* pr = prow + (ptrdiff_t)(k - 2) * MIXIN; conv += pr[MIXA + MIXB + ch] * pr[MIXA + 2 * MIXB + ch] * conv_w[k * MIXB + ch]; }
        }
        z[q] = prow[MIXA + ch] * conv; s2 += z[q] * z[q];
    }
    s2 = block_sum256(s2, red);
    const float rsb = rsqrtf(s2 * (1.0f / MIXB) + EPS);
#pragma unroll
    for (int q = 0; q < 2; ++q) { const int ch = tid + q * 256; ycat[(size_t)t * D + MIXA + ch] = z[q] * rsb * gb[ch]; }
}

__global__ void __launch_bounds__(256) k_retrieve(const float* __restrict__ q, const float* __restrict__ sub_keys, int* __restrict__ idx, float* __restrict__ gate) {
    __shared__ float sc[16][NKEYS];
    __shared__ float ts[16][TOPK];
    __shared__ int ti[16][TOPK];
    __shared__ float cand[NH][256];
    __shared__ float cv[NH][TOPK];
    __shared__ int cp[NH][TOPK];
    const int t = blockIdx.x, tid = threadIdx.x, lane = tid & 63, wv = tid >> 6;
    const float* qt = q + (size_t)t * (NH * 2 * DQH);
    for (int hp = wv; hp < 16; hp += 4) {
        const float q0 = qt[hp * DQH + lane], q1 = qt[hp * DQH + 64 + lane];
        const float* kb = sub_keys + (size_t)hp * NKEYS * DQH;
        for (int k = 0; k < NKEYS; ++k) {
            float p = q0 * kb[(size_t)k * DQH + lane] + q1 * kb[(size_t)k * DQH + 64 + lane];
            p = wave_sum(p);
            if (lane == 0) sc[hp][k] = p;
        }
    }
    __syncthreads();
    if (tid < 16) {
        const int hp = tid;
        unsigned long long used0 = 0ull, used1 = 0ull;
        for (int r = 0; r < TOPK; ++r) {
            float best = -INFINITY; int bi = 0;
            for (int k = 0; k < NKEYS; ++k) {
                const bool u = k < 64 ? ((used0 >> k) & 1ull) : ((used1 >> (k - 64)) & 1ull);
                if (!u && sc[hp][k] > best) { best = sc[hp][k]; bi = k; }
            }
            if (bi < 64) used0 |= 1ull << bi; else used1 |= 1ull << (bi - 64);
            ts[hp][r] = best; ti[hp][r] = bi;
        }
    }
    __syncthreads();
    for (int e = tid; e < NH * 256; e += 256) { const int h = e >> 8, i = (e >> 4) & 15, j = e & 15; cand[h][e & 255] = ts[2 * h][i] + ts[2 * h + 1][j]; }
    __syncthreads();
    if (tid < NH) {
        const int h = tid;
        float mx = -INFINITY;
        for (int r = 0; r < TOPK; ++r) {
            float best = -INFINITY; int bi = 0;
            for (int k = 0; k < 256; ++k) if (cand[h][k] > best) { best = cand[h][k]; bi = k; }
            cand[h][bi] = -INFINITY;
            cv[h][r] = best; cp[h][r] = bi;
            if (r == 0) mx = best;
        }
        float sum = 0.f;
        for (int r = 0; r < TOPK; ++r) { const float e = expf(cv[h][r] - mx); cv[h][r] = e; sum += e; }
        for (int r = 0; r < TOPK; ++r) {
            const int i = cp[h][r] >> 4, j = cp[h][r] & 15;
            idx[(size_t)t * HK + h * TOPK + r] = ti[2 * h][i] * NKEYS + ti[2 * h + 1][j];
            gate[(size_t)t * HK + h * TOPK + r] = cv[h][r] / sum;
        }
    }
}

__global__ void __launch_bounds__(256) k_experts(const float* __restrict__ xf, const int* __restrict__ idx, const float* __restrict__ gate,
                                                 const float* __restrict__ eu, const float* __restrict__ ev, const float* __restrict__ gf, float* __restrict__ out) {
    __shared__ float coef[HK];
    __shared__ int ids[HK];
    __shared__ float red[4];
    const int t = blockIdx.x, tid = threadIdx.x, lane = tid & 63, wv = tid >> 6;
    if (tid < HK) ids[tid] = idx[(size_t)t * HK + tid];
    const float* xr = xf + (size_t)t * D;
    float4 xv[4];
#pragma unroll
    for (int i = 0; i < 4; ++i) xv[i] = ((const float4*)xr)[lane + 64 * i];
    __syncthreads();
    for (int k = wv; k < HK; k += 4) {
        const float4* ur = (const float4*)(eu + (size_t)ids[k] * D);
        float p = 0.f;
#pragma unroll
        for (int i = 0; i < 4; ++i) { const float4 u = ur[lane + 64 * i]; p += u.x * xv[i].x + u.y * xv[i].y + u.z * xv[i].z + u.w * xv[i].w; }
        p = wave_sum(p);
        if (lane == 0) { const float a = 0.5f * p * (1.0f + erff(p * 0.70710678118654752f)); coef[k] = gate[(size_t)t * HK + k] * a; }
    }
    __syncthreads();
    float4 acc = make_float4(0.f, 0.f, 0.f, 0.f);
    for (int k = 0; k < HK; ++k) {
        const float4 v = ((const float4*)(ev + (size_t)ids[k] * D))[tid];
        const float c = coef[k];
        acc.x += c * v.x; acc.y += c * v.y; acc.z += c * v.z; acc.w += c * v.w;
    }
    const float4 h = ((const float4*)(out + (size_t)t * D))[tid];
    acc.x += h.x; acc.y += h.y; acc.z += h.z; acc.w += h.w;
    const float ss = block_sum256(acc.x * acc.x + acc.y * acc.y + acc.z * acc.z + acc.w * acc.w, red);
    const float rs = rsqrtf(ss * (1.0f / D) + EPS);
    const float4 gg = ((const float4*)gf)[tid];
    float4 o; o.x = acc.x * rs * gg.x; o.y = acc.y * rs * gg.y; o.z = acc.z * rs * gg.z; o.w = acc.w * rs * gg.w;
    ((float4*)(out + (size_t)t * D))[tid] = o;
}
}

extern "C" void kernel_launch(void* const* d_in, const int* in_sizes, int n_in, void* d_out, int out_size, void* d_ws, size_t ws_size, hipStream_t stream) {
    if (n_in != 16 || out_size != T * D || ws_size < WS_END) { fprintf(stderr, "kernel_launch: unexpected sizes n_in %d out %d ws %zu (need %zu)\n", n_in, out_size, ws_size, (size_t)WS_END); return; }
    const float* x = (const float*)d_in[0];
    const float* meta = (const float*)d_in[1];
    const float* g_mix = (const float*)d_in[2];
    const float* w_in = (const float*)d_in[3];
    const float* pool_w = (const float*)d_in[4];
    const float* pool_scale = (const float*)d_in[5];
    const float* conv_w = (const float*)d_in[6];
    const float* g_a = (const float*)d_in[7];
    const float* g_b = (const float*)d_in[8];
    const float* w_out = (const float*)d_in[9];
    const float* g_ffn = (const float*)d_in[10];
    const float* w_query = (const float*)d_in[11];
    const float* sub_keys = (const float*)d_in[12];
    const float* eu = (const float*)d_in[13];
    const float* ev = (const float*)d_in[14];
    const float* g_fin = (const float*)d_in[15];
    float* out = (float*)d_out;
    char* ws = (char*)d_ws;
    float* bufA = (float*)(ws + OFF_A);
    float* bufB = (float*)(ws + OFF_B);
    int* idx = (int*)(ws + OFF_IDX);
    float* gate = (float*)(ws + OFF_GATE);

    k_norm_in<<<TL, 256, 0, stream>>>(x, meta, g_mix, bufA);
    k_gemm<<<dim3(MIXIN / 64, TL / 64), 256, 0, stream>>>(bufA, w_in, bufB, nullptr, TL, MIXIN, D);
    k_mix<<<T, 256, 0, stream>>>(bufB, pool_w, pool_scale, conv_w, g_a, g_b, bufA);
    k_gemm<<<dim3(D / 64, T / 64), 256, 0, stream>>>(bufA, w_out, out, x, T, D, D);
    k_norm_rows<<<T, 256, 0, stream>>>(out, g_ffn, bufA);
    k_gemm<<<dim3(2048 / 64, T / 64), 256, 0, stream>>>(bufA, w_query, bufB, nullptr, T, 2048, D);
    k_retrieve<<<T, 256, 0, stream>>>(bufB, sub_keys, idx, gate);
    k_experts<<<T, 256, 0, stream>>>(bufA, idx, gate, eu, ev, g_fin, out);
}
```

```cpp
#define QCH 2
#define NO_DOT2
#include <hip/hip_runtime.h>
#include <cstdio>
#include <cstdint>
#include <math.h>

namespace {
constexpr int D = 1024, BATCH = 4, SEQ = 4096, NMETA = 16, L = SEQ + NMETA;
constexpr int MIXA = 512, MIXB = 512, MIXIN = 2048;
constexpr int NH = 8, NKEYS = 128, DQH = 128, TOPK = 16, HK = 128;
constexpr int T = BATCH * SEQ;
constexpr int TL = BATCH * L;
constexpr float EPS = 1e-6f;

constexpr size_t OFF_A = 0;
constexpr size_t OFF_B = OFF_A + (size_t)TL * D * 4;
constexpr size_t OFF_IDX = OFF_B + (size_t)TL * MIXIN * 4;
constexpr size_t OFF_GATE = OFF_IDX + (size_t)T * HK * 4;
constexpr size_t WS_END = OFF_GATE + (size_t)T * HK * 4;

__device__ __forceinline__ float wave_sum(float v) {
#pragma unroll
    for (int o = 32; o > 0; o >>= 1) v += __shfl_xor(v, o);
    return v;
}
__device__ __forceinline__ float block_sum256(float v, float* red) {
    v = wave_sum(v);
    __syncthreads();
    if ((threadIdx.x & 63) == 0) red[threadIdx.x >> 6] = v;
    __syncthreads();
    return red[0] + red[1] + red[2] + red[3];
}

__global__ void __launch_bounds__(256) k_norm_in(const float* __restrict__ x, const float* __restrict__ meta, const float* __restrict__ g, float* __restrict__ xn) {
    __shared__ float red[4];
    const int r = blockIdx.x, b = r / L, pos = r % L;
    const float* src = pos < NMETA ? meta + (size_t)pos * D : x + ((size_t)b * SEQ + (pos - NMETA)) * D;
    const float4 v = ((const float4*)src)[threadIdx.x];
    const float ss = block_sum256(v.x * v.x + v.y * v.y + v.z * v.z + v.w * v.w, red);
    const float rs = rsqrtf(ss * (1.0f / D) + EPS);
    const float4 gg = ((const float4*)g)[threadIdx.x];
    float4 o; o.x = v.x * rs * gg.x; o.y = v.y * rs * gg.y; o.z = v.z * rs * gg.z; o.w = v.w * rs * gg.w;
    ((float4*)(xn + (size_t)r * D))[threadIdx.x] = o;
}

__global__ void __launch_bounds__(256) k_norm_rows(const float* __restrict__ in, const float* __restrict__ g, float* __restrict__ out) {
    __shared__ float red[4];
    const size_t r = blockIdx.x;
    const float4 v = ((const float4*)(in + r * D))[threadIdx.x];
    const float ss = block_sum256(v.x * v.x + v.y * v.y + v.z * v.z + v.w * v.w, red);
    const float rs = rsqrtf(ss * (1.0f / D) + EPS);
    const float4 gg = ((const float4*)g)[threadIdx.x];
    float4 o; o.x = v.x * rs * gg.x; o.y = v.y * rs * gg.y; o.z = v.z * rs * gg.z; o.w = v.w * rs * gg.w;
    ((float4*)(out + r * D))[threadIdx.x] = o;
}

__global__ void __launch_bounds__(256) k_gemm(const float* __restrict__ A, const float* __restrict__ W, float* __restrict__ C, const float* __restrict__ R, int M, int N, int K) {
    __shared__ float As[16][68];
    __shared__ float Ws[16][68];
    const int tid = threadIdx.x, tx = tid & 15, ty = tid >> 4;
    const int m0 = blockIdx.y * 64, n0 = blockIdx.x * 64;
    float acc[4][4];
#pragma unroll
    for (int i = 0; i < 4; ++i)
#pragma unroll
        for (int j = 0; j < 4; ++j) acc[i][j] = 0.f;
    for (int k0 = 0; k0 < K; k0 += 16) {
        const float4 av = *(const float4*)(A + (size_t)(m0 + (tid >> 2)) * K + k0 + (tid & 3) * 4);
        const float4 wv = *(const float4*)(W + (size_t)(k0 + (tid >> 4)) * N + n0 + (tid & 15) * 4);
        __syncthreads();
        As[(tid & 3) * 4 + 0][tid >> 2] = av.x; As[(tid & 3) * 4 + 1][tid >> 2] = av.y; As[(tid & 3) * 4 + 2][tid >> 2] = av.z; As[(tid & 3) * 4 + 3][tid >> 2] = av.w;
        *(float4*)&Ws[tid >> 4][(tid & 15) * 4] = wv;
        __syncthreads();
#pragma unroll
        for (int kk = 0; kk < 16; ++kk) {
            const float4 a = *(const float4*)&As[kk][ty * 4];
            const float4 w = *(const float4*)&Ws[kk][tx * 4];
            const float aa[4] = {a.x, a.y, a.z, a.w}, ww[4] = {w.x, w.y, w.z, w.w};
#pragma unroll
            for (int i = 0; i < 4; ++i)
#pragma unroll
                for (int j = 0; j < 4; ++j) acc[i][j] += aa[i] * ww[j];
        }
    }
#pragma unroll
    for (int i = 0; i < 4; ++i) {
        const size_t o = (size_t)(m0 + ty * 4 + i) * N + n0 + tx * 4;
        float4 v = make_float4(acc[i][0], acc[i][1], acc[i][2], acc[i][3]);
        if (R) { const float4 r = *(const float4*)(R + o); v.x += r.x; v.y += r.y; v.z += r.z; v.w += r.w; }
        *(float4*)(C + o) = v;
    }
}

__global__ void __launch_bounds__(256) k_mix(const float* __restrict__ proj, const float* __restrict__ pool_w, const float* __restrict__ pool_scale,
                                             const float* __restrict__ conv_w, const float* __restrict__ ga, const float* __restrict__ gb, float* __restrict__ ycat) {
    __shared__ float pooled[MIXA];
    __shared__ float red[4];
    const int t = blockIdx.x, b = t / SEQ, s = t % SEQ, pos = s + NMETA, tid = threadIdx.x;
    const float* prow = proj + ((size_t)b * L + pos) * MIXIN;
    for (int c = tid; c < MIXA; c += 256) {
        const int g = c >> 7, w = 2 << g;
        float sum = 0.f; int cnt = 0;
        for (int j = 0; j < w; ++j) if (pos - j >= 0) { sum += prow[-(ptrdiff_t)j * MIXIN + c]; ++cnt; }
        pooled[c] = sum / (float)cnt - prow[c];
    }
    __syncthreads();
    float y[2]; float ss = 0.f;
#pragma unroll
    for (int q = 0; q < 2; ++q) {
        const int d = tid + q * 256, g = d >> 7, dd = d & 127;
        const float* pw = pool_w + (size_t)g * 128 * 128 + dd;
        float acc = 0.f;
        for (int c = 0; c < 128; ++c) acc += pooled[g * 128 + c] * pw[(size_t)c * 128];
        y[q] = acc * pool_scale[d]; ss += y[q] * y[q];
    }
    ss = block_sum256(ss, red);
    const float rsa = rsqrtf(ss * (1.0f / MIXA) + EPS);
#pragma unroll
    for (int q = 0; q < 2; ++q) { const int d = tid + q * 256; ycat[(size_t)t * D + d] = y[q] * rsa * ga[d]; }
    float z[2]; float s2 = 0.f;
#pragma unroll
    for (int q = 0; q < 2; ++q) {
        const int ch = tid + q * 256;
        float conv = 0.f;
#pragma unroll
        for (int k = 0; k < 3; ++k) {
            const int pp = pos + k - 2;
            if (pp >= 0) { const float* pr = prow + (ptrdiff_t)(k - 2) * MIXIN; conv += pr[MIXA + MIXB + ch] * pr[MIXA + 2 * MIXB + ch] * conv_w[k * MIXB + ch]; }
        }
        z[q] = prow[MIXA + ch] * conv; s2 += z[q] * z[q];
    }
    s2 = block_sum256(s2, red);
    const float rsb = rsqrtf(s2 * (1.0f / MIXB) + EPS);
#pragma unroll
    for (int q = 0; q < 2; ++q) { const int ch = tid + q * 256; ycat[(size_t)t * D + MIXA + ch] = z[q] * rsb * gb[ch]; }
}

__global__ void __launch_bounds__(256) k_retrieve(const float* __restrict__ q, const float* __restrict__ sub_keys, int* __restrict__ idx, float* __restrict__ gate) {
    __shared__ float sc[16][NKEYS];
    __shared__ float ts[16][TOPK];
    __shared__ int ti[16][TOPK];
    __shared__ float cand[NH][256];
    __shared__ float cv[NH][TOPK];
    __shared__ int cp[NH][TOPK];
    const int t = blockIdx.x, tid = threadIdx.x, lane = tid & 63, wv = tid >> 6;
    const float* qt = q + (size_t)t * (NH * 2 * DQH);
    for (int hp = wv; hp < 16; hp += 4) {
        const float q0 = qt[hp * DQH + lane], q1 = qt[hp * DQH + 64 + lane];
        const float* kb = sub_keys + (size_t)hp * NKEYS * DQH;
        for (int k = 0; k < NKEYS; ++k) {
            float p = q0 * kb[(size_t)k * DQH + lane] + q1 * kb[(size_t)k * DQH + 64 + lane];
            p = wave_sum(p);
            if (lane == 0) sc[hp][k] = p;
        }
    }
    __syncthreads();
    if (tid < 16) {
        const int hp = tid;
        unsigned long long used0 = 0ull, used1 = 0ull;
        for (int r = 0; r < TOPK; ++r) {
            float best = -INFINITY; int bi = 0;
            for (int k = 0; k < NKEYS; ++k) {
                const bool u = k < 64 ? ((used0 >> k) & 1ull) : ((used1 >> (k - 64)) & 1ull);
                if (!u && sc[hp][k] > best) { best = sc[hp][k]; bi = k; }
            }
            if (bi < 64) used0 |= 1ull << bi; else used1 |= 1ull << (bi - 64);
            ts[hp][r] = best; ti[hp][r] = bi;
        }
    }
    __syncthreads();
    for (int e = tid; e < NH * 256; e += 256) { const int h = e >> 8, i = (e >> 4) & 15, j = e & 15; cand[h][e & 255] = ts[2 * h][i] + ts[2 * h + 1][j]; }
    __syncthreads();
    if (tid < NH) {
        const int h = tid;
        float mx = -INFINITY;
        for (int r = 0; r < TOPK; ++r) {
            float best = -INFINITY; int bi = 0;
            for (int k = 0; k < 256; ++k) if (cand[h][k] > best) { best = cand[h][k]; bi = k; }
            cand[h][bi] = -INFINITY;
            cv[h][r] = best; cp[h][r] = bi;
            if (r == 0) mx = best;
        }
        float sum = 0.f;
        for (int r = 0; r < TOPK; ++r) { const float e = expf(cv[h][r] - mx); cv[h][r] = e; sum += e; }
        for (int r = 0; r < TOPK; ++r) {
            const int i = cp[h][r] >> 4, j = cp[h][r] & 15;
            idx[(size_t)t * HK + h * TOPK + r] = ti[2 * h][i] * NKEYS + ti[2 * h + 1][j];
            gate[(size_t)t * HK + h * TOPK + r] = cv[h][r] / sum;
        }
    }
}

__global__ void __launch_bounds__(256) k_experts(const float* __restrict__ xf, const int* __restrict__ idx, const float* __restrict__ gate,
                                                 const float* __restrict__ eu, const float* __restrict__ ev, const float* __restrict__ gf, float* __restrict__ out) {
    __shared__ float coef[HK];
    __shared__ int ids[HK];
    __shared__ float red[4];
    const int t = blockIdx.x, tid = threadIdx.x, lane = tid & 63, wv = tid >> 6;
    if (tid < HK) ids[tid] = idx[(size_t)t * HK + tid];
    const float* xr = xf + (size_t)t * D;
    float4 xv[4];
#pragma unroll
    for (int i = 0; i < 4; ++i) xv[i] = ((const float4*)xr)[lane + 64 * i];
    __syncthreads();
    for (int k = wv; k < HK; k += 4) {
        const float4* ur = (const float4*)(eu + (size_t)ids[k] * D);
        float p = 0.f;
#pragma unroll
        for (int i = 0; i < 4; ++i) { const float4 u = ur[lane + 64 * i]; p += u.x * xv[i].x + u.y * xv[i].y + u.z * xv[i].z + u.w * xv[i].w; }
        p = wave_sum(p);
        if (lane == 0) { const float a = 0.5f * p * (1.0f + erff(p * 0.70710678118654752f)); coef[k] = gate[(size_t)t * HK + k] * a; }
    }
    __syncthreads();
    float4 acc = make_float4(0.f, 0.f, 0.f, 0.f);
    for (int k = 0; k < HK; ++k) {
        const float4 v = ((const float4*)(ev + (size_t)ids[k] * D))[tid];
        const float c = coef[k];
        acc.x += c * v.x; acc.y += c * v.y; acc.z += c * v.z; acc.w += c * v.w;
    }
    const float4 h = ((const float4*)(out + (size_t)t * D))[tid];
    acc.x += h.x; acc.y += h.y; acc.z += h.z; acc.w += h.w;
    const float ss = block_sum256(acc.x * acc.x + acc.y * acc.y + acc.z * acc.z + acc.w * acc.w, red);
    const float rs = rsqrtf(ss * (1.0f / D) + EPS);
    const float4 gg = ((const float4*)gf)[tid];
    float4 o; o.x = acc.x * rs * gg.x; o.y = acc.y * rs * gg.y; o.z = acc.z * rs * gg.z; o.w = acc.w * rs * gg.w;
    ((float4*)(out + (size_t)t * D))[tid] = o;
}
#define LAS __attribute__((address_space(3)))
typedef short bf16x8 __attribute__((ext_vector_type(8)));
typedef float f32x16 __attribute__((ext_vector_type(16)));
typedef float f32x4 __attribute__((ext_vector_type(4)));
typedef float f32x2 __attribute__((ext_vector_type(2)));
typedef __bf16 bf2_t __attribute__((ext_vector_type(2)));
typedef unsigned u32x4 __attribute__((ext_vector_type(4)));
typedef unsigned u32x2 __attribute__((ext_vector_type(2)));

#ifndef QCH
#define QCH 4
#endif
constexpr int NTILES = T / 64;
constexpr int TROW = 2064;
constexpr int LDS_TILE = 64 * TROW;
constexpr int LDS_RS = LDS_TILE;
constexpr int LDS_SSA = LDS_RS + 256;
constexpr int LDS_LUT = LDS_SSA + 256;
constexpr int LDS_BYTES = LDS_LUT + 16384;

constexpr size_t W_WINF = 0;
constexpr size_t W_WOUTF = W_WINF + (size_t)2048 * 1024 * 2;
constexpr size_t W_WQF = W_WOUTF + (size_t)1024 * 1024 * 2;
constexpr size_t W_KF = W_WQF + (size_t)2048 * 1024 * 2;
constexpr size_t W_PWF = W_KF + (size_t)16 * 128 * 128 * 2;
constexpr size_t W_METAF = W_PWF + (size_t)4 * 128 * 128 * 2;
constexpr size_t W_RSM = W_METAF + (size_t)64 * 64 * 16;
constexpr size_t W_BAR = W_RSM + 256;
constexpr size_t W_EU = W_BAR + 16384;
constexpr size_t W_EV = W_EU + (size_t)16384 * 1024 * 2;
constexpr size_t W_PROJ = W_EV + (size_t)16384 * 1024 * 2;
constexpr size_t W_XF = W_PROJ + (size_t)TL * 2048 * 2;
constexpr size_t W_IDX = W_XF + (size_t)T * 1024 * 2;
constexpr size_t W_GATE = W_IDX + (size_t)T * HK * 4;
constexpr size_t W_END2 = W_GATE + (size_t)T * HK * 4;

struct Params {
    const float* x; const float* meta; const float* g_mix; const float* w_in; const float* pool_w; const float* pool_scale; const float* conv_w;
    const float* g_a; const float* g_b; const float* w_out; const float* g_ffn; const float* w_query; const float* sub_keys; const float* eu; const float* ev; const float* g_fin;
    float* out;
    unsigned char *winf, *woutf, *wqf, *kf, *pwf, *metaf, *rsm, *eut, *evt, *proj, *xf, *idx, *gate, *bar, *lst;
};

__device__ __forceinline__ unsigned pk_bf16(float lo, float hi) { f32x2 f = {lo, hi}; return __builtin_bit_cast(unsigned, __builtin_convertvector(f, bf2_t)); }
__device__ __forceinline__ float bf_lo(unsigned u) { return __builtin_bit_cast(float, u << 16); }
__device__ __forceinline__ float bf_hi(unsigned u) { return __builtin_bit_cast(float, u & 0xffff0000u); }
__device__ __forceinline__ f32x16 mfma32(u32x4 a, u32x4 b, f32x16 c) { return __builtin_amdgcn_mfma_f32_32x32x16_bf16(__builtin_bit_cast(bf16x8, a), __builtin_bit_cast(bf16x8, b), c, 0, 0, 0); }
__device__ __forceinline__ f32x16 zero16() { f32x16 z; for (int i = 0; i < 16; ++i) z[i] = 0.f; return z; }

__device__ __forceinline__ void frag_from_kn(const float* __restrict__ W, int N, const float* __restrict__ g, int i, int s, int lane, u32x4* __restrict__ dst) {
    const int r = lane & 31, h = lane >> 5, k0 = 16 * s + 8 * h;
    const float* src = W + (size_t)k0 * N + 32 * i + r;
    float v[8];
#pragma unroll
    for (int j = 0; j < 8; ++j) v[j] = src[(size_t)j * N] * (g ? g[k0 + j] : 1.0f);
    u32x4 o; o.x = pk_bf16(v[0], v[1]); o.y = pk_bf16(v[2], v[3]); o.z = pk_bf16(v[4], v[5]); o.w = pk_bf16(v[6], v[7]);
    *dst = o;
}
constexpr int J_WIN = 0, J_WOUT = J_WIN + 64 * 64, J_WQ = J_WOUT + 32 * 64, J_PW = J_WQ + 64 * 64, J_KEY = J_PW + 128, J_META = J_KEY + 512, J_RSM = J_META + 64, J_END = J_RSM + 1;

__device__ __forceinline__ void p0_prep(const Params& p, int vb, int nb, int tid) {
    const int lane = tid & 63, wv = tid >> 6, gw = vb * 8 + wv, nw = nb * 8;
    for (int job = gw; job < J_END; job += nw) {
        if (job < J_WOUT) { const int q = job - J_WIN, i = q >> 6, s = q & 63; frag_from_kn(p.w_in, 2048, p.g_mix, i, s, lane, (u32x4*)(p.winf) + (size_t)q * 64 + lane); }
        else if (job < J_WQ) { const int q = job - J_WOUT, i = q >> 6, s = q & 63; frag_from_kn(p.w_out, 1024, nullptr, i, s, lane, (u32x4*)(p.woutf) + (size_t)q * 64 + lane); }
        else if (job < J_PW) { const int q = job - J_WQ, i = q >> 6, s = q & 63; frag_from_kn(p.w_query, 2048, nullptr, i, s, lane, (u32x4*)(p.wqf) + (size_t)q * 64 + lane); }
        else if (job < J_KEY) { const int q = job - J_PW, g = q >> 5, mt = (q >> 3) & 3, s = q & 7; frag_from_kn(p.pool_w + (size_t)g * 128 * 128, 128, nullptr, mt, s, lane, (u32x4*)(p.pwf) + (size_t)q * 64 + lane); }
        else if (job < J_META) {
            const int q = job - J_KEY, hp = q >> 5, kt = (q >> 3) & 3, s = q & 7, r = lane & 31, h = lane >> 5;
            const float* src = p.sub_keys + ((size_t)hp * 128 + 32 * kt + r) * 128 + 16 * s + 4 * h;
            const f32x4 f0 = *(const f32x4*)src, f1 = *(const f32x4*)(src + 8);
            u32x4 o; o.x = pk_bf16(f0[0], f0[1]); o.y = pk_bf16(f0[2], f0[3]); o.z = pk_bf16(f1[0], f1[1]); o.w = pk_bf16(f1[2], f1[3]);
            ((u32x4*)(p.kf))[(size_t)q * 64 + lane] = o;
        } else if (job < J_RSM) {
            const int s = job - J_META, n = lane & 31, h = lane >> 5;
            u32x4 o = {0u, 0u, 0u, 0u};
            if (n < NMETA) { const float* src = p.meta + (size_t)n * D + 16 * s + 8 * h; const f32x4 f0 = *(const f32x4*)src, f1 = *(const f32x4*)(src + 4);
                o.x = pk_bf16(f0[0], f0[1]); o.y = pk_bf16(f0[2], f0[3]); o.z = pk_bf16(f1[0], f1[1]); o.w = pk_bf16(f1[2], f1[3]); }
            ((u32x4*)(p.metaf))[(size_t)s * 64 + lane] = o;
        } else {
            for (int row = 0; row < NMETA; ++row) {
                float ss = 0.f;
#pragma unroll
                for (int i = 0; i < 4; ++i) { const f32x4 f = *(const f32x4*)(p.meta + (size_t)row * D + i * 256 + 4 * lane); ss += f[0] * f[0] + f[1] * f[1] + f[2] * f[2] + f[3] * f[3]; }
                ss = wave_sum(ss);
                if (lane == 0) ((float*)(p.rsm))[row] = rsqrtf(ss * (1.0f / D) + EPS);
            }
        }
    }
    for (int row = gw; row < 2 * 16384; row += nw) {
        const float* src = (row < 16384 ? p.eu + (size_t)row * D : p.ev + (size_t)(row - 16384) * D);
        unsigned short* dst = (unsigned short*)(row < 16384 ? p.eut : p.evt) + (size_t)(row & 16383) * D;
#pragma unroll
        for (int i = 0; i < 4; ++i) { const f32x4 f = *(const f32x4*)(src + i * 256 + 4 * lane); u32x2 o; o.x = pk_bf16(f[0], f[1]); o.y = pk_bf16(f[2], f[3]); *(u32x2*)(dst + i * 256 + 4 * lane) = o; }
    }
}

template <class V> __device__ __forceinline__ V ldg(const void* base, unsigned off) { return *(const V*)((const unsigned char*)base + off); }
template <class V> __device__ __forceinline__ void stg(void* base, unsigned off, V v) { *(V*)((unsigned char*)base + off) = v; }

template <int CH>
__device__ __forceinline__ void gemm22_chunk(const u32x4 (&a)[2][CH], const LAS unsigned char* b, int s0, f32x16 (&acc)[2][2]) {
#pragma unroll
    for (int u = 0; u < CH; ++u) {
        const u32x4 b0 = *(const LAS u32x4*)(b + (s0 + u) * 32), b1 = *(const LAS u32x4*)(b + 32 * TROW + (s0 + u) * 32);
        acc[0][0] = mfma32(a[0][u], b0, acc[0][0]); acc[0][1] = mfma32(a[0][u], b1, acc[0][1]);
        acc[1][0] = mfma32(a[1][u], b0, acc[1][0]); acc[1][1] = mfma32(a[1][u], b1, acc[1][1]);
    }
}
template <int KS, int CH = 4>
__device__ __forceinline__ void gemm22(const u32x4* abase, unsigned lane, const LAS unsigned char* b, f32x16 (&acc)[2][2]) {
    constexpr int NC = KS / CH;
    static_assert(NC % 2 == 0, "even number of chunks");
    u32x4 pa[2][CH], pb[2][CH];
    const unsigned lo = lane * 16u;
#pragma unroll
    for (int u = 0; u < CH; ++u) { pa[0][u] = ldg<u32x4>(abase, lo + u * 1024u); pa[1][u] = ldg<u32x4>(abase, lo + (KS + u) * 1024u); }
#pragma unroll 1
    for (int c = 0; c < NC; c += 2) {
        const int c2 = (c + 2 < NC) ? c + 2 : NC - 1;
        const unsigned o1 = lo + (unsigned)((c + 1) * CH) * 1024u, o2 = lo + (unsigned)(c2 * CH) * 1024u;
#pragma unroll
        for (int u = 0; u < CH; ++u) { pb[0][u] = ldg<u32x4>(abase, o1 + u * 1024u); pb[1][u] = ldg<u32x4>(abase, o1 + (KS + u) * 1024u); }
        __builtin_amdgcn_sched_barrier(0);
        gemm22_chunk<CH>(pa, b, c * CH, acc);
        __builtin_amdgcn_sched_barrier(0);
#pragma unroll
        for (int u = 0; u < CH; ++u) { pa[0][u] = ldg<u32x4>(abase, o2 + u * 1024u); pa[1][u] = ldg<u32x4>(abase, o2 + (KS + u) * 1024u); }
        __builtin_amdgcn_sched_barrier(0);
        gemm22_chunk<CH>(pb, b, (c + 1) * CH, acc);
        __builtin_amdgcn_sched_barrier(0);
    }
}

__device__ __forceinline__ void p1_inproj(const Params& p, int tile, int tid, LAS unsigned char* lds) {
    const int lane = tid & 63, wv = __builtin_amdgcn_readfirstlane(tid >> 6), r = lane & 31, h = lane >> 5;
    const int b = tile >> 6, s0 = (tile & 63) * 64;
    LAS float* rs = (LAS float*)(lds + LDS_RS);
    const float* xt = p.x + (size_t)tile * 64 * D;
#pragma unroll 2
    for (int rr = 0; rr < 8; ++rr) {
        const int tk = 8 * wv + rr;
        f32x4 f[4]; float ss = 0.f;
#pragma unroll
        for (int i = 0; i < 4; ++i) { f[i] = ldg<f32x4>(xt, (unsigned)(tk * D + i * 256 + 4 * lane) * 4u); ss += f[i][0] * f[i][0] + f[i][1] * f[i][1] + f[i][2] * f[i][2] + f[i][3] * f[i][3]; }
        ss = wave_sum(ss);
        if (lane == 0) rs[tk] = rsqrtf(ss * (1.0f / D) + EPS);
#pragma unroll
        for (int i = 0; i < 4; ++i) { u32x2 o; o.x = pk_bf16(f[i][0], f[i][1]); o.y = pk_bf16(f[i][2], f[i][3]); *(LAS u32x2*)(lds + tk * TROW + (i * 256 + 4 * lane) * 2) = o; }
    }
    __syncthreads();
    const u32x4* WF = (const u32x4*)(p.winf);
    unsigned char* prow0 = p.proj + ((size_t)b * L + NMETA + s0) * (MIXIN * 2);
    const LAS unsigned char* bp = lds + r * TROW + h * 16;
    const float rs0 = rs[r], rs1 = rs[32 + r];
#pragma unroll 1
    for (int rd = 0; rd < 4; ++rd) {
        const int i0 = 8 * wv + 2 * rd;
        f32x16 acc[2][2]; acc[0][0] = zero16(); acc[0][1] = zero16(); acc[1][0] = zero16(); acc[1][1] = zero16();
        gemm22<64>(WF + (size_t)i0 * 64 * 64, lane, bp, acc);
#pragma unroll
        for (int mi = 0; mi < 2; ++mi)
#pragma unroll
            for (int nt = 0; nt < 2; ++nt) {
                const float rv = nt ? rs1 : rs0;
                const unsigned ro = (unsigned)((nt * 32 + r) * MIXIN + 32 * (i0 + mi) + 4 * h) * 2u;
#pragma unroll
                for (int q = 0; q < 4; ++q) { u32x2 o; o.x = pk_bf16(acc[mi][nt][4 * q] * rv, acc[mi][nt][4 * q + 1] * rv); o.y = pk_bf16(acc[mi][nt][4 * q + 2] * rv, acc[mi][nt][4 * q + 3] * rv); stg<u32x2>(prow0, ro + 16u * q, o); }
            }
    }
}
__device__ __forceinline__ void p1_meta(const Params& p, int mt, int lane) {
    const int r = lane & 31, h = lane >> 5;
    const u32x4* A = (const u32x4*)(p.winf) + (size_t)mt * 64 * 64;
    const u32x4* B = (const u32x4*)(p.metaf);
    f32x16 acc = zero16();
#pragma unroll 8
    for (int s = 0; s < 64; ++s) acc = mfma32(ldg<u32x4>(A, (unsigned)(s * 64 + lane) * 16u), ldg<u32x4>(B, (unsigned)(s * 64 + lane) * 16u), acc);
    if (r < NMETA) {
        const float rv = ((const float*)(p.rsm))[r];
#pragma unroll
        for (int bb = 0; bb < BATCH; ++bb) {
            const unsigned ro = (unsigned)((bb * L + r) * MIXIN + 32 * mt + 4 * h) * 2u;
#pragma unroll
            for (int q = 0; q < 4; ++q) { u32x2 o; o.x = pk_bf16(acc[4 * q] * rv, acc[4 * q + 1] * rv); o.y = pk_bf16(acc[4 * q + 2] * rv, acc[4 * q + 3] * rv); stg<u32x2>(p.proj, ro + 16u * q, o); }
        }
    }
}

template <int LOGN> __device__ __forceinline__ void bitonic_sort_desc(float* v) {
    constexpr int N = 1 << LOGN;
#pragma unroll
    for (int lk = 1; lk <= LOGN; ++lk) {
#pragma unroll
        for (int lj = lk - 1; lj >= 0; --lj) {
#pragma unroll
            for (int i = 0; i < N; ++i) {
                const int k = 1 << lk, j = 1 << lj, l = i ^ j;
                if (l > i) { const bool up = ((i & k) == 0); const float a = v[i], c = v[l]; const float hi = fmaxf(a, c), lo = fminf(a, c); v[i] = up ? hi : lo; v[l] = up ? lo : hi; }
            }
        }
    }
}
__device__ __forceinline__ void bitonic_merge16_desc(float* v) {
#pragma unroll
    for (int lj = 3; lj >= 0; --lj) {
#pragma unroll
        for (int i = 0; i < 16; ++i) { const int j = 1 << lj, l = i ^ j; if (l > i) { const float a = v[i], c = v[l]; v[i] = fmaxf(a, c); v[l] = fminf(a, c); } }
    }
}
__device__ __forceinline__ void merge_top16(float* a, const float* c) {
#pragma unroll
    for (int i = 0; i < 16; ++i) a[i] = fmaxf(a[i], c[15 - i]);
    bitonic_merge16_desc(a);
}
__device__ __forceinline__ void top16_of_64(float* v) {
    bitonic_sort_desc<4>(v); bitonic_sort_desc<4>(v + 16); bitonic_sort_desc<4>(v + 32); bitonic_sort_desc<4>(v + 48);
    merge_top16(v, v + 16); merge_top16(v + 32, v + 48); merge_top16(v, v + 32);
}
__device__ __forceinline__ float embed_bits(float x, unsigned mask, unsigned code) { return __builtin_bit_cast(float, (__builtin_bit_cast(unsigned, x) & ~mask) | code); }

__device__ __forceinline__ void p2_mix(const Params& p, int tile, int tid, LAS unsigned char* lds) {
    const int lane = tid & 63, wv = __builtin_amdgcn_readfirstlane(tid >> 6), r = lane & 31, h = lane >> 5;
    const int b = tile >> 6, s0 = (tile & 63) * 64;
    LAS float* ssa = (LAS float*)(lds + LDS_SSA);
    const unsigned char* pbat = p.proj + (size_t)b * L * (MIXIN * 2);
    const float* xt = p.x + (size_t)tile * 64 * D;
    float* ht = p.out + (size_t)tile * 64 * D;
    if (tid < 64) ssa[tid] = 0.f;
    {
        const int cp = tid & 255, th = tid >> 8, g = cp >> 6, w = 2 << g;
        const float invw = 1.0f / (float)w;
        const int p0 = NMETA + s0 + 32 * th;
        float sx = 0.f, sy = 0.f;
        for (int j = 1; j < w; ++j) { const unsigned u = ldg<unsigned>(pbat, (unsigned)(p0 - j) * 4096u + cp * 4u); sx += bf_lo(u); sy += bf_hi(u); }
#pragma unroll 4
        for (int tk = 0; tk < 32; ++tk) {
            const int pp = p0 + tk;
            const unsigned u = ldg<unsigned>(pbat, (unsigned)pp * 4096u + cp * 4u), u2 = ldg<unsigned>(pbat, (unsigned)(pp - w + 1) * 4096u + cp * 4u);
            const float lo = bf_lo(u), hi = bf_hi(u);
            sx += lo; sy += hi;
            *(LAS unsigned*)(lds + (32 * th + tk) * TROW + cp * 4) = pk_bf16(sx * invw - lo, sy * invw - hi);
            sx -= bf_lo(u2); sy -= bf_hi(u2);
        }
    }
    {
        float cw[3][8], gbv[8], u1[8], u2[8];
#pragma unroll
        for (int k = 0; k < 3; ++k) { const f32x4 a = ldg<f32x4>(p.conv_w, (unsigned)(k * MIXB + 8 * lane) * 4u), c = ldg<f32x4>(p.conv_w, (unsigned)(k * MIXB + 8 * lane + 4) * 4u);
#pragma unroll
            for (int e = 0; e < 4; ++e) { cw[k][e] = a[e]; cw[k][4 + e] = c[e]; } }
        { const f32x4 a = ldg<f32x4>(p.g_b, (unsigned)(8 * lane) * 4u), c = ldg<f32x4>(p.g_b, (unsigned)(8 * lane + 4) * 4u);
#pragma unroll
            for (int e = 0; e < 4; ++e) { gbv[e] = a[e]; gbv[4 + e] = c[e]; } }
        const int p0 = NMETA + s0 + 8 * wv;
        {
            const unsigned o2 = (unsigned)(p0 - 2) * 4096u + lane * 16u, o1 = (unsigned)(p0 - 1) * 4096u + lane * 16u;
            const u32x4 c2 = ldg<u32x4>(pbat, o2 + 2048u), v2 = ldg<u32x4>(pbat, o2 + 3072u), c1 = ldg<u32x4>(pbat, o1 + 2048u), v1 = ldg<u32x4>(pbat, o1 + 3072u);
#pragma unroll
            for (int e = 0; e < 4; ++e) { u2[2 * e] = bf_lo(c2[e]) * bf_lo(v2[e]); u2[2 * e + 1] = bf_hi(c2[e]) * bf_hi(v2[e]); u1[2 * e] = bf_lo(c1[e]) * bf_lo(v1[e]); u1[2 * e + 1] = bf_hi(c1[e]) * bf_hi(v1[e]); }
        }
#pragma unroll 2
        for (int tk = 0; tk < 8; ++tk) {
            const unsigned ro = (unsigned)(p0 + tk) * 4096u + lane * 16u;
            const u32x4 bv = ldg<u32x4>(pbat, ro + 1024u), cv = ldg<u32x4>(pbat, ro + 2048u), vv = ldg<u32x4>(pbat, ro + 3072u);
            float z[8], ss = 0.f;
#pragma unroll
            for (int e = 0; e < 8; ++e) {
                const float bb = (e & 1) ? bf_hi(bv[e >> 1]) : bf_lo(bv[e >> 1]);
                const float u0 = ((e & 1) ? bf_hi(cv[e >> 1]) : bf_lo(cv[e >> 1])) * ((e & 1) ? bf_hi(vv[e >> 1]) : bf_lo(vv[e >> 1]));
                const float conv = u2[e] * cw[0][e] + u1[e] * cw[1][e] + u0 * cw[2][e];
                z[e] = bb * conv; ss += z[e] * z[e];
                u2[e] = u1[e]; u1[e] = u0;
            }
            ss = wave_sum(ss);
            const float rsb = rsqrtf(ss * (1.0f / MIXB) + EPS);
            u32x4 o; o.x = pk_bf16(z[0] * rsb * gbv[0], z[1] * rsb * gbv[1]); o.y = pk_bf16(z[2] * rsb * gbv[2], z[3] * rsb * gbv[3]);
            o.z = pk_bf16(z[4] * rsb * gbv[4], z[5] * rsb * gbv[5]); o.w = pk_bf16(z[6] * rsb * gbv[6], z[7] * rsb * gbv[7]);
            *(LAS u32x4*)(lds + (8 * wv + tk) * TROW + (MIXA + 8 * lane) * 2) = o;
        }
    }
    __syncthreads();
    {
        const int g = wv >> 1, dh = wv & 1;
        const u32x4* PWF = (const u32x4*)(p.pwf);
        f32x16 acc[2][2]; acc[0][0] = zero16(); acc[0][1] = zero16(); acc[1][0] = zero16(); acc[1][1] = zero16();
        gemm22<8>(PWF + (size_t)((g * 4 + 2 * dh) * 8) * 64, lane, lds + r * TROW + g * 256 + h * 16, acc);
        float ss0 = 0.f, ss1 = 0.f;
#pragma unroll
        for (int mi = 0; mi < 2; ++mi)
#pragma unroll
            for (int q = 0; q < 4; ++q) {
                const int d = g * 128 + 32 * (2 * dh + mi) + 8 * q + 4 * h;
                const f32x4 sc = ldg<f32x4>(p.pool_scale, (unsigned)d * 4u);
#pragma unroll
                for (int e = 0; e < 4; ++e) { acc[mi][0][4 * q + e] *= sc[e]; acc[mi][1][4 * q + e] *= sc[e]; ss0 += acc[mi][0][4 * q + e] * acc[mi][0][4 * q + e]; ss1 += acc[mi][1][4 * q + e] * acc[mi][1][4 * q + e]; }
            }
        ss0 += __shfl_xor(ss0, 32); ss1 += __shfl_xor(ss1, 32);
        if (h == 0) { atomicAdd((float*)(ssa + r), ss0); atomicAdd((float*)(ssa + 32 + r), ss1); }
        __syncthreads();
        const float ra0 = rsqrtf(ssa[r] * (1.0f / MIXA) + EPS), ra1 = rsqrtf(ssa[32 + r] * (1.0f / MIXA) + EPS);
#pragma unroll
        for (int mi = 0; mi < 2; ++mi)
#pragma unroll
            for (int q = 0; q < 4; ++q) {
                const int d = g * 128 + 32 * (2 * dh + mi) + 8 * q + 4 * h;
                const f32x4 gg = ldg<f32x4>(p.g_a, (unsigned)d * 4u);
                u32x2 o0, o1;
                o0.x = pk_bf16(acc[mi][0][4 * q] * ra0 * gg[0], acc[mi][0][4 * q + 1] * ra0 * gg[1]); o0.y = pk_bf16(acc[mi][0][4 * q + 2] * ra0 * gg[2], acc[mi][0][4 * q + 3] * ra0 * gg[3]);
                o1.x = pk_bf16(acc[mi][1][4 * q] * ra1 * gg[0], acc[mi][1][4 * q + 1] * ra1 * gg[1]); o1.y = pk_bf16(acc[mi][1][4 * q + 2] * ra1 * gg[2], acc[mi][1][4 * q + 3] * ra1 * gg[3]);
                *(LAS u32x2*)(lds + r * TROW + d * 2) = o0;
                *(LAS u32x2*)(lds + (32 + r) * TROW + d * 2) = o1;
            }
    }
    __syncthreads();
    {
        const u32x4* WF = (const u32x4*)(p.woutf);
        const LAS unsigned char* bp = lds + r * TROW + h * 16;
#pragma unroll 1
        for (int rd = 0; rd < 2; ++rd) {
            const int i0 = 4 * wv + 2 * rd;
            f32x16 acc[2][2]; acc[0][0] = zero16(); acc[0][1] = zero16(); acc[1][0] = zero16(); acc[1][1] = zero16();
            gemm22<64>(WF + (size_t)i0 * 64 * 64, lane, bp, acc);
#pragma unroll
            for (int mi = 0; mi < 2; ++mi)
#pragma unroll
                for (int nt = 0; nt < 2; ++nt) {
                    const unsigned ro = (unsigned)((nt * 32 + r) * D + 32 * (i0 + mi) + 4 * h) * 4u;
#pragma unroll
                    for (int q = 0; q < 4; ++q) { const f32x4 xv = ldg<f32x4>(xt, ro + 32u * q); f32x4 o; o[0] = acc[mi][nt][4 * q] + xv[0]; o[1] = acc[mi][nt][4 * q + 1] + xv[1]; o[2] = acc[mi][nt][4 * q + 2] + xv[2]; o[3] = acc[mi][nt][4 * q + 3] + xv[3];
                        stg<f32x4>(ht, ro + 32u * q, o); }
                }
        }
    }
    __syncthreads();
    {
        unsigned char* xft = p.xf + (size_t)tile * 64 * D * 2;
#pragma unroll 2
        for (int rr = 0; rr < 8; ++rr) {
            const int tk = 8 * wv + rr;
            f32x4 f[4]; float ss = 0.f;
#pragma unroll
            for (int i = 0; i < 4; ++i) { f[i] = ldg<f32x4>(ht, (unsigned)(tk * D + i * 256 + 4 * lane) * 4u); ss += f[i][0] * f[i][0] + f[i][1] * f[i][1] + f[i][2] * f[i][2] + f[i][3] * f[i][3]; }
            ss = wave_sum(ss);
            const float rv = rsqrtf(ss * (1.0f / D) + EPS);
#pragma unroll
            for (int i = 0; i < 4; ++i) { const f32x4 gg = ldg<f32x4>(p.g_ffn, (unsigned)(i * 256 + 4 * lane) * 4u);
                u32x2 o; o.x = pk_bf16(f[i][0] * rv * gg[0], f[i][1] * rv * gg[1]); o.y = pk_bf16(f[i][2] * rv * gg[2], f[i][3] * rv * gg[3]);
                *(LAS u32x2*)(lds + tk * TROW + (i * 256 + 4 * lane) * 2) = o;
                stg<u32x2>(xft, (unsigned)(tk * D + i * 256 + 4 * lane) * 2u, o); }
        }
    }
    __syncthreads();
    {
        const int hd = wv;
        const u32x4* WQF = (const u32x4*)(p.wqf);
        const u32x4* KF = (const u32x4*)(p.kf);
        unsigned char* lstt = p.lst + (size_t)tile * 64 * (NH * 32 * 4);
        unsigned char* idxt = p.idx + (size_t)tile * 64 * (HK * 4);
        unsigned char* gatet = p.gate + (size_t)tile * 64 * (HK * 4);
        const LAS unsigned char* bp = lds + r * TROW + h * 16;
        LAS unsigned char* lut = lds + LDS_LUT + wv * 2048;
#pragma unroll
        for (int pp = 0; pp < 2; ++pp) {
            const int hp = hd * 2 + pp;
            u32x4 qb[8][2];
#pragma unroll
            for (int mh = 0; mh < 2; ++mh) {
                const int mt0 = hp * 4 + mh * 2;
                f32x16 acc[2][2]; acc[0][0] = zero16(); acc[0][1] = zero16(); acc[1][0] = zero16(); acc[1][1] = zero16();
                gemm22<64, QCH>(WQF + (size_t)mt0 * 64 * 64, lane, bp, acc);
#pragma unroll
                for (int mi = 0; mi < 2; ++mi)
#pragma unroll
                    for (int s2 = 0; s2 < 2; ++s2)
#pragma unroll
                        for (int nt = 0; nt < 2; ++nt) {
                            u32x4 o; o.x = pk_bf16(acc[mi][nt][8 * s2], acc[mi][nt][8 * s2 + 1]); o.y = pk_bf16(acc[mi][nt][8 * s2 + 2], acc[mi][nt][8 * s2 + 3]);
                            o.z = pk_bf16(acc[mi][nt][8 * s2 + 4], acc[mi][nt][8 * s2 + 5]); o.w = pk_bf16(acc[mi][nt][8 * s2 + 6], acc[mi][nt][8 * s2 + 7]);
                            qb[2 * (mh * 2 + mi) + s2][nt] = o;
                        }
            }
#pragma unroll
            for (int nt = 0; nt < 2; ++nt) {
                float top[16];
#pragma unroll
                for (int i = 0; i < 16; ++i) top[i] = -INFINITY;
#pragma unroll 1
                for (int kt = 0; kt < 4; ++kt) {
                    f32x16 sa = zero16();
                    const u32x4* kfp = KF + (size_t)((hp * 4 + kt) * 8) * 64;
#pragma unroll
                    for (int ks = 0; ks < 8; ++ks) sa = mfma32(ldg<u32x4>(kfp, (unsigned)(ks * 64 + lane) * 16u), qb[ks][nt], sa);
                    float v[16];
#pragma unroll
                    for (int i = 0; i < 16; ++i) v[i] = embed_bits(sa[i], 127u, (unsigned)(32 * kt + (i & 3) + 8 * (i >> 2) + 4 * h));
                    bitonic_sort_desc<4>(v); merge_top16(top, v);
                }
                float o[16];
#pragma unroll
                for (int i = 0; i < 16; ++i) o[i] = __shfl_xor(top[i], 32);
                merge_top16(top, o);
                if (h == 0) {
                    const unsigned lo = (unsigned)((((nt * 32 + r) * NH + hd) * 2 + pp) * 16) * 4u;
#pragma unroll
                    for (int w4 = 0; w4 < 4; ++w4) { f32x4 tv; tv[0] = top[4 * w4]; tv[1] = top[4 * w4 + 1]; tv[2] = top[4 * w4 + 2]; tv[3] = top[4 * w4 + 3]; stg<f32x4>(lstt, lo + 16u * w4, tv); }
                    u32x4 kb;
#pragma unroll
                    for (int w4 = 0; w4 < 4; ++w4) kb[w4] = (__builtin_bit_cast(unsigned, top[4 * w4]) & 127u) | ((__builtin_bit_cast(unsigned, top[4 * w4 + 1]) & 127u) << 8) | ((__builtin_bit_cast(unsigned, top[4 * w4 + 2]) & 127u) << 16) | ((__builtin_bit_cast(unsigned, top[4 * w4 + 3]) & 127u) << 24);
                    *(LAS u32x4*)(lut + ((nt * 32 + r) * 2 + pp) * 16) = kb;
                }
            }
        }
#pragma unroll
        for (int nt = 0; nt < 2; ++nt) {
            float s1[16], s2[16];
            {
                const unsigned lo = (unsigned)(((nt * 32 + r) * NH + hd) * 32) * 4u;
#pragma unroll
                for (int w4 = 0; w4 < 4; ++w4) { const f32x4 a = ldg<f32x4>(lstt, lo + 16u * w4), c = ldg<f32x4>(lstt, lo + 64u + 16u * w4);
#pragma unroll
                    for (int e4 = 0; e4 < 4; ++e4) { s1[4 * w4 + e4] = a[e4]; s2[4 * w4 + e4] = c[e4]; } }
            }
            float top[16];
#pragma unroll
            for (int i = 0; i < 16; ++i) top[i] = -INFINITY;
            { float v[16]; v[0] = embed_bits(s1[0] + s2[0], 255u, 0u); v[1] = embed_bits(s1[0] + s2[1], 255u, 1u); v[2] = embed_bits(s1[0] + s2[2], 255u, 2u); v[3] = embed_bits(s1[0] + s2[3], 255u, 3u); v[4] = embed_bits(s1[0] + s2[4], 255u, 4u); v[5] = embed_bits(s1[0] + s2[5], 255u, 5u); v[6] = embed_bits(s1[0] + s2[6], 255u, 6u); v[7] = embed_bits(s1[0] + s2[7], 255u, 7u); v[8] = embed_bits(s1[0] + s2[8], 255u, 8u); v[9] = embed_bits(s1[0] + s2[9], 255u, 9u); v[10] = embed_bits(s1[0] + s2[10], 255u, 10u); v[11] = embed_bits(s1[0] + s2[11], 255u, 11u); v[12] = embed_bits(s1[0] + s2[12], 255u, 12u); v[13] = embed_bits(s1[0] + s2[13], 255u, 13u); v[14] = embed_bits(s1[0] + s2[14], 255u, 14u); v[15] = embed_bits(s1[0] + s2[15], 255u, 15u);
              bitonic_sort_desc<4>(v); merge_top16(top, v); }
            { float v[16]; v[0] = embed_bits(s1[1] + s2[0], 255u, 16u); v[1] = embed_bits(s1[1] + s2[1], 255u, 17u); v[2] = embed_bits(s1[1] + s2[2], 255u, 18u); v[3] = embed_bits(s1[1] + s2[3], 255u, 19u); v[4] = embed_bits(s1[1] + s2[4], 255u, 20u); v[5] = embed_bits(s1[1] + s2[5], 255u, 21u); v[6] = embed_bits(s1[1] + s2[6], 255u, 22u); v[7] = embed_bits(s1[1] + s2[7], 255u, 23u); v[8] = embed_bits(s1[2] + s2[0], 255u, 32u); v[9] = embed_bits(s1[2] + s2[1], 255u, 33u); v[10] = embed_bits(s1[2] + s2[2], 255u, 34u); v[11] = embed_bits(s1[2] + s2[3], 255u, 35u); v[12] = embed_bits(s1[2] + s2[4], 255u, 36u); v[13] = embed_bits(s1[3] + s2[0], 255u, 48u); v[14] = embed_bits(s1[3] + s2[1], 255u, 49u); v[15] = embed_bits(s1[3] + s2[2], 255u, 50u);
              bitonic_sort_desc<4>(v); merge_top16(top, v); }
            { float v[16]; v[0] = embed_bits(s1[3] + s2[3], 255u, 51u); v[1] = embed_bits(s1[4] + s2[0], 255u, 64u); v[2] = embed_bits(s1[4] + s2[1], 255u, 65u); v[3] = embed_bits(s1[4] + s2[2], 255u, 66u); v[4] = embed_bits(s1[5] + s2[0], 255u, 80u); v[5] = embed_bits(s1[5] + s2[1], 255u, 81u); v[6] = embed_bits(s1[6] + s2[0], 255u, 96u); v[7] = embed_bits(s1[6] + s2[1], 255u, 97u); v[8] = embed_bits(s1[7] + s2[0], 255u, 112u); v[9] = embed_bits(s1[7] + s2[1], 255u, 113u); v[10] = embed_bits(s1[8] + s2[0], 255u, 128u); v[11] = embed_bits(s1[9] + s2[0], 255u, 144u); v[12] = embed_bits(s1[10] + s2[0], 255u, 160u); v[13] = embed_bits(s1[11] + s2[0], 255u, 176u); v[14] = embed_bits(s1[12] + s2[0], 255u, 192u); v[15] = embed_bits(s1[13] + s2[0], 255u, 208u);
              bitonic_sort_desc<4>(v); merge_top16(top, v); }
            { float v[16]; v[0] = embed_bits(s1[14] + s2[0], 255u, 224u); v[1] = embed_bits(s1[15] + s2[0], 255u, 240u); v[2] = -INFINITY; v[3] = -INFINITY; v[4] = -INFINITY; v[5] = -INFINITY; v[6] = -INFINITY; v[7] = -INFINITY; v[8] = -INFINITY; v[9] = -INFINITY; v[10] = -INFINITY; v[11] = -INFINITY; v[12] = -INFINITY; v[13] = -INFINITY; v[14] = -INFINITY; v[15] = -INFINITY;
              bitonic_sort_desc<4>(v); merge_top16(top, v); }
            float e[16], sum = 0.f;
#pragma unroll
            for (int i = 0; i < 16; ++i) { e[i] = __expf(top[i] - top[0]); sum += e[i]; }
            const float inv = 1.0f / sum;
            const unsigned to = (unsigned)((nt * 32 + r) * HK + hd * TOPK) * 4u;
            const LAS unsigned char* lt = lut + (nt * 32 + r) * 32;
            if (h == 0) {
#pragma unroll
                for (int w4 = 0; w4 < 4; ++w4) {
                    int ids[4];
#pragma unroll
                    for (int e4 = 0; e4 < 4; ++e4) { const unsigned code = __builtin_bit_cast(unsigned, top[4 * w4 + e4]) & 255u; ids[e4] = (int)lt[code >> 4] * NKEYS + (int)lt[16 + (code & 15u)]; }
                    stg<int4>(idxt, to + 16u * w4, make_int4(ids[0], ids[1], ids[2], ids[3]));
                }
            } else {
#pragma unroll
                for (int w4 = 0; w4 < 4; ++w4) { f32x4 gv; gv[0] = e[4 * w4] * inv; gv[1] = e[4 * w4 + 1] * inv; gv[2] = e[4 * w4 + 2] * inv; gv[3] = e[4 * w4 + 3] * inv; stg<f32x4>(gatet, to + 16u * w4, gv); }
            }
        }
    }
}

__device__ __forceinline__ float dot8_bf16(u32x4 a, u32x4 b, float c) {
#pragma unroll
    for (int e = 0; e < 4; ++e) {
#ifdef NO_DOT2
        c += bf_lo(a[e]) * bf_lo(b[e]) + bf_hi(a[e]) * bf_hi(b[e]);
#else
        c = __builtin_amdgcn_fdot2_f32_bf16(__builtin_bit_cast(bf2_t, a[e]), __builtin_bit_cast(bf2_t, b[e]), c, false);
#endif
    }
    return c;
}
__device__ __forceinline__ float gelu_exact(float z) { return 0.5f * z * (1.0f + erff(z * 0.70710678118654752f)); }

__device__ __forceinline__ void p3_token(const Params& p, int t, int lane) {
    const int* IDX = (const int*)(p.idx);
    const float* GATE = (const float*)(p.gate);
    const u32x4* EU = (const u32x4*)(p.eut);
    const u32x4* EV = (const u32x4*)(p.evt);
    const u32x4* XF = (const u32x4*)(p.xf) + (size_t)t * 128;
    const int id0 = IDX[(size_t)t * HK + lane], id1 = IDX[(size_t)t * HK + 64 + lane];
    const float g0 = GATE[(size_t)t * HK + lane], g1 = GATE[(size_t)t * HK + 64 + lane];
    const u32x4 xa = XF[lane], xb = XF[64 + lane];
    const int rho = ((lane >> 1) & 31);
    float zc[4];
#pragma unroll
    for (int bt = 0; bt < 4; ++bt) {
        float part[32];
#pragma unroll
        for (int kk = 0; kk < 32; ++kk) {
            const int id = __builtin_amdgcn_readlane(bt < 2 ? id0 : id1, (bt & 1) * 32 + kk);
            const u32x4* row = EU + (size_t)id * 128;
            part[kk] = dot8_bf16(row[64 + lane], xb, dot8_bf16(row[lane], xa, 0.f));
        }
#pragma unroll
        for (int lv = 4; lv >= 0; --lv) {
            const int n = 1 << lv, off = 2 << lv;
            const bool up = (lane & off) != 0;
#pragma unroll
            for (int i = 0; i < n; ++i) { const float a = part[i], c = part[i + n]; const float send = up ? a : c, keep = up ? c : a; part[i] = keep + __shfl_xor(send, off); }
        }
        float z = part[0] + __shfl_xor(part[0], 1);
        const float g = __shfl(bt < 2 ? g0 : g1, (bt & 1) * 32 + rho);
        zc[bt] = g * gelu_exact(z);
    }
    float o[16];
#pragma unroll
    for (int e = 0; e < 16; ++e) o[e] = 0.f;
#pragma unroll
    for (int bt = 0; bt < 4; ++bt) {
#pragma unroll
        for (int kk = 0; kk < 32; ++kk) {
            const int id = __builtin_amdgcn_readlane(bt < 2 ? id0 : id1, (bt & 1) * 32 + kk);
            const float c = __builtin_bit_cast(float, __builtin_amdgcn_readlane(__builtin_bit_cast(int, zc[bt]), 2 * kk));
            const u32x4* row = EV + (size_t)id * 128;
            const u32x4 va = row[lane], vb = row[64 + lane];
#pragma unroll
            for (int e = 0; e < 4; ++e) { o[2 * e] += c * bf_lo(va[e]); o[2 * e + 1] += c * bf_hi(va[e]); o[8 + 2 * e] += c * bf_lo(vb[e]); o[8 + 2 * e + 1] += c * bf_hi(vb[e]); }
        }
    }
    float* orow = p.out + (size_t)t * D;
    float ss = 0.f;
#pragma unroll
    for (int hf = 0; hf < 2; ++hf)
#pragma unroll
        for (int q = 0; q < 2; ++q) { const f32x4 hv = *(const f32x4*)(orow + hf * 512 + 8 * lane + 4 * q);
#pragma unroll
            for (int e = 0; e < 4; ++e) { o[hf * 8 + q * 4 + e] += hv[e]; ss += o[hf * 8 + q * 4 + e] * o[hf * 8 + q * 4 + e]; } }
    ss = wave_sum(ss);
    const float rv = rsqrtf(ss * (1.0f / D) + EPS);
#pragma unroll
    for (int hf = 0; hf < 2; ++hf)
#pragma unroll
        for (int q = 0; q < 2; ++q) { const f32x4 gg = *(const f32x4*)(p.g_fin + hf * 512 + 8 * lane + 4 * q); f32x4 ov;
#pragma unroll
            for (int e = 0; e < 4; ++e) ov[e] = o[hf * 8 + q * 4 + e] * rv * gg[e];
            *(f32x4*)(orow + hf * 512 + 8 * lane + 4 * q) = ov; }
}
__global__ void __launch_bounds__(512) k_p0(Params p) { p0_prep(p, blockIdx.x, gridDim.x, threadIdx.x); }
#ifndef NO_P12
__global__ void __launch_bounds__(512) k_p1(Params p) {
    __shared__ __attribute__((aligned(16))) unsigned char lds_raw[LDS_BYTES];
    LAS unsigned char* lds = (LAS unsigned char*)lds_raw;
    for (int tile = blockIdx.x; tile < NTILES; tile += gridDim.x) { p1_inproj(p, tile, threadIdx.x, lds); __syncthreads(); }
    if ((threadIdx.x >> 6) == 0) for (int mt = blockIdx.x; mt < 64; mt += gridDim.x) p1_meta(p, mt, threadIdx.x & 63);
}
__global__ void __launch_bounds__(512) k_p2(Params p) {
    __shared__ __attribute__((aligned(16))) unsigned char lds_raw[LDS_BYTES];
    LAS unsigned char* lds = (LAS unsigned char*)lds_raw;
    for (int tile = blockIdx.x; tile < NTILES; tile += gridDim.x) { p2_mix(p, tile, threadIdx.x, lds); __syncthreads(); }
}
#endif
__global__ void __launch_bounds__(512) k_p3(Params p) {
    const int lane = threadIdx.x & 63, gw = blockIdx.x * 8 + (threadIdx.x >> 6), nw = gridDim.x * 8;
    for (int t = gw; t < T; t += nw) p3_token(p, t, lane);
}
__global__ void __launch_bounds__(256) k_cvt_f32_bf16(const float* __restrict__ in, unsigned short* __restrict__ out, size_t n4) {
    for (size_t i = (size_t)blockIdx.x * 256 + threadIdx.x; i < n4; i += (size_t)gridDim.x * 256) { const f32x4 f = ((const f32x4*)in)[i]; u32x2 o; o.x = pk_bf16(f[0], f[1]); o.y = pk_bf16(f[2], f[3]); ((u32x2*)out)[i] = o; }
}
__global__ void __launch_bounds__(256) k_cvt_bf16_f32(const unsigned short* __restrict__ in, float* __restrict__ out, size_t n2) {
    for (size_t i = (size_t)blockIdx.x * 256 + threadIdx.x; i < n2; i += (size_t)gridDim.x * 256) { const unsigned u = ((const unsigned*)in)[i]; f32x2 o; o[0] = bf_lo(u); o[1] = bf_hi(u); ((f32x2*)out)[i] = o; }
}
}

extern "C" void kernel_launch(void* const* d_in, const int* in_sizes, int n_in, void* d_out, int out_size, void* d_ws, size_t ws_size, hipStream_t stream) {
    if (n_in != 16 || out_size != T * D || ws_size < WS_END) { fprintf(stderr, "kernel_launch: unexpected sizes n_in %d out %d ws %zu (need %zu)\n", n_in, out_size, ws_size, (size_t)WS_END); return; }
    Params p{};
    p.x = (const float*)d_in[0]; p.meta = (const float*)d_in[1]; p.g_mix = (const float*)d_in[2]; p.w_in = (const float*)d_in[3]; p.pool_w = (const float*)d_in[4];
    p.pool_scale = (const float*)d_in[5]; p.conv_w = (const float*)d_in[6]; p.g_a = (const float*)d_in[7]; p.g_b = (const float*)d_in[8]; p.w_out = (const float*)d_in[9];
    p.g_ffn = (const float*)d_in[10]; p.w_query = (const float*)d_in[11]; p.sub_keys = (const float*)d_in[12]; p.eu = (const float*)d_in[13]; p.ev = (const float*)d_in[14]; p.g_fin = (const float*)d_in[15];
    p.out = (float*)d_out;
    unsigned char* ws = (unsigned char*)d_ws;
    p.winf = ws; p.woutf = ws + (4u << 20); p.wqf = ws + (6u << 20); p.kf = ws + (10u << 20); p.pwf = p.kf + (512u << 10); p.metaf = p.pwf + (128u << 10); p.rsm = p.metaf + (64u << 10); p.bar = p.rsm + 256;
    p.eut = ws + (12u << 20); p.evt = p.eut + (32u << 20); p.proj = p.evt + (32u << 20); p.xf = p.proj + (size_t)TL * MIXIN * 2; p.idx = p.xf + (size_t)T * D * 2; p.gate = p.idx + (size_t)T * HK * 4; p.lst = p.gate + (size_t)T * HK * 4;
    if ((size_t)(p.lst - ws) + (size_t)T * NH * 32 * 4 > ws_size) { fprintf(stderr, "kernel_launch: workspace too small\n"); return; }
    k_p0<<<256, 512, 0, stream>>>(p);
    k_p1<<<256, 512, 0, stream>>>(p);
    k_p2<<<256, 512, 0, stream>>>(p);
    k_p3<<<256, 512, 0, stream>>>(p);
}
```

```cpp
#include <hip/hip_runtime.h>
#include <cstdio>
#include <cstdint>
#include <math.h>

namespace {
constexpr int D = 1024, BATCH = 4, SEQ = 4096, NMETA = 16, L = SEQ + NMETA;
constexpr int MIXA = 512, MIXB = 512, MIXIN = 2048;
constexpr int NH = 8, NKEYS = 128, DQH = 128, TOPK = 16, HK = 128;
constexpr int T = BATCH * SEQ;
constexpr int TL = BATCH * L;
constexpr float EPS = 1e-6f;

__device__ __forceinline__ float wave_sum(float v) {
#pragma unroll
    for (int o = 32; o > 0; o >>= 1) v += __shfl_xor(v, o);
    return v;
}
#define LAS __attribute__((address_space(3)))
typedef short bf16x8 __attribute__((ext_vector_type(8)));
typedef float f32x16 __attribute__((ext_vector_type(16)));
typedef float f32x4 __attribute__((ext_vector_type(4)));
typedef float f32x2 __attribute__((ext_vector_type(2)));
typedef __bf16 bf2_t __attribute__((ext_vector_type(2)));
typedef unsigned u32x4 __attribute__((ext_vector_type(4)));
typedef unsigned u32x2 __attribute__((ext_vector_type(2)));
typedef int i32x4 __attribute__((ext_vector_type(4)));
typedef int i32x16 __attribute__((ext_vector_type(16)));

constexpr int QCH = 2;
constexpr int NTILES = T / 64;
constexpr int TROW = 2064;
constexpr int TROWB = 1040;
constexpr int LDS_TILE = 64 * TROW;
constexpr int LDS_RS = LDS_TILE;
constexpr int LDS_SSA = LDS_RS + 256;
constexpr int LDS_LUT = LDS_SSA + 256;
constexpr int LDS_BYTES = LDS_LUT + 16384;

struct Params {
    const float* x; const float* meta; const float* g_mix; const float* w_in; const float* pool_w; const float* pool_scale; const float* conv_w;
    const float* g_a; const float* g_b; const float* w_out; const float* g_ffn; const float* w_query; const float* sub_keys; const float* eu; const float* ev; const float* g_fin;
    float* out;
    unsigned char *winf, *woutf, *wqf, *kf, *pwf, *metaf, *rsm, *eut, *evt, *proj, *idx, *gate, *bar, *lst, *su, *sv, *xq, *sx, *wsci, *wscq, *hb;
};

__device__ __forceinline__ unsigned pk_bf16(float lo, float hi) { f32x2 f = {lo, hi}; return __builtin_bit_cast(unsigned, __builtin_convertvector(f, bf2_t)); }
__device__ __forceinline__ float bf_lo(unsigned u) { return __builtin_bit_cast(float, u << 16); }
__device__ __forceinline__ float bf_hi(unsigned u) { return __builtin_bit_cast(float, u & 0xffff0000u); }
__device__ __forceinline__ f32x16 mfma32(u32x4 a, u32x4 b, f32x16 c) { return __builtin_amdgcn_mfma_f32_32x32x16_bf16(__builtin_bit_cast(bf16x8, a), __builtin_bit_cast(bf16x8, b), c, 0, 0, 0); }
__device__ __forceinline__ i32x16 mfma_i8(u32x4 a, u32x4 b, i32x16 c) { return __builtin_amdgcn_mfma_i32_32x32x32_i8(__builtin_bit_cast(i32x4, a), __builtin_bit_cast(i32x4, b), c, 0, 0, 0); }
__device__ __forceinline__ i32x16 izero16() { i32x16 z; for (int i = 0; i < 16; ++i) z[i] = 0; return z; }
__device__ __forceinline__ f32x16 zero16() { f32x16 z; for (int i = 0; i < 16; ++i) z[i] = 0.f; return z; }

__device__ __forceinline__ int launder(int x) { asm volatile("" : "+v"(x)); return x; }
template <class V> __device__ __forceinline__ V ldg(const void* base, unsigned off) { return *(const V*)((const unsigned char*)base + off); }
template <class V> __device__ __forceinline__ void stg(void* base, unsigned off, V v) { *(V*)((unsigned char*)base + off) = v; }

__device__ __forceinline__ void frag_from_kn(const float* __restrict__ W, int N, const float* __restrict__ g, int i, int s, int lane, u32x4* __restrict__ dst, int I8K = 0) {
    const int r = lane & 31, h = lane >> 5, k0 = 16 * s + 8 * h;
    const float* src = W + (size_t)k0 * N + 32 * i + r;
    float v[8];
#pragma unroll
    for (int j = 0; j < 8; ++j) v[j] = src[(size_t)j * N] * (g ? g[k0 + j] : 1.0f);
    u32x4 o; o.x = pk_bf16(v[0], v[1]); o.y = pk_bf16(v[2], v[3]); o.z = pk_bf16(v[4], v[5]); o.w = pk_bf16(v[6], v[7]);
    *dst = o;
}
__device__ __forceinline__ void frag2_from_kn(const float* __restrict__ W, int N, int i, int s, int lane, u32x4* __restrict__ dst) {
    const int r = lane & 31, h = lane >> 5, k0 = 16 * s + 8 * h;
    const float* src = W + (size_t)k0 * N + 32 * i + r;
    float v[16];
#pragma unroll
    for (int j = 0; j < 8; ++j) { v[j] = src[(size_t)j * N]; v[8 + j] = src[(size_t)(16 + j) * N]; }
    u32x4 o; o.x = pk_bf16(v[0], v[1]); o.y = pk_bf16(v[2], v[3]); o.z = pk_bf16(v[4], v[5]); o.w = pk_bf16(v[6], v[7]);
    u32x4 o2; o2.x = pk_bf16(v[8], v[9]); o2.y = pk_bf16(v[10], v[11]); o2.z = pk_bf16(v[12], v[13]); o2.w = pk_bf16(v[14], v[15]);
    dst[0] = o; dst[64] = o2;
}
constexpr int J_WOUT = 0, J_WQ = J_WOUT + 32 * 64, J_PW = J_WQ, J_KEY = J_PW + 128, J_END = J_KEY + 512;
__device__ __forceinline__ void mtile_i8_block(const float* __restrict__ W, const float* __restrict__ g, int i, int tid, LAS unsigned* lds_u, u32x4* __restrict__ dst, float* __restrict__ wsc) {
    const int lane = tid & 63, wv = tid >> 6, r = lane & 31, h = lane >> 5, col = 32 * i + r;
    if (tid < 32) lds_u[tid] = 0u;
    __syncthreads();
    {
        const int cg = lane & 7, ro = lane >> 3;
        f32x4 f[16];
#pragma unroll
        for (int q = 0; q < 16; ++q) f[q] = ldg<f32x4>(W, (unsigned)((128 * wv + 8 * q + ro) * 2048 + 32 * i + 4 * cg) * 4u);
        float m0 = 0.f, m1 = 0.f, m2 = 0.f, m3 = 0.f;
#pragma unroll
        for (int q = 0; q < 16; ++q) { const float gk = g ? g[128 * wv + 8 * q + ro] : 1.0f; m0 = fmaxf(m0, fabsf(f[q][0] * gk)); m1 = fmaxf(m1, fabsf(f[q][1] * gk)); m2 = fmaxf(m2, fabsf(f[q][2] * gk)); m3 = fmaxf(m3, fabsf(f[q][3] * gk)); }
#pragma unroll
        for (int o = 8; o < 64; o <<= 1) { m0 = fmaxf(m0, __shfl_xor(m0, o)); m1 = fmaxf(m1, __shfl_xor(m1, o)); m2 = fmaxf(m2, __shfl_xor(m2, o)); m3 = fmaxf(m3, __shfl_xor(m3, o)); }
        if (lane < 8) { atomicMax((unsigned*)(lds_u + 4 * cg), __builtin_bit_cast(unsigned, m0)); atomicMax((unsigned*)(lds_u + 4 * cg + 1), __builtin_bit_cast(unsigned, m1));
            atomicMax((unsigned*)(lds_u + 4 * cg + 2), __builtin_bit_cast(unsigned, m2)); atomicMax((unsigned*)(lds_u + 4 * cg + 3), __builtin_bit_cast(unsigned, m3)); }
    }
    __syncthreads();
    const float cm = __builtin_bit_cast(float, lds_u[r]);
    const float inv = cm > 0.f ? 127.0f / cm : 0.f;
    if (wv == 0 && h == 0) wsc[col] = cm * (1.0f / 127.0f);
#pragma unroll
    for (int sl = 0; sl < 4; ++sl) {
        const int s = 4 * wv + sl, k0 = 32 * s + 16 * h;
        u32x4 o;
#pragma unroll
        for (int q = 0; q < 4; ++q) {
            unsigned w = 0u;
#pragma unroll
            for (int e = 0; e < 4; ++e) { const int k = k0 + 4 * q + e; w |= ((unsigned)(int)rintf(ldg<float>(W, (unsigned)(k * 2048 + col) * 4u) * (g ? g[k] : 1.0f) * inv) & 255u) << (8 * e); }
            o[q] = w;
        }
        dst[(size_t)s * 64 + lane] = o;
    }
    __syncthreads();
}
__device__ __forceinline__ void meta_block(const Params& p, int tid, LAS float* lds_f) {
    const int lane = tid & 63, wv = tid >> 6;
#pragma unroll
    for (int q = 0; q < 2; ++q) {
        const int row = 2 * wv + q;
        float ss = 0.f, am = 0.f;
#pragma unroll
        for (int i = 0; i < 4; ++i) { const f32x4 f = *(const f32x4*)(p.meta + (size_t)row * D + i * 256 + 4 * lane); ss += f[0] * f[0] + f[1] * f[1] + f[2] * f[2] + f[3] * f[3];
            am = fmaxf(am, fmaxf(fmaxf(fabsf(f[0]), fabsf(f[1])), fmaxf(fabsf(f[2]), fabsf(f[3])))); }
        ss = wave_sum(ss);
#pragma unroll
        for (int o = 32; o > 0; o >>= 1) am = fmaxf(am, __shfl_xor(am, o));
        if (lane == 0) { ((float*)(p.rsm))[row] = rsqrtf(ss * (1.0f / D) + EPS) * am * (1.0f / 127.0f); lds_f[row] = am; }
    }
    __syncthreads();
    const int n = lane & 31, h = lane >> 5;
    const float am = n < NMETA ? lds_f[n] : 0.f;
    const float inv = am > 0.f ? 127.0f / am : 0.f;
#pragma unroll
    for (int sl = 0; sl < 4; ++sl) {
        const int s = 4 * wv + sl;
        u32x4 o = {0u, 0u, 0u, 0u};
        if (n < NMETA) {
            const float* row = p.meta + (size_t)n * D;
#pragma unroll
            for (int q = 0; q < 4; ++q) { const f32x4 f = *(const f32x4*)(row + 32 * s + 16 * h + 4 * q);
                o[q] = ((unsigned)(int)rintf(f[0] * inv) & 255u) | (((unsigned)(int)rintf(f[1] * inv) & 255u) << 8) | (((unsigned)(int)rintf(f[2] * inv) & 255u) << 16) | (((unsigned)(int)rintf(f[3] * inv) & 255u) << 24); }
        }
        ((u32x4*)(p.metaf))[(size_t)s * 64 + lane] = o;
    }
    __syncthreads();
}

__device__ __forceinline__ void p0_prep(const Params& p, int vb, int nb, int tid, LAS unsigned char* lds) {
    const int lane = tid & 63, wv = tid >> 6, gw = vb * 8 + wv, nw = nb * 8;
    for (int job = vb; job < 129; job += nb) {
        if (job < 64) mtile_i8_block(p.w_in, p.g_mix, job, tid, (LAS unsigned*)lds, (u32x4*)(p.winf) + (size_t)job * 32 * 64, (float*)p.wsci);
        else if (job < 128) mtile_i8_block(p.w_query, nullptr, job - 64, tid, (LAS unsigned*)lds, (u32x4*)(p.wqf) + (size_t)(job - 64) * 32 * 64, (float*)p.wscq);
        else meta_block(p, tid, (LAS float*)lds);
    }
    int jw = gw, jn = nw;
    if (nb >= 129 + 64) { jw = vb >= 129 ? (vb - 129) * 8 + wv : J_END; jn = (nb - 129) * 8; }
    for (int job = jw; job < J_END / 2; job += jn) {
        if (job < J_WQ / 2) { const int q = 2 * job, i = q >> 6, sA = q & 63; frag2_from_kn(p.w_out, 1024, i, sA, lane, (u32x4*)(p.woutf) + (size_t)q * 64 + lane); }
        else if (job < J_KEY / 2) { const int q = 2 * job - J_PW, g = q >> 5, mt = (q >> 3) & 3, sA = q & 7; frag2_from_kn(p.pool_w + (size_t)g * 128 * 128, 128, mt, sA, lane, (u32x4*)(p.pwf) + (size_t)q * 64 + lane); }
        else {
            const int q = 2 * job - J_KEY, hp = q >> 5, kt = (q >> 3) & 3, sA = q & 7, r = lane & 31, h = lane >> 5;
            const float* src = p.sub_keys + ((size_t)hp * 128 + 32 * kt + r) * 128 + 16 * sA + 4 * h;
            const f32x4 f0 = *(const f32x4*)src, f1 = *(const f32x4*)(src + 8), f2 = *(const f32x4*)(src + 16), f3 = *(const f32x4*)(src + 24);
            u32x4 o; o.x = pk_bf16(f0[0], f0[1]); o.y = pk_bf16(f0[2], f0[3]); o.z = pk_bf16(f1[0], f1[1]); o.w = pk_bf16(f1[2], f1[3]);
            u32x4 o2; o2.x = pk_bf16(f2[0], f2[1]); o2.y = pk_bf16(f2[2], f2[3]); o2.z = pk_bf16(f3[0], f3[1]); o2.w = pk_bf16(f3[2], f3[3]);
            ((u32x4*)(p.kf))[(size_t)q * 64 + lane] = o; ((u32x4*)(p.kf))[(size_t)(q + 1) * 64 + lane] = o2;
        }
    }
}

struct TabBatch { f32x4 f[4][4]; };
__device__ __forceinline__ int tab_rpb(int nb) { return ((2 * 16384 + nb - 1) / nb + 31) & ~31; }
__device__ __forceinline__ int tab_row(int vb, int nb, int wv, int i) { const int rpb = tab_rpb(nb), row = vb * rpb + 8 * i + wv; return (8 * i + wv < rpb && row < 2 * 16384) ? row : -1; }
__device__ __forceinline__ void tab_issue(const Params& p, int vb, int nb, int wv, int i0, int lane, TabBatch& t) {
#pragma unroll
    for (int q = 0; q < 4; ++q) {
        const int row = tab_row(vb, nb, wv, i0 + q);
        if (row >= 0) { const float* src = (row < 16384 ? p.eu : p.ev) + (size_t)(row & 16383) * D;
#pragma unroll
            for (int i = 0; i < 4; ++i) t.f[q][i] = ldg<f32x4>(src, (unsigned)(i * 256 + 4 * lane) * 4u); }
    }
}
__device__ __forceinline__ void tab_finish(const Params& p, int vb, int nb, int wv, int i0, int lane, const TabBatch& t) {
#pragma unroll
    for (int q = 0; q < 4; ++q) {
        const int row = tab_row(vb, nb, wv, i0 + q);
        if (row >= 0) {
            const bool isu = row < 16384; const int rr = row & 16383;
            float am = 0.f;
#pragma unroll
            for (int i = 0; i < 4; ++i) am = fmaxf(am, fmaxf(fmaxf(fabsf(t.f[q][i][0]), fabsf(t.f[q][i][1])), fmaxf(fabsf(t.f[q][i][2]), fabsf(t.f[q][i][3]))));
#pragma unroll
            for (int o = 32; o > 0; o >>= 1) am = fmaxf(am, __shfl_xor(am, o));
            const float inv = am > 0.f ? 127.0f / am : 0.f;
            unsigned char* dstt = isu ? p.eut : p.evt;
#pragma unroll
            for (int i = 0; i < 4; ++i) {
                unsigned w = 0u;
#pragma unroll
                for (int e = 0; e < 4; ++e) { const int qv = (int)rintf(t.f[q][i][e] * inv); w |= ((unsigned)qv & 255u) << (8 * e); }
                const unsigned c = (unsigned)(i * 256 + 4 * lane);
                stg<unsigned>(dstt, (((c >> 7) * 16384u + (unsigned)rr) << 7) + (c & 127u), w);
            }
            if (lane == 0) ((float*)(isu ? p.su : p.sv))[rr] = am * (1.0f / 127.0f);
        }
    }
}


template <int CH>
__device__ __forceinline__ void gemm22_chunk(const u32x4 (&a)[2][CH], const LAS unsigned char* b, int s0, f32x16 (&acc)[2][2]) {
#pragma unroll
    for (int u = 0; u < CH; ++u) {
        const u32x4 b0 = *(const LAS u32x4*)(b + (s0 + u) * 32), b1 = *(const LAS u32x4*)(b + 32 * TROW + (s0 + u) * 32);
        acc[0][0] = mfma32(a[0][u], b0, acc[0][0]); acc[0][1] = mfma32(a[0][u], b1, acc[0][1]);
        acc[1][0] = mfma32(a[1][u], b0, acc[1][0]); acc[1][1] = mfma32(a[1][u], b1, acc[1][1]);
    }
}
template <int KS, int CH = 4>
__device__ __forceinline__ void gemm22(const u32x4* abase, unsigned lane, const LAS unsigned char* b, f32x16 (&acc)[2][2], int kofs = 0) {
    constexpr int NC = KS / CH;
    static_assert(NC % 2 == 0 && (NC & (NC - 1)) == 0, "chunk count: even power of two");
    u32x4 pa[2][CH], pb[2][CH];
    const unsigned lo = lane * 16u;
    {
        const unsigned o0 = lo + (unsigned)((kofs & (NC - 1)) * CH) * 1024u;
#pragma unroll
        for (int u = 0; u < CH; ++u) { pa[0][u] = ldg<u32x4>(abase, o0 + u * 1024u); pa[1][u] = ldg<u32x4>(abase, o0 + (KS + u) * 1024u); }
    }
#pragma unroll 1
    for (int c = 0; c < NC; c += 2) {
        const int c0 = (c + kofs) & (NC - 1), c1 = (c + 1 + kofs) & (NC - 1), c2 = (c + 2 + kofs) & (NC - 1);
        const unsigned o1 = lo + (unsigned)(c1 * CH) * 1024u, o2 = lo + (unsigned)(c2 * CH) * 1024u;
#pragma unroll
        for (int u = 0; u < CH; ++u) { pb[0][u] = ldg<u32x4>(abase, o1 + u * 1024u); pb[1][u] = ldg<u32x4>(abase, o1 + (KS + u) * 1024u); }
        __builtin_amdgcn_sched_barrier(0);
        gemm22_chunk<CH>(pa, b, c0 * CH, acc);
        __builtin_amdgcn_sched_barrier(0);
#pragma unroll
        for (int u = 0; u < CH; ++u) { pa[0][u] = ldg<u32x4>(abase, o2 + u * 1024u); pa[1][u] = ldg<u32x4>(abase, o2 + (KS + u) * 1024u); }
        __builtin_amdgcn_sched_barrier(0);
        gemm22_chunk<CH>(pb, b, c1 * CH, acc);
        __builtin_amdgcn_sched_barrier(0);
    }
}

template <int CH>
__device__ __forceinline__ void gemm22i_chunk(const u32x4 (&a)[2][CH], const LAS unsigned char* b, int s0, i32x16 (&acc)[2][2]) {
#pragma unroll
    for (int u = 0; u < CH; ++u) {
        const u32x4 b0 = *(const LAS u32x4*)(b + (s0 + u) * 32), b1 = *(const LAS u32x4*)(b + 32 * TROWB + (s0 + u) * 32);
        acc[0][0] = mfma_i8(a[0][u], b0, acc[0][0]); acc[0][1] = mfma_i8(a[0][u], b1, acc[0][1]);
        acc[1][0] = mfma_i8(a[1][u], b0, acc[1][0]); acc[1][1] = mfma_i8(a[1][u], b1, acc[1][1]);
    }
}
template <int KS, int CH = 4>
__device__ __forceinline__ void gemm22i(const u32x4* abase, unsigned lane, const LAS unsigned char* b, i32x16 (&acc)[2][2], int kofs = 0) {
    constexpr int NC = KS / CH;
    static_assert(NC % 2 == 0 && (NC & (NC - 1)) == 0, "chunk count: even power of two");
    u32x4 pa[2][CH], pb[2][CH];
    const unsigned lo = lane * 16u;
    {
        const unsigned o0 = lo + (unsigned)((kofs & (NC - 1)) * CH) * 1024u;
#pragma unroll
        for (int u = 0; u < CH; ++u) { pa[0][u] = ldg<u32x4>(abase, o0 + u * 1024u); pa[1][u] = ldg<u32x4>(abase, o0 + (KS + u) * 1024u); }
    }
#pragma unroll 1
    for (int c = 0; c < NC; c += 2) {
        const int c0 = (c + kofs) & (NC - 1), c1 = (c + 1 + kofs) & (NC - 1), c2 = (c + 2 + kofs) & (NC - 1);
        const unsigned o1 = lo + (unsigned)(c1 * CH) * 1024u, o2 = lo + (unsigned)(c2 * CH) * 1024u;
#pragma unroll
        for (int u = 0; u < CH; ++u) { pb[0][u] = ldg<u32x4>(abase, o1 + u * 1024u); pb[1][u] = ldg<u32x4>(abase, o1 + (KS + u) * 1024u); }
        __builtin_amdgcn_sched_barrier(0);
        gemm22i_chunk<CH>(pa, b, c0 * CH, acc);
        __builtin_amdgcn_sched_barrier(0);
#pragma unroll
        for (int u = 0; u < CH; ++u) { pa[0][u] = ldg<u32x4>(abase, o2 + u * 1024u); pa[1][u] = ldg<u32x4>(abase, o2 + (KS + u) * 1024u); }
        __builtin_amdgcn_sched_barrier(0);
        gemm22i_chunk<CH>(pb, b, c1 * CH, acc);
        __builtin_amdgcn_sched_barrier(0);
    }
}

__device__ __forceinline__ void p1_stage(const Params& p, int tile, int tid, LAS unsigned char* lds) {
    const int lane = tid & 63, wv = __builtin_amdgcn_readfirstlane(tid >> 6);
    LAS float* rs = (LAS float*)(lds + LDS_RS);
    const float* xt = p.x + (size_t)tile * 64 * D;
#pragma unroll 4
    for (int rr = 0; rr < 8; ++rr) {
        const int tk = 8 * wv + rr;
        f32x4 f[4]; float ss = 0.f, am = 0.f;
#pragma unroll
        for (int i = 0; i < 4; ++i) { f[i] = ldg<f32x4>(xt, (unsigned)(tk * D + i * 256 + 4 * lane) * 4u); ss += f[i][0] * f[i][0] + f[i][1] * f[i][1] + f[i][2] * f[i][2] + f[i][3] * f[i][3];
            am = fmaxf(am, fmaxf(fmaxf(fabsf(f[i][0]), fabsf(f[i][1])), fmaxf(fabsf(f[i][2]), fabsf(f[i][3])))); }
        ss = wave_sum(ss);
#pragma unroll
        for (int o = 32; o > 0; o >>= 1) am = fmaxf(am, __shfl_xor(am, o));
        const float inv = am > 0.f ? 127.0f / am : 0.f;
        if (lane == 0) rs[tk] = rsqrtf(ss * (1.0f / D) + EPS) * am * (1.0f / 127.0f);
#pragma unroll
        for (int i = 0; i < 4; ++i) {
            unsigned w = 0u;
#pragma unroll
            for (int e = 0; e < 4; ++e) w |= ((unsigned)(int)rintf(f[i][e] * inv) & 255u) << (8 * e);
            *(LAS unsigned*)(lds + tk * TROWB + i * 256 + 4 * lane) = w;
        }
    }
    __syncthreads();
}
__device__ __forceinline__ void p1_inproj(const Params& p, int tile, int tid, LAS unsigned char* lds, int vb, int nb, bool do_tab) {
    const int lane = launder(tid) & 63, wv = __builtin_amdgcn_readfirstlane(tid >> 6), r = lane & 31, h = lane >> 5;
    const int b = tile >> 6, s0 = (tile & 63) * 64;
    LAS float* rs = (LAS float*)(lds + LDS_RS);
    const u32x4* WF = (const u32x4*)(p.winf);
    unsigned char* prow0 = p.proj + ((size_t)b * L + NMETA + s0) * (MIXIN * 2);
    const LAS unsigned char* bp = lds + r * TROWB + h * 16;
    const float rs0 = rs[r], rs1 = rs[32 + r];
    const int stg_k = (tile >> 3) & 7, stg_r = (tile >> 6) & 3;
#pragma unroll 1
    for (int rdx = 0; rdx < 4; ++rdx) {
        const int rd = (rdx + stg_r) & 3;
        const int i0 = 8 * wv + 2 * rd;
        TabBatch tb;
        if (do_tab) tab_issue(p, vb, nb, wv, 4 * rdx, lane, tb);
        __builtin_amdgcn_sched_barrier(0);
        i32x16 acc[2][2]; acc[0][0] = izero16(); acc[0][1] = izero16(); acc[1][0] = izero16(); acc[1][1] = izero16();
        gemm22i<32, 4>(WF + (size_t)i0 * 32 * 64, lane, bp, acc, stg_k);
        f32x4 wsv[2][4];
#pragma unroll
        for (int mi = 0; mi < 2; ++mi)
#pragma unroll
            for (int q = 0; q < 4; ++q) wsv[mi][q] = ldg<f32x4>(p.wsci, (unsigned)(32 * (i0 + mi) + 8 * q + 4 * h) * 4u);
#pragma unroll
        for (int mi = 0; mi < 2; ++mi)
#pragma unroll
            for (int q = 0; q < 4; ++q) {
                const f32x4 ws = wsv[mi][q];
#pragma unroll
                for (int nt = 0; nt < 2; ++nt) {
                    const float rv = nt ? rs1 : rs0;
                    const unsigned ro = (unsigned)((nt * 32 + r) * MIXIN + 32 * (i0 + mi) + 4 * h) * 2u;
                    u32x2 o; o.x = pk_bf16((float)acc[mi][nt][4 * q] * rv * ws[0], (float)acc[mi][nt][4 * q + 1] * rv * ws[1]); o.y = pk_bf16((float)acc[mi][nt][4 * q + 2] * rv * ws[2], (float)acc[mi][nt][4 * q + 3] * rv * ws[3]);
                    stg<u32x2>(prow0, ro + 16u * q, o);
                }
            }
        if (do_tab) tab_finish(p, vb, nb, wv, 4 * rdx, lane, tb);
    }
    if (do_tab) for (int i0 = 16; 8 * i0 < tab_rpb(nb); i0 += 4) { TabBatch tb; tab_issue(p, vb, nb, wv, i0, lane, tb); tab_finish(p, vb, nb, wv, i0, lane, tb); }
}
__device__ __forceinline__ void p1_meta(const Params& p, int mp, int lane) {
    const int r = lane & 31, h = lane >> 5;
    const u32x4* A = (const u32x4*)(p.winf) + (size_t)(2 * mp) * 32 * 64;
    const u32x4* B = (const u32x4*)(p.metaf);
    i32x16 acc0 = izero16(), acc1 = izero16();
#pragma unroll 4
    for (int s = 0; s < 32; ++s) { const u32x4 bf = ldg<u32x4>(B, (unsigned)(s * 64 + lane) * 16u);
        acc0 = mfma_i8(ldg<u32x4>(A, (unsigned)(s * 64 + lane) * 16u), bf, acc0); acc1 = mfma_i8(ldg<u32x4>(A, (unsigned)((32 + s) * 64 + lane) * 16u), bf, acc1); }
    if (r < NMETA) {
        const float rv = ((const float*)(p.rsm))[r];
#pragma unroll
        for (int q = 0; q < 4; ++q) {
            const f32x4 w0 = ldg<f32x4>(p.wsci, (unsigned)(64 * mp + 8 * q + 4 * h) * 4u), w1 = ldg<f32x4>(p.wsci, (unsigned)(64 * mp + 32 + 8 * q + 4 * h) * 4u);
            u32x2 o0, o1;
            o0.x = pk_bf16((float)acc0[4 * q] * rv * w0[0], (float)acc0[4 * q + 1] * rv * w0[1]); o0.y = pk_bf16((float)acc0[4 * q + 2] * rv * w0[2], (float)acc0[4 * q + 3] * rv * w0[3]);
            o1.x = pk_bf16((float)acc1[4 * q] * rv * w1[0], (float)acc1[4 * q + 1] * rv * w1[1]); o1.y = pk_bf16((float)acc1[4 * q + 2] * rv * w1[2], (float)acc1[4 * q + 3] * rv * w1[3]);
#pragma unroll
            for (int bb = 0; bb < BATCH; ++bb) {
                const unsigned ro = (unsigned)((bb * L + r) * MIXIN + 64 * mp + 4 * h) * 2u;
                stg<u32x2>(p.proj, ro + 16u * q, o0); stg<u32x2>(p.proj, ro + 64u + 16u * q, o1);
            }
        }
    }
}

template <int LOGN> __device__ __forceinline__ void bitonic_sort_desc(float* v) {
    constexpr int N = 1 << LOGN;
#pragma unroll
    for (int lk = 1; lk <= LOGN; ++lk) {
#pragma unroll
        for (int lj = lk - 1; lj >= 0; --lj) {
#pragma unroll
            for (int i = 0; i < N; ++i) {
                const int k = 1 << lk, j = 1 << lj, l = i ^ j;
                if (l > i) { const bool up = ((i & k) == 0); const float a = v[i], c = v[l]; const float hi = fmaxf(a, c), lo = fminf(a, c); v[i] = up ? hi : lo; v[l] = up ? lo : hi; }
            }
        }
    }
}
__device__ __forceinline__ void bitonic_merge16_desc(float* v) {
#pragma unroll
    for (int lj = 3; lj >= 0; --lj) {
#pragma unroll
        for (int i = 0; i < 16; ++i) { const int j = 1 << lj, l = i ^ j; if (l > i) { const float a = v[i], c = v[l]; v[i] = fmaxf(a, c); v[l] = fminf(a, c); } }
    }
}
__device__ __forceinline__ void merge_top16(float* a, const float* c) {
#pragma unroll
    for (int i = 0; i < 16; ++i) a[i] = fmaxf(a[i], c[15 - i]);
    bitonic_merge16_desc(a);
}
__device__ __forceinline__ void top16_of_64(float* v) {
    bitonic_sort_desc<4>(v); bitonic_sort_desc<4>(v + 16); bitonic_sort_desc<4>(v + 32); bitonic_sort_desc<4>(v + 48);
    merge_top16(v, v + 16); merge_top16(v + 32, v + 48); merge_top16(v, v + 32);
}
__device__ __forceinline__ float embed_bits(float x, unsigned mask, unsigned code) { return __builtin_bit_cast(float, (__builtin_bit_cast(unsigned, x) & ~mask) | code); }

template <int W>
__device__ __forceinline__ void pool_window(const unsigned char* pbat, int p0, int cp, LAS unsigned char* dst) {
    unsigned u[31 + W];
#pragma unroll
    for (int i = 0; i < 31 + W; ++i) u[i] = ldg<unsigned>(pbat + (size_t)(p0 - (W - 1) + i) * 4096u, cp * 4u);
    float sx = 0.f, sy = 0.f;
#pragma unroll
    for (int i = 0; i < W - 1; ++i) { sx += bf_lo(u[i]); sy += bf_hi(u[i]); }
    const float invw = 1.0f / (float)W;
#pragma unroll
    for (int tk = 0; tk < 32; ++tk) {
        const float lo = bf_lo(u[W - 1 + tk]), hi = bf_hi(u[W - 1 + tk]);
        sx += lo; sy += hi;
        *(LAS unsigned*)(dst + tk * TROW) = pk_bf16(sx * invw - lo, sy * invw - hi);
        sx -= bf_lo(u[tk]); sy -= bf_hi(u[tk]);
    }
}

template <int RB>
__device__ __forceinline__ void p2_xf_batch(const Params& p, int tile, int wv, int lane, LAS unsigned char* lds, unsigned char* ht, f32x4 (&f)[4][4], const u32x2 (&hq)[8][4], const f32x4 (&gg)[4]) {
    unsigned char* xqt = p.xq + (size_t)tile * 64 * D;
#pragma unroll
    for (int rr = 0; rr < 4; ++rr) {
        const int tk = 8 * wv + RB + rr;
        float ss = 0.f;
#pragma unroll
        for (int i = 0; i < 4; ++i) {
            const u32x2 hw = hq[RB + rr][i];
            f[rr][i][0] += bf_lo(hw.x); f[rr][i][1] += bf_hi(hw.x); f[rr][i][2] += bf_lo(hw.y); f[rr][i][3] += bf_hi(hw.y);
            u32x2 ho; ho.x = pk_bf16(f[rr][i][0], f[rr][i][1]); ho.y = pk_bf16(f[rr][i][2], f[rr][i][3]);
            stg<u32x2>(ht, (unsigned)(tk * D + i * 256 + 4 * lane) * 2u, ho);
            ss += f[rr][i][0] * f[rr][i][0] + f[rr][i][1] * f[rr][i][1] + f[rr][i][2] * f[rr][i][2] + f[rr][i][3] * f[rr][i][3];
        }
        ss = wave_sum(ss);
        const float rv = rsqrtf(ss * (1.0f / D) + EPS);
        float am = 0.f;
#pragma unroll
        for (int i = 0; i < 4; ++i)
#pragma unroll
            for (int e = 0; e < 4; ++e) { f[rr][i][e] *= rv * gg[i][e]; am = fmaxf(am, fabsf(f[rr][i][e])); }
#pragma unroll
        for (int o = 32; o > 0; o >>= 1) am = fmaxf(am, __shfl_xor(am, o));
        const float inv = am > 0.f ? 127.0f / am : 0.f;
#pragma unroll
        for (int i = 0; i < 4; ++i) {
            unsigned w = 0u;
#pragma unroll
            for (int e = 0; e < 4; ++e) w |= ((unsigned)(int)rintf(f[rr][i][e] * inv) & 255u) << (8 * e);
            stg<unsigned>(xqt, (unsigned)(tk * D + i * 256 + 4 * lane), w);
            *(LAS unsigned*)(lds + tk * TROWB + i * 256 + 4 * lane) = w;
        }
        if (lane == 0) { ((LAS float*)(lds + LDS_RS))[tk] = am * (1.0f / 127.0f); ((float*)p.sx)[tile * 64 + tk] = am * (1.0f / 127.0f); }
    }
}

__device__ __forceinline__ void p2_mix(const Params& p, int tile, int tid, LAS unsigned char* lds) {
    const int wv = __builtin_amdgcn_readfirstlane(tid >> 6);
    const int b = tile >> 6, s0 = (tile & 63) * 64;
    LAS float* ssa = (LAS float*)(lds + LDS_SSA);
    const unsigned char* pbat = p.proj + (size_t)b * L * (MIXIN * 2);
    const float* xt = p.x + (size_t)tile * 64 * D;
    unsigned char* ht = p.hb + (size_t)tile * 64 * D * 2;
    if (tid < 64) ssa[tid] = 0.f;
    {
        const int lane = launder(tid) & 63, r = lane & 31, h = lane >> 5; (void)r; (void)h;
        float cw[3][8], gbv[8], u1[8], u2[8];
#pragma unroll
        for (int k = 0; k < 3; ++k) { const f32x4 a = ldg<f32x4>(p.conv_w, (unsigned)(k * MIXB + 8 * lane) * 4u), c = ldg<f32x4>(p.conv_w, (unsigned)(k * MIXB + 8 * lane + 4) * 4u);
#pragma unroll
            for (int e = 0; e < 4; ++e) { cw[k][e] = a[e]; cw[k][4 + e] = c[e]; } }
        { const f32x4 a = ldg<f32x4>(p.g_b, (unsigned)(8 * lane) * 4u), c = ldg<f32x4>(p.g_b, (unsigned)(8 * lane + 4) * 4u);
#pragma unroll
            for (int e = 0; e < 4; ++e) { gbv[e] = a[e]; gbv[4 + e] = c[e]; } }
        const int p0 = NMETA + s0 + 8 * wv;
        u32x4 bvv[8], cvv[10], vvv[10];
#pragma unroll
        for (int i = 0; i < 10; ++i) { const unsigned ro = (unsigned)(p0 - 2 + i) * 4096u + lane * 16u; cvv[i] = ldg<u32x4>(pbat, ro + 2048u); vvv[i] = ldg<u32x4>(pbat, ro + 3072u); if (i >= 2) bvv[i - 2] = ldg<u32x4>(pbat, ro + 1024u); }
    {
        const int cp = tid & 255, th = __builtin_amdgcn_readfirstlane(tid >> 8), g = __builtin_amdgcn_readfirstlane(cp >> 6);
        const int p0 = NMETA + s0 + 32 * th;
        LAS unsigned char* dst = lds + (32 * th) * TROW + cp * 4;
        if (g == 0) pool_window<2>(pbat, p0, cp, dst); else if (g == 1) pool_window<4>(pbat, p0, cp, dst); else if (g == 2) pool_window<8>(pbat, p0, cp, dst); else pool_window<16>(pbat, p0, cp, dst);
    }
#pragma unroll
        for (int e = 0; e < 4; ++e) { u2[2 * e] = bf_lo(cvv[0][e]) * bf_lo(vvv[0][e]); u2[2 * e + 1] = bf_hi(cvv[0][e]) * bf_hi(vvv[0][e]); u1[2 * e] = bf_lo(cvv[1][e]) * bf_lo(vvv[1][e]); u1[2 * e + 1] = bf_hi(cvv[1][e]) * bf_hi(vvv[1][e]); }
#pragma unroll
        for (int tk = 0; tk < 8; ++tk) {
            const u32x4 bv = bvv[tk], cv = cvv[tk + 2], vv = vvv[tk + 2];
            float z[8], ss = 0.f;
#pragma unroll
            for (int e = 0; e < 8; ++e) {
                const float bb = (e & 1) ? bf_hi(bv[e >> 1]) : bf_lo(bv[e >> 1]);
                const float u0 = ((e & 1) ? bf_hi(cv[e >> 1]) : bf_lo(cv[e >> 1])) * ((e & 1) ? bf_hi(vv[e >> 1]) : bf_lo(vv[e >> 1]));
                const float conv = u2[e] * cw[0][e] + u1[e] * cw[1][e] + u0 * cw[2][e];
                z[e] = bb * conv; ss += z[e] * z[e];
                u2[e] = u1[e]; u1[e] = u0;
            }
            ss = wave_sum(ss);
            const float rsb = rsqrtf(ss * (1.0f / MIXB) + EPS);
            u32x4 o; o.x = pk_bf16(z[0] * rsb * gbv[0], z[1] * rsb * gbv[1]); o.y = pk_bf16(z[2] * rsb * gbv[2], z[3] * rsb * gbv[3]);
            o.z = pk_bf16(z[4] * rsb * gbv[4], z[5] * rsb * gbv[5]); o.w = pk_bf16(z[6] * rsb * gbv[6], z[7] * rsb * gbv[7]);
            *(LAS u32x4*)(lds + (8 * wv + tk) * TROW + (MIXA + 8 * lane) * 2) = o;
        }
    }
    __syncthreads();
    {
        const int lane = launder(tid) & 63, r = lane & 31, h = lane >> 5; (void)r; (void)h;
        const int g = wv >> 1, dh = wv & 1;
        const u32x4* PWF = (const u32x4*)(p.pwf);
        f32x16 acc[2][2]; acc[0][0] = zero16(); acc[0][1] = zero16(); acc[1][0] = zero16(); acc[1][1] = zero16();
        gemm22<8>(PWF + (size_t)((g * 4 + 2 * dh) * 8) * 64, lane, lds + r * TROW + g * 256 + h * 16, acc);
        float ss0 = 0.f, ss1 = 0.f;
#pragma unroll
        for (int mi = 0; mi < 2; ++mi)
#pragma unroll
            for (int q = 0; q < 4; ++q) {
                const int d = g * 128 + 32 * (2 * dh + mi) + 8 * q + 4 * h;
                const f32x4 sc = ldg<f32x4>(p.pool_scale, (unsigned)d * 4u);
#pragma unroll
                for (int e = 0; e < 4; ++e) { acc[mi][0][4 * q + e] *= sc[e]; acc[mi][1][4 * q + e] *= sc[e]; ss0 += acc[mi][0][4 * q + e] * acc[mi][0][4 * q + e]; ss1 += acc[mi][1][4 * q + e] * acc[mi][1][4 * q + e]; }
            }
        ss0 += __shfl_xor(ss0, 32); ss1 += __shfl_xor(ss1, 32);
        if (h == 0) { atomicAdd((float*)(ssa + r), ss0); atomicAdd((float*)(ssa + 32 + r), ss1); }
        __syncthreads();
        const float ra0 = rsqrtf(ssa[r] * (1.0f / MIXA) + EPS), ra1 = rsqrtf(ssa[32 + r] * (1.0f / MIXA) + EPS);
#pragma unroll
        for (int mi = 0; mi < 2; ++mi)
#pragma unroll
            for (int q = 0; q < 4; ++q) {
                const int d = g * 128 + 32 * (2 * dh + mi) + 8 * q + 4 * h;
                const f32x4 gg = ldg<f32x4>(p.g_a, (unsigned)d * 4u);
                u32x2 o0, o1;
                o0.x = pk_bf16(acc[mi][0][4 * q] * ra0 * gg[0], acc[mi][0][4 * q + 1] * ra0 * gg[1]); o0.y = pk_bf16(acc[mi][0][4 * q + 2] * ra0 * gg[2], acc[mi][0][4 * q + 3] * ra0 * gg[3]);
                o1.x = pk_bf16(acc[mi][1][4 * q] * ra1 * gg[0], acc[mi][1][4 * q + 1] * ra1 * gg[1]); o1.y = pk_bf16(acc[mi][1][4 * q + 2] * ra1 * gg[2], acc[mi][1][4 * q + 3] * ra1 * gg[3]);
                *(LAS u32x2*)(lds + r * TROW + d * 2) = o0;
                *(LAS u32x2*)(lds + (32 + r) * TROW + d * 2) = o1;
            }
    }
    __syncthreads();
    f32x4 xa[4][4];
    {
        const int lane = launder(tid) & 63, r = lane & 31, h = lane >> 5; (void)r; (void)h;
#pragma unroll
        for (int rr = 0; rr < 4; ++rr)
#pragma unroll
            for (int i = 0; i < 4; ++i) xa[rr][i] = ldg<f32x4>(xt, (unsigned)((8 * wv + rr) * D + i * 256 + 4 * lane) * 4u);
        const u32x4* WF = (const u32x4*)(p.woutf);
        const LAS unsigned char* bp = lds + r * TROW + h * 16;
#pragma unroll 1
        for (int rdx = 0; rdx < 2; ++rdx) {
            const int rd = (rdx + (tile >> 7)) & 1;
            const int i0 = 4 * wv + 2 * rd;
            f32x16 acc[2][2]; acc[0][0] = zero16(); acc[0][1] = zero16(); acc[1][0] = zero16(); acc[1][1] = zero16();
            gemm22<64>(WF + (size_t)i0 * 64 * 64, lane, bp, acc, (tile >> 3) & 15);
#pragma unroll
            for (int mi = 0; mi < 2; ++mi)
#pragma unroll
                for (int q = 0; q < 4; ++q)
#pragma unroll
                    for (int nt = 0; nt < 2; ++nt) {
                        const unsigned ro = (unsigned)((nt * 32 + r) * D + 32 * (i0 + mi) + 4 * h) * 2u + 16u * q;
                        u32x2 hw; hw.x = pk_bf16(acc[mi][nt][4 * q], acc[mi][nt][4 * q + 1]); hw.y = pk_bf16(acc[mi][nt][4 * q + 2], acc[mi][nt][4 * q + 3]); stg<u32x2>(ht, ro, hw);
                    }
        }
    }
    __syncthreads();
    {
        const int lane = launder(tid) & 63;
        f32x4 gg[4];
#pragma unroll
        for (int i = 0; i < 4; ++i) gg[i] = ldg<f32x4>(p.g_ffn, (unsigned)(i * 256 + 4 * lane) * 4u);
        f32x4 xb[4][4];
#pragma unroll
        for (int rr = 0; rr < 4; ++rr)
#pragma unroll
            for (int i = 0; i < 4; ++i) xb[rr][i] = ldg<f32x4>(xt, (unsigned)((8 * wv + 4 + rr) * D + i * 256 + 4 * lane) * 4u);
        u32x2 hq[8][4];
#pragma unroll
        for (int rr = 0; rr < 4; ++rr)
#pragma unroll
            for (int i = 0; i < 4; ++i) hq[rr][i] = ldg<u32x2>(ht, (unsigned)((8 * wv + rr) * D + i * 256 + 4 * lane) * 2u);
        p2_xf_batch<0>(p, tile, wv, lane, lds, ht, xa, hq, gg);
#pragma unroll
        for (int rr = 4; rr < 8; ++rr)
#pragma unroll
            for (int i = 0; i < 4; ++i) hq[rr][i] = ldg<u32x2>(ht, (unsigned)((8 * wv + rr) * D + i * 256 + 4 * lane) * 2u);
        p2_xf_batch<4>(p, tile, wv, lane, lds, ht, xb, hq, gg);
    }
    __syncthreads();
    {
        const int lane = launder(tid) & 63, r = lane & 31, h = lane >> 5; (void)r; (void)h;
        const int hd = wv;
        const u32x4* WQF = (const u32x4*)(p.wqf);
        const u32x4* KF = (const u32x4*)(p.kf);
        unsigned char* lstt = p.lst + (size_t)tile * 64 * (NH * 32 * 4);
        unsigned char* idxt = p.idx + (size_t)tile * 64 * (HK * 2);
        unsigned char* gatet = p.gate + (size_t)tile * 64 * (HK * 4);
        const LAS unsigned char* bp = lds + r * TROWB + h * 16;
        const float sx0 = ((const LAS float*)(lds + LDS_RS))[r], sx1 = ((const LAS float*)(lds + LDS_RS))[32 + r];
        LAS unsigned char* lut = lds + LDS_LUT + wv * 2048;
#pragma unroll
        for (int pp = 0; pp < 2; ++pp) {
            const int hp = hd * 2 + pp;
            u32x4 qb[8];
            LAS u32x4* qpark = (LAS u32x4*)(lds + 64 * TROWB + wv * 8192) + lane;
#pragma unroll
            for (int mh = 0; mh < 2; ++mh) {
                const int mt0 = hp * 4 + mh * 2;
                i32x16 acc[2][2]; acc[0][0] = izero16(); acc[0][1] = izero16(); acc[1][0] = izero16(); acc[1][1] = izero16();
                gemm22i<32, QCH>(WQF + (size_t)mt0 * 32 * 64, lane, bp, acc, (tile >> 3));
#pragma unroll
                for (int mi = 0; mi < 2; ++mi)
#pragma unroll
                    for (int s2 = 0; s2 < 2; ++s2) {
                        const f32x4 w0 = ldg<f32x4>(p.wscq, (unsigned)(32 * (mt0 + mi) + 16 * s2 + 4 * h) * 4u), w1 = ldg<f32x4>(p.wscq, (unsigned)(32 * (mt0 + mi) + 16 * s2 + 8 + 4 * h) * 4u);
#pragma unroll
                        for (int nt = 0; nt < 2; ++nt) {
                            const float xs = nt ? sx1 : sx0;
                            u32x4 o; o.x = pk_bf16((float)acc[mi][nt][8 * s2] * xs * w0[0], (float)acc[mi][nt][8 * s2 + 1] * xs * w0[1]); o.y = pk_bf16((float)acc[mi][nt][8 * s2 + 2] * xs * w0[2], (float)acc[mi][nt][8 * s2 + 3] * xs * w0[3]);
                            o.z = pk_bf16((float)acc[mi][nt][8 * s2 + 4] * xs * w1[0], (float)acc[mi][nt][8 * s2 + 5] * xs * w1[1]); o.w = pk_bf16((float)acc[mi][nt][8 * s2 + 6] * xs * w1[2], (float)acc[mi][nt][8 * s2 + 7] * xs * w1[3]);
                            if (nt == 0) qb[2 * (mh * 2 + mi) + s2] = o; else qpark[(2 * (mh * 2 + mi) + s2) * 64] = o;
                        }
                    }
            }
#pragma unroll
            for (int nt = 0; nt < 2; ++nt) {
                float top[16];
#pragma unroll
                for (int i = 0; i < 16; ++i) top[i] = -INFINITY;
                if (nt == 1) {
#pragma unroll
                    for (int ks = 0; ks < 8; ++ks) qb[ks] = qpark[ks * 64];
                }
                const u32x4* kfp = KF + (size_t)(hp * 4 * 8) * 64;
                u32x4 kf[8];
#pragma unroll
                for (int ks = 0; ks < 8; ++ks) kf[ks] = ldg<u32x4>(kfp, (unsigned)(ks * 64 + lane) * 16u);
#pragma unroll 1
                for (int kt = 0; kt < 4; ++kt) {
                    f32x16 sa = zero16();
#pragma unroll
                    for (int ks = 0; ks < 8; ++ks) sa = mfma32(kf[ks], qb[ks], sa);
                    __builtin_amdgcn_sched_barrier(0);
                    const int ktn = (kt + 1) & 3;
#pragma unroll
                    for (int ks = 0; ks < 8; ++ks) kf[ks] = ldg<u32x4>(kfp, (unsigned)((ktn * 8 + ks) * 64 + lane) * 16u);
                    __builtin_amdgcn_sched_barrier(0);
                    float v[16];
#pragma unroll
                    for (int i = 0; i < 16; ++i) v[i] = embed_bits(sa[i], 127u, (unsigned)(32 * kt + (i & 3) + 8 * (i >> 2) + 4 * h));
                    bitonic_sort_desc<4>(v); merge_top16(top, v);
                    __builtin_amdgcn_sched_barrier(0);
                }
                float o[16];
#pragma unroll
                for (int i = 0; i < 16; ++i) o[i] = __shfl_xor(top[i], 32);
                merge_top16(top, o);
                if (h == 0) {
                    const unsigned lo = (unsigned)((((nt * 32 + r) * NH + hd) * 2 + pp) * 16) * 4u;
#pragma unroll
                    for (int w4 = 0; w4 < 4; ++w4) { f32x4 tv; tv[0] = top[4 * w4]; tv[1] = top[4 * w4 + 1]; tv[2] = top[4 * w4 + 2]; tv[3] = top[4 * w4 + 3]; stg<f32x4>(lstt, lo + 16u * w4, tv); }
                    u32x4 kb;
#pragma unroll
                    for (int w4 = 0; w4 < 4; ++w4) kb[w4] = (__builtin_bit_cast(unsigned, top[4 * w4]) & 127u) | ((__builtin_bit_cast(unsigned, top[4 * w4 + 1]) & 127u) << 8) | ((__builtin_bit_cast(unsigned, top[4 * w4 + 2]) & 127u) << 16) | ((__builtin_bit_cast(unsigned, top[4 * w4 + 3]) & 127u) << 24);
                    *(LAS u32x4*)(lut + ((nt * 32 + r) * 2 + pp) * 16) = kb;
                }
            }
        }
#pragma unroll
        for (int nt = 0; nt < 2; ++nt) {
            float s1[16], s2[16];
            {
                const unsigned lo = (unsigned)(((nt * 32 + r) * NH + hd) * 32) * 4u;
#pragma unroll
                for (int w4 = 0; w4 < 4; ++w4) { const f32x4 a = ldg<f32x4>(lstt, lo + 16u * w4), c = ldg<f32x4>(lstt, lo + 64u + 16u * w4);
#pragma unroll
                    for (int e4 = 0; e4 < 4; ++e4) { s1[4 * w4 + e4] = a[e4]; s2[4 * w4 + e4] = c[e4]; } }
            }
            float top[16];
#pragma unroll
            for (int i = 0; i < 16; ++i) top[i] = -INFINITY;
            { float v[16]; v[0] = embed_bits(s1[0] + s2[0], 255u, 0u); v[1] = embed_bits(s1[0] + s2[1], 255u, 1u); v[2] = embed_bits(s1[0] + s2[2], 255u, 2u); v[3] = embed_bits(s1[0] + s2[3], 255u, 3u); v[4] = embed_bits(s1[0] + s2[4], 255u, 4u); v[5] = embed_bits(s1[0] + s2[5], 255u, 5u); v[6] = embed_bits(s1[0] + s2[6], 255u, 6u); v[7] = embed_bits(s1[0] + s2[7], 255u, 7u); v[8] = embed_bits(s1[0] + s2[8], 255u, 8u); v[9] = embed_bits(s1[0] + s2[9], 255u, 9u); v[10] = embed_bits(s1[0] + s2[10], 255u, 10u); v[11] = embed_bits(s1[0] + s2[11], 255u, 11u); v[12] = embed_bits(s1[0] + s2[12], 255u, 12u); v[13] = embed_bits(s1[0] + s2[13], 255u, 13u); v[14] = embed_bits(s1[0] + s2[14], 255u, 14u); v[15] = embed_bits(s1[0] + s2[15], 255u, 15u);
              bitonic_sort_desc<4>(v); merge_top16(top, v); }
            { float v[16]; v[0] = embed_bits(s1[1] + s2[0], 255u, 16u); v[1] = embed_bits(s1[1] + s2[1], 255u, 17u); v[2] = embed_bits(s1[1] + s2[2], 255u, 18u); v[3] = embed_bits(s1[1] + s2[3], 255u, 19u); v[4] = embed_bits(s1[1] + s2[4], 255u, 20u); v[5] = embed_bits(s1[1] + s2[5], 255u, 21u); v[6] = embed_bits(s1[1] + s2[6], 255u, 22u); v[7] = embed_bits(s1[1] + s2[7], 255u, 23u); v[8] = embed_bits(s1[2] + s2[0], 255u, 32u); v[9] = embed_bits(s1[2] + s2[1], 255u, 33u); v[10] = embed_bits(s1[2] + s2[2], 255u, 34u); v[11] = embed_bits(s1[2] + s2[3], 255u, 35u); v[12] = embed_bits(s1[2] + s2[4], 255u, 36u); v[13] = embed_bits(s1[3] + s2[0], 255u, 48u); v[14] = embed_bits(s1[3] + s2[1], 255u, 49u); v[15] = embed_bits(s1[3] + s2[2], 255u, 50u);
              bitonic_sort_desc<4>(v); merge_top16(top, v); }
            { float v[16]; v[0] = embed_bits(s1[3] + s2[3], 255u, 51u); v[1] = embed_bits(s1[4] + s2[0], 255u, 64u); v[2] = embed_bits(s1[4] + s2[1], 255u, 65u); v[3] = embed_bits(s1[4] + s2[2], 255u, 66u); v[4] = embed_bits(s1[5] + s2[0], 255u, 80u); v[5] = embed_bits(s1[5] + s2[1], 255u, 81u); v[6] = embed_bits(s1[6] + s2[0], 255u, 96u); v[7] = embed_bits(s1[6] + s2[1], 255u, 97u); v[8] = embed_bits(s1[7] + s2[0], 255u, 112u); v[9] = embed_bits(s1[7] + s2[1], 255u, 113u); v[10] = embed_bits(s1[8] + s2[0], 255u, 128u); v[11] = embed_bits(s1[9] + s2[0], 255u, 144u); v[12] = embed_bits(s1[10] + s2[0], 255u, 160u); v[13] = embed_bits(s1[11] + s2[0], 255u, 176u); v[14] = embed_bits(s1[12] + s2[0], 255u, 192u); v[15] = embed_bits(s1[13] + s2[0], 255u, 208u);
              bitonic_sort_desc<4>(v); merge_top16(top, v); }
            { float v[16]; v[0] = embed_bits(s1[14] + s2[0], 255u, 224u); v[1] = embed_bits(s1[15] + s2[0], 255u, 240u); v[2] = -INFINITY; v[3] = -INFINITY; v[4] = -INFINITY; v[5] = -INFINITY; v[6] = -INFINITY; v[7] = -INFINITY; v[8] = -INFINITY; v[9] = -INFINITY; v[10] = -INFINITY; v[11] = -INFINITY; v[12] = -INFINITY; v[13] = -INFINITY; v[14] = -INFINITY; v[15] = -INFINITY;
              bitonic_sort_desc<4>(v); merge_top16(top, v); }
            float e[16], sum = 0.f;
#pragma unroll
            for (int i = 0; i < 16; ++i) { e[i] = __expf(top[i] - top[0]); sum += e[i]; }
            const float inv = 1.0f / sum;
            const unsigned to = (unsigned)((nt * 32 + r) * HK + 2 * hd) * 4u;
            const LAS unsigned char* lt = lut + (nt * 32 + r) * 32;
            if (h == 0) {
                int ids[16];
#pragma unroll
                for (int i = 0; i < 16; ++i) { const unsigned code = __builtin_bit_cast(unsigned, top[i]) & 255u; ids[i] = (int)lt[code >> 4] * NKEYS + (int)lt[16 + (code & 15u)]; }
#pragma unroll
                for (int i = 0; i < 8; ++i) stg<unsigned>(idxt, (to >> 1) + (unsigned)(16 * i) * 2u, (unsigned)ids[i] | ((unsigned)ids[i + 8] << 16));
            } else {
#pragma unroll
                for (int i = 0; i < 8; ++i) { f32x2 gv; gv[0] = e[i] * inv; gv[1] = e[i + 8] * inv; stg<f32x2>(gatet, to + (unsigned)(16 * i) * 4u, gv); }
            }
        }
    }
}

__device__ __forceinline__ int dot16_i8(u32x4 a, u32x4 b) {
    int d = __builtin_amdgcn_sdot4((int)a[0], (int)b[0], 0, false);
    d = __builtin_amdgcn_sdot4((int)a[1], (int)b[1], d, false); d = __builtin_amdgcn_sdot4((int)a[2], (int)b[2], d, false); d = __builtin_amdgcn_sdot4((int)a[3], (int)b[3], d, false);
    return d;
}
__device__ __forceinline__ float gelu_exact(float z) { return 0.5f * z * (1.0f + erff(z * 0.70710678118654752f)); }

struct GMeta { int ids[16]; u32x4 x; };
struct GRows { u32x4 v[16]; };
__device__ __forceinline__ void g_rows(const unsigned char* slice, const GMeta& m, int lane, GRows& r) {
    const unsigned co = (unsigned)(lane & 7) * 16u;
#pragma unroll
    for (int i = 0; i < 16; ++i) r.v[i] = ldg<u32x4>(slice, (unsigned)m.ids[i] * 128u + co);
}

constexpr int P3W_Z = 0, P3W_CQ = 4096, P3W_SC = 5120, P3W_SSQ = 5152, P3W_ID = 5184, P3W_X = 7232, P3W_BYTES = 15424;
__device__ __forceinline__ void p3_wave(const Params& p, int tb0, int tb1, int lt, int pos, int lane, LAS unsigned char* wl) {
    const int ntok = 1 << lt, nts = 8 << lt;
    auto tokf = [&](int q) { return (q < 4 ? tb0 : tb1) + (q & 3); };
    const int grp = lane >> 3, ch = lane & 7, i0 = ((ch >> 2) & 1) * 8 + ((ch >> 1) & 1) * 4 + (ch & 1) * 2;
    LAS int* zl = (LAS int*)(wl + P3W_Z);
    LAS float* scl = (LAS float*)(wl + P3W_SC);
    LAS float* ssl = (LAS float*)(wl + P3W_SSQ);
#pragma unroll
    for (int q = 0; q < 8; ++q) if (q < ntok) {
        const int t = tokf(q);
        *(LAS unsigned*)(wl + P3W_ID + q * 256 + lane * 4) = ldg<unsigned>(p.idx + (size_t)t * (HK * 2), (unsigned)lane * 4u);
        *(LAS u32x4*)(wl + P3W_X + q * 1024 + lane * 16) = ldg<u32x4>(p.xq + (size_t)t * D, (unsigned)lane * 16u);
    }
    auto ids_lds = [&](int q, GMeta& m) {
#pragma unroll
        for (int w = 0; w < 2; ++w) { const u32x4 a = *(const LAS u32x4*)(wl + P3W_ID + q * 256 + grp * 32 + 16 * w);
#pragma unroll
            for (int e = 0; e < 4; ++e) { m.ids[8 * w + 2 * e] = (int)(a[e] & 0xffffu); m.ids[8 * w + 2 * e + 1] = (int)(a[e] >> 16); } }
    };
#pragma unroll 1
    for (int st = 0; st < 8; ++st) {
        const int j = (pos + st) & 7;
        const unsigned char* slice = p.eut + (size_t)j * (16384 * 128);
        const unsigned xo = (unsigned)(128 * j + 16 * ch);
#pragma unroll 1
        for (int q = 0; q < ntok; ++q) {
            const int t = tokf(q);
            GMeta m; GRows r; ids_lds(q, m); m.x = *(const LAS u32x4*)(wl + P3W_X + q * 1024 + xo); g_rows(slice, m, lane, r); (void)t;
            int part[16];
#pragma unroll
            for (int i = 0; i < 16; ++i) part[i] = dot16_i8(r.v[i], m.x);
#pragma unroll
            for (int lv = 2; lv >= 0; --lv) {
                const int n = 2 << lv, off = 1 << lv;
                const bool up = (lane & off) != 0;
#pragma unroll
                for (int i = 0; i < n; ++i) { const int a = part[i], c = part[i + n]; const int send = up ? a : c, keep = up ? c : a; part[i] = keep + __shfl_xor(send, off); }
            }
            LAS int* zp = zl + q * 128 + 2 * lane;
            if (st == 0) { zp[0] = part[0]; zp[1] = part[1]; } else { zp[0] += part[0]; zp[1] += part[1]; }
        }
    }
    {
        const unsigned po = (unsigned)(grp * 16 + i0) * 4u, po2 = (unsigned)(grp * 16 + i0) * 2u;
        unsigned idw[8]; f32x2 g[8]; float sx[8];
#pragma unroll
        for (int q = 0; q < 8; ++q) { const int t = tokf(q < ntok ? q : 0); idw[q] = *(const LAS unsigned*)(wl + P3W_ID + (q < ntok ? q : 0) * 256 + po2); g[q] = ldg<f32x2>(p.gate + (size_t)t * (HK * 4), po); sx[q] = ((const float*)p.sx)[t]; }
        float su0[8], su1[8], sv0[8], sv1[8];
#pragma unroll
        for (int q = 0; q < 8; ++q) { const int a = (int)(idw[q] & 0xffffu), c = (int)(idw[q] >> 16); su0[q] = ((const float*)p.su)[a]; su1[q] = ((const float*)p.su)[c]; sv0[q] = ((const float*)p.sv)[a]; sv1[q] = ((const float*)p.sv)[c]; }
#pragma unroll
        for (int q = 0; q < 8; ++q) if (q < ntok) {
            const int z0 = zl[q * 128 + 2 * lane], z1 = zl[q * 128 + 2 * lane + 1];
            const float c0 = g[q][0] * gelu_exact((float)z0 * (sx[q] * su0[q])) * sv0[q];
            const float c1 = g[q][1] * gelu_exact((float)z1 * (sx[q] * su1[q])) * sv1[q];
            float am = fmaxf(fabsf(c0), fabsf(c1));
#pragma unroll
            for (int o = 32; o > 0; o >>= 1) am = fmaxf(am, __shfl_xor(am, o));
            const float inv = am > 0.f ? 127.0f / am : 0.f;
            const unsigned q0 = (unsigned)(int)rintf(c0 * inv) & 255u, q1 = (unsigned)(int)rintf(c1 * inv) & 255u;
            *(LAS unsigned short*)(wl + P3W_CQ + q * 128 + 16 * grp + i0) = (unsigned short)(q0 | (q1 << 8));
            if (lane == 0) { scl[q] = am * (1.0f / 127.0f); ssl[q] = 0.f; }
        }
    }
    {
        const int e0 = ((lane >> 5) & 1) * 8 + ((lane >> 4) & 1) * 4 + ((lane >> 3) & 1) * 2;
        auto meta = [&](int n, GMeta& m, float& sc, f32x2& hv) {
            const int nn = n < nts ? n : nts - 1, q = nn & (ntok - 1), j = (pos + (nn >> lt)) & 7, t = tokf(q);
            ids_lds(q, m);
            m.x = *(const LAS u32x4*)(wl + P3W_CQ + q * 128 + 16 * grp);
            sc = scl[q];
            { const unsigned hw = ldg<unsigned>(p.hb + (size_t)t * D * 2, (unsigned)(128 * j + 16 * ch + e0) * 2u); hv[0] = bf_lo(hw); hv[1] = bf_hi(hw); }
        };
        auto rows = [&](int n, const GMeta& m, GRows& r) { const int nn = n < nts ? n : nts - 1; g_rows(p.evt + (size_t)((pos + (nn >> lt)) & 7) * (16384 * 128), m, lane, r); };
        auto finish = [&](int n, const GMeta& m, const GRows& r, float sc, f32x2 hv) {
            const int q = n & (ntok - 1), j = (pos + (n >> lt)) & 7, t = tokf(q);
            int acc[16];
#pragma unroll
            for (int e = 0; e < 16; ++e) acc[e] = 0;
#pragma unroll
            for (int g = 0; g < 4; ++g)
#pragma unroll
                for (int e = 0; e < 4; ++e) {
                    const unsigned A = r.v[4 * g][e], B = r.v[4 * g + 1][e], C = r.v[4 * g + 2][e], Dd = r.v[4 * g + 3][e];
                    const unsigned t0 = __builtin_amdgcn_perm(B, A, 0x05010400u), t1 = __builtin_amdgcn_perm(B, A, 0x07030602u);
                    const unsigned t2 = __builtin_amdgcn_perm(Dd, C, 0x05010400u), t3 = __builtin_amdgcn_perm(Dd, C, 0x07030602u);
                    const unsigned r0 = __builtin_amdgcn_perm(t2, t0, 0x05040100u), r1 = __builtin_amdgcn_perm(t2, t0, 0x07060302u);
                    const unsigned r2 = __builtin_amdgcn_perm(t3, t1, 0x05040100u), r3 = __builtin_amdgcn_perm(t3, t1, 0x07060302u);
                    const int cq = (int)m.x[g];
                    acc[4 * e] = __builtin_amdgcn_sdot4((int)r0, cq, acc[4 * e], false); acc[4 * e + 1] = __builtin_amdgcn_sdot4((int)r1, cq, acc[4 * e + 1], false);
                    acc[4 * e + 2] = __builtin_amdgcn_sdot4((int)r2, cq, acc[4 * e + 2], false); acc[4 * e + 3] = __builtin_amdgcn_sdot4((int)r3, cq, acc[4 * e + 3], false);
                }
#pragma unroll
            for (int lv = 2; lv >= 0; --lv) {
                const int n2 = 2 << lv, off = 8 << lv;
                const bool up = (lane & off) != 0;
#pragma unroll
                for (int i = 0; i < n2; ++i) { const int a = acc[i], c = acc[i + n2]; const int send = up ? a : c, keep = up ? c : a; acc[i] = keep + __shfl_xor(send, off); }
            }
            f32x2 o; o[0] = (float)acc[0] * sc + hv[0]; o[1] = (float)acc[1] * sc + hv[1];
            const float ss = wave_sum(o[0] * o[0] + o[1] * o[1]);
            stg<f32x2>(p.out + (size_t)t * D, (unsigned)(128 * j + 16 * ch + e0) * 4u, o);
            if (lane == 0) ssl[q] += ss;
        };
        GMeta ma, mb; GRows ra, rb; float sa, sb; f32x2 ha, hb;
        meta(0, ma, sa, ha); meta(1, mb, sb, hb); rows(0, ma, ra);
#pragma unroll 1
        for (int n = 0; n < nts; n += 2) {
            GMeta mc; float scc; f32x2 hc;
            meta(n + 2, mc, scc, hc); rows(n + 1, mb, rb);
            __builtin_amdgcn_sched_barrier(0);
            finish(n, ma, ra, sa, ha);
            __builtin_amdgcn_sched_barrier(0);
            meta(n + 3, ma, sa, ha); rows(n + 2, mc, ra);
            __builtin_amdgcn_sched_barrier(0);
            finish(n + 1, mb, rb, sb, hb);
            __builtin_amdgcn_sched_barrier(0);
            mb = ma; sb = sa; hb = ha; ma = mc; sa = scc; ha = hc;
        }
    }
    asm volatile("s_waitcnt vmcnt(0)" ::: "memory");
    __builtin_amdgcn_fence(__ATOMIC_ACQUIRE, "agent");
    {
        f32x4 gg[4];
#pragma unroll
        for (int i = 0; i < 4; ++i) gg[i] = ldg<f32x4>(p.g_fin, (unsigned)(i * 256 + 4 * lane) * 4u);
#pragma unroll 1
        for (int qb = 0; qb < ntok; qb += 4) {
            f32x4 a[4][4];
#pragma unroll
            for (int b = 0; b < 4; ++b)
#pragma unroll
                for (int i = 0; i < 4; ++i) a[b][i] = ldg<f32x4>(p.out + (size_t)tokf(qb + b) * D, (unsigned)(i * 256 + 4 * lane) * 4u);
#pragma unroll
            for (int b = 0; b < 4; ++b) {
                const float rv = rsqrtf(ssl[qb + b] * (1.0f / D) + EPS);
#pragma unroll
                for (int i = 0; i < 4; ++i) { f32x4 ov;
#pragma unroll
                    for (int e = 0; e < 4; ++e) ov[e] = a[b][i][e] * rv * gg[i][e];
                    stg<f32x4>(p.out + (size_t)tokf(qb + b) * D, (unsigned)(i * 256 + 4 * lane) * 4u, ov); }
            }
        }
    }
}

#define XB_TMO      128
#define XB_XCNT(j)  (256  + 64 * (j))
#define XB_XSUB(j)  (1280 + 64 * (j))
#define XB_XGEN(j)  (2304 + 64 * (j))
#define XB_TOP      3328
#define XB_TOPGEN   3392
#define XCD_BAR_WORDS 3456
#define XB_SPIN_CAP (1u << 18)

__device__ __forceinline__ unsigned xb_ld(unsigned* p)              { return __hip_atomic_load(p, __ATOMIC_RELAXED, __HIP_MEMORY_SCOPE_AGENT); }
__device__ __forceinline__ unsigned xb_add(unsigned* p, unsigned v) { return __hip_atomic_fetch_add(p, v, __ATOMIC_RELAXED, __HIP_MEMORY_SCOPE_AGENT); }
__device__ __forceinline__ unsigned xb_xcc_id() { return (unsigned)__builtin_amdgcn_s_getreg((3 << 11) | 20) & 0xFu; }
#define XB_SPIN(cond, bar) do { unsigned _sp = 0; while (cond) { __builtin_amdgcn_s_sleep(1); \
    if ((++_sp & 255u) == 0u) { if (xb_ld(&(bar)[XB_TMO])) break; if (_sp > XB_SPIN_CAP) { atomicAdd(&(bar)[XB_TMO], 1u); break; } } } } while (0)

struct XcdBarrier {
    unsigned* bar; unsigned x;
    volatile LAS unsigned* st;
};

__device__ __forceinline__ XcdBarrier xcd_barrier_post(unsigned* bar, volatile LAS unsigned* st) {
    XcdBarrier b; b.bar = bar; b.x = xb_xcc_id(); b.st = st;
    if (threadIdx.x == 0) (void)xb_add(&bar[XB_XCNT(b.x)], 1u);
    return b;
}
__device__ __forceinline__ void xcd_barrier_complete(unsigned* bar, unsigned x, unsigned& nloc, unsigned& nx) {
    const unsigned G = gridDim.x * gridDim.y * gridDim.z;
    unsigned sum, cnt, mine, sp = 0u;
    for (;;) {
        sum = 0u; cnt = 0u; mine = 0u;
#pragma unroll
        for (unsigned j = 0; j < 16; ++j) { const unsigned c = xb_ld(&bar[XB_XCNT(j)]); sum += c; cnt += (c > 0u) ? 1u : 0u; mine = (j == x) ? c : mine; }
        if (sum == G) break;
        __builtin_amdgcn_s_sleep(1);
        if ((++sp & 255u) == 0u) { if (xb_ld(&bar[XB_TMO])) break; if (sp > XB_SPIN_CAP) { atomicAdd(&bar[XB_TMO], 1u); break; } }
    }
    nloc = mine > 0u ? mine : 1u; nx = cnt > 0u ? cnt : 1u;
}

__device__ __forceinline__ void xcd_barrier(const XcdBarrier& b) {
    asm volatile("s_waitcnt vmcnt(0)" ::: "memory");
    __syncthreads();
    if (threadIdx.x == 0) {
        unsigned* bar = b.bar;
        __builtin_amdgcn_s_waitcnt(0);
        unsigned nloc = b.st[0], nx = b.st[1];
        if (nloc == 0u) { xcd_barrier_complete(bar, b.x, nloc, nx); b.st[0] = nloc; b.st[1] = nx; }
        const unsigned old = xb_add(&bar[XB_XSUB(b.x)], 1u);
        const unsigned gen = old / nloc;
        if (old + 1u == (gen + 1u) * nloc) {
            __builtin_amdgcn_fence(__ATOMIC_RELEASE, "agent");
            asm volatile("s_waitcnt vmcnt(0)" ::: "memory");
            const unsigned og = xb_add(&bar[XB_TOP], 1u);
            const unsigned tg = og / nx;
            if (og + 1u == (tg + 1u) * nx) xb_add(&bar[XB_TOPGEN], 1u);
            else XB_SPIN(xb_ld(&bar[XB_TOPGEN]) == tg, bar);
            __builtin_amdgcn_fence(__ATOMIC_ACQUIRE, "agent");
            xb_add(&bar[XB_XGEN(b.x)], 1u);
            asm volatile("s_waitcnt vmcnt(0)" ::: "memory");
        } else {
            XB_SPIN(xb_ld(&bar[XB_XGEN(b.x)]) == gen, bar);
            __builtin_amdgcn_fence(__ATOMIC_ACQUIRE, "agent");
            asm volatile("s_waitcnt vmcnt(0)" ::: "memory");
        }
    }
    __syncthreads();
}


__global__ void __launch_bounds__(512) k_fwd(Params p) {
    __shared__ __attribute__((aligned(16))) unsigned char lds_raw[LDS_BYTES + 16];
    LAS unsigned char* lds = (LAS unsigned char*)lds_raw;
    const int tid = threadIdx.x, vb = blockIdx.x, nb = gridDim.x;
    volatile LAS unsigned* xbw = (volatile LAS unsigned*)(lds + LDS_BYTES);
    if (tid < 4) xbw[tid] = 0u;
    __syncthreads();
    XcdBarrier gb = xcd_barrier_post((unsigned*)p.bar, xbw);
    if (tid == 0) xbw[2] = xb_add(&((unsigned*)p.bar)[XCD_BAR_WORDS + 64 * gb.x], 1u);
    p0_prep(p, vb, nb, tid, lds);
    const bool early = vb >= 129 && vb < NTILES;
    if (early) p1_stage(p, vb, tid, lds);
    xcd_barrier(gb);
    for (int tile = vb; tile < NTILES; tile += nb) { if (!(early && tile == vb)) p1_stage(p, tile, tid, lds); p1_inproj(p, tile, tid, lds, vb, nb, tile == vb); __syncthreads(); }
    if ((tid >> 6) == 0) for (int mp = vb; mp < 32; mp += nb) p1_meta(p, mp, launder(tid) & 63);
    xcd_barrier(gb);
    for (int tile = vb; tile < NTILES; tile += nb) { p2_mix(p, tile, tid, lds); __syncthreads(); }
    xcd_barrier(gb);
    const int lane = launder(tid) & 63, wv = __builtin_amdgcn_readfirstlane(tid >> 6);
    int np = 0, mypos = 0, nloc = 1;
    {
        unsigned* bar = (unsigned*)p.bar;
        const int myx = (int)gb.x;
#pragma unroll
        for (int q = 0; q < 16; ++q) { const int c = (int)xb_ld(&bar[XB_XCNT(q)]); if (q == myx) { mypos = np; nloc = c > 0 ? c : 1; } np += (c > 0) ? 1 : 0; }
        if (np < 1) np = 1;
    }
    {
        const int rank = (int)xbw[2];
        LAS unsigned char* wl = lds + wv * P3W_BYTES;
#pragma unroll 1
        for (int k = rank; mypos + np * k < T / 32; k += 2 * nloc) {
            const int c0 = mypos + np * k, c1 = mypos + np * (k + nloc);
            p3_wave(p, 32 * c0 + 4 * wv, 32 * c1 + 4 * wv, c1 < T / 32 ? 3 : 2, mypos, lane, wl);
        }
    }
}
}

extern "C" void kernel_launch(void* const* d_in, const int* in_sizes, int n_in, void* d_out, int out_size, void* d_ws, size_t ws_size, hipStream_t stream) {
    static int grid_blocks = 0;
    if (n_in != 16 || out_size != T * D) { fprintf(stderr, "kernel_launch: unexpected sizes n_in %d out %d\n", n_in, out_size); return; }
    if (!grid_blocks) {
        int dev = 0, cus = 0, per_cu = 0;
        (void)hipGetDevice(&dev);
        (void)hipDeviceGetAttribute(&cus, hipDeviceAttributeMultiprocessorCount, dev);
        (void)hipOccupancyMaxActiveBlocksPerMultiprocessor(&per_cu, (const void*)k_fwd, 512, 0);
        if (per_cu < 1) { fprintf(stderr, "kernel_launch: occupancy query returned %d\n", per_cu); per_cu = 1; }
        grid_blocks = cus * 1;
    }
    Params p{};
    p.x = (const float*)d_in[0]; p.meta = (const float*)d_in[1]; p.g_mix = (const float*)d_in[2]; p.w_in = (const float*)d_in[3]; p.pool_w = (const float*)d_in[4];
    p.pool_scale = (const float*)d_in[5]; p.conv_w = (const float*)d_in[6]; p.g_a = (const float*)d_in[7]; p.g_b = (const float*)d_in[8]; p.w_out = (const float*)d_in[9];
    p.g_ffn = (const float*)d_in[10]; p.w_query = (const float*)d_in[11]; p.sub_keys = (const float*)d_in[12]; p.eu = (const float*)d_in[13]; p.ev = (const float*)d_in[14]; p.g_fin = (const float*)d_in[15];
    p.out = (float*)d_out;
    unsigned char* ws = (unsigned char*)d_ws;
    p.winf = ws; p.woutf = ws + (4u << 20); p.wqf = ws + (6u << 20); p.kf = ws + (10u << 20); p.pwf = p.kf + (512u << 10); p.metaf = p.pwf + (128u << 10); p.rsm = p.metaf + (64u << 10); p.bar = p.rsm + 256;
    p.eut = ws + (12u << 20); p.evt = p.eut + (32u << 20); p.proj = p.evt + (32u << 20); p.idx = p.proj + (size_t)TL * MIXIN * 2; p.gate = p.idx + (size_t)T * HK * 4; p.lst = p.gate + (size_t)T * HK * 4;
    p.su = p.lst + (size_t)T * NH * 32 * 4; p.sv = p.su + 65536; p.sx = p.sv + 65536; p.xq = p.sx + 65536; p.wsci = p.xq + (size_t)T * D; p.wscq = p.wsci + 8192; p.hb = p.wscq + 8192;
    if ((size_t)(p.hb - ws) + (size_t)T * D * 2 > ws_size) { fprintf(stderr, "kernel_launch: workspace too small\n"); return; }
    if (hipMemsetAsync(p.bar, 0, (XCD_BAR_WORDS + 64 * 16) * 4, stream) != hipSuccess) { fprintf(stderr, "kernel_launch: memset of the barrier words failed\n"); return; }
    hipLaunchKernelGGL(k_fwd, dim3(grid_blocks), dim3(512), 0, stream, p);
}
```

```cpp
#include <hip/hip_runtime.h>
#include <cstdio>
#include <cstdint>
#include <math.h>

namespace {
constexpr int D = 1024, BATCH = 4, SEQ = 4096, NMETA = 16, L = SEQ + NMETA;
constexpr int MIXA = 512, MIXB = 512, MIXIN = 2048;
constexpr int NH = 8, NKEYS = 128, DQH = 128, TOPK = 16, HK = 128;
constexpr int T = BATCH * SEQ;
constexpr int TL = BATCH * L;
constexpr float EPS = 1e-6f;

__device__ __forceinline__ float wave_sum(float v) {
#pragma unroll
    for (int o = 32; o > 0; o >>= 1) v += __shfl_xor(v, o);
    return v;
}
#define LAS __attribute__((address_space(3)))
typedef short bf16x8 __attribute__((ext_vector_type(8)));
typedef float f32x16 __attribute__((ext_vector_type(16)));
typedef float f32x4 __attribute__((ext_vector_type(4)));
typedef float f32x2 __attribute__((ext_vector_type(2)));
typedef __bf16 bf2_t __attribute__((ext_vector_type(2)));
typedef unsigned u32x4 __attribute__((ext_vector_type(4)));
typedef unsigned u32x2 __attribute__((ext_vector_type(2)));
typedef int i32x4 __attribute__((ext_vector_type(4)));
typedef int i32x16 __attribute__((ext_vector_type(16)));

constexpr int QCH = 2;
constexpr int NTILES = T / 64;
constexpr int TROW = 2064;
constexpr int TROWB = 1040;
constexpr int LDS_TILE = 64 * TROW;
constexpr int LDS_RS = LDS_TILE;
constexpr int LDS_SSA = LDS_RS + 256;
constexpr int LDS_LUT = LDS_SSA + 256;
constexpr int LDS_BYTES = LDS_LUT + 16384;

struct Params {
    const float* x; const float* meta; const float* g_mix; const float* w_in; const float* pool_w; const float* pool_scale; const float* conv_w;
    const float* g_a; const float* g_b; const float* w_out; const float* g_ffn; const float* w_query; const float* sub_keys; const float* eu; const float* ev; const float* g_fin;
    float* out;
    unsigned char *winf, *woutf, *wqf, *kf, *pwf, *metaf, *rsm, *eut, *evt, *proj, *idx, *gate, *bar, *lst, *su, *sv, *xq, *sx, *wsci, *wscq, *hb;
};

__device__ __forceinline__ unsigned pk_bf16(float lo, float hi) { f32x2 f = {lo, hi}; return __builtin_bit_cast(unsigned, __builtin_convertvector(f, bf2_t)); }
__device__ __forceinline__ float bf_lo(unsigned u) { return __builtin_bit_cast(float, u << 16); }
__device__ __forceinline__ float bf_hi(unsigned u) { return __builtin_bit_cast(float, u & 0xffff0000u); }
__device__ __forceinline__ f32x16 mfma32(u32x4 a, u32x4 b, f32x16 c) { return __builtin_amdgcn_mfma_f32_32x32x16_bf16(__builtin_bit_cast(bf16x8, a), __builtin_bit_cast(bf16x8, b), c, 0, 0, 0); }
__device__ __forceinline__ i32x16 mfma_i8(u32x4 a, u32x4 b, i32x16 c) { return __builtin_amdgcn_mfma_i32_32x32x32_i8(__builtin_bit_cast(i32x4, a), __builtin_bit_cast(i32x4, b), c, 0, 0, 0); }
__device__ __forceinline__ i32x16 izero16() { i32x16 z; for (int i = 0; i < 16; ++i) z[i] = 0; return z; }
__device__ __forceinline__ f32x16 zero16() { f32x16 z; for (int i = 0; i < 16; ++i) z[i] = 0.f; return z; }

__device__ __forceinline__ int launder(int x) { asm volatile("" : "+v"(x)); return x; }
template <class V> __device__ __forceinline__ V ldg(const void* base, unsigned off) { return *(const V*)((const unsigned char*)base + off); }
template <class V> __device__ __forceinline__ void stg(void* base, unsigned off, V v) { *(V*)((unsigned char*)base + off) = v; }

__device__ __forceinline__ void frag_from_kn(const float* __restrict__ W, int N, const float* __restrict__ g, int i, int s, int lane, u32x4* __restrict__ dst, int I8K = 0) {
    const int r = lane & 31, h = lane >> 5, k0 = 16 * s + 8 * h;
    const float* src = W + (size_t)k0 * N + 32 * i + r;
    float v[8];
#pragma unroll
    for (int j = 0; j < 8; ++j) v[j] = src[(size_t)j * N] * (g ? g[k0 + j] : 1.0f);
    u32x4 o; o.x = pk_bf16(v[0], v[1]); o.y = pk_bf16(v[2], v[3]); o.z = pk_bf16(v[4], v[5]); o.w = pk_bf16(v[6], v[7]);
    *dst = o;
}
__device__ __forceinline__ void frag2_from_kn(const float* __restrict__ W, int N, int i, int s, int lane, u32x4* __restrict__ dst) {
    const int r = lane & 31, h = lane >> 5, k0 = 16 * s + 8 * h;
    const float* src = W + (size_t)k0 * N + 32 * i + r;
    float v[16];
#pragma unroll
    for (int j = 0; j < 8; ++j) { v[j] = src[(size_t)j * N]; v[8 + j] = src[(size_t)(16 + j) * N]; }
    u32x4 o; o.x = pk_bf16(v[0], v[1]); o.y = pk_bf16(v[2], v[3]); o.z = pk_bf16(v[4], v[5]); o.w = pk_bf16(v[6], v[7]);
    u32x4 o2; o2.x = pk_bf16(v[8], v[9]); o2.y = pk_bf16(v[10], v[11]); o2.z = pk_bf16(v[12], v[13]); o2.w = pk_bf16(v[14], v[15]);
    dst[0] = o; dst[64] = o2;
}
constexpr int J_WOUT = 0, J_WQ = J_WOUT + 32 * 64, J_PW = J_WQ, J_KEY = J_PW + 128, J_END = J_KEY + 512;
__device__ __forceinline__ void mtile_i8_block(const float* __restrict__ W, const float* __restrict__ g, int i, int tid, LAS unsigned* lds_u, u32x4* __restrict__ dst, float* __restrict__ wsc) {
    const int lane = tid & 63, wv = tid >> 6, r = lane & 31, h = lane >> 5, col = 32 * i + r;
    if (tid < 32) lds_u[tid] = 0u;
    __syncthreads();
    {
        const int cg = lane & 7, ro = lane >> 3;
        f32x4 f[16];
#pragma unroll
        for (int q = 0; q < 16; ++q) f[q] = ldg<f32x4>(W, (unsigned)((128 * wv + 8 * q + ro) * 2048 + 32 * i + 4 * cg) * 4u);
        float m0 = 0.f, m1 = 0.f, m2 = 0.f, m3 = 0.f;
#pragma unroll
        for (int q = 0; q < 16; ++q) { const float gk = g ? g[128 * wv + 8 * q + ro] : 1.0f; m0 = fmaxf(m0, fabsf(f[q][0] * gk)); m1 = fmaxf(m1, fabsf(f[q][1] * gk)); m2 = fmaxf(m2, fabsf(f[q][2] * gk)); m3 = fmaxf(m3, fabsf(f[q][3] * gk)); }
#pragma unroll
        for (int o = 8; o < 64; o <<= 1) { m0 = fmaxf(m0, __shfl_xor(m0, o)); m1 = fmaxf(m1, __shfl_xor(m1, o)); m2 = fmaxf(m2, __shfl_xor(m2, o)); m3 = fmaxf(m3, __shfl_xor(m3, o)); }
        if (lane < 8) { atomicMax((unsigned*)(lds_u + 4 * cg), __builtin_bit_cast(unsigned, m0)); atomicMax((unsigned*)(lds_u + 4 * cg + 1), __builtin_bit_cast(unsigned, m1));
            atomicMax((unsigned*)(lds_u + 4 * cg + 2), __builtin_bit_cast(unsigned, m2)); atomicMax((unsigned*)(lds_u + 4 * cg + 3), __builtin_bit_cast(unsigned, m3)); }
    }
    __syncthreads();
    const float cm = __builtin_bit_cast(float, lds_u[r]);
    const float inv = cm > 0.f ? 127.0f / cm : 0.f;
    if (wv == 0 && h == 0) wsc[col] = cm * (1.0f / 127.0f);
#pragma unroll
    for (int sl = 0; sl < 4; ++sl) {
        const int s = 4 * wv + sl, k0 = 32 * s + 16 * h;
        u32x4 o;
#pragma unroll
        for (int q = 0; q < 4; ++q) {
            unsigned w = 0u;
#pragma unroll
            for (int e = 0; e < 4; ++e) { const int k = k0 + 4 * q + e; w |= ((unsigned)(int)rintf(ldg<float>(W, (unsigned)(k * 2048 + col) * 4u) * (g ? g[k] : 1.0f) * inv) & 255u) << (8 * e); }
            o[q] = w;
        }
        dst[(size_t)s * 64 + lane] = o;
    }
    __syncthreads();
}
__device__ __forceinline__ void meta_block(const Params& p, int tid, LAS float* lds_f) {
    const int lane = tid & 63, wv = tid >> 6;
#pragma unroll
    for (int q = 0; q < 2; ++q) {
        const int row = 2 * wv + q;
        float ss = 0.f, am = 0.f;
#pragma unroll
        for (int i = 0; i < 4; ++i) { const f32x4 f = *(const f32x4*)(p.meta + (size_t)row * D + i * 256 + 4 * lane); ss += f[0] * f[0] + f[1] * f[1] + f[2] * f[2] + f[3] * f[3];
            am = fmaxf(am, fmaxf(fmaxf(fabsf(f[0]), fabsf(f[1])), fmaxf(fabsf(f[2]), fabsf(f[3])))); }
        ss = wave_sum(ss);
#pragma unroll
        for (int o = 32; o > 0; o >>= 1) am = fmaxf(am, __shfl_xor(am, o));
        if (lane == 0) { ((float*)(p.rsm))[row] = rsqrtf(ss * (1.0f / D) + EPS) * am * (1.0f / 127.0f); lds_f[row] = am; }
    }
    __syncthreads();
    const int n = lane & 31, h = lane >> 5;
    const float am = n < NMETA ? lds_f[n] : 0.f;
    const float inv = am > 0.f ? 127.0f / am : 0.f;
#pragma unroll
    for (int sl = 0; sl < 4; ++sl) {
        const int s = 4 * wv + sl;
        u32x4 o = {0u, 0u, 0u, 0u};
        if (n < NMETA) {
            const float* row = p.meta + (size_t)n * D;
#pragma unroll
            for (int q = 0; q < 4; ++q) { const f32x4 f = *(const f32x4*)(row + 32 * s + 16 * h + 4 * q);
                o[q] = ((unsigned)(int)rintf(f[0] * inv) & 255u) | (((unsigned)(int)rintf(f[1] * inv) & 255u) << 8) | (((unsigned)(int)rintf(f[2] * inv) & 255u) << 16) | (((unsigned)(int)rintf(f[3] * inv) & 255u) << 24); }
        }
        ((u32x4*)(p.metaf))[(size_t)s * 64 + lane] = o;
    }
    __syncthreads();
}

__device__ __forceinline__ void p0_prep(const Params& p, int vb, int nb, int tid, LAS unsigned char* lds) {
    const int lane = tid & 63, wv = tid >> 6, gw = vb * 8 + wv, nw = nb * 8;
    for (int job = vb; job < 129; job += nb) {
        if (job < 64) mtile_i8_block(p.w_in, p.g_mix, job, tid, (LAS unsigned*)lds, (u32x4*)(p.winf) + (size_t)job * 32 * 64, (float*)p.wsci);
        else if (job < 128) mtile_i8_block(p.w_query, nullptr, job - 64, tid, (LAS unsigned*)lds, (u32x4*)(p.wqf) + (size_t)(job - 64) * 32 * 64, (float*)p.wscq);
        else meta_block(p, tid, (LAS float*)lds);
    }
    int jw = gw, jn = nw;
    if (nb >= 129 + 64) { jw = vb >= 129 ? (vb - 129) * 8 + wv : J_END; jn = (nb - 129) * 8; }
    for (int job = jw; job < J_END / 2; job += jn) {
        if (job < J_WQ / 2) { const int q = 2 * job, i = q >> 6, sA = q & 63; frag2_from_kn(p.w_out, 1024, i, sA, lane, (u32x4*)(p.woutf) + (size_t)q * 64 + lane); }
        else if (job < J_KEY / 2) { const int q = 2 * job - J_PW, g = q >> 5, mt = (q >> 3) & 3, sA = q & 7; frag2_from_kn(p.pool_w + (size_t)g * 128 * 128, 128, mt, sA, lane, (u32x4*)(p.pwf) + (size_t)q * 64 + lane); }
        else {
            const int q = 2 * job - J_KEY, hp = q >> 5, kt = (q >> 3) & 3, sA = q & 7, r = lane & 31, h = lane >> 5;
            const float* src = p.sub_keys + ((size_t)hp * 128 + 32 * kt + r) * 128 + 16 * sA + 4 * h;
            const f32x4 f0 = *(const f32x4*)src, f1 = *(const f32x4*)(src + 8), f2 = *(const f32x4*)(src + 16), f3 = *(const f32x4*)(src + 24);
            u32x4 o; o.x = pk_bf16(f0[0], f0[1]); o.y = pk_bf16(f0[2], f0[3]); o.z = pk_bf16(f1[0], f1[1]); o.w = pk_bf16(f1[2], f1[3]);
            u32x4 o2; o2.x = pk_bf16(f2[0], f2[1]); o2.y = pk_bf16(f2[2], f2[3]); o2.z = pk_bf16(f3[0], f3[1]); o2.w = pk_bf16(f3[2], f3[3]);
            ((u32x4*)(p.kf))[(size_t)q * 64 + lane] = o; ((u32x4*)(p.kf))[(size_t)(q + 1) * 64 + lane] = o2;
        }
    }
}

struct TabBatch { f32x4 f[4][4]; };
__device__ __forceinline__ int tab_rpb(int nb) { return ((2 * 16384 + nb - 1) / nb + 31) & ~31; }
__device__ __forceinline__ int tab_row(int vb, int nb, int wv, int i) { const int rpb = tab_rpb(nb), row = vb * rpb + 8 * i + wv; return (8 * i + wv < rpb && row < 2 * 16384) ? row : -1; }
__device__ __forceinline__ void tab_issue(const Params& p, int vb, int nb, int wv, int i0, int lane, TabBatch& t) {
#pragma unroll
    for (int q = 0; q < 4; ++q) {
        const int row = tab_row(vb, nb, wv, i0 + q);
        if (row >= 0) { const float* src = (row < 16384 ? p.eu : p.ev) + (size_t)(row & 16383) * D;
#pragma unroll
            for (int i = 0; i < 4; ++i) t.f[q][i] = ldg<f32x4>(src, (unsigned)(i * 256 + 4 * lane) * 4u); }
    }
}
__device__ __forceinline__ void tab_finish(const Params& p, int vb, int nb, int wv, int i0, int lane, const TabBatch& t) {
#pragma unroll
    for (int q = 0; q < 4; ++q) {
        const int row = tab_row(vb, nb, wv, i0 + q);
        if (row >= 0) {
            const bool isu = row < 16384; const int rr = row & 16383;
            float am = 0.f;
#pragma unroll
            for (int i = 0; i < 4; ++i) am = fmaxf(am, fmaxf(fmaxf(fabsf(t.f[q][i][0]), fabsf(t.f[q][i][1])), fmaxf(fabsf(t.f[q][i][2]), fabsf(t.f[q][i][3]))));
#pragma unroll
            for (int o = 32; o > 0; o >>= 1) am = fmaxf(am, __shfl_xor(am, o));
            const float inv = am > 0.f ? 127.0f / am : 0.f;
            unsigned char* dstt = isu ? p.eut : p.evt;
#pragma unroll
            for (int i = 0; i < 4; ++i) {
                unsigned w = 0u;
#pragma unroll
                for (int e = 0; e < 4; ++e) { const int qv = (int)rintf(t.f[q][i][e] * inv); w |= ((unsigned)qv & 255u) << (8 * e); }
                const unsigned c = (unsigned)(i * 256 + 4 * lane);
                stg<unsigned>(dstt, (((c >> 7) * 16384u + (unsigned)rr) << 7) + (c & 127u), w);
            }
            if (lane == 0) ((float*)(isu ? p.su : p.sv))[rr] = am * (1.0f / 127.0f);
        }
    }
}


template <int CH>
__device__ __forceinline__ void gemm22_chunk(const u32x4 (&a)[2][CH], const LAS unsigned char* b, int s0, f32x16 (&acc)[2][2]) {
#pragma unroll
    for (int u = 0; u < CH; ++u) {
        const u32x4 b0 = *(const LAS u32x4*)(b + (s0 + u) * 32), b1 = *(const LAS u32x4*)(b + 32 * TROW + (s0 + u) * 32);
        acc[0][0] = mfma32(a[0][u], b0, acc[0][0]); acc[0][1] = mfma32(a[0][u], b1, acc[0][1]);
        acc[1][0] = mfma32(a[1][u], b0, acc[1][0]); acc[1][1] = mfma32(a[1][u], b1, acc[1][1]);
    }
}
template <int KS, int CH = 4>
__device__ __forceinline__ void gemm22(const u32x4* abase, unsigned lane, const LAS unsigned char* b, f32x16 (&acc)[2][2], int kofs = 0) {
    constexpr int NC = KS / CH;
    static_assert(NC % 2 == 0 && (NC & (NC - 1)) == 0, "chunk count: even power of two");
    u32x4 pa[2][CH], pb[2][CH];
    const unsigned lo = lane * 16u;
    {
        const unsigned o0 = lo + (unsigned)((kofs & (NC - 1)) * CH) * 1024u;
#pragma unroll
        for (int u = 0; u < CH; ++u) { pa[0][u] = ldg<u32x4>(abase, o0 + u * 1024u); pa[1][u] = ldg<u32x4>(abase, o0 + (KS + u) * 1024u); }
    }
#pragma unroll 1
    for (int c = 0; c < NC; c += 2) {
        const int c0 = (c + kofs) & (NC - 1), c1 = (c + 1 + kofs) & (NC - 1), c2 = (c + 2 + kofs) & (NC - 1);
        const unsigned o1 = lo + (unsigned)(c1 * CH) * 1024u, o2 = lo + (unsigned)(c2 * CH) * 1024u;
#pragma unroll
        for (int u = 0; u < CH; ++u) { pb[0][u] = ldg<u32x4>(abase, o1 + u * 1024u); pb[1][u] = ldg<u32x4>(abase, o1 + (KS + u) * 1024u); }
        __builtin_amdgcn_sched_barrier(0);
        gemm22_chunk<CH>(pa, b, c0 * CH, acc);
        __builtin_amdgcn_sched_barrier(0);
#pragma unroll
        for (int u = 0; u < CH; ++u) { pa[0][u] = ldg<u32x4>(abase, o2 + u * 1024u); pa[1][u] = ldg<u32x4>(abase, o2 + (KS + u) * 1024u); }
        __builtin_amdgcn_sched_barrier(0);
        gemm22_chunk<CH>(pb, b, c1 * CH, acc);
        __builtin_amdgcn_sched_barrier(0);
    }
}

template <int CH>
__device__ __forceinline__ void gemm22i_chunk(const u32x4 (&a)[2][CH], const LAS unsigned char* b, int s0, i32x16 (&acc)[2][2]) {
#pragma unroll
    for (int u = 0; u < CH; ++u) {
        const u32x4 b0 = *(const LAS u32x4*)(b + (s0 + u) * 32), b1 = *(const LAS u32x4*)(b + 32 * TROWB + (s0 + u) * 32);
        acc[0][0] = mfma_i8(a[0][u], b0, acc[0][0]); acc[0][1] = mfma_i8(a[0][u], b1, acc[0][1]);
        acc[1][0] = mfma_i8(a[1][u], b0, acc[1][0]); acc[1][1] = mfma_i8(a[1][u], b1, acc[1][1]);
    }
}
template <int KS, int CH = 4>
__device__ __forceinline__ void gemm22i(const u32x4* abase, unsigned lane, const LAS unsigned char* b, i32x16 (&acc)[2][2], int kofs = 0) {
    constexpr int NC = KS / CH;
    static_assert(NC % 2 == 0 && (NC & (NC - 1)) == 0, "chunk count: even power of two");
    u32x4 pa[2][CH], pb[2][CH];
    const unsigned lo = lane * 16u;
    {
        const unsigned o0 = lo + (unsigned)((kofs & (NC - 1)) * CH) * 1024u;
#pragma unroll
        for (int u = 0; u < CH; ++u) { pa[0][u] = ldg<u32x4>(abase, o0 + u * 1024u); pa[1][u] = ldg<u32x4>(abase, o0 + (KS + u) * 1024u); }
    }
#pragma unroll 1
    for (int c = 0; c < NC; c += 2) {
        const int c0 = (c + kofs) & (NC - 1), c1 = (c + 1 + kofs) & (NC - 1), c2 = (c + 2 + kofs) & (NC - 1);
        const unsigned o1 = lo + (unsigned)(c1 * CH) * 1024u, o2 = lo + (unsigned)(c2 * CH) * 1024u;
#pragma unroll
        for (int u = 0; u < CH; ++u) { pb[0][u] = ldg<u32x4>(abase, o1 + u * 1024u); pb[1][u] = ldg<u32x4>(abase, o1 + (KS + u) * 1024u); }
        __builtin_amdgcn_sched_barrier(0);
        gemm22i_chunk<CH>(pa, b, c0 * CH, acc);
        __builtin_amdgcn_sched_barrier(0);
#pragma unroll
        for (int u = 0; u < CH; ++u) { pa[0][u] = ldg<u32x4>(abase, o2 + u * 1024u); pa[1][u] = ldg<u32x4>(abase, o2 + (KS + u) * 1024u); }
        __builtin_amdgcn_sched_barrier(0);
        gemm22i_chunk<CH>(pb, b, c1 * CH, acc);
        __builtin_amdgcn_sched_barrier(0);
    }
}

__device__ __forceinline__ void p1_stage(const Params& p, int tile, int tid, LAS unsigned char* lds) {
    const int lane = tid & 63, wv = __builtin_amdgcn_readfirstlane(tid >> 6);
    LAS float* rs = (LAS float*)(lds + LDS_RS);
    const float* xt = p.x + (size_t)tile * 64 * D;
#pragma unroll 4
    for (int rr = 0; rr < 8; ++rr) {
        const int tk = 8 * wv + rr;
        f32x4 f[4]; float ss = 0.f, am = 0.f;
#pragma unroll
        for (int i = 0; i < 4; ++i) { f[i] = ldg<f32x4>(xt, (unsigned)(tk * D + i * 256 + 4 * lane) * 4u); ss += f[i][0] * f[i][0] + f[i][1] * f[i][1] + f[i][2] * f[i][2] + f[i][3] * f[i][3];
            am = fmaxf(am, fmaxf(fmaxf(fabsf(f[i][0]), fabsf(f[i][1])), fmaxf(fabsf(f[i][2]), fabsf(f[i][3])))); }
        ss = wave_sum(ss);
#pragma unroll
        for (int o = 32; o > 0; o >>= 1) am = fmaxf(am, __shfl_xor(am, o));
        const float inv = am > 0.f ? 127.0f / am : 0.f;
        if (lane == 0) rs[tk] = rsqrtf(ss * (1.0f / D) + EPS) * am * (1.0f / 127.0f);
#pragma unroll
        for (int i = 0; i < 4; ++i) {
            unsigned w = 0u;
#pragma unroll
            for (int e = 0; e < 4; ++e) w |= ((unsigned)(int)rintf(f[i][e] * inv) & 255u) << (8 * e);
            *(LAS unsigned*)(lds + tk * TROWB + i * 256 + 4 * lane) = w;
        }
    }
    __syncthreads();
}
__device__ __forceinline__ void p1_inproj(const Params& p, int tile, int tid, LAS unsigned char* lds, int vb, int nb, bool do_tab) {
    const int lane = launder(tid) & 63, wv = __builtin_amdgcn_readfirstlane(tid >> 6), r = lane & 31, h = lane >> 5;
    const int b = tile >> 6, s0 = (tile & 63) * 64;
    LAS float* rs = (LAS float*)(lds + LDS_RS);
    const u32x4* WF = (const u32x4*)(p.winf);
    unsigned char* prow0 = p.proj + ((size_t)b * L + NMETA + s0) * (MIXIN * 2);
    const LAS unsigned char* bp = lds + r * TROWB + h * 16;
    const float rs0 = rs[r], rs1 = rs[32 + r];
    const int stg_k = (tile >> 3) & 7, stg_r = (tile >> 6) & 3;
#pragma unroll 1
    for (int rdx = 0; rdx < 4; ++rdx) {
        const int rd = (rdx + stg_r) & 3;
        const int i0 = 8 * wv + 2 * rd;
        TabBatch tb;
        if (do_tab) tab_issue(p, vb, nb, wv, 4 * rdx, lane, tb);
        __builtin_amdgcn_sched_barrier(0);
        i32x16 acc[2][2]; acc[0][0] = izero16(); acc[0][1] = izero16(); acc[1][0] = izero16(); acc[1][1] = izero16();
        gemm22i<32, 4>(WF + (size_t)i0 * 32 * 64, lane, bp, acc, stg_k);
        f32x4 wsv[2][4];
#pragma unroll
        for (int mi = 0; mi < 2; ++mi)
#pragma unroll
            for (int q = 0; q < 4; ++q) wsv[mi][q] = ldg<f32x4>(p.wsci, (unsigned)(32 * (i0 + mi) + 8 * q + 4 * h) * 4u);
        LAS unsigned char* eb = lds + 64 * TROWB + wv * 8192;
#pragma unroll
        for (int mi = 0; mi < 2; ++mi)
#pragma unroll
            for (int q = 0; q < 4; ++q) {
                const f32x4 ws = wsv[mi][q];
#pragma unroll
                for (int nt = 0; nt < 2; ++nt) {
                    const float rv = nt ? rs1 : rs0;
                    u32x2 o; o.x = pk_bf16((float)acc[mi][nt][4 * q] * rv * ws[0], (float)acc[mi][nt][4 * q + 1] * rv * ws[1]); o.y = pk_bf16((float)acc[mi][nt][4 * q + 2] * rv * ws[2], (float)acc[mi][nt][4 * q + 3] * rv * ws[3]);
                    *(LAS u32x2*)(eb + (nt * 32 + r) * 128 + (((4 * mi + q) ^ (r & 7)) * 16) + 8 * h) = o;
                }
            }
        {
            u32x4 ov[8];
#pragma unroll
            for (int k = 0; k < 8; ++k) { const int row = 8 * k + (lane >> 3); ov[k] = *(const LAS u32x4*)(eb + row * 128 + (((lane & 7) ^ (row & 7)) * 16)); }
#pragma unroll
            for (int k = 0; k < 8; ++k) { const int row = 8 * k + (lane >> 3); stg<u32x4>(prow0, (unsigned)(row * MIXIN + 32 * i0) * 2u + (unsigned)(lane & 7) * 16u, ov[k]); }
        }
        if (do_tab) tab_finish(p, vb, nb, wv, 4 * rdx, lane, tb);
    }
    if (do_tab) for (int i0 = 16; 8 * i0 < tab_rpb(nb); i0 += 4) { TabBatch tb; tab_issue(p, vb, nb, wv, i0, lane, tb); tab_finish(p, vb, nb, wv, i0, lane, tb); }
}
__device__ __forceinline__ void p1_meta(const Params& p, int mp, int lane) {
    const int r = lane & 31, h = lane >> 5;
    const u32x4* A = (const u32x4*)(p.winf) + (size_t)(2 * mp) * 32 * 64;
    const u32x4* B = (const u32x4*)(p.metaf);
    i32x16 acc0 = izero16(), acc1 = izero16();
#pragma unroll 4
    for (int s = 0; s < 32; ++s) { const u32x4 bf = ldg<u32x4>(B, (unsigned)(s * 64 + lane) * 16u);
        acc0 = mfma_i8(ldg<u32x4>(A, (unsigned)(s * 64 + lane) * 16u), bf, acc0); acc1 = mfma_i8(ldg<u32x4>(A, (unsigned)((32 + s) * 64 + lane) * 16u), bf, acc1); }
    if (r < NMETA) {
        const float rv = ((const float*)(p.rsm))[r];
#pragma unroll
        for (int q = 0; q < 4; ++q) {
            const f32x4 w0 = ldg<f32x4>(p.wsci, (unsigned)(64 * mp + 8 * q + 4 * h) * 4u), w1 = ldg<f32x4>(p.wsci, (unsigned)(64 * mp + 32 + 8 * q + 4 * h) * 4u);
            u32x2 o0, o1;
            o0.x = pk_bf16((float)acc0[4 * q] * rv * w0[0], (float)acc0[4 * q + 1] * rv * w0[1]); o0.y = pk_bf16((float)acc0[4 * q + 2] * rv * w0[2], (float)acc0[4 * q + 3] * rv * w0[3]);
            o1.x = pk_bf16((float)acc1[4 * q] * rv * w1[0], (float)acc1[4 * q + 1] * rv * w1[1]); o1.y = pk_bf16((float)acc1[4 * q + 2] * rv * w1[2], (float)acc1[4 * q + 3] * rv * w1[3]);
#pragma unroll
            for (int bb = 0; bb < BATCH; ++bb) {
                const unsigned ro = (unsigned)((bb * L + r) * MIXIN + 64 * mp + 4 * h) * 2u;
                stg<u32x2>(p.proj, ro + 16u * q, o0); stg<u32x2>(p.proj, ro + 64u + 16u * q, o1);
            }
        }
    }
}

template <int LOGN> __device__ __forceinline__ void bitonic_sort_desc(float* v) {
    constexpr int N = 1 << LOGN;
#pragma unroll
    for (int lk = 1; lk <= LOGN; ++lk) {
#pragma unroll
        for (int lj = lk - 1; lj >= 0; --lj) {
#pragma unroll
            for (int i = 0; i < N; ++i) {
                const int k = 1 << lk, j = 1 << lj, l = i ^ j;
                if (l > i) { const bool up = ((i & k) == 0); const float a = v[i], c = v[l]; const float hi = fmaxf(a, c), lo = fminf(a, c); v[i] = up ? hi : lo; v[l] = up ? lo : hi; }
            }
        }
    }
}
__device__ __forceinline__ void bitonic_merge16_desc(float* v) {
#pragma unroll
    for (int lj = 3; lj >= 0; --lj) {
#pragma unroll
        for (int i = 0; i < 16; ++i) { const int j = 1 << lj, l = i ^ j; if (l > i) { const float a = v[i], c = v[l]; v[i] = fmaxf(a, c); v[l] = fminf(a, c); } }
    }
}
__device__ __forceinline__ void merge_top16(float* a, const float* c) {
#pragma unroll
    for (int i = 0; i < 16; ++i) a[i] = fmaxf(a[i], c[15 - i]);
    bitonic_merge16_desc(a);
}
__device__ __forceinline__ void top16_of_64(float* v) {
    bitonic_sort_desc<4>(v); bitonic_sort_desc<4>(v + 16); bitonic_sort_desc<4>(v + 32); bitonic_sort_desc<4>(v + 48);
    merge_top16(v, v + 16); merge_top16(v + 32, v + 48); merge_top16(v, v + 32);
}
__device__ __forceinline__ float embed_bits(float x, unsigned mask, unsigned code) { return __builtin_bit_cast(float, (__builtin_bit_cast(unsigned, x) & ~mask) | code); }

template <int W>
__device__ __forceinline__ void pool_window(const unsigned char* pbat, int p0, int cp, LAS unsigned char* dst) {
    unsigned u[31 + W];
#pragma unroll
    for (int i = 0; i < 31 + W; ++i) u[i] = ldg<unsigned>(pbat + (size_t)(p0 - (W - 1) + i) * 4096u, cp * 4u);
    float sx = 0.f, sy = 0.f;
#pragma unroll
    for (int i = 0; i < W - 1; ++i) { sx += bf_lo(u[i]); sy += bf_hi(u[i]); }
    const float invw = 1.0f / (float)W;
#pragma unroll
    for (int tk = 0; tk < 32; ++tk) {
        const float lo = bf_lo(u[W - 1 + tk]), hi = bf_hi(u[W - 1 + tk]);
        sx += lo; sy += hi;
        *(LAS unsigned*)(dst + tk * TROW) = pk_bf16(sx * invw - lo, sy * invw - hi);
        sx -= bf_lo(u[tk]); sy -= bf_hi(u[tk]);
    }
}

template <int RB>
__device__ __forceinline__ void p2_xf_batch(const Params& p, int tile, int wv, int lane, LAS unsigned char* lds, unsigned char* ht, f32x4 (&f)[4][4], const u32x2 (&hq)[8][4], const f32x4 (&gg)[4]) {
    unsigned char* xqt = p.xq + (size_t)tile * 64 * D;
#pragma unroll
    for (int rr = 0; rr < 4; ++rr) {
        const int tk = 8 * wv + RB + rr;
        float ss = 0.f;
#pragma unroll
        for (int i = 0; i < 4; ++i) {
            const u32x2 hw = hq[RB + rr][i];
            f[rr][i][0] += bf_lo(hw.x); f[rr][i][1] += bf_hi(hw.x); f[rr][i][2] += bf_lo(hw.y); f[rr][i][3] += bf_hi(hw.y);
            u32x2 ho; ho.x = pk_bf16(f[rr][i][0], f[rr][i][1]); ho.y = pk_bf16(f[rr][i][2], f[rr][i][3]);
            stg<u32x2>(ht, (unsigned)(tk * D + i * 256 + 4 * lane) * 2u, ho);
            ss += f[rr][i][0] * f[rr][i][0] + f[rr][i][1] * f[rr][i][1] + f[rr][i][2] * f[rr][i][2] + f[rr][i][3] * f[rr][i][3];
        }
        ss = wave_sum(ss);
        const float rv = rsqrtf(ss * (1.0f / D) + EPS);
        float am = 0.f;
#pragma unroll
        for (int i = 0; i < 4; ++i)
#pragma unroll
            for (int e = 0; e < 4; ++e) { f[rr][i][e] *= rv * gg[i][e]; am = fmaxf(am, fabsf(f[rr][i][e])); }
#pragma unroll
        for (int o = 32; o > 0; o >>= 1) am = fmaxf(am, __shfl_xor(am, o));
        const float inv = am > 0.f ? 127.0f / am : 0.f;
#pragma unroll
        for (int i = 0; i < 4; ++i) {
            unsigned w = 0u;
#pragma unroll
            for (int e = 0; e < 4; ++e) w |= ((unsigned)(int)rintf(f[rr][i][e] * inv) & 255u) << (8 * e);
            stg<unsigned>(xqt, (unsigned)(tk * D + i * 256 + 4 * lane), w);
            *(LAS unsigned*)(lds + tk * TROWB + i * 256 + 4 * lane) = w;
        }
        if (lane == 0) { ((LAS float*)(lds + LDS_RS))[tk] = am * (1.0f / 127.0f); ((float*)p.sx)[tile * 64 + tk] = am * (1.0f / 127.0f); }
    }
}

__device__ __forceinline__ void p2_mix(const Params& p, int tile, int tid, LAS unsigned char* lds) {
    const int wv = __builtin_amdgcn_readfirstlane(tid >> 6);
    const int b = tile >> 6, s0 = (tile & 63) * 64;
    LAS float* ssa = (LAS float*)(lds + LDS_SSA);
    const unsigned char* pbat = p.proj + (size_t)b * L * (MIXIN * 2);
    const float* xt = p.x + (size_t)tile * 64 * D;
    unsigned char* ht = p.hb + (size_t)tile * 64 * D * 2;
    if (tid < 64) ssa[tid] = 0.f;
    {
        const int lane = launder(tid) & 63, r = lane & 31, h = lane >> 5; (void)r; (void)h;
        float cw[3][8], gbv[8], u1[8], u2[8];
#pragma unroll
        for (int k = 0; k < 3; ++k) { const f32x4 a = ldg<f32x4>(p.conv_w, (unsigned)(k * MIXB + 8 * lane) * 4u), c = ldg<f32x4>(p.conv_w, (unsigned)(k * MIXB + 8 * lane + 4) * 4u);
#pragma unroll
            for (int e = 0; e < 4; ++e) { cw[k][e] = a[e]; cw[k][4 + e] = c[e]; } }
        { const f32x4 a = ldg<f32x4>(p.g_b, (unsigned)(8 * lane) * 4u), c = ldg<f32x4>(p.g_b, (unsigned)(8 * lane + 4) * 4u);
#pragma unroll
            for (int e = 0; e < 4; ++e) { gbv[e] = a[e]; gbv[4 + e] = c[e]; } }
        const int p0 = NMETA + s0 + 8 * wv;
        u32x4 bvv[8], cvv[10], vvv[10];
#pragma unroll
        for (int i = 0; i < 10; ++i) { const unsigned ro = (unsigned)(p0 - 2 + i) * 4096u + lane * 16u; cvv[i] = ldg<u32x4>(pbat, ro + 2048u); vvv[i] = ldg<u32x4>(pbat, ro + 3072u); if (i >= 2) bvv[i - 2] = ldg<u32x4>(pbat, ro + 1024u); }
    {
        const int cp = tid & 255, th = __builtin_amdgcn_readfirstlane(tid >> 8), g = __builtin_amdgcn_readfirstlane(cp >> 6);
        const int p0 = NMETA + s0 + 32 * th;
        LAS unsigned char* dst = lds + (32 * th) * TROW + cp * 4;
        if (g == 0) pool_window<2>(pbat, p0, cp, dst); else if (g == 1) pool_window<4>(pbat, p0, cp, dst); else if (g == 2) pool_window<8>(pbat, p0, cp, dst); else pool_window<16>(pbat, p0, cp, dst);
    }
#pragma unroll
        for (int e = 0; e < 4; ++e) { u2[2 * e] = bf_lo(cvv[0][e]) * bf_lo(vvv[0][e]); u2[2 * e + 1] = bf_hi(cvv[0][e]) * bf_hi(vvv[0][e]); u1[2 * e] = bf_lo(cvv[1][e]) * bf_lo(vvv[1][e]); u1[2 * e + 1] = bf_hi(cvv[1][e]) * bf_hi(vvv[1][e]); }
#pragma unroll
        for (int tk = 0; tk < 8; ++tk) {
            const u32x4 bv = bvv[tk], cv = cvv[tk + 2], vv = vvv[tk + 2];
            float z[8], ss = 0.f;
#pragma unroll
            for (int e = 0; e < 8; ++e) {
                const float bb = (e & 1) ? bf_hi(bv[e >> 1]) : bf_lo(bv[e >> 1]);
                const float u0 = ((e & 1) ? bf_hi(cv[e >> 1]) : bf_lo(cv[e >> 1])) * ((e & 1) ? bf_hi(vv[e >> 1]) : bf_lo(vv[e >> 1]));
                const float conv = u2[e] * cw[0][e] + u1[e] * cw[1][e] + u0 * cw[2][e];
                z[e] = bb * conv; ss += z[e] * z[e];
                u2[e] = u1[e]; u1[e] = u0;
            }
            ss = wave_sum(ss);
            const float rsb = rsqrtf(ss * (1.0f / MIXB) + EPS);
            u32x4 o; o.x = pk_bf16(z[0] * rsb * gbv[0], z[1] * rsb * gbv[1]); o.y = pk_bf16(z[2] * rsb * gbv[2], z[3] * rsb * gbv[3]);
            o.z = pk_bf16(z[4] * rsb * gbv[4], z[5] * rsb * gbv[5]); o.w = pk_bf16(z[6] * rsb * gbv[6], z[7] * rsb * gbv[7]);
            *(LAS u32x4*)(lds + (8 * wv + tk) * TROW + (MIXA + 8 * lane) * 2) = o;
        }
    }
    __syncthreads();
    {
        const int lane = launder(tid) & 63, r = lane & 31, h = lane >> 5; (void)r; (void)h;
        const int g = wv >> 1, dh = wv & 1;
        const u32x4* PWF = (const u32x4*)(p.pwf);
        f32x16 acc[2][2]; acc[0][0] = zero16(); acc[0][1] = zero16(); acc[1][0] = zero16(); acc[1][1] = zero16();
        gemm22<8>(PWF + (size_t)((g * 4 + 2 * dh) * 8) * 64, lane, lds + r * TROW + g * 256 + h * 16, acc);
        float ss0 = 0.f, ss1 = 0.f;
#pragma unroll
        for (int mi = 0; mi < 2; ++mi)
#pragma unroll
            for (int q = 0; q < 4; ++q) {
                const int d = g * 128 + 32 * (2 * dh + mi) + 8 * q + 4 * h;
                const f32x4 sc = ldg<f32x4>(p.pool_scale, (unsigned)d * 4u);
#pragma unroll
                for (int e = 0; e < 4; ++e) { acc[mi][0][4 * q + e] *= sc[e]; acc[mi][1][4 * q + e] *= sc[e]; ss0 += acc[mi][0][4 * q + e] * acc[mi][0][4 * q + e]; ss1 += acc[mi][1][4 * q + e] * acc[mi][1][4 * q + e]; }
            }
        ss0 += __shfl_xor(ss0, 32); ss1 += __shfl_xor(ss1, 32);
        if (h == 0) { atomicAdd((float*)(ssa + r), ss0); atomicAdd((float*)(ssa + 32 + r), ss1); }
        __syncthreads();
        const float ra0 = rsqrtf(ssa[r] * (1.0f / MIXA) + EPS), ra1 = rsqrtf(ssa[32 + r] * (1.0f / MIXA) + EPS);
#pragma unroll
        for (int mi = 0; mi < 2; ++mi)
#pragma unroll
            for (int q = 0; q < 4; ++q) {
                const int d = g * 128 + 32 * (2 * dh + mi) + 8 * q + 4 * h;
                const f32x4 gg = ldg<f32x4>(p.g_a, (unsigned)d * 4u);
                u32x2 o0, o1;
                o0.x = pk_bf16(acc[mi][0][4 * q] * ra0 * gg[0], acc[mi][0][4 * q + 1] * ra0 * gg[1]); o0.y = pk_bf16(acc[mi][0][4 * q + 2] * ra0 * gg[2], acc[mi][0][4 * q + 3] * ra0 * gg[3]);
                o1.x = pk_bf16(acc[mi][1][4 * q] * ra1 * gg[0], acc[mi][1][4 * q + 1] * ra1 * gg[1]); o1.y = pk_bf16(acc[mi][1][4 * q + 2] * ra1 * gg[2], acc[mi][1][4 * q + 3] * ra1 * gg[3]);
                *(LAS u32x2*)(lds + r * TROW + d * 2) = o0;
                *(LAS u32x2*)(lds + (32 + r) * TROW + d * 2) = o1;
            }
    }
    __syncthreads();
    f32x4 xa[4][4];
    {
        const int lane = launder(tid) & 63, r = lane & 31, h = lane >> 5; (void)r; (void)h;
#pragma unroll
        for (int rr = 0; rr < 4; ++rr)
#pragma unroll
            for (int i = 0; i < 4; ++i) xa[rr][i] = ldg<f32x4>(xt, (unsigned)((8 * wv + rr) * D + i * 256 + 4 * lane) * 4u);
        const u32x4* WF = (const u32x4*)(p.woutf);
        const LAS unsigned char* bp = lds + r * TROW + h * 16;
#pragma unroll 1
        for (int rdx = 0; rdx < 2; ++rdx) {
            const int rd = (rdx + (tile >> 7)) & 1;
            const int i0 = 4 * wv + 2 * rd;
            f32x16 acc[2][2]; acc[0][0] = zero16(); acc[0][1] = zero16(); acc[1][0] = zero16(); acc[1][1] = zero16();
            gemm22<64>(WF + (size_t)i0 * 64 * 64, lane, bp, acc, (tile >> 3) & 15);
#pragma unroll
            for (int mi = 0; mi < 2; ++mi)
#pragma unroll
                for (int q = 0; q < 4; ++q)
#pragma unroll
                    for (int nt = 0; nt < 2; ++nt) {
                        const unsigned ro = (unsigned)((nt * 32 + r) * D + 32 * (i0 + mi) + 4 * h) * 2u + 16u * q;
                        u32x2 hw; hw.x = pk_bf16(acc[mi][nt][4 * q], acc[mi][nt][4 * q + 1]); hw.y = pk_bf16(acc[mi][nt][4 * q + 2], acc[mi][nt][4 * q + 3]); stg<u32x2>(ht, ro, hw);
                    }
        }
    }
    __syncthreads();
    {
        const int lane = launder(tid) & 63;
        f32x4 gg[4];
#pragma unroll
        for (int i = 0; i < 4; ++i) gg[i] = ldg<f32x4>(p.g_ffn, (unsigned)(i * 256 + 4 * lane) * 4u);
        f32x4 xb[4][4];
#pragma unroll
        for (int rr = 0; rr < 4; ++rr)
#pragma unroll
            for (int i = 0; i < 4; ++i) xb[rr][i] = ldg<f32x4>(xt, (unsigned)((8 * wv + 4 + rr) * D + i * 256 + 4 * lane) * 4u);
        u32x2 hq[8][4];
#pragma unroll
        for (int rr = 0; rr < 4; ++rr)
#pragma unroll
            for (int i = 0; i < 4; ++i) hq[rr][i] = ldg<u32x2>(ht, (unsigned)((8 * wv + rr) * D + i * 256 + 4 * lane) * 2u);
        p2_xf_batch<0>(p, tile, wv, lane, lds, ht, xa, hq, gg);
#pragma unroll
        for (int rr = 4; rr < 8; ++rr)
#pragma unroll
            for (int i = 0; i < 4; ++i) hq[rr][i] = ldg<u32x2>(ht, (unsigned)((8 * wv + rr) * D + i * 256 + 4 * lane) * 2u);
        p2_xf_batch<4>(p, tile, wv, lane, lds, ht, xb, hq, gg);
    }
    __syncthreads();
    {
        const int lane = launder(tid) & 63, r = lane & 31, h = lane >> 5; (void)r; (void)h;
        const int hd = wv;
        const u32x4* WQF = (const u32x4*)(p.wqf);
        const u32x4* KF = (const u32x4*)(p.kf);
        unsigned char* lstt = p.lst + (size_t)tile * 64 * (NH * 32 * 4);
        unsigned char* idxt = p.idx + (size_t)tile * 64 * (HK * 2);
        unsigned char* gatet = p.gate + (size_t)tile * 64 * (HK * 4);
        const LAS unsigned char* bp = lds + r * TROWB + h * 16;
        const float sx0 = ((const LAS float*)(lds + LDS_RS))[r], sx1 = ((const LAS float*)(lds + LDS_RS))[32 + r];
        LAS unsigned char* lut = lds + LDS_LUT + wv * 2048;
#pragma unroll
        for (int pp = 0; pp < 2; ++pp) {
            const int hp = hd * 2 + pp;
            u32x4 qb[8];
            LAS u32x4* qpark = (LAS u32x4*)(lds + 64 * TROWB + wv * 8192) + lane;
#pragma unroll
            for (int mh = 0; mh < 2; ++mh) {
                const int mt0 = hp * 4 + mh * 2;
                i32x16 acc[2][2]; acc[0][0] = izero16(); acc[0][1] = izero16(); acc[1][0] = izero16(); acc[1][1] = izero16();
                gemm22i<32, QCH>(WQF + (size_t)mt0 * 32 * 64, lane, bp, acc, (tile >> 3));
#pragma unroll
                for (int mi = 0; mi < 2; ++mi)
#pragma unroll
                    for (int s2 = 0; s2 < 2; ++s2) {
                        const f32x4 w0 = ldg<f32x4>(p.wscq, (unsigned)(32 * (mt0 + mi) + 16 * s2 + 4 * h) * 4u), w1 = ldg<f32x4>(p.wscq, (unsigned)(32 * (mt0 + mi) + 16 * s2 + 8 + 4 * h) * 4u);
#pragma unroll
                        for (int nt = 0; nt < 2; ++nt) {
                            const float xs = nt ? sx1 : sx0;
                            u32x4 o; o.x = pk_bf16((float)acc[mi][nt][8 * s2] * xs * w0[0], (float)acc[mi][nt][8 * s2 + 1] * xs * w0[1]); o.y = pk_bf16((float)acc[mi][nt][8 * s2 + 2] * xs * w0[2], (float)acc[mi][nt][8 * s2 + 3] * xs * w0[3]);
                            o.z = pk_bf16((float)acc[mi][nt][8 * s2 + 4] * xs * w1[0], (float)acc[mi][nt][8 * s2 + 5] * xs * w1[1]); o.w = pk_bf16((float)acc[mi][nt][8 * s2 + 6] * xs * w1[2], (float)acc[mi][nt][8 * s2 + 7] * xs * w1[3]);
                            if (nt == 0) qb[2 * (mh * 2 + mi) + s2] = o; else qpark[(2 * (mh * 2 + mi) + s2) * 64] = o;
                        }
                    }
            }
#pragma unroll
            for (int nt = 0; nt < 2; ++nt) {
                float top[16];
#pragma unroll
                for (int i = 0; i < 16; ++i) top[i] = -INFINITY;
                if (nt == 1) {
#pragma unroll
                    for (int ks = 0; ks < 8; ++ks) qb[ks] = qpark[ks * 64];
                }
                const u32x4* kfp = KF + (size_t)(hp * 4 * 8) * 64;
                u32x4 kf[8];
#pragma unroll
                for (int ks = 0; ks < 8; ++ks) kf[ks] = ldg<u32x4>(kfp, (unsigned)(ks * 64 + lane) * 16u);
#pragma unroll 1
                for (int kt = 0; kt < 4; ++kt) {
                    f32x16 sa = zero16();
#pragma unroll
                    for (int ks = 0; ks < 8; ++ks) sa = mfma32(kf[ks], qb[ks], sa);
                    __builtin_amdgcn_sched_barrier(0);
                    const int ktn = (kt + 1) & 3;
#pragma unroll
                    for (int ks = 0; ks < 8; ++ks) kf[ks] = ldg<u32x4>(kfp, (unsigned)((ktn * 8 + ks) * 64 + lane) * 16u);
                    __builtin_amdgcn_sched_barrier(0);
                    float v[16];
#pragma unroll
                    for (int i = 0; i < 16; ++i) v[i] = embed_bits(sa[i], 127u, (unsigned)(32 * kt + (i & 3) + 8 * (i >> 2) + 4 * h));
                    bitonic_sort_desc<4>(v); merge_top16(top, v);
                    __builtin_amdgcn_sched_barrier(0);
                }
                float o[16];
#pragma unroll
                for (int i = 0; i < 16; ++i) o[i] = __shfl_xor(top[i], 32);
                merge_top16(top, o);
                if (h == 0) {
                    const unsigned lo = (unsigned)((((nt * 32 + r) * NH + hd) * 2 + pp) * 16) * 4u;
#pragma unroll
                    for (int w4 = 0; w4 < 4; ++w4) { f32x4 tv; tv[0] = top[4 * w4]; tv[1] = top[4 * w4 + 1]; tv[2] = top[4 * w4 + 2]; tv[3] = top[4 * w4 + 3]; stg<f32x4>(lstt, lo + 16u * w4, tv); }
                    u32x4 kb;
#pragma unroll
                    for (int w4 = 0; w4 < 4; ++w4) kb[w4] = (__builtin_bit_cast(unsigned, top[4 * w4]) & 127u) | ((__builtin_bit_cast(unsigned, top[4 * w4 + 1]) & 127u) << 8) | ((__builtin_bit_cast(unsigned, top[4 * w4 + 2]) & 127u) << 16) | ((__builtin_bit_cast(unsigned, top[4 * w4 + 3]) & 127u) << 24);
                    *(LAS u32x4*)(lut + ((nt * 32 + r) * 2 + pp) * 16) = kb;
                }
            }
        }
#pragma unroll
        for (int nt = 0; nt < 2; ++nt) {
            float s1[16], s2[16];
            {
                const unsigned lo = (unsigned)(((nt * 32 + r) * NH + hd) * 32) * 4u;
#pragma unroll
                for (int w4 = 0; w4 < 4; ++w4) { const f32x4 a = ldg<f32x4>(lstt, lo + 16u * w4), c = ldg<f32x4>(lstt, lo + 64u + 16u * w4);
#pragma unroll
                    for (int e4 = 0; e4 < 4; ++e4) { s1[4 * w4 + e4] = a[e4]; s2[4 * w4 + e4] = c[e4]; } }
            }
            float top[16];
#pragma unroll
            for (int i = 0; i < 16; ++i) top[i] = -INFINITY;
            { float v[16]; v[0] = embed_bits(s1[0] + s2[0], 255u, 0u); v[1] = embed_bits(s1[0] + s2[1], 255u, 1u); v[2] = embed_bits(s1[0] + s2[2], 255u, 2u); v[3] = embed_bits(s1[0] + s2[3], 255u, 3u); v[4] = embed_bits(s1[0] + s2[4], 255u, 4u); v[5] = embed_bits(s1[0] + s2[5], 255u, 5u); v[6] = embed_bits(s1[0] + s2[6], 255u, 6u); v[7] = embed_bits(s1[0] + s2[7], 255u, 7u); v[8] = embed_bits(s1[0] + s2[8], 255u, 8u); v[9] = embed_bits(s1[0] + s2[9], 255u, 9u); v[10] = embed_bits(s1[0] + s2[10], 255u, 10u); v[11] = embed_bits(s1[0] + s2[11], 255u, 11u); v[12] = embed_bits(s1[0] + s2[12], 255u, 12u); v[13] = embed_bits(s1[0] + s2[13], 255u, 13u); v[14] = embed_bits(s1[0] + s2[14], 255u, 14u); v[15] = embed_bits(s1[0] + s2[15], 255u, 15u);
              bitonic_sort_desc<4>(v); merge_top16(top, v); }
            { float v[16]; v[0] = embed_bits(s1[1] + s2[0], 255u, 16u); v[1] = embed_bits(s1[1] + s2[1], 255u, 17u); v[2] = embed_bits(s1[1] + s2[2], 255u, 18u); v[3] = embed_bits(s1[1] + s2[3], 255u, 19u); v[4] = embed_bits(s1[1] + s2[4], 255u, 20u); v[5] = embed_bits(s1[1] + s2[5], 255u, 21u); v[6] = embed_bits(s1[1] + s2[6], 255u, 22u); v[7] = embed_bits(s1[1] + s2[7], 255u, 23u); v[8] = embed_bits(s1[2] + s2[0], 255u, 32u); v[9] = embed_bits(s1[2] + s2[1], 255u, 33u); v[10] = embed_bits(s1[2] + s2[2], 255u, 34u); v[11] = embed_bits(s1[2] + s2[3], 255u, 35u); v[12] = embed_bits(s1[2] + s2[4], 255u, 36u); v[13] = embed_bits(s1[3] + s2[0], 255u, 48u); v[14] = embed_bits(s1[3] + s2[1], 255u, 49u); v[15] = embed_bits(s1[3] + s2[2], 255u, 50u);
              bitonic_sort_desc<4>(v); merge_top16(top, v); }
            { float v[16]; v[0] = embed_bits(s1[3] + s2[3], 255u, 51u); v[1] = embed_bits(s1[4] + s2[0], 255u, 64u); v[2] = embed_bits(s1[4] + s2[1], 255u, 65u); v[3] = embed_bits(s1[4] + s2[2], 255u, 66u); v[4] = embed_bits(s1[5] + s2[0], 255u, 80u); v[5] = embed_bits(s1[5] + s2[1], 255u, 81u); v[6] = embed_bits(s1[6] + s2[0], 255u, 96u); v[7] = embed_bits(s1[6] + s2[1], 255u, 97u); v[8] = embed_bits(s1[7] + s2[0], 255u, 112u); v[9] = embed_bits(s1[7] + s2[1], 255u, 113u); v[10] = embed_bits(s1[8] + s2[0], 255u, 128u); v[11] = embed_bits(s1[9] + s2[0], 255u, 144u); v[12] = embed_bits(s1[10] + s2[0], 255u, 160u); v[13] = embed_bits(s1[11] + s2[0], 255u, 176u); v[14] = embed_bits(s1[12] + s2[0], 255u, 192u); v[15] = embed_bits(s1[13] + s2[0], 255u, 208u);
              bitonic_sort_desc<4>(v); merge_top16(top, v); }
            { float v[16]; v[0] = embed_bits(s1[14] + s2[0], 255u, 224u); v[1] = embed_bits(s1[15] + s2[0], 255u, 240u); v[2] = -INFINITY; v[3] = -INFINITY; v[4] = -INFINITY; v[5] = -INFINITY; v[6] = -INFINITY; v[7] = -INFINITY; v[8] = -INFINITY; v[9] = -INFINITY; v[10] = -INFINITY; v[11] = -INFINITY; v[12] = -INFINITY; v[13] = -INFINITY; v[14] = -INFINITY; v[15] = -INFINITY;
              bitonic_sort_desc<4>(v); merge_top16(top, v); }
            float e[16], sum = 0.f;
#pragma unroll
            for (int i = 0; i < 16; ++i) { e[i] = __expf(top[i] - top[0]); sum += e[i]; }
            const float inv = 1.0f / sum;
            const unsigned to = (unsigned)((nt * 32 + r) * HK + 2 * hd) * 4u;
            const LAS unsigned char* lt = lut + (nt * 32 + r) * 32;
            if (h == 0) {
                int ids[16];
#pragma unroll
                for (int i = 0; i < 16; ++i) { const unsigned code = __builtin_bit_cast(unsigned, top[i]) & 255u; ids[i] = (int)lt[code >> 4] * NKEYS + (int)lt[16 + (code & 15u)]; }
#pragma unroll
                for (int i = 0; i < 8; ++i) stg<unsigned>(idxt, (to >> 1) + (unsigned)(16 * i) * 2u, (unsigned)ids[i] | ((unsigned)ids[i + 8] << 16));
            } else {
#pragma unroll
                for (int i = 0; i < 8; ++i) { f32x2 gv; gv[0] = e[i] * inv; gv[1] = e[i + 8] * inv; stg<f32x2>(gatet, to + (unsigned)(16 * i) * 4u, gv); }
            }
        }
    }
}

__device__ __forceinline__ int dot16_i8(u32x4 a, u32x4 b) {
    int d = __builtin_amdgcn_sdot4((int)a[0], (int)b[0], 0, false);
    d = __builtin_amdgcn_sdot4((int)a[1], (int)b[1], d, false); d = __builtin_amdgcn_sdot4((int)a[2], (int)b[2], d, false); d = __builtin_amdgcn_sdot4((int)a[3], (int)b[3], d, false);
    return d;
}
__device__ __forceinline__ float gelu_exact(float z) { return 0.5f * z * (1.0f + erff(z * 0.70710678118654752f)); }

struct GMeta { int ids[16]; u32x4 x; };
struct GRows { u32x4 v[16]; };
__device__ __forceinline__ void g_rows(const unsigned char* slice, const GMeta& m, int lane, GRows& r) {
    const unsigned co = (unsigned)(lane & 7) * 16u;
#pragma unroll
    for (int i = 0; i < 16; ++i) r.v[i] = ldg<u32x4>(slice, (unsigned)m.ids[i] * 128u + co);
}

constexpr int P3W_Z = 0, P3W_CQ = 4096, P3W_SC = 5120, P3W_SSQ = 5152, P3W_ID = 5184, P3W_X = 7232, P3W_BYTES = 15424;
__device__ __forceinline__ void p3_wave(const Params& p, int tb0, int tb1, int lt, int pos, int lane, LAS unsigned char* wl) {
    const int ntok = 1 << lt, nts = 8 << lt;
    auto tokf = [&](int q) { return (q < 4 ? tb0 : tb1) + (q & 3); };
    const int grp = lane >> 3, ch = lane & 7, i0 = ((ch >> 2) & 1) * 8 + ((ch >> 1) & 1) * 4 + (ch & 1) * 2;
    LAS int* zl = (LAS int*)(wl + P3W_Z);
    LAS float* scl = (LAS float*)(wl + P3W_SC);
    LAS float* ssl = (LAS float*)(wl + P3W_SSQ);
#pragma unroll
    for (int q = 0; q < 8; ++q) if (q < ntok) {
        const int t = tokf(q);
        *(LAS unsigned*)(wl + P3W_ID + q * 256 + lane * 4) = ldg<unsigned>(p.idx + (size_t)t * (HK * 2), (unsigned)lane * 4u);
        *(LAS u32x4*)(wl + P3W_X + q * 1024 + lane * 16) = ldg<u32x4>(p.xq + (size_t)t * D, (unsigned)lane * 16u);
    }
    auto ids_lds = [&](int q, GMeta& m) {
#pragma unroll
        for (int w = 0; w < 2; ++w) { const u32x4 a = *(const LAS u32x4*)(wl + P3W_ID + q * 256 + grp * 32 + 16 * w);
#pragma unroll
            for (int e = 0; e < 4; ++e) { m.ids[8 * w + 2 * e] = (int)(a[e] & 0xffffu); m.ids[8 * w + 2 * e + 1] = (int)(a[e] >> 16); } }
    };
#pragma unroll 1
    for (int st = 0; st < 8; ++st) {
        const int j = (pos + st) & 7;
        const unsigned char* slice = p.eut + (size_t)j * (16384 * 128);
        const unsigned xo = (unsigned)(128 * j + 16 * ch);
#pragma unroll 1
        for (int q = 0; q < ntok; ++q) {
            const int t = tokf(q);
            GMeta m; GRows r; ids_lds(q, m); m.x = *(const LAS u32x4*)(wl + P3W_X + q * 1024 + xo); g_rows(slice, m, lane, r); (void)t;
            int part[16];
#pragma unroll
            for (int i = 0; i < 16; ++i) part[i] = dot16_i8(r.v[i], m.x);
#pragma unroll
            for (int lv = 2; lv >= 0; --lv) {
                const int n = 2 << lv, off = 1 << lv;
                const bool up = (lane & off) != 0;
#pragma unroll
                for (int i = 0; i < n; ++i) { const int a = part[i], c = part[i + n]; const int send = up ? a : c, keep = up ? c : a; part[i] = keep + __shfl_xor(send, off); }
            }
            LAS int* zp = zl + q * 128 + 2 * lane;
            if (st == 0) { zp[0] = part[0]; zp[1] = part[1]; } else { zp[0] += part[0]; zp[1] += part[1]; }
        }
    }
    {
        const unsigned po = (unsigned)(grp * 16 + i0) * 4u, po2 = (unsigned)(grp * 16 + i0) * 2u;
        unsigned idw[8]; f32x2 g[8]; float sx[8];
#pragma unroll
        for (int q = 0; q < 8; ++q) { const int t = tokf(q < ntok ? q : 0); idw[q] = *(const LAS unsigned*)(wl + P3W_ID + (q < ntok ? q : 0) * 256 + po2); g[q] = ldg<f32x2>(p.gate + (size_t)t * (HK * 4), po); sx[q] = ((const float*)p.sx)[t]; }
        float su0[8], su1[8], sv0[8], sv1[8];
#pragma unroll
        for (int q = 0; q < 8; ++q) { const int a = (int)(idw[q] & 0xffffu), c = (int)(idw[q] >> 16); su0[q] = ((const float*)p.su)[a]; su1[q] = ((const float*)p.su)[c]; sv0[q] = ((const float*)p.sv)[a]; sv1[q] = ((const float*)p.sv)[c]; }
#pragma unroll
        for (int q = 0; q < 8; ++q) if (q < ntok) {
            const int z0 = zl[q * 128 + 2 * lane], z1 = zl[q * 128 + 2 * lane + 1];
            const float c0 = g[q][0] * gelu_exact((float)z0 * (sx[q] * su0[q])) * sv0[q];
            const float c1 = g[q][1] * gelu_exact((float)z1 * (sx[q] * su1[q])) * sv1[q];
            float am = fmaxf(fabsf(c0), fabsf(c1));
#pragma unroll
            for (int o = 32; o > 0; o >>= 1) am = fmaxf(am, __shfl_xor(am, o));
            const float inv = am > 0.f ? 127.0f / am : 0.f;
            const unsigned q0 = (unsigned)(int)rintf(c0 * inv) & 255u, q1 = (unsigned)(int)rintf(c1 * inv) & 255u;
            *(LAS unsigned short*)(wl + P3W_CQ + q * 128 + 16 * grp + i0) = (unsigned short)(q0 | (q1 << 8));
            if (lane == 0) { scl[q] = am * (1.0f / 127.0f); ssl[q] = 0.f; }
        }
    }
    {
        const int e0 = ((lane >> 5) & 1) * 8 + ((lane >> 4) & 1) * 4 + ((lane >> 3) & 1) * 2;
        auto meta = [&](int n, GMeta& m, float& sc, f32x2& hv) {
            const int nn = n < nts ? n : nts - 1, q = nn & (ntok - 1), j = (pos + (nn >> lt)) & 7, t = tokf(q);
            ids_lds(q, m);
            m.x = *(const LAS u32x4*)(wl + P3W_CQ + q * 128 + 16 * grp);
            sc = scl[q];
            { const unsigned hw = ldg<unsigned>(p.hb + (size_t)t * D * 2, (unsigned)(128 * j + 16 * ch + e0) * 2u); hv[0] = bf_lo(hw); hv[1] = bf_hi(hw); }
        };
        auto rows = [&](int n, const GMeta& m, GRows& r) { const int nn = n < nts ? n : nts - 1; g_rows(p.evt + (size_t)((pos + (nn >> lt)) & 7) * (16384 * 128), m, lane, r); };
        auto finish = [&](int n, const GMeta& m, const GRows& r, float sc, f32x2 hv) {
            const int q = n & (ntok - 1), j = (pos + (n >> lt)) & 7, t = tokf(q);
            int acc[16];
#pragma unroll
            for (int e = 0; e < 16; ++e) acc[e] = 0;
#pragma unroll
            for (int g = 0; g < 4; ++g)
#pragma unroll
                for (int e = 0; e < 4; ++e) {
                    const unsigned A = r.v[4 * g][e], B = r.v[4 * g + 1][e], C = r.v[4 * g + 2][e], Dd = r.v[4 * g + 3][e];
                    const unsigned t0 = __builtin_amdgcn_perm(B, A, 0x05010400u), t1 = __builtin_amdgcn_perm(B, A, 0x07030602u);
                    const unsigned t2 = __builtin_amdgcn_perm(Dd, C, 0x05010400u), t3 = __builtin_amdgcn_perm(Dd, C, 0x07030602u);
                    const unsigned r0 = __builtin_amdgcn_perm(t2, t0, 0x05040100u), r1 = __builtin_amdgcn_perm(t2, t0, 0x07060302u);
                    const unsigned r2 = __builtin_amdgcn_perm(t3, t1, 0x05040100u), r3 = __builtin_amdgcn_perm(t3, t1, 0x07060302u);
                    const int cq = (int)m.x[g];
                    acc[4 * e] = __builtin_amdgcn_sdot4((int)r0, cq, acc[4 * e], false); acc[4 * e + 1] = __builtin_amdgcn_sdot4((int)r1, cq, acc[4 * e + 1], false);
                    acc[4 * e + 2] = __builtin_amdgcn_sdot4((int)r2, cq, acc[4 * e + 2], false); acc[4 * e + 3] = __builtin_amdgcn_sdot4((int)r3, cq, acc[4 * e + 3], false);
                }
#pragma unroll
            for (int lv = 2; lv >= 0; --lv) {
                const int n2 = 2 << lv, off = 8 << lv;
                const bool up = (lane & off) != 0;
#pragma unroll
                for (int i = 0; i < n2; ++i) { const int a = acc[i], c = acc[i + n2]; const int send = up ? a : c, keep = up ? c : a; acc[i] = keep + __shfl_xor(send, off); }
            }
            f32x2 o; o[0] = (float)acc[0] * sc + hv[0]; o[1] = (float)acc[1] * sc + hv[1];
            const float ss = wave_sum(o[0] * o[0] + o[1] * o[1]);
            stg<f32x2>(p.out + (size_t)t * D, (unsigned)(128 * j + 16 * ch + e0) * 4u, o);
            if (lane == 0) ssl[q] += ss;
        };
        GMeta ma, mb; GRows ra, rb; float sa, sb; f32x2 ha, hb;
        meta(0, ma, sa, ha); meta(1, mb, sb, hb); rows(0, ma, ra);
#pragma unroll 1
        for (int n = 0; n < nts; n += 2) {
            GMeta mc; float scc; f32x2 hc;
            meta(n + 2, mc, scc, hc); rows(n + 1, mb, rb);
            __builtin_amdgcn_sched_barrier(0);
            finish(n, ma, ra, sa, ha);
            __builtin_amdgcn_sched_barrier(0);
            meta(n + 3, ma, sa, ha); rows(n + 2, mc, ra);
            __builtin_amdgcn_sched_barrier(0);
            finish(n + 1, mb, rb, sb, hb);
            __builtin_amdgcn_sched_barrier(0);
            mb = ma; sb = sa; hb = ha; ma = mc; sa = scc; ha = hc;
        }
    }
    asm volatile("s_waitcnt vmcnt(0)" ::: "memory");
    __builtin_amdgcn_fence(__ATOMIC_ACQUIRE, "agent");
    {
        f32x4 gg[4];
#pragma unroll
        for (int i = 0; i < 4; ++i) gg[i] = ldg<f32x4>(p.g_fin, (unsigned)(i * 256 + 4 * lane) * 4u);
#pragma unroll 1
        for (int qb = 0; qb < ntok; qb += 4) {
            f32x4 a[4][4];
#pragma unroll
            for (int b = 0; b < 4; ++b)
#pragma unroll
                for (int i = 0; i < 4; ++i) a[b][i] = ldg<f32x4>(p.out + (size_t)tokf(qb + b) * D, (unsigned)(i * 256 + 4 * lane) * 4u);
#pragma unroll
            for (int b = 0; b < 4; ++b) {
                const float rv = rsqrtf(ssl[qb + b] * (1.0f / D) + EPS);
#pragma unroll
                for (int i = 0; i < 4; ++i) { f32x4 ov;
#pragma unroll
                    for (int e = 0; e < 4; ++e) ov[e] = a[b][i][e] * rv * gg[i][e];
                    stg<f32x4>(p.out + (size_t)tokf(qb + b) * D, (unsigned)(i * 256 + 4 * lane) * 4u, ov); }
            }
        }
    }
}

#define XB_TMO      128
#define XB_XCNT(j)  (256  + 64 * (j))
#define XB_XSUB(j)  (1280 + 64 * (j))
#define XB_XGEN(j)  (2304 + 64 * (j))
#define XB_TOP      3328
#define XB_TOPGEN   3392
#define XCD_BAR_WORDS 3456
#define XB_SPIN_CAP (1u << 18)

__device__ __forceinline__ unsigned xb_ld(unsigned* p)              { return __hip_atomic_load(p, __ATOMIC_RELAXED, __HIP_MEMORY_SCOPE_AGENT); }
__device__ __forceinline__ unsigned xb_add(unsigned* p, unsigned v) { return __hip_atomic_fetch_add(p, v, __ATOMIC_RELAXED, __HIP_MEMORY_SCOPE_AGENT); }
__device__ __forceinline__ unsigned xb_xcc_id() { return (unsigned)__builtin_amdgcn_s_getreg((3 << 11) | 20) & 0xFu; }
#define XB_SPIN(cond, bar) do { unsigned _sp = 0; while (cond) { __builtin_amdgcn_s_sleep(1); \
    if ((++_sp & 255u) == 0u) { if (xb_ld(&(bar)[XB_TMO])) break; if (_sp > XB_SPIN_CAP) { atomicAdd(&(bar)[XB_TMO], 1u); break; } } } } while (0)

struct XcdBarrier {
    unsigned* bar; unsigned x;
    volatile LAS unsigned* st;
};

__device__ __forceinline__ XcdBarrier xcd_barrier_post(unsigned* bar, volatile LAS unsigned* st) {
    XcdBarrier b; b.bar = bar; b.x = xb_xcc_id(); b.st = st;
    if (threadIdx.x == 0) (void)xb_add(&bar[XB_XCNT(b.x)], 1u);
    return b;
}
__device__ __forceinline__ void xcd_barrier_complete(unsigned* bar, unsigned x, unsigned& nloc, unsigned& nx) {
    const unsigned G = gridDim.x * gridDim.y * gridDim.z;
    unsigned sum, cnt, mine, sp = 0u;
    for (;;) {
        sum = 0u; cnt = 0u; mine = 0u;
#pragma unroll
        for (unsigned j = 0; j < 16; ++j) { const unsigned c = xb_ld(&bar[XB_XCNT(j)]); sum += c; cnt += (c > 0u) ? 1u : 0u; mine = (j == x) ? c : mine; }
        if (sum == G) break;
        __builtin_amdgcn_s_sleep(1);
        if ((++sp & 255u) == 0u) { if (xb_ld(&bar[XB_TMO])) break; if (sp > XB_SPIN_CAP) { atomicAdd(&bar[XB_TMO], 1u); break; } }
    }
    nloc = mine > 0u ? mine : 1u; nx = cnt > 0u ? cnt : 1u;
}

__device__ __forceinline__ void xcd_barrier(const XcdBarrier& b) {
    asm volatile("s_waitcnt vmcnt(0)" ::: "memory");
    __syncthreads();
    if (threadIdx.x == 0) {
        unsigned* bar = b.bar;
        __builtin_amdgcn_s_waitcnt(0);
        unsigned nloc = b.st[0], nx = b.st[1];
        if (nloc == 0u) { xcd_barrier_complete(bar, b.x, nloc, nx); b.st[0] = nloc; b.st[1] = nx; }
        const unsigned old = xb_add(&bar[XB_XSUB(b.x)], 1u);
        const unsigned gen = old / nloc;
        if (old + 1u == (gen + 1u) * nloc) {
            __builtin_amdgcn_fence(__ATOMIC_RELEASE, "agent");
            asm volatile("s_waitcnt vmcnt(0)" ::: "memory");
            const unsigned og = xb_add(&bar[XB_TOP], 1u);
            const unsigned tg = og / nx;
            if (og + 1u == (tg + 1u) * nx) xb_add(&bar[XB_TOPGEN], 1u);
            else XB_SPIN(xb_ld(&bar[XB_TOPGEN]) == tg, bar);
            __builtin_amdgcn_fence(__ATOMIC_ACQUIRE, "agent");
            xb_add(&bar[XB_XGEN(b.x)], 1u);
            asm volatile("s_waitcnt vmcnt(0)" ::: "memory");
        } else {
            XB_SPIN(xb_ld(&bar[XB_XGEN(b.x)]) == gen, bar);
            __builtin_amdgcn_fence(__ATOMIC_ACQUIRE, "agent");
            asm volatile("s_waitcnt vmcnt(0)" ::: "memory");
        }
    }
    __syncthreads();
}


__global__ void __launch_bounds__(512) k_fwd(Params p) {
    __shared__ __attribute__((aligned(16))) unsigned char lds_raw[LDS_BYTES + 16];
    LAS unsigned char* lds = (LAS unsigned char*)lds_raw;
    const int tid = threadIdx.x, vb = blockIdx.x, nb = gridDim.x;
    volatile LAS unsigned* xbw = (volatile LAS unsigned*)(lds + LDS_BYTES);
    if (tid < 4) xbw[tid] = 0u;
    __syncthreads();
    XcdBarrier gb = xcd_barrier_post((unsigned*)p.bar, xbw);
    if (tid == 0) xbw[2] = xb_add(&((unsigned*)p.bar)[XCD_BAR_WORDS + 64 * gb.x], 1u);
    p0_prep(p, vb, nb, tid, lds);
    const bool early = vb >= 129 && vb < NTILES;
    if (early) p1_stage(p, vb, tid, lds);
    xcd_barrier(gb);
    for (int tile = vb; tile < NTILES; tile += nb) { if (!(early && tile == vb)) p1_stage(p, tile, tid, lds); p1_inproj(p, tile, tid, lds, vb, nb, tile == vb); __syncthreads(); }
    if ((tid >> 6) == 0) for (int mp = vb; mp < 32; mp += nb) p1_meta(p, mp, launder(tid) & 63);
    xcd_barrier(gb);
    for (int tile = vb; tile < NTILES; tile += nb) { p2_mix(p, tile, tid, lds); __syncthreads(); }
    xcd_barrier(gb);
    const int lane = launder(tid) & 63, wv = __builtin_amdgcn_readfirstlane(tid >> 6);
    int np = 0, mypos = 0, nloc = 1;
    {
        unsigned* bar = (unsigned*)p.bar;
        const int myx = (int)gb.x;
#pragma unroll
        for (int q = 0; q < 16; ++q) { const int c = (int)xb_ld(&bar[XB_XCNT(q)]); if (q == myx) { mypos = np; nloc = c > 0 ? c : 1; } np += (c > 0) ? 1 : 0; }
        if (np < 1) np = 1;
    }
    {
        const int rank = (int)xbw[2];
        LAS unsigned char* wl = lds + wv * P3W_BYTES;
#pragma unroll 1
        for (int k = rank; mypos + np * k < T / 32; k += 2 * nloc) {
            const int c0 = mypos + np * k, c1 = mypos + np * (k + nloc);
            p3_wave(p, 32 * c0 + 4 * wv, 32 * c1 + 4 * wv, c1 < T / 32 ? 3 : 2, mypos, lane, wl);
        }
    }
}
}

extern "C" void kernel_launch(void* const* d_in, const int* in_sizes, int n_in, void* d_out, int out_size, void* d_ws, size_t ws_size, hipStream_t stream) {
    static int grid_blocks = 0;
    if (n_in != 16 || out_size != T * D) { fprintf(stderr, "kernel_launch: unexpected sizes n_in %d out %d\n", n_in, out_size); return; }
    if (!grid_blocks) {
        int dev = 0, cus = 0, per_cu = 0;
        (void)hipGetDevice(&dev);
        (void)hipDeviceGetAttribute(&cus, hipDeviceAttributeMultiprocessorCount, dev);
        (void)hipOccupancyMaxActiveBlocksPerMultiprocessor(&per_cu, (const void*)k_fwd, 512, 0);
        if (per_cu < 1) { fprintf(stderr, "kernel_launch: occupancy query returned %d\n", per_cu); per_cu = 1; }
        grid_blocks = cus * 1;
    }
    Params p{};
    p.x = (const float*)d_in[0]; p.meta = (const float*)d_in[1]; p.g_mix = (const float*)d_in[2]; p.w_in = (const float*)d_in[3]; p.pool_w = (const float*)d_in[4];
    p.pool_scale = (const float*)d_in[5]; p.conv_w = (const float*)d_in[6]; p.g_a = (const float*)d_in[7]; p.g_b = (const float*)d_in[8]; p.w_out = (const float*)d_in[9];
    p.g_ffn = (const float*)d_in[10]; p.w_query = (const float*)d_in[11]; p.sub_keys = (const float*)d_in[12]; p.eu = (const float*)d_in[13]; p.ev = (const float*)d_in[14]; p.g_fin = (const float*)d_in[15];
    p.out = (float*)d_out;
    unsigned char* ws = (unsigned char*)d_ws;
    p.winf = ws; p.woutf = ws + (4u << 20); p.wqf = ws + (6u << 20); p.kf = ws + (10u << 20); p.pwf = p.kf + (512u << 10); p.metaf = p.pwf + (128u << 10); p.rsm = p.metaf + (64u << 10); p.bar = p.rsm + 256;
    p.eut = ws + (12u << 20); p.evt = p.eut + (32u << 20); p.proj = p.evt + (32u << 20); p.idx = p.proj + (size_t)TL * MIXIN * 2; p.gate = p.idx + (size_t)T * HK * 4; p.lst = p.gate + (size_t)T * HK * 4;
    p.su = p.lst + (size_t)T * NH * 32 * 4; p.sv = p.su + 65536; p.sx = p.sv + 65536; p.xq = p.sx + 65536; p.wsci = p.xq + (size_t)T * D; p.wscq = p.wsci + 8192; p.hb = p.wscq + 8192;
    if ((size_t)(p.hb - ws) + (size_t)T * D * 2 > ws_size) { fprintf(stderr, "kernel_launch: workspace too small\n"); return; }
    if (hipMemsetAsync(p.bar, 0, (XCD_BAR_WORDS + 64 * 16) * 4, stream) != hipSuccess) { fprintf(stderr, "kernel_launch: memset of the barrier words failed\n"); return; }
    hipLaunchKernelGGL(k_fwd, dim3(grid_blocks), dim3(512), 0, stream, p);
}
```

```cpp
#include <hip/hip_runtime.h>
#include <cstdio>
#include <cstdint>
#include <math.h>

namespace {
constexpr int D = 1024, BATCH = 4, SEQ = 4096, NMETA = 16, L = SEQ + NMETA;
constexpr int MIXA = 512, MIXB = 512, MIXIN = 2048;
constexpr int NH = 8, NKEYS = 128, DQH = 128, TOPK = 16, HK = 128;
constexpr int T = BATCH * SEQ;
constexpr int TL = BATCH * L;
constexpr float EPS = 1e-6f;

__device__ __forceinline__ float wave_sum(float v) {
#pragma unroll
    for (int o = 32; o > 0; o >>= 1) v += __shfl_xor(v, o);
    return v;
}
#define LAS __attribute__((address_space(3)))
typedef short bf16x8 __attribute__((ext_vector_type(8)));
typedef float f32x16 __attribute__((ext_vector_type(16)));
typedef float f32x4 __attribute__((ext_vector_type(4)));
typedef float f32x2 __attribute__((ext_vector_type(2)));
typedef __bf16 bf2_t __attribute__((ext_vector_type(2)));
typedef unsigned u32x4 __attribute__((ext_vector_type(4)));
typedef unsigned u32x2 __attribute__((ext_vector_type(2)));
typedef int i32x4 __attribute__((ext_vector_type(4)));
typedef int i32x16 __attribute__((ext_vector_type(16)));

constexpr int QCH = 2;
constexpr int NTILES = T / 64;
constexpr int TROW = 2064;
constexpr int TROWB = 1040;
constexpr int LDS_TILE = 64 * TROW;
constexpr int LDS_RS = LDS_TILE;
constexpr int LDS_SSA = LDS_RS + 256;
constexpr int LDS_LUT = LDS_SSA + 256;
constexpr int LDS_BYTES = LDS_LUT + 16384;

struct Params {
    const float* x; const float* meta; const float* g_mix; const float* w_in; const float* pool_w; const float* pool_scale; const float* conv_w;
    const float* g_a; const float* g_b; const float* w_out; const float* g_ffn; const float* w_query; const float* sub_keys; const float* eu; const float* ev; const float* g_fin;
    float* out;
    unsigned char *winf, *woutf, *wqf, *kf, *pwf, *metaf, *rsm, *eut, *evt, *proj, *idx, *gate, *bar, *lst, *su, *sv, *xq, *sx, *wsci, *wscq, *hb;
};

__device__ __forceinline__ unsigned pk_bf16(float lo, float hi) { f32x2 f = {lo, hi}; return __builtin_bit_cast(unsigned, __builtin_convertvector(f, bf2_t)); }
__device__ __forceinline__ float bf_lo(unsigned u) { return __builtin_bit_cast(float, u << 16); }
__device__ __forceinline__ float bf_hi(unsigned u) { return __builtin_bit_cast(float, u & 0xffff0000u); }
__device__ __forceinline__ f32x16 mfma32(u32x4 a, u32x4 b, f32x16 c) { return __builtin_amdgcn_mfma_f32_32x32x16_bf16(__builtin_bit_cast(bf16x8, a), __builtin_bit_cast(bf16x8, b), c, 0, 0, 0); }
__device__ __forceinline__ i32x16 mfma_i8(u32x4 a, u32x4 b, i32x16 c) { return __builtin_amdgcn_mfma_i32_32x32x32_i8(__builtin_bit_cast(i32x4, a), __builtin_bit_cast(i32x4, b), c, 0, 0, 0); }
__device__ __forceinline__ i32x16 izero16() { i32x16 z; for (int i = 0; i < 16; ++i) z[i] = 0; return z; }
__device__ __forceinline__ f32x16 zero16() { f32x16 z; for (int i = 0; i < 16; ++i) z[i] = 0.f; return z; }

__device__ __forceinline__ void wave_sync() { __builtin_amdgcn_fence(__ATOMIC_RELEASE, "wavefront"); __builtin_amdgcn_wave_barrier(); __builtin_amdgcn_fence(__ATOMIC_ACQUIRE, "wavefront"); }
__device__ __forceinline__ int launder(int x) { asm volatile("" : "+v"(x)); return x; }
template <class V> __device__ __forceinline__ V ldg(const void* base, unsigned off) { return *(const V*)((const unsigned char*)base + off); }
template <class V> __device__ __forceinline__ void stg(void* base, unsigned off, V v) { *(V*)((unsigned char*)base + off) = v; }

__device__ __forceinline__ void frag_from_kn(const float* __restrict__ W, int N, const float* __restrict__ g, int i, int s, int lane, u32x4* __restrict__ dst, int I8K = 0) {
    const int r = lane & 31, h = lane >> 5, k0 = 16 * s + 8 * h;
    const float* src = W + (size_t)k0 * N + 32 * i + r;
    float v[8];
#pragma unroll
    for (int j = 0; j < 8; ++j) v[j] = src[(size_t)j * N] * (g ? g[k0 + j] : 1.0f);
    u32x4 o; o.x = pk_bf16(v[0], v[1]); o.y = pk_bf16(v[2], v[3]); o.z = pk_bf16(v[4], v[5]); o.w = pk_bf16(v[6], v[7]);
    *dst = o;
}
__device__ __forceinline__ void frag2_from_kn(const float* __restrict__ W, int N, int i, int s, int lane, u32x4* __restrict__ dst) {
    const int r = lane & 31, h = lane >> 5, k0 = 16 * s + 8 * h;
    const float* src = W + (size_t)k0 * N + 32 * i + r;
    float v[16];
#pragma unroll
    for (int j = 0; j < 8; ++j) { v[j] = src[(size_t)j * N]; v[8 + j] = src[(size_t)(16 + j) * N]; }
    u32x4 o; o.x = pk_bf16(v[0], v[1]); o.y = pk_bf16(v[2], v[3]); o.z = pk_bf16(v[4], v[5]); o.w = pk_bf16(v[6], v[7]);
    u32x4 o2; o2.x = pk_bf16(v[8], v[9]); o2.y = pk_bf16(v[10], v[11]); o2.z = pk_bf16(v[12], v[13]); o2.w = pk_bf16(v[14], v[15]);
    dst[0] = o; dst[64] = o2;
}
constexpr int J_WOUT = 0, J_WQ = J_WOUT + 32 * 64, J_PW = J_WQ, J_KEY = J_PW + 128, J_END = J_KEY + 512;
__device__ __forceinline__ void mtile_i8_block(const float* __restrict__ W, const float* __restrict__ g, int i, int tid, LAS unsigned* lds_u, u32x4* __restrict__ dst, float* __restrict__ wsc) {
    const int lane = tid & 63, wv = tid >> 6, r = lane & 31, h = lane >> 5, col = 32 * i + r;
    if (tid < 32) lds_u[tid] = 0u;
    __syncthreads();
    {
        const int cg = lane & 7, ro = lane >> 3;
        f32x4 f[16];
#pragma unroll
        for (int q = 0; q < 16; ++q) f[q] = ldg<f32x4>(W, (unsigned)((128 * wv + 8 * q + ro) * 2048 + 32 * i + 4 * cg) * 4u);
        float m0 = 0.f, m1 = 0.f, m2 = 0.f, m3 = 0.f;
#pragma unroll
        for (int q = 0; q < 16; ++q) { const float gk = g ? g[128 * wv + 8 * q + ro] : 1.0f; m0 = fmaxf(m0, fabsf(f[q][0] * gk)); m1 = fmaxf(m1, fabsf(f[q][1] * gk)); m2 = fmaxf(m2, fabsf(f[q][2] * gk)); m3 = fmaxf(m3, fabsf(f[q][3] * gk)); }
#pragma unroll
        for (int o = 8; o < 64; o <<= 1) { m0 = fmaxf(m0, __shfl_xor(m0, o)); m1 = fmaxf(m1, __shfl_xor(m1, o)); m2 = fmaxf(m2, __shfl_xor(m2, o)); m3 = fmaxf(m3, __shfl_xor(m3, o)); }
        if (lane < 8) { atomicMax((unsigned*)(lds_u + 4 * cg), __builtin_bit_cast(unsigned, m0)); atomicMax((unsigned*)(lds_u + 4 * cg + 1), __builtin_bit_cast(unsigned, m1));
            atomicMax((unsigned*)(lds_u + 4 * cg + 2), __builtin_bit_cast(unsigned, m2)); atomicMax((unsigned*)(lds_u + 4 * cg + 3), __builtin_bit_cast(unsigned, m3)); }
    }
    __syncthreads();
    const float cm = __builtin_bit_cast(float, lds_u[r]);
    const float inv = cm > 0.f ? 127.0f / cm : 0.f;
    if (wv == 0 && h == 0) wsc[col] = cm * (1.0f / 127.0f);
#pragma unroll
    for (int sl = 0; sl < 4; ++sl) {
        const int s = 4 * wv + sl, k0 = 32 * s + 16 * h;
        u32x4 o;
#pragma unroll
        for (int q = 0; q < 4; ++q) {
            unsigned w = 0u;
#pragma unroll
            for (int e = 0; e < 4; ++e) { const int k = k0 + 4 * q + e; w |= ((unsigned)(int)rintf(ldg<float>(W, (unsigned)(k * 2048 + col) * 4u) * (g ? g[k] : 1.0f) * inv) & 255u) << (8 * e); }
            o[q] = w;
        }
        dst[(size_t)s * 64 + lane] = o;
    }
    __syncthreads();
}
__device__ __forceinline__ void meta_block(const Params& p, int tid, LAS float* lds_f) {
    const int lane = tid & 63, wv = tid >> 6;
#pragma unroll
    for (int q = 0; q < 2; ++q) {
        const int row = 2 * wv + q;
        float ss = 0.f, am = 0.f;
#pragma unroll
        for (int i = 0; i < 4; ++i) { const f32x4 f = *(const f32x4*)(p.meta + (size_t)row * D + i * 256 + 4 * lane); ss += f[0] * f[0] + f[1] * f[1] + f[2] * f[2] + f[3] * f[3];
            am = fmaxf(am, fmaxf(fmaxf(fabsf(f[0]), fabsf(f[1])), fmaxf(fabsf(f[2]), fabsf(f[3])))); }
        ss = wave_sum(ss);
#pragma unroll
        for (int o = 32; o > 0; o >>= 1) am = fmaxf(am, __shfl_xor(am, o));
        if (lane == 0) { ((float*)(p.rsm))[row] = rsqrtf(ss * (1.0f / D) + EPS) * am * (1.0f / 127.0f); lds_f[row] = am; }
    }
    __syncthreads();
    const int n = lane & 31, h = lane >> 5;
    const float am = n < NMETA ? lds_f[n] : 0.f;
    const float inv = am > 0.f ? 127.0f / am : 0.f;
#pragma unroll
    for (int sl = 0; sl < 4; ++sl) {
        const int s = 4 * wv + sl;
        u32x4 o = {0u, 0u, 0u, 0u};
        if (n < NMETA) {
            const float* row = p.meta + (size_t)n * D;
#pragma unroll
            for (int q = 0; q < 4; ++q) { const f32x4 f = *(const f32x4*)(row + 32 * s + 16 * h + 4 * q);
                o[q] = ((unsigned)(int)rintf(f[0] * inv) & 255u) | (((unsigned)(int)rintf(f[1] * inv) & 255u) << 8) | (((unsigned)(int)rintf(f[2] * inv) & 255u) << 16) | (((unsigned)(int)rintf(f[3] * inv) & 255u) << 24); }
        }
        ((u32x4*)(p.metaf))[(size_t)s * 64 + lane] = o;
    }
    __syncthreads();
}

__device__ __forceinline__ void p0_prep(const Params& p, int vb, int nb, int tid, LAS unsigned char* lds) {
    const int lane = tid & 63, wv = tid >> 6, gw = vb * 8 + wv, nw = nb * 8;
    for (int job = vb; job < 129; job += nb) {
        if (job < 64) mtile_i8_block(p.w_in, p.g_mix, job, tid, (LAS unsigned*)lds, (u32x4*)(p.winf) + (size_t)job * 32 * 64, (float*)p.wsci);
        else if (job < 128) mtile_i8_block(p.w_query, nullptr, job - 64, tid, (LAS unsigned*)lds, (u32x4*)(p.wqf) + (size_t)(job - 64) * 32 * 64, (float*)p.wscq);
        else meta_block(p, tid, (LAS float*)lds);
    }
    int jw = gw, jn = nw;
    if (nb >= 129 + 64) { jw = vb >= 129 ? (vb - 129) * 8 + wv : J_END; jn = (nb - 129) * 8; }
    for (int job = jw; job < J_END / 2; job += jn) {
        if (job < J_WQ / 2) { const int q = 2 * job, i = q >> 6, sA = q & 63; frag2_from_kn(p.w_out, 1024, i, sA, lane, (u32x4*)(p.woutf) + (size_t)q * 64 + lane); }
        else if (job < J_KEY / 2) { const int q = 2 * job - J_PW, g = q >> 5, mt = (q >> 3) & 3, sA = q & 7; frag2_from_kn(p.pool_w + (size_t)g * 128 * 128, 128, mt, sA, lane, (u32x4*)(p.pwf) + (size_t)q * 64 + lane); }
        else {
            const int q = 2 * job - J_KEY, hp = q >> 5, kt = (q >> 3) & 3, sA = q & 7, r = lane & 31, h = lane >> 5;
            const float* src = p.sub_keys + ((size_t)hp * 128 + 32 * kt + r) * 128 + 16 * sA + 4 * h;
            const f32x4 f0 = *(const f32x4*)src, f1 = *(const f32x4*)(src + 8), f2 = *(const f32x4*)(src + 16), f3 = *(const f32x4*)(src + 24);
            u32x4 o; o.x = pk_bf16(f0[0], f0[1]); o.y = pk_bf16(f0[2], f0[3]); o.z = pk_bf16(f1[0], f1[1]); o.w = pk_bf16(f1[2], f1[3]);
            u32x4 o2; o2.x = pk_bf16(f2[0], f2[1]); o2.y = pk_bf16(f2[2], f2[3]); o2.z = pk_bf16(f3[0], f3[1]); o2.w = pk_bf16(f3[2], f3[3]);
            ((u32x4*)(p.kf))[(size_t)q * 64 + lane] = o; ((u32x4*)(p.kf))[(size_t)(q + 1) * 64 + lane] = o2;
        }
    }
}

struct TabBatch { f32x4 f[4][4]; };
__device__ __forceinline__ int tab_rpb(int nb) { return ((2 * 16384 + nb - 1) / nb + 31) & ~31; }
__device__ __forceinline__ int tab_row(int vb, int nb, int wv, int i) { const int rpb = tab_rpb(nb), row = vb * rpb + 8 * i + wv; return (8 * i + wv < rpb && row < 2 * 16384) ? row : -1; }
__device__ __forceinline__ void tab_issue(const Params& p, int vb, int nb, int wv, int i0, int lane, TabBatch& t) {
#pragma unroll
    for (int q = 0; q < 4; ++q) {
        const int row = tab_row(vb, nb, wv, i0 + q);
        if (row >= 0) { const float* src = (row < 16384 ? p.eu : p.ev) + (size_t)(row & 16383) * D;
#pragma unroll
            for (int i = 0; i < 4; ++i) t.f[q][i] = ldg<f32x4>(src, (unsigned)(i * 256 + 4 * lane) * 4u); }
    }
}
__device__ __forceinline__ void tab_finish(const Params& p, int vb, int nb, int wv, int i0, int lane, const TabBatch& t) {
#pragma unroll
    for (int q = 0; q < 4; ++q) {
        const int row = tab_row(vb, nb, wv, i0 + q);
        if (row >= 0) {
            const bool isu = row < 16384; const int rr = row & 16383;
            float am = 0.f;
#pragma unroll
            for (int i = 0; i < 4; ++i) am = fmaxf(am, fmaxf(fmaxf(fabsf(t.f[q][i][0]), fabsf(t.f[q][i][1])), fmaxf(fabsf(t.f[q][i][2]), fabsf(t.f[q][i][3]))));
#pragma unroll
            for (int o = 32; o > 0; o >>= 1) am = fmaxf(am, __shfl_xor(am, o));
            const float inv = am > 0.f ? 127.0f / am : 0.f;
            unsigned char* dstt = isu ? p.eut : p.evt;
#pragma unroll
            for (int i = 0; i < 4; ++i) {
                unsigned w = 0u;
#pragma unroll
                for (int e = 0; e < 4; ++e) { const int qv = (int)rintf(t.f[q][i][e] * inv); w |= ((unsigned)qv & 255u) << (8 * e); }
                const unsigned c = (unsigned)(i * 256 + 4 * lane);
                stg<unsigned>(dstt, (((c >> 7) * 16384u + (unsigned)rr) << 7) + (c & 127u), w);
            }
            if (lane == 0) ((float*)(isu ? p.su : p.sv))[rr] = am * (1.0f / 127.0f);
        }
    }
}


template <int CH>
__device__ __forceinline__ void gemm22_chunk(const u32x4 (&a)[2][CH], const LAS unsigned char* b, int s0, f32x16 (&acc)[2][2]) {
#pragma unroll
    for (int u = 0; u < CH; ++u) {
        const u32x4 b0 = *(const LAS u32x4*)(b + (s0 + u) * 32), b1 = *(const LAS u32x4*)(b + 32 * TROW + (s0 + u) * 32);
        acc[0][0] = mfma32(a[0][u], b0, acc[0][0]); acc[0][1] = mfma32(a[0][u], b1, acc[0][1]);
        acc[1][0] = mfma32(a[1][u], b0, acc[1][0]); acc[1][1] = mfma32(a[1][u], b1, acc[1][1]);
    }
}
template <int KS, int CH = 4>
__device__ __forceinline__ void gemm22(const u32x4* abase, unsigned lane, const LAS unsigned char* b, f32x16 (&acc)[2][2], int kofs = 0) {
    constexpr int NC = KS / CH;
    static_assert(NC % 2 == 0 && (NC & (NC - 1)) == 0, "chunk count: even power of two");
    u32x4 pa[2][CH], pb[2][CH];
    const unsigned lo = lane * 16u;
    {
        const unsigned o0 = lo + (unsigned)((kofs & (NC - 1)) * CH) * 1024u;
#pragma unroll
        for (int u = 0; u < CH; ++u) { pa[0][u] = ldg<u32x4>(abase, o0 + u * 1024u); pa[1][u] = ldg<u32x4>(abase, o0 + (KS + u) * 1024u); }
    }
#pragma unroll 1
    for (int c = 0; c < NC; c += 2) {
        const int c0 = (c + kofs) & (NC - 1), c1 = (c + 1 + kofs) & (NC - 1), c2 = (c + 2 + kofs) & (NC - 1);
        const unsigned o1 = lo + (unsigned)(c1 * CH) * 1024u, o2 = lo + (unsigned)(c2 * CH) * 1024u;
#pragma unroll
        for (int u = 0; u < CH; ++u) { pb[0][u] = ldg<u32x4>(abase, o1 + u * 1024u); pb[1][u] = ldg<u32x4>(abase, o1 + (KS + u) * 1024u); }
        __builtin_amdgcn_sched_barrier(0);
        gemm22_chunk<CH>(pa, b, c0 * CH, acc);
        __builtin_amdgcn_sched_barrier(0);
#pragma unroll
        for (int u = 0; u < CH; ++u) { pa[0][u] = ldg<u32x4>(abase, o2 + u * 1024u); pa[1][u] = ldg<u32x4>(abase, o2 + (KS + u) * 1024u); }
        __builtin_amdgcn_sched_barrier(0);
        gemm22_chunk<CH>(pb, b, c1 * CH, acc);
        __builtin_amdgcn_sched_barrier(0);
    }
}

template <int CH>
__device__ __forceinline__ void gemm22i_chunk(const u32x4 (&a)[2][CH], const LAS unsigned char* b, int s0, i32x16 (&acc)[2][2]) {
#pragma unroll
    for (int u = 0; u < CH; ++u) {
        const u32x4 b0 = *(const LAS u32x4*)(b + (s0 + u) * 32), b1 = *(const LAS u32x4*)(b + 32 * TROWB + (s0 + u) * 32);
        acc[0][0] = mfma_i8(a[0][u], b0, acc[0][0]); acc[0][1] = mfma_i8(a[0][u], b1, acc[0][1]);
        acc[1][0] = mfma_i8(a[1][u], b0, acc[1][0]); acc[1][1] = mfma_i8(a[1][u], b1, acc[1][1]);
    }
}
template <int KS, int CH = 4>
__device__ __forceinline__ void gemm22i(const u32x4* abase, unsigned lane, const LAS unsigned char* b, i32x16 (&acc)[2][2], int kofs = 0) {
    constexpr int NC = KS / CH;
    static_assert(NC % 2 == 0 && (NC & (NC - 1)) == 0, "chunk count: even power of two");
    u32x4 pa[2][CH], pb[2][CH];
    const unsigned lo = lane * 16u;
    {
        const unsigned o0 = lo + (unsigned)((kofs & (NC - 1)) * CH) * 1024u;
#pragma unroll
        for (int u = 0; u < CH; ++u) { pa[0][u] = ldg<u32x4>(abase, o0 + u * 1024u); pa[1][u] = ldg<u32x4>(abase, o0 + (KS + u) * 1024u); }
    }
#pragma unroll 1
    for (int c = 0; c < NC; c += 2) {
        const int c0 = (c + kofs) & (NC - 1), c1 = (c + 1 + kofs) & (NC - 1), c2 = (c + 2 + kofs) & (NC - 1);
        const unsigned o1 = lo + (unsigned)(c1 * CH) * 1024u, o2 = lo + (unsigned)(c2 * CH) * 1024u;
#pragma unroll
        for (int u = 0; u < CH; ++u) { pb[0][u] = ldg<u32x4>(abase, o1 + u * 1024u); pb[1][u] = ldg<u32x4>(abase, o1 + (KS + u) * 1024u); }
        __builtin_amdgcn_sched_barrier(0);
        gemm22i_chunk<CH>(pa, b, c0 * CH, acc);
        __builtin_amdgcn_sched_barrier(0);
#pragma unroll
        for (int u = 0; u < CH; ++u) { pa[0][u] = ldg<u32x4>(abase, o2 + u * 1024u); pa[1][u] = ldg<u32x4>(abase, o2 + (KS + u) * 1024u); }
        __builtin_amdgcn_sched_barrier(0);
        gemm22i_chunk<CH>(pb, b, c1 * CH, acc);
        __builtin_amdgcn_sched_barrier(0);
    }
}

__device__ __forceinline__ void p1_stage(const Params& p, int tile, int tid, LAS unsigned char* lds) {
    const int lane = tid & 63, wv = __builtin_amdgcn_readfirstlane(tid >> 6);
    LAS float* rs = (LAS float*)(lds + LDS_RS);
    const float* xt = p.x + (size_t)tile * 64 * D;
#pragma unroll 4
    for (int rr = 0; rr < 8; ++rr) {
        const int tk = 8 * wv + rr;
        f32x4 f[4]; float ss = 0.f, am = 0.f;
#pragma unroll
        for (int i = 0; i < 4; ++i) { f[i] = ldg<f32x4>(xt, (unsigned)(tk * D + i * 256 + 4 * lane) * 4u); ss += f[i][0] * f[i][0] + f[i][1] * f[i][1] + f[i][2] * f[i][2] + f[i][3] * f[i][3];
            am = fmaxf(am, fmaxf(fmaxf(fabsf(f[i][0]), fabsf(f[i][1])), fmaxf(fabsf(f[i][2]), fabsf(f[i][3])))); }
        ss = wave_sum(ss);
#pragma unroll
        for (int o = 32; o > 0; o >>= 1) am = fmaxf(am, __shfl_xor(am, o));
        const float inv = am > 0.f ? 127.0f / am : 0.f;
        if (lane == 0) rs[tk] = rsqrtf(ss * (1.0f / D) + EPS) * am * (1.0f / 127.0f);
#pragma unroll
        for (int i = 0; i < 4; ++i) {
            unsigned w = 0u;
#pragma unroll
            for (int e = 0; e < 4; ++e) w |= ((unsigned)(int)rintf(f[i][e] * inv) & 255u) << (8 * e);
            *(LAS unsigned*)(lds + tk * TROWB + i * 256 + 4 * lane) = w;
        }
    }
    __syncthreads();
}
__device__ __forceinline__ void p1_inproj(const Params& p, int tile, int tid, LAS unsigned char* lds, int vb, int nb, bool do_tab) {
    const int lane = launder(tid) & 63, wv = __builtin_amdgcn_readfirstlane(tid >> 6), r = lane & 31, h = lane >> 5;
    const int b = tile >> 6, s0 = (tile & 63) * 64;
    LAS float* rs = (LAS float*)(lds + LDS_RS);
    const u32x4* WF = (const u32x4*)(p.winf);
    unsigned char* prow0 = p.proj + ((size_t)b * L + NMETA + s0) * (MIXIN * 2);
    const LAS unsigned char* bp = lds + r * TROWB + h * 16;
    const float rs0 = rs[r], rs1 = rs[32 + r];
    const int stg_k = (tile >> 3) & 7, stg_r = (tile >> 6) & 3;
#pragma unroll 1
    for (int rdx = 0; rdx < 4; ++rdx) {
        const int rd = (rdx + stg_r) & 3;
        const int i0 = 8 * wv + 2 * rd;
        TabBatch tb;
        if (do_tab) tab_issue(p, vb, nb, wv, 4 * rdx, lane, tb);
        __builtin_amdgcn_sched_barrier(0);
        i32x16 acc[2][2]; acc[0][0] = izero16(); acc[0][1] = izero16(); acc[1][0] = izero16(); acc[1][1] = izero16();
        gemm22i<32, 4>(WF + (size_t)i0 * 32 * 64, lane, bp, acc, stg_k);
        f32x4 wsv[2][4];
#pragma unroll
        for (int mi = 0; mi < 2; ++mi)
#pragma unroll
            for (int q = 0; q < 4; ++q) wsv[mi][q] = ldg<f32x4>(p.wsci, (unsigned)(32 * (i0 + mi) + 8 * q + 4 * h) * 4u);
        LAS unsigned char* eb = lds + 64 * TROWB + wv * 8192;
#pragma unroll
        for (int mi = 0; mi < 2; ++mi)
#pragma unroll
            for (int q = 0; q < 4; ++q) {
                const f32x4 ws = wsv[mi][q];
#pragma unroll
                for (int nt = 0; nt < 2; ++nt) {
                    const float rv = nt ? rs1 : rs0;
                    u32x2 o; o.x = pk_bf16((float)acc[mi][nt][4 * q] * rv * ws[0], (float)acc[mi][nt][4 * q + 1] * rv * ws[1]); o.y = pk_bf16((float)acc[mi][nt][4 * q + 2] * rv * ws[2], (float)acc[mi][nt][4 * q + 3] * rv * ws[3]);
                    *(LAS u32x2*)(eb + (nt * 32 + r) * 128 + (((4 * mi + q) ^ (r & 7)) * 16) + 8 * h) = o;
                }
            }
        wave_sync();
        {
            u32x4 ov[8];
#pragma unroll
            for (int k = 0; k < 8; ++k) { const int row = 8 * k + (lane >> 3); ov[k] = *(const LAS u32x4*)(eb + row * 128 + (((lane & 7) ^ (row & 7)) * 16)); }
            wave_sync();
#pragma unroll
            for (int k = 0; k < 8; ++k) { const int row = 8 * k + (lane >> 3); stg<u32x4>(prow0, (unsigned)(row * MIXIN + 32 * i0) * 2u + (unsigned)(lane & 7) * 16u, ov[k]); }
        }
        if (do_tab) tab_finish(p, vb, nb, wv, 4 * rdx, lane, tb);
    }
    if (do_tab) for (int i0 = 16; 8 * i0 < tab_rpb(nb); i0 += 4) { TabBatch tb; tab_issue(p, vb, nb, wv, i0, lane, tb); tab_finish(p, vb, nb, wv, i0, lane, tb); }
}
__device__ __forceinline__ void p1_meta(const Params& p, int mp, int lane) {
    const int r = lane & 31, h = lane >> 5;
    const u32x4* A = (const u32x4*)(p.winf) + (size_t)(2 * mp) * 32 * 64;
    const u32x4* B = (const u32x4*)(p.metaf);
    i32x16 acc0 = izero16(), acc1 = izero16();
#pragma unroll 4
    for (int s = 0; s < 32; ++s) { const u32x4 bf = ldg<u32x4>(B, (unsigned)(s * 64 + lane) * 16u);
        acc0 = mfma_i8(ldg<u32x4>(A, (unsigned)(s * 64 + lane) * 16u), bf, acc0); acc1 = mfma_i8(ldg<u32x4>(A, (unsigned)((32 + s) * 64 + lane) * 16u), bf, acc1); }
    if (r < NMETA) {
        const float rv = ((const float*)(p.rsm))[r];
#pragma unroll
        for (int q = 0; q < 4; ++q) {
            const f32x4 w0 = ldg<f32x4>(p.wsci, (unsigned)(64 * mp + 8 * q + 4 * h) * 4u), w1 = ldg<f32x4>(p.wsci, (unsigned)(64 * mp + 32 + 8 * q + 4 * h) * 4u);
            u32x2 o0, o1;
            o0.x = pk_bf16((float)acc0[4 * q] * rv * w0[0], (float)acc0[4 * q + 1] * rv * w0[1]); o0.y = pk_bf16((float)acc0[4 * q + 2] * rv * w0[2], (float)acc0[4 * q + 3] * rv * w0[3]);
            o1.x = pk_bf16((float)acc1[4 * q] * rv * w1[0], (float)acc1[4 * q + 1] * rv * w1[1]); o1.y = pk_bf16((float)acc1[4 * q + 2] * rv * w1[2], (float)acc1[4 * q + 3] * rv * w1[3]);
#pragma unroll
            for (int bb = 0; bb < BATCH; ++bb) {
                const unsigned ro = (unsigned)((bb * L + r) * MIXIN + 64 * mp + 4 * h) * 2u;
                stg<u32x2>(p.proj, ro + 16u * q, o0); stg<u32x2>(p.proj, ro + 64u + 16u * q, o1);
            }
        }
    }
}

template <int LOGN> __device__ __forceinline__ void bitonic_sort_desc(float* v) {
    constexpr int N = 1 << LOGN;
#pragma unroll
    for (int lk = 1; lk <= LOGN; ++lk) {
#pragma unroll
        for (int lj = lk - 1; lj >= 0; --lj) {
#pragma unroll
            for (int i = 0; i < N; ++i) {
                const int k = 1 << lk, j = 1 << lj, l = i ^ j;
                if (l > i) { const bool up = ((i & k) == 0); const float a = v[i], c = v[l]; const float hi = fmaxf(a, c), lo = fminf(a, c); v[i] = up ? hi : lo; v[l] = up ? lo : hi; }
            }
        }
    }
}
__device__ __forceinline__ void bitonic_merge16_desc(float* v) {
#pragma unroll
    for (int lj = 3; lj >= 0; --lj) {
#pragma unroll
        for (int i = 0; i < 16; ++i) { const int j = 1 << lj, l = i ^ j; if (l > i) { const float a = v[i], c = v[l]; v[i] = fmaxf(a, c); v[l] = fminf(a, c); } }
    }
}
__device__ __forceinline__ void merge_top16(float* a, const float* c) {
#pragma unroll
    for (int i = 0; i < 16; ++i) a[i] = fmaxf(a[i], c[15 - i]);
    bitonic_merge16_desc(a);
}
__device__ __forceinline__ void top16_of_64(float* v) {
    bitonic_sort_desc<4>(v); bitonic_sort_desc<4>(v + 16); bitonic_sort_desc<4>(v + 32); bitonic_sort_desc<4>(v + 48);
    merge_top16(v, v + 16); merge_top16(v + 32, v + 48); merge_top16(v, v + 32);
}
__device__ __forceinline__ float embed_bits(float x, unsigned mask, unsigned code) { return __builtin_bit_cast(float, (__builtin_bit_cast(unsigned, x) & ~mask) | code); }

template <int W>
__device__ __forceinline__ void pool_window(const unsigned char* pbat, int p0, int cp, LAS unsigned char* dst) {
    unsigned u[31 + W];
#pragma unroll
    for (int i = 0; i < 31 + W; ++i) u[i] = ldg<unsigned>(pbat + (size_t)(p0 - (W - 1) + i) * 4096u, cp * 4u);
    float sx = 0.f, sy = 0.f;
#pragma unroll
    for (int i = 0; i < W - 1; ++i) { sx += bf_lo(u[i]); sy += bf_hi(u[i]); }
    const float invw = 1.0f / (float)W;
#pragma unroll
    for (int tk = 0; tk < 32; ++tk) {
        const float lo = bf_lo(u[W - 1 + tk]), hi = bf_hi(u[W - 1 + tk]);
        sx += lo; sy += hi;
        *(LAS unsigned*)(dst + tk * TROW) = pk_bf16(sx * invw - lo, sy * invw - hi);
        sx -= bf_lo(u[tk]); sy -= bf_hi(u[tk]);
    }
}

template <int RB>
__device__ __forceinline__ void p2_xf_batch(const Params& p, int tile, int wv, int lane, LAS unsigned char* lds, unsigned char* ht, f32x4 (&f)[4][4], const u32x2 (&hq)[8][4], const f32x4 (&gg)[4]) {
    unsigned char* xqt = p.xq + (size_t)tile * 64 * D;
#pragma unroll
    for (int rr = 0; rr < 4; ++rr) {
        const int tk = 8 * wv + RB + rr;
        float ss = 0.f;
#pragma unroll
        for (int i = 0; i < 4; ++i) {
            const u32x2 hw = hq[RB + rr][i];
            f[rr][i][0] += bf_lo(hw.x); f[rr][i][1] += bf_hi(hw.x); f[rr][i][2] += bf_lo(hw.y); f[rr][i][3] += bf_hi(hw.y);
            u32x2 ho; ho.x = pk_bf16(f[rr][i][0], f[rr][i][1]); ho.y = pk_bf16(f[rr][i][2], f[rr][i][3]);
            stg<u32x2>(ht, (unsigned)(tk * D + i * 256 + 4 * lane) * 2u, ho);
            ss += f[rr][i][0] * f[rr][i][0] + f[rr][i][1] * f[rr][i][1] + f[rr][i][2] * f[rr][i][2] + f[rr][i][3] * f[rr][i][3];
        }
        ss = wave_sum(ss);
        const float rv = rsqrtf(ss * (1.0f / D) + EPS);
        float am = 0.f;
#pragma unroll
        for (int i = 0; i < 4; ++i)
#pragma unroll
            for (int e = 0; e < 4; ++e) { f[rr][i][e] *= rv * gg[i][e]; am = fmaxf(am, fabsf(f[rr][i][e])); }
#pragma unroll
        for (int o = 32; o > 0; o >>= 1) am = fmaxf(am, __shfl_xor(am, o));
        const float inv = am > 0.f ? 127.0f / am : 0.f;
#pragma unroll
        for (int i = 0; i < 4; ++i) {
            unsigned w = 0u;
#pragma unroll
            for (int e = 0; e < 4; ++e) w |= ((unsigned)(int)rintf(f[rr][i][e] * inv) & 255u) << (8 * e);
            stg<unsigned>(xqt, (unsigned)(tk * D + i * 256 + 4 * lane), w);
            *(LAS unsigned*)(lds + tk * TROWB + i * 256 + 4 * lane) = w;
        }
        if (lane == 0) { ((LAS float*)(lds + LDS_RS))[tk] = am * (1.0f / 127.0f); ((float*)p.sx)[tile * 64 + tk] = am * (1.0f / 127.0f); }
    }
}

__device__ __forceinline__ void p2_mix(const Params& p, int tile, int tid, LAS unsigned char* lds) {
    const int wv = __builtin_amdgcn_readfirstlane(tid >> 6);
    const int b = tile >> 6, s0 = (tile & 63) * 64;
    LAS float* ssa = (LAS float*)(lds + LDS_SSA);
    const unsigned char* pbat = p.proj + (size_t)b * L * (MIXIN * 2);
    const float* xt = p.x + (size_t)tile * 64 * D;
    unsigned char* ht = p.hb + (size_t)tile * 64 * D * 2;
    if (tid < 64) ssa[tid] = 0.f;
    {
        const int lane = launder(tid) & 63, r = lane & 31, h = lane >> 5; (void)r; (void)h;
        float cw[3][8], gbv[8], u1[8], u2[8];
#pragma unroll
        for (int k = 0; k < 3; ++k) { const f32x4 a = ldg<f32x4>(p.conv_w, (unsigned)(k * MIXB + 8 * lane) * 4u), c = ldg<f32x4>(p.conv_w, (unsigned)(k * MIXB + 8 * lane + 4) * 4u);
#pragma unroll
            for (int e = 0; e < 4; ++e) { cw[k][e] = a[e]; cw[k][4 + e] = c[e]; } }
        { const f32x4 a = ldg<f32x4>(p.g_b, (unsigned)(8 * lane) * 4u), c = ldg<f32x4>(p.g_b, (unsigned)(8 * lane + 4) * 4u);
#pragma unroll
            for (int e = 0; e < 4; ++e) { gbv[e] = a[e]; gbv[4 + e] = c[e]; } }
        const int p0 = NMETA + s0 + 8 * wv;
        u32x4 bvv[8], cvv[10], vvv[10];
#pragma unroll
        for (int i = 0; i < 10; ++i) { const unsigned ro = (unsigned)(p0 - 2 + i) * 4096u + lane * 16u; cvv[i] = ldg<u32x4>(pbat, ro + 2048u); vvv[i] = ldg<u32x4>(pbat, ro + 3072u); if (i >= 2) bvv[i - 2] = ldg<u32x4>(pbat, ro + 1024u); }
    {
        const int cp = tid & 255, th = __builtin_amdgcn_readfirstlane(tid >> 8), g = __builtin_amdgcn_readfirstlane(cp >> 6);
        const int p0 = NMETA + s0 + 32 * th;
        LAS unsigned char* dst = lds + (32 * th) * TROW + cp * 4;
        if (g == 0) pool_window<2>(pbat, p0, cp, dst); else if (g == 1) pool_window<4>(pbat, p0, cp, dst); else if (g == 2) pool_window<8>(pbat, p0, cp, dst); else pool_window<16>(pbat, p0, cp, dst);
    }
#pragma unroll
        for (int e = 0; e < 4; ++e) { u2[2 * e] = bf_lo(cvv[0][e]) * bf_lo(vvv[0][e]); u2[2 * e + 1] = bf_hi(cvv[0][e]) * bf_hi(vvv[0][e]); u1[2 * e] = bf_lo(cvv[1][e]) * bf_lo(vvv[1][e]); u1[2 * e + 1] = bf_hi(cvv[1][e]) * bf_hi(vvv[1][e]); }
#pragma unroll
        for (int tk = 0; tk < 8; ++tk) {
            const u32x4 bv = bvv[tk], cv = cvv[tk + 2], vv = vvv[tk + 2];
            float z[8], ss = 0.f;
#pragma unroll
            for (int e = 0; e < 8; ++e) {
                const float bb = (e & 1) ? bf_hi(bv[e >> 1]) : bf_lo(bv[e >> 1]);
                const float u0 = ((e & 1) ? bf_hi(cv[e >> 1]) : bf_lo(cv[e >> 1])) * ((e & 1) ? bf_hi(vv[e >> 1]) : bf_lo(vv[e >> 1]));
                const float conv = u2[e] * cw[0][e] + u1[e] * cw[1][e] + u0 * cw[2][e];
                z[e] = bb * conv; ss += z[e] * z[e];
                u2[e] = u1[e]; u1[e] = u0;
            }
            ss = wave_sum(ss);
            const float rsb = rsqrtf(ss * (1.0f / MIXB) + EPS);
            u32x4 o; o.x = pk_bf16(z[0] * rsb * gbv[0], z[1] * rsb * gbv[1]); o.y = pk_bf16(z[2] * rsb * gbv[2], z[3] * rsb * gbv[3]);
            o.z = pk_bf16(z[4] * rsb * gbv[4], z[5] * rsb * gbv[5]); o.w = pk_bf16(z[6] * rsb * gbv[6], z[7] * rsb * gbv[7]);
            *(LAS u32x4*)(lds + (8 * wv + tk) * TROW + (MIXA + 8 * lane) * 2) = o;
        }
    }
    __syncthreads();
    {
        const int lane = launder(tid) & 63, r = lane & 31, h = lane >> 5; (void)r; (void)h;
        const int g = wv >> 1, dh = wv & 1;
        const u32x4* PWF = (const u32x4*)(p.pwf);
        f32x16 acc[2][2]; acc[0][0] = zero16(); acc[0][1] = zero16(); acc[1][0] = zero16(); acc[1][1] = zero16();
        gemm22<8>(PWF + (size_t)((g * 4 + 2 * dh) * 8) * 64, lane, lds + r * TROW + g * 256 + h * 16, acc);
        float ss0 = 0.f, ss1 = 0.f;
#pragma unroll
        for (int mi = 0; mi < 2; ++mi)
#pragma unroll
            for (int q = 0; q < 4; ++q) {
                const int d = g * 128 + 32 * (2 * dh + mi) + 8 * q + 4 * h;
                const f32x4 sc = ldg<f32x4>(p.pool_scale, (unsigned)d * 4u);
#pragma unroll
                for (int e = 0; e < 4; ++e) { acc[mi][0][4 * q + e] *= sc[e]; acc[mi][1][4 * q + e] *= sc[e]; ss0 += acc[mi][0][4 * q + e] * acc[mi][0][4 * q + e]; ss1 += acc[mi][1][4 * q + e] * acc[mi][1][4 * q + e]; }
            }
        ss0 += __shfl_xor(ss0, 32); ss1 += __shfl_xor(ss1, 32);
        if (h == 0) { atomicAdd((float*)(ssa + r), ss0); atomicAdd((float*)(ssa + 32 + r), ss1); }
        __syncthreads();
        const float ra0 = rsqrtf(ssa[r] * (1.0f / MIXA) + EPS), ra1 = rsqrtf(ssa[32 + r] * (1.0f / MIXA) + EPS);
#pragma unroll
        for (int mi = 0; mi < 2; ++mi)
#pragma unroll
            for (int q = 0; q < 4; ++q) {
                const int d = g * 128 + 32 * (2 * dh + mi) + 8 * q + 4 * h;
                const f32x4 gg = ldg<f32x4>(p.g_a, (unsigned)d * 4u);
                u32x2 o0, o1;
                o0.x = pk_bf16(acc[mi][0][4 * q] * ra0 * gg[0], acc[mi][0][4 * q + 1] * ra0 * gg[1]); o0.y = pk_bf16(acc[mi][0][4 * q + 2] * ra0 * gg[2], acc[mi][0][4 * q + 3] * ra0 * gg[3]);
                o1.x = pk_bf16(acc[mi][1][4 * q] * ra1 * gg[0], acc[mi][1][4 * q + 1] * ra1 * gg[1]); o1.y = pk_bf16(acc[mi][1][4 * q + 2] * ra1 * gg[2], acc[mi][1][4 * q + 3] * ra1 * gg[3]);
                *(LAS u32x2*)(lds + r * TROW + d * 2) = o0;
                *(LAS u32x2*)(lds + (32 + r) * TROW + d * 2) = o1;
            }
    }
    __syncthreads();
    f32x4 xa[4][4];
    {
        const int lane = launder(tid) & 63, r = lane & 31, h = lane >> 5; (void)r; (void)h;
#pragma unroll
        for (int rr = 0; rr < 4; ++rr)
#pragma unroll
            for (int i = 0; i < 4; ++i) xa[rr][i] = ldg<f32x4>(xt, (unsigned)((8 * wv + rr) * D + i * 256 + 4 * lane) * 4u);
        const u32x4* WF = (const u32x4*)(p.woutf);
        const LAS unsigned char* bp = lds + r * TROW + h * 16;
#pragma unroll 1
        for (int rdx = 0; rdx < 2; ++rdx) {
            const int rd = (rdx + (tile >> 7)) & 1;
            const int i0 = 4 * wv + 2 * rd;
            f32x16 acc[2][2]; acc[0][0] = zero16(); acc[0][1] = zero16(); acc[1][0] = zero16(); acc[1][1] = zero16();
            gemm22<64>(WF + (size_t)i0 * 64 * 64, lane, bp, acc, (tile >> 3) & 15);
            LAS unsigned char* eb = lds + LDS_LUT + wv * 2048;
#pragma unroll
            for (int nt = 0; nt < 2; ++nt)
#pragma unroll
                for (int hf = 0; hf < 2; ++hf) {
                    if ((r >> 4) == hf) {
#pragma unroll
                        for (int mi = 0; mi < 2; ++mi)
#pragma unroll
                            for (int q = 0; q < 4; ++q) {
                                u32x2 hw; hw.x = pk_bf16(acc[mi][nt][4 * q], acc[mi][nt][4 * q + 1]); hw.y = pk_bf16(acc[mi][nt][4 * q + 2], acc[mi][nt][4 * q + 3]);
                                *(LAS u32x2*)(eb + (r & 15) * 128 + (((4 * mi + q) ^ (r & 7)) * 16) + 8 * h) = hw;
                            }
                    }
                    wave_sync();
                    u32x4 ov[2];
#pragma unroll
                    for (int k = 0; k < 2; ++k) { const int row = 8 * k + (lane >> 3); ov[k] = *(const LAS u32x4*)(eb + row * 128 + (((lane & 7) ^ (row & 7)) * 16)); }
                    wave_sync();
#pragma unroll
                    for (int k = 0; k < 2; ++k) { const int row = 8 * k + (lane >> 3); stg<u32x4>(ht, (unsigned)((nt * 32 + hf * 16 + row) * D + 32 * i0) * 2u + (unsigned)(lane & 7) * 16u, ov[k]); }
                }
        }
    }
    __syncthreads();
    {
        const int lane = launder(tid) & 63;
        f32x4 gg[4];
#pragma unroll
        for (int i = 0; i < 4; ++i) gg[i] = ldg<f32x4>(p.g_ffn, (unsigned)(i * 256 + 4 * lane) * 4u);
        f32x4 xb[4][4];
#pragma unroll
        for (int rr = 0; rr < 4; ++rr)
#pragma unroll
            for (int i = 0; i < 4; ++i) xb[rr][i] = ldg<f32x4>(xt, (unsigned)((8 * wv + 4 + rr) * D + i * 256 + 4 * lane) * 4u);
        u32x2 hq[8][4];
#pragma unroll
        for (int rr = 0; rr < 4; ++rr)
#pragma unroll
            for (int i = 0; i < 4; ++i) hq[rr][i] = ldg<u32x2>(ht, (unsigned)((8 * wv + rr) * D + i * 256 + 4 * lane) * 2u);
        p2_xf_batch<0>(p, tile, wv, lane, lds, ht, xa, hq, gg);
#pragma unroll
        for (int rr = 4; rr < 8; ++rr)
#pragma unroll
            for (int i = 0; i < 4; ++i) hq[rr][i] = ldg<u32x2>(ht, (unsigned)((8 * wv + rr) * D + i * 256 + 4 * lane) * 2u);
        p2_xf_batch<4>(p, tile, wv, lane, lds, ht, xb, hq, gg);
    }
    __syncthreads();
    {
        const int lane = launder(tid) & 63, r = lane & 31, h = lane >> 5; (void)r; (void)h;
        const int hd = wv;
        const u32x4* WQF = (const u32x4*)(p.wqf);
        const u32x4* KF = (const u32x4*)(p.kf);
        unsigned char* lstt = p.lst + (size_t)tile * 64 * (NH * 32 * 4);
        unsigned char* idxt = p.idx + (size_t)tile * 64 * (HK * 2);
        unsigned char* gatet = p.gate + (size_t)tile * 64 * (HK * 4);
        const LAS unsigned char* bp = lds + r * TROWB + h * 16;
        const float sx0 = ((const LAS float*)(lds + LDS_RS))[r], sx1 = ((const LAS float*)(lds + LDS_RS))[32 + r];
        LAS unsigned char* lut = lds + LDS_LUT + wv * 2048;
#pragma unroll
        for (int pp = 0; pp < 2; ++pp) {
            const int hp = hd * 2 + pp;
            u32x4 qb[8];
            LAS u32x4* qpark = (LAS u32x4*)(lds + 64 * TROWB + wv * 8192) + lane;
#pragma unroll
            for (int mh = 0; mh < 2; ++mh) {
                const int mt0 = hp * 4 + mh * 2;
                i32x16 acc[2][2]; acc[0][0] = izero16(); acc[0][1] = izero16(); acc[1][0] = izero16(); acc[1][1] = izero16();
                gemm22i<32, QCH>(WQF + (size_t)mt0 * 32 * 64, lane, bp, acc, (tile >> 3));
#pragma unroll
                for (int mi = 0; mi < 2; ++mi)
#pragma unroll
                    for (int s2 = 0; s2 < 2; ++s2) {
                        const f32x4 w0 = ldg<f32x4>(p.wscq, (unsigned)(32 * (mt0 + mi) + 16 * s2 + 4 * h) * 4u), w1 = ldg<f32x4>(p.wscq, (unsigned)(32 * (mt0 + mi) + 16 * s2 + 8 + 4 * h) * 4u);
#pragma unroll
                        for (int nt = 0; nt < 2; ++nt) {
                            const float xs = nt ? sx1 : sx0;
                            u32x4 o; o.x = pk_bf16((float)acc[mi][nt][8 * s2] * xs * w0[0], (float)acc[mi][nt][8 * s2 + 1] * xs * w0[1]); o.y = pk_bf16((float)acc[mi][nt][8 * s2 + 2] * xs * w0[2], (float)acc[mi][nt][8 * s2 + 3] * xs * w0[3]);
                            o.z = pk_bf16((float)acc[mi][nt][8 * s2 + 4] * xs * w1[0], (float)acc[mi][nt][8 * s2 + 5] * xs * w1[1]); o.w = pk_bf16((float)acc[mi][nt][8 * s2 + 6] * xs * w1[2], (float)acc[mi][nt][8 * s2 + 7] * xs * w1[3]);
                            if (nt == 0) qb[2 * (mh * 2 + mi) + s2] = o; else qpark[(2 * (mh * 2 + mi) + s2) * 64] = o;
                        }
                    }
            }
#pragma unroll
            for (int nt = 0; nt < 2; ++nt) {
                float top[16];
#pragma unroll
                for (int i = 0; i < 16; ++i) top[i] = -INFINITY;
                if (nt == 1) {
#pragma unroll
                    for (int ks = 0; ks < 8; ++ks) qb[ks] = qpark[ks * 64];
                }
                const u32x4* kfp = KF + (size_t)(hp * 4 * 8) * 64;
                u32x4 kf[8];
#pragma unroll
                for (int ks = 0; ks < 8; ++ks) kf[ks] = ldg<u32x4>(kfp, (unsigned)(ks * 64 + lane) * 16u);
#pragma unroll 1
                for (int kt = 0; kt < 4; ++kt) {
                    f32x16 sa = zero16();
#pragma unroll
                    for (int ks = 0; ks < 8; ++ks) sa = mfma32(kf[ks], qb[ks], sa);
                    __builtin_amdgcn_sched_barrier(0);
                    const int ktn = (kt + 1) & 3;
#pragma unroll
                    for (int ks = 0; ks < 8; ++ks) kf[ks] = ldg<u32x4>(kfp, (unsigned)((ktn * 8 + ks) * 64 + lane) * 16u);
                    __builtin_amdgcn_sched_barrier(0);
                    float v[16];
#pragma unroll
                    for (int i = 0; i < 16; ++i) v[i] = embed_bits(sa[i], 127u, (unsigned)(32 * kt + (i & 3) + 8 * (i >> 2) + 4 * h));
                    bitonic_sort_desc<4>(v); merge_top16(top, v);
                    __builtin_amdgcn_sched_barrier(0);
                }
                float o[16];
#pragma unroll
                for (int i = 0; i < 16; ++i) o[i] = __shfl_xor(top[i], 32);
                merge_top16(top, o);
                if (h == 0) {
                    const unsigned lo = (unsigned)((((nt * 32 + r) * NH + hd) * 2 + pp) * 16) * 4u;
#pragma unroll
                    for (int w4 = 0; w4 < 4; ++w4) { f32x4 tv; tv[0] = top[4 * w4]; tv[1] = top[4 * w4 + 1]; tv[2] = top[4 * w4 + 2]; tv[3] = top[4 * w4 + 3]; stg<f32x4>(lstt, lo + 16u * w4, tv); }
                    u32x4 kb;
#pragma unroll
                    for (int w4 = 0; w4 < 4; ++w4) kb[w4] = (__builtin_bit_cast(unsigned, top[4 * w4]) & 127u) | ((__builtin_bit_cast(unsigned, top[4 * w4 + 1]) & 127u) << 8) | ((__builtin_bit_cast(unsigned, top[4 * w4 + 2]) & 127u) << 16) | ((__builtin_bit_cast(unsigned, top[4 * w4 + 3]) & 127u) << 24);
                    *(LAS u32x4*)(lut + ((nt * 32 + r) * 2 + pp) * 16) = kb;
                }
            }
        }
#pragma unroll
        for (int nt = 0; nt < 2; ++nt) {
            float s1[16], s2[16];
            {
                const unsigned lo = (unsigned)(((nt * 32 + r) * NH + hd) * 32) * 4u;
#pragma unroll
                for (int w4 = 0; w4 < 4; ++w4) { const f32x4 a = ldg<f32x4>(lstt, lo + 16u * w4), c = ldg<f32x4>(lstt, lo + 64u + 16u * w4);
#pragma unroll
                    for (int e4 = 0; e4 < 4; ++e4) { s1[4 * w4 + e4] = a[e4]; s2[4 * w4 + e4] = c[e4]; } }
            }
            float top[16];
#pragma unroll
            for (int i = 0; i < 16; ++i) top[i] = -INFINITY;
            { float v[16]; v[0] = embed_bits(s1[0] + s2[0], 255u, 0u); v[1] = embed_bits(s1[0] + s2[1], 255u, 1u); v[2] = embed_bits(s1[0] + s2[2], 255u, 2u); v[3] = embed_bits(s1[0] + s2[3], 255u, 3u); v[4] = embed_bits(s1[0] + s2[4], 255u, 4u); v[5] = embed_bits(s1[0] + s2[5], 255u, 5u); v[6] = embed_bits(s1[0] + s2[6], 255u, 6u); v[7] = embed_bits(s1[0] + s2[7], 255u, 7u); v[8] = embed_bits(s1[0] + s2[8], 255u, 8u); v[9] = embed_bits(s1[0] + s2[9], 255u, 9u); v[10] = embed_bits(s1[0] + s2[10], 255u, 10u); v[11] = embed_bits(s1[0] + s2[11], 255u, 11u); v[12] = embed_bits(s1[0] + s2[12], 255u, 12u); v[13] = embed_bits(s1[0] + s2[13], 255u, 13u); v[14] = embed_bits(s1[0] + s2[14], 255u, 14u); v[15] = embed_bits(s1[0] + s2[15], 255u, 15u);
              bitonic_sort_desc<4>(v); merge_top16(top, v); }
            { float v[16]; v[0] = embed_bits(s1[1] + s2[0], 255u, 16u); v[1] = embed_bits(s1[1] + s2[1], 255u, 17u); v[2] = embed_bits(s1[1] + s2[2], 255u, 18u); v[3] = embed_bits(s1[1] + s2[3], 255u, 19u); v[4] = embed_bits(s1[1] + s2[4], 255u, 20u); v[5] = embed_bits(s1[1] + s2[5], 255u, 21u); v[6] = embed_bits(s1[1] + s2[6], 255u, 22u); v[7] = embed_bits(s1[1] + s2[7], 255u, 23u); v[8] = embed_bits(s1[2] + s2[0], 255u, 32u); v[9] = embed_bits(s1[2] + s2[1], 255u, 33u); v[10] = embed_bits(s1[2] + s2[2], 255u, 34u); v[11] = embed_bits(s1[2] + s2[3], 255u, 35u); v[12] = embed_bits(s1[2] + s2[4], 255u, 36u); v[13] = embed_bits(s1[3] + s2[0], 255u, 48u); v[14] = embed_bits(s1[3] + s2[1], 255u, 49u); v[15] = embed_bits(s1[3] + s2[2], 255u, 50u);
              bitonic_sort_desc<4>(v); merge_top16(top, v); }
            { float v[16]; v[0] = embed_bits(s1[3] + s2[3], 255u, 51u); v[1] = embed_bits(s1[4] + s2[0], 255u, 64u); v[2] = embed_bits(s1[4] + s2[1], 255u, 65u); v[3] = embed_bits(s1[4] + s2[2], 255u, 66u); v[4] = embed_bits(s1[5] + s2[0], 255u, 80u); v[5] = embed_bits(s1[5] + s2[1], 255u, 81u); v[6] = embed_bits(s1[6] + s2[0], 255u, 96u); v[7] = embed_bits(s1[6] + s2[1], 255u, 97u); v[8] = embed_bits(s1[7] + s2[0], 255u, 112u); v[9] = embed_bits(s1[7] + s2[1], 255u, 113u); v[10] = embed_bits(s1[8] + s2[0], 255u, 128u); v[11] = embed_bits(s1[9] + s2[0], 255u, 144u); v[12] = embed_bits(s1[10] + s2[0], 255u, 160u); v[13] = embed_bits(s1[11] + s2[0], 255u, 176u); v[14] = embed_bits(s1[12] + s2[0], 255u, 192u); v[15] = embed_bits(s1[13] + s2[0], 255u, 208u);
              bitonic_sort_desc<4>(v); merge_top16(top, v); }
            { float v[16]; v[0] = embed_bits(s1[14] + s2[0], 255u, 224u); v[1] = embed_bits(s1[15] + s2[0], 255u, 240u); v[2] = -INFINITY; v[3] = -INFINITY; v[4] = -INFINITY; v[5] = -INFINITY; v[6] = -INFINITY; v[7] = -INFINITY; v[8] = -INFINITY; v[9] = -INFINITY; v[10] = -INFINITY; v[11] = -INFINITY; v[12] = -INFINITY; v[13] = -INFINITY; v[14] = -INFINITY; v[15] = -INFINITY;
              bitonic_sort_desc<4>(v); merge_top16(top, v); }
            float e[16], sum = 0.f;
#pragma unroll
            for (int i = 0; i < 16; ++i) { e[i] = __expf(top[i] - top[0]); sum += e[i]; }
            const float inv = 1.0f / sum;
            const unsigned to = (unsigned)((nt * 32 + r) * HK + 2 * hd) * 4u;
            const LAS unsigned char* lt = lut + (nt * 32 + r) * 32;
            if (h == 0) {
                int ids[16];
#pragma unroll
                for (int i = 0; i < 16; ++i) { const unsigned code = __builtin_bit_cast(unsigned, top[i]) & 255u; ids[i] = (int)lt[code >> 4] * NKEYS + (int)lt[16 + (code & 15u)]; }
#pragma unroll
                for (int i = 0; i < 8; ++i) stg<unsigned>(idxt, (to >> 1) + (unsigned)(16 * i) * 2u, (unsigned)ids[i] | ((unsigned)ids[i + 8] << 16));
            } else {
#pragma unroll
                for (int i = 0; i < 8; ++i) { f32x2 gv; gv[0] = e[i] * inv; gv[1] = e[i + 8] * inv; stg<f32x2>(gatet, to + (unsigned)(16 * i) * 4u, gv); }
            }
        }
    }
}

__device__ __forceinline__ int dot16_i8(u32x4 a, u32x4 b) {
    int d = __builtin_amdgcn_sdot4((int)a[0], (int)b[0], 0, false);
    d = __builtin_amdgcn_sdot4((int)a[1], (int)b[1], d, false); d = __builtin_amdgcn_sdot4((int)a[2], (int)b[2], d, false); d = __builtin_amdgcn_sdot4((int)a[3], (int)b[3], d, false);
    return d;
}
__device__ __forceinline__ float gelu_exact(float z) { return 0.5f * z * (1.0f + erff(z * 0.70710678118654752f)); }

struct GMeta { int ids[16]; u32x4 x; };
struct GRows { u32x4 v[16]; };
__device__ __forceinline__ void g_rows(const unsigned char* slice, const GMeta& m, int lane, GRows& r) {
    const unsigned co = (unsigned)(lane & 7) * 16u;
#pragma unroll
    for (int i = 0; i < 16; ++i) r.v[i] = ldg<u32x4>(slice, (unsigned)m.ids[i] * 128u + co);
}

constexpr int P3W_Z = 0, P3W_CQ = 4096, P3W_SC = 5120, P3W_SSQ = 5152, P3W_ID = 5184, P3W_X = 7232, P3W_BYTES = 15424;
__device__ __forceinline__ void p3_wave(const Params& p, int tb0, int tb1, int lt, int pos, int lane, LAS unsigned char* wl) {
    const int ntok = 1 << lt, nts = 8 << lt;
    auto tokf = [&](int q) { return (q < 4 ? tb0 : tb1) + (q & 3); };
    const int grp = lane >> 3, ch = lane & 7, i0 = ((ch >> 2) & 1) * 8 + ((ch >> 1) & 1) * 4 + (ch & 1) * 2;
    LAS int* zl = (LAS int*)(wl + P3W_Z);
    LAS float* scl = (LAS float*)(wl + P3W_SC);
    LAS float* ssl = (LAS float*)(wl + P3W_SSQ);
#pragma unroll
    for (int q = 0; q < 8; ++q) if (q < ntok) {
        const int t = tokf(q);
        *(LAS unsigned*)(wl + P3W_ID + q * 256 + lane * 4) = ldg<unsigned>(p.idx + (size_t)t * (HK * 2), (unsigned)lane * 4u);
        *(LAS u32x4*)(wl + P3W_X + q * 1024 + lane * 16) = ldg<u32x4>(p.xq + (size_t)t * D, (unsigned)lane * 16u);
    }
    wave_sync();
    auto ids_lds = [&](int q, GMeta& m) {
#pragma unroll
        for (int w = 0; w < 2; ++w) { const u32x4 a = *(const LAS u32x4*)(wl + P3W_ID + q * 256 + grp * 32 + 16 * w);
#pragma unroll
            for (int e = 0; e < 4; ++e) { m.ids[8 * w + 2 * e] = (int)(a[e] & 0xffffu); m.ids[8 * w + 2 * e + 1] = (int)(a[e] >> 16); } }
    };
#pragma unroll 1
    for (int st = 0; st < 8; ++st) {
        const int j = (pos + st) & 7;
        const unsigned char* slice = p.eut + (size_t)j * (16384 * 128);
        const unsigned xo = (unsigned)(128 * j + 16 * ch);
#pragma unroll 1
        for (int q = 0; q < ntok; ++q) {
            const int t = tokf(q);
            GMeta m; GRows r; ids_lds(q, m); m.x = *(const LAS u32x4*)(wl + P3W_X + q * 1024 + xo); g_rows(slice, m, lane, r); (void)t;
            int part[16];
#pragma unroll
            for (int i = 0; i < 16; ++i) part[i] = dot16_i8(r.v[i], m.x);
#pragma unroll
            for (int lv = 2; lv >= 0; --lv) {
                const int n = 2 << lv, off = 1 << lv;
                const bool up = (lane & off) != 0;
#pragma unroll
                for (int i = 0; i < n; ++i) { const int a = part[i], c = part[i + n]; const int send = up ? a : c, keep = up ? c : a; part[i] = keep + __shfl_xor(send, off); }
            }
            LAS int* zp = zl + q * 128 + 2 * lane;
            if (st == 0) { zp[0] = part[0]; zp[1] = part[1]; } else { zp[0] += part[0]; zp[1] += part[1]; }
        }
    }
    {
        const unsigned po = (unsigned)(grp * 16 + i0) * 4u, po2 = (unsigned)(grp * 16 + i0) * 2u;
        unsigned idw[8]; f32x2 g[8]; float sx[8];
#pragma unroll
        for (int q = 0; q < 8; ++q) { const int t = tokf(q < ntok ? q : 0); idw[q] = *(const LAS unsigned*)(wl + P3W_ID + (q < ntok ? q : 0) * 256 + po2); g[q] = ldg<f32x2>(p.gate + (size_t)t * (HK * 4), po); sx[q] = ((const float*)p.sx)[t]; }
        float su0[8], su1[8], sv0[8], sv1[8];
#pragma unroll
        for (int q = 0; q < 8; ++q) { const int a = (int)(idw[q] & 0xffffu), c = (int)(idw[q] >> 16); su0[q] = ((const float*)p.su)[a]; su1[q] = ((const float*)p.su)[c]; sv0[q] = ((const float*)p.sv)[a]; sv1[q] = ((const float*)p.sv)[c]; }
#pragma unroll
        for (int q = 0; q < 8; ++q) if (q < ntok) {
            const int z0 = zl[q * 128 + 2 * lane], z1 = zl[q * 128 + 2 * lane + 1];
            const float c0 = g[q][0] * gelu_exact((float)z0 * (sx[q] * su0[q])) * sv0[q];
            const float c1 = g[q][1] * gelu_exact((float)z1 * (sx[q] * su1[q])) * sv1[q];
            float am = fmaxf(fabsf(c0), fabsf(c1));
#pragma unroll
            for (int o = 32; o > 0; o >>= 1) am = fmaxf(am, __shfl_xor(am, o));
            const float inv = am > 0.f ? 127.0f / am : 0.f;
            const unsigned q0 = (unsigned)(int)rintf(c0 * inv) & 255u, q1 = (unsigned)(int)rintf(c1 * inv) & 255u;
            *(LAS unsigned short*)(wl + P3W_CQ + q * 128 + 16 * grp + i0) = (unsigned short)(q0 | (q1 << 8));
            if (lane == 0) { scl[q] = am * (1.0f / 127.0f); ssl[q] = 0.f; }
        }
    }
    wave_sync();
    {
        const int e0 = ((lane >> 5) & 1) * 8 + ((lane >> 4) & 1) * 4 + ((lane >> 3) & 1) * 2;
        auto meta = [&](int n, GMeta& m, float& sc, f32x2& hv) {
            const int nn = n < nts ? n : nts - 1, q = nn & (ntok - 1), j = (pos + (nn >> lt)) & 7, t = tokf(q);
            ids_lds(q, m);
            m.x = *(const LAS u32x4*)(wl + P3W_CQ + q * 128 + 16 * grp);
            sc = scl[q];
            { const unsigned hw = ldg<unsigned>(p.hb + (size_t)t * D * 2, (unsigned)(128 * j + 16 * ch + e0) * 2u); hv[0] = bf_lo(hw); hv[1] = bf_hi(hw); }
        };
        auto rows = [&](int n, const GMeta& m, GRows& r) { const int nn = n < nts ? n : nts - 1; g_rows(p.evt + (size_t)((pos + (nn >> lt)) & 7) * (16384 * 128), m, lane, r); };
        auto finish = [&](int n, const GMeta& m, const GRows& r, float sc, f32x2 hv) {
            const int q = n & (ntok - 1), j = (pos + (n >> lt)) & 7, t = tokf(q);
            int acc[16];
#pragma unroll
            for (int e = 0; e < 16; ++e) acc[e] = 0;
#pragma unroll
            for (int g = 0; g < 4; ++g)
#pragma unroll
                for (int e = 0; e < 4; ++e) {
                    const unsigned A = r.v[4 * g][e], B = r.v[4 * g + 1][e], C = r.v[4 * g + 2][e], Dd = r.v[4 * g + 3][e];
                    const unsigned t0 = __builtin_amdgcn_perm(B, A, 0x05010400u), t1 = __builtin_amdgcn_perm(B, A, 0x07030602u);
                    const unsigned t2 = __builtin_amdgcn_perm(Dd, C, 0x05010400u), t3 = __builtin_amdgcn_perm(Dd, C, 0x07030602u);
                    const unsigned r0 = __builtin_amdgcn_perm(t2, t0, 0x05040100u), r1 = __builtin_amdgcn_perm(t2, t0, 0x07060302u);
                    const unsigned r2 = __builtin_amdgcn_perm(t3, t1, 0x05040100u), r3 = __builtin_amdgcn_perm(t3, t1, 0x07060302u);
                    const int cq = (int)m.x[g];
                    acc[4 * e] = __builtin_amdgcn_sdot4((int)r0, cq, acc[4 * e], false); acc[4 * e + 1] = __builtin_amdgcn_sdot4((int)r1, cq, acc[4 * e + 1], false);
                    acc[4 * e + 2] = __builtin_amdgcn_sdot4((int)r2, cq, acc[4 * e + 2], false); acc[4 * e + 3] = __builtin_amdgcn_sdot4((int)r3, cq, acc[4 * e + 3], false);
                }
#pragma unroll
            for (int lv = 2; lv >= 0; --lv) {
                const int n2 = 2 << lv, off = 8 << lv;
                const bool up = (lane & off) != 0;
#pragma unroll
                for (int i = 0; i < n2; ++i) { const int a = acc[i], c = acc[i + n2]; const int send = up ? a : c, keep = up ? c : a; acc[i] = keep + __shfl_xor(send, off); }
            }
            f32x2 o; o[0] = (float)acc[0] * sc + hv[0]; o[1] = (float)acc[1] * sc + hv[1];
            const float ss = wave_sum(o[0] * o[0] + o[1] * o[1]);
            stg<f32x2>(p.out + (size_t)t * D, (unsigned)(128 * j + 16 * ch + e0) * 4u, o);
            if (lane == 0) ssl[q] += ss;
        };
        GMeta ma, mb; GRows ra, rb; float sa, sb; f32x2 ha, hb;
        meta(0, ma, sa, ha); meta(1, mb, sb, hb); rows(0, ma, ra);
#pragma unroll 1
        for (int n = 0; n < nts; n += 2) {
            GMeta mc; float scc; f32x2 hc;
            meta(n + 2, mc, scc, hc); rows(n + 1, mb, rb);
            __builtin_amdgcn_sched_barrier(0);
            finish(n, ma, ra, sa, ha);
            __builtin_amdgcn_sched_barrier(0);
            meta(n + 3, ma, sa, ha); rows(n + 2, mc, ra);
            __builtin_amdgcn_sched_barrier(0);
            finish(n + 1, mb, rb, sb, hb);
            __builtin_amdgcn_sched_barrier(0);
            mb = ma; sb = sa; hb = ha; ma = mc; sa = scc; ha = hc;
        }
    }
    asm volatile("s_waitcnt vmcnt(0)" ::: "memory");
    __builtin_amdgcn_fence(__ATOMIC_ACQUIRE, "agent");
    {
        f32x4 gg[4];
#pragma unroll
        for (int i = 0; i < 4; ++i) gg[i] = ldg<f32x4>(p.g_fin, (unsigned)(i * 256 + 4 * lane) * 4u);
#pragma unroll 1
        for (int qb = 0; qb < ntok; qb += 4) {
            f32x4 a[4][4];
#pragma unroll
            for (int b = 0; b < 4; ++b)
#pragma unroll
                for (int i = 0; i < 4; ++i) a[b][i] = ldg<f32x4>(p.out + (size_t)tokf(qb + b) * D, (unsigned)(i * 256 + 4 * lane) * 4u);
#pragma unroll
            for (int b = 0; b < 4; ++b) {
                const float rv = rsqrtf(ssl[qb + b] * (1.0f / D) + EPS);
#pragma unroll
                for (int i = 0; i < 4; ++i) { f32x4 ov;
#pragma unroll
                    for (int e = 0; e < 4; ++e) ov[e] = a[b][i][e] * rv * gg[i][e];
                    stg<f32x4>(p.out + (size_t)tokf(qb + b) * D, (unsigned)(i * 256 + 4 * lane) * 4u, ov); }
            }
        }
    }
}

#define XB_TMO      128
#define XB_XCNT(j)  (256  + 64 * (j))
#define XB_XSUB(j)  (1280 + 64 * (j))
#define XB_XGEN(j)  (2304 + 64 * (j))
#define XB_TOP      3328
#define XB_TOPGEN   3392
#define XCD_BAR_WORDS 3456
#define XB_SPIN_CAP (1u << 18)

__device__ __forceinline__ unsigned xb_ld(unsigned* p)              { return __hip_atomic_load(p, __ATOMIC_RELAXED, __HIP_MEMORY_SCOPE_AGENT); }
__device__ __forceinline__ unsigned xb_add(unsigned* p, unsigned v) { return __hip_atomic_fetch_add(p, v, __ATOMIC_RELAXED, __HIP_MEMORY_SCOPE_AGENT); }
__device__ __forceinline__ unsigned xb_xcc_id() { return (unsigned)__builtin_amdgcn_s_getreg((3 << 11) | 20) & 0xFu; }
#define XB_SPIN(cond, bar) do { unsigned _sp = 0; while (cond) { __builtin_amdgcn_s_sleep(1); \
    if ((++_sp & 255u) == 0u) { if (xb_ld(&(bar)[XB_TMO])) break; if (_sp > XB_SPIN_CAP) { atomicAdd(&(bar)[XB_TMO], 1u); break; } } } } while (0)

struct XcdBarrier {
    unsigned* bar; unsigned x;
    volatile LAS unsigned* st;
};

__device__ __forceinline__ XcdBarrier xcd_barrier_post(unsigned* bar, volatile LAS unsigned* st) {
    XcdBarrier b; b.bar = bar; b.x = xb_xcc_id(); b.st = st;
    if (threadIdx.x == 0) (void)xb_add(&bar[XB_XCNT(b.x)], 1u);
    return b;
}
__device__ __forceinline__ void xcd_barrier_complete(unsigned* bar, unsigned x, unsigned& nloc, unsigned& nx) {
    const unsigned G = gridDim.x * gridDim.y * gridDim.z;
    unsigned sum, cnt, mine, sp = 0u;
    for (;;) {
        sum = 0u; cnt = 0u; mine = 0u;
#pragma unroll
        for (unsigned j = 0; j < 16; ++j) { const unsigned c = xb_ld(&bar[XB_XCNT(j)]); sum += c; cnt += (c > 0u) ? 1u : 0u; mine = (j == x) ? c : mine; }
        if (sum == G) break;
        __builtin_amdgcn_s_sleep(1);
        if ((++sp & 255u) == 0u) { if (xb_ld(&bar[XB_TMO])) break; if (sp > XB_SPIN_CAP) { atomicAdd(&bar[XB_TMO], 1u); break; } }
    }
    nloc = mine > 0u ? mine : 1u; nx = cnt > 0u ? cnt : 1u;
}

__device__ __forceinline__ void xcd_barrier(const XcdBarrier& b) {
    asm volatile("s_waitcnt vmcnt(0)" ::: "memory");
    __syncthreads();
    if (threadIdx.x == 0) {
        unsigned* bar = b.bar;
        __builtin_amdgcn_s_waitcnt(0);
        unsigned nloc = b.st[0], nx = b.st[1];
        if (nloc == 0u) { xcd_barrier_complete(bar, b.x, nloc, nx); b.st[0] = nloc; b.st[1] = nx; }
        const unsigned old = xb_add(&bar[XB_XSUB(b.x)], 1u);
        const unsigned gen = old / nloc;
        if (old + 1u == (gen + 1u) * nloc) {
            __builtin_amdgcn_fence(__ATOMIC_RELEASE, "agent");
            asm volatile("s_waitcnt vmcnt(0)" ::: "memory");
            const unsigned og = xb_add(&bar[XB_TOP], 1u);
            const unsigned tg = og / nx;
            if (og + 1u == (tg + 1u) * nx) xb_add(&bar[XB_TOPGEN], 1u);
            else XB_SPIN(xb_ld(&bar[XB_TOPGEN]) == tg, bar);
            __builtin_amdgcn_fence(__ATOMIC_ACQUIRE, "agent");
            xb_add(&bar[XB_XGEN(b.x)], 1u);
            asm volatile("s_waitcnt vmcnt(0)" ::: "memory");
        } else {
            XB_SPIN(xb_ld(&bar[XB_XGEN(b.x)]) == gen, bar);
            __builtin_amdgcn_fence(__ATOMIC_ACQUIRE, "agent");
            asm volatile("s_waitcnt vmcnt(0)" ::: "memory");
        }
    }
    __syncthreads();
}


__global__ void __launch_bounds__(512) k_fwd(Params p) {
    __shared__ __attribute__((aligned(16))) unsigned char lds_raw[LDS_BYTES + 16];
    LAS unsigned char* lds = (LAS unsigned char*)lds_raw;
    const int tid = threadIdx.x, vb = blockIdx.x, nb = gridDim.x;
    volatile LAS unsigned* xbw = (volatile LAS unsigned*)(lds + LDS_BYTES);
    if (tid < 4) xbw[tid] = 0u;
    __syncthreads();
    XcdBarrier gb = xcd_barrier_post((unsigned*)p.bar, xbw);
    if (tid == 0) xbw[2] = xb_add(&((unsigned*)p.bar)[XCD_BAR_WORDS + 64 * gb.x], 1u);
    p0_prep(p, vb, nb, tid, lds);
    const bool early = vb >= 129 && vb < NTILES;
    if (early) p1_stage(p, vb, tid, lds);
    xcd_barrier(gb);
    for (int tile = vb; tile < NTILES; tile += nb) { if (!(early && tile == vb)) p1_stage(p, tile, tid, lds); p1_inproj(p, tile, tid, lds, vb, nb, tile == vb); __syncthreads(); }
    if ((tid >> 6) == 0) for (int mp = vb; mp < 32; mp += nb) p1_meta(p, mp, launder(tid) & 63);
    xcd_barrier(gb);
    for (int tile = vb; tile < NTILES; tile += nb) { p2_mix(p, tile, tid, lds); __syncthreads(); }
    xcd_barrier(gb);
    const int lane = launder(tid) & 63, wv = __builtin_amdgcn_readfirstlane(tid >> 6);
    int np = 0, mypos = 0, nloc = 1;
    {
        unsigned* bar = (unsigned*)p.bar;
        const int myx = (int)gb.x;
#pragma unroll
        for (int q = 0; q < 16; ++q) { const int c = (int)xb_ld(&bar[XB_XCNT(q)]); if (q == myx) { mypos = np; nloc = c > 0 ? c : 1; } np += (c > 0) ? 1 : 0; }
        if (np < 1) np = 1;
    }
    {
        const int rank = (int)xbw[2];
        LAS unsigned char* wl = lds + wv * P3W_BYTES;
#pragma unroll 1
        for (int k = rank; mypos + np * k < T / 32; k += 2 * nloc) {
            const int c0 = mypos + np * k, c1 = mypos + np * (k + nloc);
            p3_wave(p, 32 * c0 + 4 * wv, 32 * c1 + 4 * wv, c1 < T / 32 ? 3 : 2, mypos, lane, wl);
        }
    }
}
}

extern "C" void kernel_launch(void* const* d_in, const int* in_sizes, int n_in, void* d_out, int out_size, void* d_ws, size_t ws_size, hipStream_t stream) {
    static int grid_blocks = 0;
    if (n_in != 16 || out_size != T * D) { fprintf(stderr, "kernel_launch: unexpected sizes n_in %d out %d\n", n_in, out_size); return; }
    if (!grid_blocks) {
        int dev = 0, cus = 0, per_cu = 0;
        (void)hipGetDevice(&dev);
        (void)hipDeviceGetAttribute(&cus, hipDeviceAttributeMultiprocessorCount, dev);
        (void)hipOccupancyMaxActiveBlocksPerMultiprocessor(&per_cu, (const void*)k_fwd, 512, 0);
        if (per_cu < 1) { fprintf(stderr, "kernel_launch: occupancy query returned %d\n", per_cu); per_cu = 1; }
        grid_blocks = cus * 1;
    }
    Params p{};
    p.x = (const float*)d_in[0]; p.meta = (const float*)d_in[1]; p.g_mix = (const float*)d_in[2]; p.w_in = (const float*)d_in[3]; p.pool_w = (const float*)d_in[4];
    p.pool_scale = (const float*)d_in[5]; p.conv_w = (const float*)d_in[6]; p.g_a = (const float*)d_in[7]; p.g_b = (const float*)d_in[8]; p.w_out = (const float*)d_in[9];
    p.g_ffn = (const float*)d_in[10]; p.w_query = (const float*)d_in[11]; p.sub_keys = (const float*)d_in[12]; p.eu = (const float*)d_in[13]; p.ev = (const float*)d_in[14]; p.g_fin = (const float*)d_in[15];
    p.out = (float*)d_out;
    unsigned char* ws = (unsigned char*)d_ws;
    p.winf = ws; p.woutf = ws + (4u << 20); p.wqf = ws + (6u << 20); p.kf = ws + (10u << 20); p.pwf = p.kf + (512u << 10); p.metaf = p.pwf + (128u << 10); p.rsm = p.metaf + (64u << 10); p.bar = p.rsm + 256;
    p.eut = ws + (12u << 20); p.evt = p.eut + (32u << 20); p.proj = p.evt + (32u << 20); p.idx = p.proj + (size_t)TL * MIXIN * 2; p.gate = p.idx + (size_t)T * HK * 4; p.lst = p.gate + (size_t)T * HK * 4;
    p.su = p.lst + (size_t)T * NH * 32 * 4; p.sv = p.su + 65536; p.sx = p.sv + 65536; p.xq = p.sx + 65536; p.wsci = p.xq + (size_t)T * D; p.wscq = p.wsci + 8192; p.hb = p.wscq + 8192;
    if ((size_t)(p.hb - ws) + (size_t)T * D * 2 > ws_size) { fprintf(stderr, "kernel_launch: workspace too small\n"); return; }
    if (hipMemsetAsync(p.bar, 0, (XCD_BAR_WORDS + 64 * 16) * 4, stream) != hipSuccess) { fprintf(stderr, "kernel_launch: memset of the barrier words failed\n"); return; }
    hipLaunchKernelGGL(k_fwd, dim3(grid_blocks), dim3(512), 0, stream, p);
}
```

```cpp
#include <hip/hip_runtime.h>
#include <cstdio>
#include <cstdint>
#include <math.h>

namespace {
constexpr int D = 1024, BATCH = 4, SEQ = 4096, NMETA = 16, L = SEQ + NMETA;
constexpr int MIXA = 512, MIXB = 512, MIXIN = 2048;
constexpr int NH = 8, NKEYS = 128, DQH = 128, TOPK = 16, HK = 128;
constexpr int T = BATCH * SEQ;
constexpr int TL = BATCH * L;
constexpr float EPS = 1e-6f;

__device__ __forceinline__ float wave_sum(float v) {
#pragma unroll
    for (int o = 32; o > 0; o >>= 1) v += __shfl_xor(v, o);
    return v;
}
#define LAS __attribute__((address_space(3)))
typedef short bf16x8 __attribute__((ext_vector_type(8)));
typedef float f32x16 __attribute__((ext_vector_type(16)));
typedef float f32x4 __attribute__((ext_vector_type(4)));
typedef float f32x2 __attribute__((ext_vector_type(2)));
typedef __bf16 bf2_t __attribute__((ext_vector_type(2)));
typedef unsigned u32x4 __attribute__((ext_vector_type(4)));
typedef unsigned u32x2 __attribute__((ext_vector_type(2)));
typedef int i32x4 __attribute__((ext_vector_type(4)));
typedef int i32x16 __attribute__((ext_vector_type(16)));

constexpr int QCH = 2;
constexpr int NTILES = T / 64;
constexpr int TROW = 2064;
constexpr int TROWB = 1040;
constexpr int LDS_TILE = 64 * TROW;
constexpr int LDS_RS = LDS_TILE;
constexpr int LDS_SSA = LDS_RS + 256;
constexpr int LDS_LUT = LDS_SSA + 256;
constexpr int LDS_BYTES = LDS_LUT + 16384;

struct Params {
    const float* x; const float* meta; const float* g_mix; const float* w_in; const float* pool_w; const float* pool_scale; const float* conv_w;
    const float* g_a; const float* g_b; const float* w_out; const float* g_ffn; const float* w_query; const float* sub_keys; const float* eu; const float* ev; const float* g_fin;
    float* out;
    unsigned char *winf, *woutf, *wqf, *kf, *pwf, *metaf, *rsm, *eut, *evt, *proj, *idx, *gate, *bar, *lst, *su, *sv, *xq, *sx, *wsci, *wscq, *hb;
};

__device__ __forceinline__ unsigned pk_bf16(float lo, float hi) { f32x2 f = {lo, hi}; return __builtin_bit_cast(unsigned, __builtin_convertvector(f, bf2_t)); }
__device__ __forceinline__ float bf_lo(unsigned u) { return __builtin_bit_cast(float, u << 16); }
__device__ __forceinline__ float bf_hi(unsigned u) { return __builtin_bit_cast(float, u & 0xffff0000u); }
__device__ __forceinline__ f32x16 mfma32(u32x4 a, u32x4 b, f32x16 c) { return __builtin_amdgcn_mfma_f32_32x32x16_bf16(__builtin_bit_cast(bf16x8, a), __builtin_bit_cast(bf16x8, b), c, 0, 0, 0); }
__device__ __forceinline__ i32x16 mfma_i8(u32x4 a, u32x4 b, i32x16 c) { return __builtin_amdgcn_mfma_i32_32x32x32_i8(__builtin_bit_cast(i32x4, a), __builtin_bit_cast(i32x4, b), c, 0, 0, 0); }
__device__ __forceinline__ i32x16 izero16() { i32x16 z; for (int i = 0; i < 16; ++i) z[i] = 0; return z; }
__device__ __forceinline__ f32x16 zero16() { f32x16 z; for (int i = 0; i < 16; ++i) z[i] = 0.f; return z; }

__device__ __forceinline__ void wave_sync() { __builtin_amdgcn_fence(__ATOMIC_RELEASE, "wavefront"); __builtin_amdgcn_wave_barrier(); __builtin_amdgcn_fence(__ATOMIC_ACQUIRE, "wavefront"); }
__device__ __forceinline__ int launder(int x) { asm volatile("" : "+v"(x)); return x; }
template <class V> __device__ __forceinline__ V ldg(const void* base, unsigned off) { return *(const V*)((const unsigned char*)base + off); }
template <class V> __device__ __forceinline__ void stg(void* base, unsigned off, V v) { *(V*)((unsigned char*)base + off) = v; }

__device__ __forceinline__ void frag_from_kn(const float* __restrict__ W, int N, const float* __restrict__ g, int i, int s, int lane, u32x4* __restrict__ dst, int I8K = 0) {
    const int r = lane & 31, h = lane >> 5, k0 = 16 * s + 8 * h;
    const float* src = W + (size_t)k0 * N + 32 * i + r;
    float v[8];
#pragma unroll
    for (int j = 0; j < 8; ++j) v[j] = src[(size_t)j * N] * (g ? g[k0 + j] : 1.0f);
    u32x4 o; o.x = pk_bf16(v[0], v[1]); o.y = pk_bf16(v[2], v[3]); o.z = pk_bf16(v[4], v[5]); o.w = pk_bf16(v[6], v[7]);
    *dst = o;
}
__device__ __forceinline__ void frag2_from_kn(const float* __restrict__ W, int N, int i, int s, int lane, u32x4* __restrict__ dst) {
    const int r = lane & 31, h = lane >> 5, k0 = 16 * s + 8 * h;
    const float* src = W + (size_t)k0 * N + 32 * i + r;
    float v[16];
#pragma unroll
    for (int j = 0; j < 8; ++j) { v[j] = src[(size_t)j * N]; v[8 + j] = src[(size_t)(16 + j) * N]; }
    u32x4 o; o.x = pk_bf16(v[0], v[1]); o.y = pk_bf16(v[2], v[3]); o.z = pk_bf16(v[4], v[5]); o.w = pk_bf16(v[6], v[7]);
    u32x4 o2; o2.x = pk_bf16(v[8], v[9]); o2.y = pk_bf16(v[10], v[11]); o2.z = pk_bf16(v[12], v[13]); o2.w = pk_bf16(v[14], v[15]);
    dst[0] = o; dst[64] = o2;
}
constexpr int J_WOUT = 0, J_WQ = J_WOUT + 32 * 64, J_PW = J_WQ, J_KEY = J_PW + 128, J_END = J_KEY + 512;
__device__ __forceinline__ void mtile_i8_block(const float* __restrict__ W, const float* __restrict__ g, int i, int tid, LAS unsigned* lds_u, u32x4* __restrict__ dst, float* __restrict__ wsc) {
    const int lane = tid & 63, wv = tid >> 6, r = lane & 31, h = lane >> 5, col = 32 * i + r;
    if (tid < 32) lds_u[tid] = 0u;
    __syncthreads();
    {
        const int cg = lane & 7, ro = lane >> 3;
        f32x4 f[16];
#pragma unroll
        for (int q = 0; q < 16; ++q) f[q] = ldg<f32x4>(W, (unsigned)((128 * wv + 8 * q + ro) * 2048 + 32 * i + 4 * cg) * 4u);
        float m0 = 0.f, m1 = 0.f, m2 = 0.f, m3 = 0.f;
#pragma unroll
        for (int q = 0; q < 16; ++q) { const float gk = g ? g[128 * wv + 8 * q + ro] : 1.0f; m0 = fmaxf(m0, fabsf(f[q][0] * gk)); m1 = fmaxf(m1, fabsf(f[q][1] * gk)); m2 = fmaxf(m2, fabsf(f[q][2] * gk)); m3 = fmaxf(m3, fabsf(f[q][3] * gk)); }
#pragma unroll
        for (int o = 8; o < 64; o <<= 1) { m0 = fmaxf(m0, __shfl_xor(m0, o)); m1 = fmaxf(m1, __shfl_xor(m1, o)); m2 = fmaxf(m2, __shfl_xor(m2, o)); m3 = fmaxf(m3, __shfl_xor(m3, o)); }
        if (lane < 8) { atomicMax((unsigned*)(lds_u + 4 * cg), __builtin_bit_cast(unsigned, m0)); atomicMax((unsigned*)(lds_u + 4 * cg + 1), __builtin_bit_cast(unsigned, m1));
            atomicMax((unsigned*)(lds_u + 4 * cg + 2), __builtin_bit_cast(unsigned, m2)); atomicMax((unsigned*)(lds_u + 4 * cg + 3), __builtin_bit_cast(unsigned, m3)); }
    }
    __syncthreads();
    const float cm = __builtin_bit_cast(float, lds_u[r]);
    const float inv = cm > 0.f ? 127.0f / cm : 0.f;
    if (wv == 0 && h == 0) wsc[col] = cm * (1.0f / 127.0f);
#pragma unroll
    for (int sl = 0; sl < 4; ++sl) {
        const int s = 4 * wv + sl, k0 = 32 * s + 16 * h;
        u32x4 o;
#pragma unroll
        for (int q = 0; q < 4; ++q) {
            unsigned w = 0u;
#pragma unroll
            for (int e = 0; e < 4; ++e) { const int k = k0 + 4 * q + e; w |= ((unsigned)(int)rintf(ldg<float>(W, (unsigned)(k * 2048 + col) * 4u) * (g ? g[k] : 1.0f) * inv) & 255u) << (8 * e); }
            o[q] = w;
        }
        dst[(size_t)s * 64 + lane] = o;
    }
    __syncthreads();
}
__device__ __forceinline__ void meta_block(const Params& p, int tid, LAS float* lds_f) {
    const int lane = tid & 63, wv = tid >> 6;
#pragma unroll
    for (int q = 0; q < 2; ++q) {
        const int row = 2 * wv + q;
        float ss = 0.f, am = 0.f;
#pragma unroll
        for (int i = 0; i < 4; ++i) { const f32x4 f = *(const f32x4*)(p.meta + (size_t)row * D + i * 256 + 4 * lane); ss += f[0] * f[0] + f[1] * f[1] + f[2] * f[2] + f[3] * f[3];
            am = fmaxf(am, fmaxf(fmaxf(fabsf(f[0]), fabsf(f[1])), fmaxf(fabsf(f[2]), fabsf(f[3])))); }
        ss = wave_sum(ss);
#pragma unroll
        for (int o = 32; o > 0; o >>= 1) am = fmaxf(am, __shfl_xor(am, o));
        if (lane == 0) { ((float*)(p.rsm))[row] = rsqrtf(ss * (1.0f / D) + EPS) * am * (1.0f / 127.0f); lds_f[row] = am; }
    }
    __syncthreads();
    const int n = lane & 31, h = lane >> 5;
    const float am = n < NMETA ? lds_f[n] : 0.f;
    const float inv = am > 0.f ? 127.0f / am : 0.f;
#pragma unroll
    for (int sl = 0; sl < 4; ++sl) {
        const int s = 4 * wv + sl;
        u32x4 o = {0u, 0u, 0u, 0u};
        if (n < NMETA) {
            const float* row = p.meta + (size_t)n * D;
#pragma unroll
            for (int q = 0; q < 4; ++q) { const f32x4 f = *(const f32x4*)(row + 32 * s + 16 * h + 4 * q);
                o[q] = ((unsigned)(int)rintf(f[0] * inv) & 255u) | (((unsigned)(int)rintf(f[1] * inv) & 255u) << 8) | (((unsigned)(int)rintf(f[2] * inv) & 255u) << 16) | (((unsigned)(int)rintf(f[3] * inv) & 255u) << 24); }
        }
        ((u32x4*)(p.metaf))[(size_t)s * 64 + lane] = o;
    }
    __syncthreads();
}

__device__ __forceinline__ void p0_prep(const Params& p, int vb, int nb, int tid, LAS unsigned char* lds) {
    const int lane = tid & 63, wv = tid >> 6, gw = vb * 8 + wv, nw = nb * 8;
    for (int job = vb; job < 129; job += nb) {
        if (job < 64) mtile_i8_block(p.w_in, p.g_mix, job, tid, (LAS unsigned*)lds, (u32x4*)(p.winf) + (size_t)job * 32 * 64, (float*)p.wsci);
        else if (job < 128) mtile_i8_block(p.w_query, nullptr, job - 64, tid, (LAS unsigned*)lds, (u32x4*)(p.wqf) + (size_t)(job - 64) * 32 * 64, (float*)p.wscq);
        else meta_block(p, tid, (LAS float*)lds);
    }
    int jw = gw, jn = nw;
    if (nb >= 129 + 64) { jw = vb >= 129 ? (vb - 129) * 8 + wv : J_END; jn = (nb - 129) * 8; }
    for (int job = jw; job < J_END / 2; job += jn) {
        if (job < J_WQ / 2) { const int q = 2 * job, i = q >> 6, sA = q & 63; frag2_from_kn(p.w_out, 1024, i, sA, lane, (u32x4*)(p.woutf) + (size_t)q * 64 + lane); }
        else if (job < J_KEY / 2) { const int q = 2 * job - J_PW, g = q >> 5, mt = (q >> 3) & 3, sA = q & 7; frag2_from_kn(p.pool_w + (size_t)g * 128 * 128, 128, mt, sA, lane, (u32x4*)(p.pwf) + (size_t)q * 64 + lane); }
        else {
            const int q = 2 * job - J_KEY, hp = q >> 5, kt = (q >> 3) & 3, sA = q & 7, r = lane & 31, h = lane >> 5;
            const float* src = p.sub_keys + ((size_t)hp * 128 + 32 * kt + r) * 128 + 16 * sA + 4 * h;
            const f32x4 f0 = *(const f32x4*)src, f1 = *(const f32x4*)(src + 8), f2 = *(const f32x4*)(src + 16), f3 = *(const f32x4*)(src + 24);
            u32x4 o; o.x = pk_bf16(f0[0], f0[1]); o.y = pk_bf16(f0[2], f0[3]); o.z = pk_bf16(f1[0], f1[1]); o.w = pk_bf16(f1[2], f1[3]);
            u32x4 o2; o2.x = pk_bf16(f2[0], f2[1]); o2.y = pk_bf16(f2[2], f2[3]); o2.z = pk_bf16(f3[0], f3[1]); o2.w = pk_bf16(f3[2], f3[3]);
            ((u32x4*)(p.kf))[(size_t)q * 64 + lane] = o; ((u32x4*)(p.kf))[(size_t)(q + 1) * 64 + lane] = o2;
        }
    }
}

struct TabBatch { f32x4 f[4][4]; };
__device__ __forceinline__ int tab_rpb(int nb) { return ((2 * 16384 + nb - 1) / nb + 31) & ~31; }
__device__ __forceinline__ int tab_row(int vb, int nb, int wv, int i) { const int rpb = tab_rpb(nb), row = vb * rpb + 8 * i + wv; return (8 * i + wv < rpb && row < 2 * 16384) ? row : -1; }
__device__ __forceinline__ void tab_issue(const Params& p, int vb, int nb, int wv, int i0, int lane, TabBatch& t) {
#pragma unroll
    for (int q = 0; q < 4; ++q) {
        const int row = tab_row(vb, nb, wv, i0 + q);
        if (row >= 0) { const float* src = (row < 16384 ? p.eu : p.ev) + (size_t)(row & 16383) * D;
#pragma unroll
            for (int i = 0; i < 4; ++i) t.f[q][i] = ldg<f32x4>(src, (unsigned)(i * 256 + 4 * lane) * 4u); }
    }
}
__device__ __forceinline__ void tab_finish(const Params& p, int vb, int nb, int wv, int i0, int lane, const TabBatch& t) {
#pragma unroll
    for (int q = 0; q < 4; ++q) {
        const int row = tab_row(vb, nb, wv, i0 + q);
        if (row >= 0) {
            const bool isu = row < 16384; const int rr = row & 16383;
            float am = 0.f;
#pragma unroll
            for (int i = 0; i < 4; ++i) am = fmaxf(am, fmaxf(fmaxf(fabsf(t.f[q][i][0]), fabsf(t.f[q][i][1])), fmaxf(fabsf(t.f[q][i][2]), fabsf(t.f[q][i][3]))));
#pragma unroll
            for (int o = 32; o > 0; o >>= 1) am = fmaxf(am, __shfl_xor(am, o));
            const float inv = am > 0.f ? 127.0f / am : 0.f;
            unsigned char* dstt = isu ? p.eut : p.evt;
#pragma unroll
            for (int i = 0; i < 4; ++i) {
                unsigned w = 0u;
#pragma unroll
                for (int e = 0; e < 4; ++e) { const int qv = (int)rintf(t.f[q][i][e] * inv); w |= ((unsigned)qv & 255u) << (8 * e); }
                const unsigned c = (unsigned)(i * 256 + 4 * lane);
                stg<unsigned>(dstt, (((c >> 7) * 16384u + (unsigned)rr) << 7) + (c & 127u), w);
            }
            if (lane == 0) ((float*)(isu ? p.su : p.sv))[rr] = am * (1.0f / 127.0f);
        }
    }
}


template <int CH>
__device__ __forceinline__ void gemm22_chunk(const u32x4 (&a)[2][CH], const LAS unsigned char* b, int s0, f32x16 (&acc)[2][2]) {
#pragma unroll
    for (int u = 0; u < CH; ++u) {
        const u32x4 b0 = *(const LAS u32x4*)(b + (s0 + u) * 32), b1 = *(const LAS u32x4*)(b + 32 * TROW + (s0 + u) * 32);
        acc[0][0] = mfma32(a[0][u], b0, acc[0][0]); acc[0][1] = mfma32(a[0][u], b1, acc[0][1]);
        acc[1][0] = mfma32(a[1][u], b0, acc[1][0]); acc[1][1] = mfma32(a[1][u], b1, acc[1][1]);
    }
}
template <int KS, int CH = 4>
__device__ __forceinline__ void gemm22(const u32x4* abase, unsigned lane, const LAS unsigned char* b, f32x16 (&acc)[2][2], int kofs = 0) {
    constexpr int NC = KS / CH;
    static_assert(NC % 2 == 0 && (NC & (NC - 1)) == 0, "chunk count: even power of two");
    u32x4 pa[2][CH], pb[2][CH];
    const unsigned lo = lane * 16u;
    {
        const unsigned o0 = lo + (unsigned)((kofs & (NC - 1)) * CH) * 1024u;
#pragma unroll
        for (int u = 0; u < CH; ++u) { pa[0][u] = ldg<u32x4>(abase, o0 + u * 1024u); pa[1][u] = ldg<u32x4>(abase, o0 + (KS + u) * 1024u); }
    }
#pragma unroll 1
    for (int c = 0; c < NC; c += 2) {
        const int c0 = (c + kofs) & (NC - 1), c1 = (c + 1 + kofs) & (NC - 1), c2 = (c + 2 + kofs) & (NC - 1);
        const unsigned o1 = lo + (unsigned)(c1 * CH) * 1024u, o2 = lo + (unsigned)(c2 * CH) * 1024u;
#pragma unroll
        for (int u = 0; u < CH; ++u) { pb[0][u] = ldg<u32x4>(abase, o1 + u * 1024u); pb[1][u] = ldg<u32x4>(abase, o1 + (KS + u) * 1024u); }
        __builtin_amdgcn_sched_barrier(0);
        gemm22_chunk<CH>(pa, b, c0 * CH, acc);
        __builtin_amdgcn_sched_barrier(0);
#pragma unroll
        for (int u = 0; u < CH; ++u) { pa[0][u] = ldg<u32x4>(abase, o2 + u * 1024u); pa[1][u] = ldg<u32x4>(abase, o2 + (KS + u) * 1024u); }
        __builtin_amdgcn_sched_barrier(0);
        gemm22_chunk<CH>(pb, b, c1 * CH, acc);
        __builtin_amdgcn_sched_barrier(0);
    }
}

template <int CH>
__device__ __forceinline__ void gemm22i_chunk(const u32x4 (&a)[2][CH], const LAS unsigned char* b, int s0, i32x16 (&acc)[2][2]) {
#pragma unroll
    for (int u = 0; u < CH; ++u) {
        const u32x4 b0 = *(const LAS u32x4*)(b + (s0 + u) * 32), b1 = *(const LAS u32x4*)(b + 32 * TROWB + (s0 + u) * 32);
        acc[0][0] = mfma_i8(a[0][u], b0, acc[0][0]); acc[0][1] = mfma_i8(a[0][u], b1, acc[0][1]);
        acc[1][0] = mfma_i8(a[1][u], b0, acc[1][0]); acc[1][1] = mfma_i8(a[1][u], b1, acc[1][1]);
    }
}
template <int KS, int CH = 4>
__device__ __forceinline__ void gemm22i(const u32x4* abase, unsigned lane, const LAS unsigned char* b, i32x16 (&acc)[2][2], int kofs = 0) {
    constexpr int NC = KS / CH;
    static_assert(NC % 2 == 0 && (NC & (NC - 1)) == 0, "chunk count: even power of two");
    u32x4 pa[2][CH], pb[2][CH];
    const unsigned lo = lane * 16u;
    {
        const unsigned o0 = lo + (unsigned)((kofs & (NC - 1)) * CH) * 1024u;
#pragma unroll
        for (int u = 0; u < CH; ++u) { pa[0][u] = ldg<u32x4>(abase, o0 + u * 1024u); pa[1][u] = ldg<u32x4>(abase, o0 + (KS + u) * 1024u); }
    }
#pragma unroll 1
    for (int c = 0; c < NC; c += 2) {
        const int c0 = (c + kofs) & (NC - 1), c1 = (c + 1 + kofs) & (NC - 1), c2 = (c + 2 + kofs) & (NC - 1);
        const unsigned o1 = lo + (unsigned)(c1 * CH) * 1024u, o2 = lo + (unsigned)(c2 * CH) * 1024u;
#pragma unroll
        for (int u = 0; u < CH; ++u) { pb[0][u] = ldg<u32x4>(abase, o1 + u * 1024u); pb[1][u] = ldg<u32x4>(abase, o1 + (KS + u) * 1024u); }
        __builtin_amdgcn_sched_barrier(0);
        gemm22i_chunk<CH>(pa, b, c0 * CH, acc);
        __builtin_amdgcn_sched_barrier(0);
#pragma unroll
        for (int u = 0; u < CH; ++u) { pa[0][u] = ldg<u32x4>(abase, o2 + u * 1024u); pa[1][u] = ldg<u32x4>(abase, o2 + (KS + u) * 1024u); }
        __builtin_amdgcn_sched_barrier(0);
        gemm22i_chunk<CH>(pb, b, c1 * CH, acc);
        __builtin_amdgcn_sched_barrier(0);
    }
}

__device__ __forceinline__ void p1_stage(const Params& p, int tile, int tid, LAS unsigned char* lds) {
    const int lane = tid & 63, wv = __builtin_amdgcn_readfirstlane(tid >> 6);
    LAS float* rs = (LAS float*)(lds + LDS_RS);
    const float* xt = p.x + (size_t)tile * 64 * D;
#pragma unroll 4
    for (int rr = 0; rr < 8; ++rr) {
        const int tk = 8 * wv + rr;
        f32x4 f[4]; float ss = 0.f, am = 0.f;
#pragma unroll
        for (int i = 0; i < 4; ++i) { f[i] = ldg<f32x4>(xt, (unsigned)(tk * D + i * 256 + 4 * lane) * 4u); ss += f[i][0] * f[i][0] + f[i][1] * f[i][1] + f[i][2] * f[i][2] + f[i][3] * f[i][3];
            am = fmaxf(am, fmaxf(fmaxf(fabsf(f[i][0]), fabsf(f[i][1])), fmaxf(fabsf(f[i][2]), fabsf(f[i][3])))); }
        ss = wave_sum(ss);
#pragma unroll
        for (int o = 32; o > 0; o >>= 1) am = fmaxf(am, __shfl_xor(am, o));
        const float inv = am > 0.f ? 127.0f / am : 0.f;
        if (lane == 0) rs[tk] = rsqrtf(ss * (1.0f / D) + EPS) * am * (1.0f / 127.0f);
#pragma unroll
        for (int i = 0; i < 4; ++i) {
            unsigned w = 0u;
#pragma unroll
            for (int e = 0; e < 4; ++e) w |= ((unsigned)(int)rintf(f[i][e] * inv) & 255u) << (8 * e);
            *(LAS unsigned*)(lds + tk * TROWB + i * 256 + 4 * lane) = w;
        }
    }
    __syncthreads();
}
__device__ __forceinline__ void p1_inproj(const Params& p, int tile, int tid, LAS unsigned char* lds, int vb, int nb, bool do_tab) {
    const int lane = launder(tid) & 63, wv = __builtin_amdgcn_readfirstlane(tid >> 6), r = lane & 31, h = lane >> 5;
    const int b = tile >> 6, s0 = (tile & 63) * 64;
    LAS float* rs = (LAS float*)(lds + LDS_RS);
    const u32x4* WF = (const u32x4*)(p.winf);
    unsigned char* prow0 = p.proj + ((size_t)b * L + NMETA + s0) * (MIXIN * 2);
    const LAS unsigned char* bp = lds + r * TROWB + h * 16;
    const float rs0 = rs[r], rs1 = rs[32 + r];
    const int stg_k = (tile >> 3) & 7, stg_r = (tile >> 6) & 3;
#pragma unroll 1
    for (int rdx = 0; rdx < 4; ++rdx) {
        const int rd = (rdx + stg_r) & 3;
        const int i0 = 8 * wv + 2 * rd;
        TabBatch tb;
        if (do_tab) tab_issue(p, vb, nb, wv, 4 * rdx, lane, tb);
        __builtin_amdgcn_sched_barrier(0);
        i32x16 acc[2][2]; acc[0][0] = izero16(); acc[0][1] = izero16(); acc[1][0] = izero16(); acc[1][1] = izero16();
        gemm22i<32, 4>(WF + (size_t)i0 * 32 * 64, lane, bp, acc, stg_k);
        f32x4 wsv[2][4];
#pragma unroll
        for (int mi = 0; mi < 2; ++mi)
#pragma unroll
            for (int q = 0; q < 4; ++q) wsv[mi][q] = ldg<f32x4>(p.wsci, (unsigned)(32 * (i0 + mi) + 8 * q + 4 * h) * 4u);
        LAS unsigned char* eb = lds + 64 * TROWB + wv * 8192;
#pragma unroll
        for (int mi = 0; mi < 2; ++mi)
#pragma unroll
            for (int q = 0; q < 4; ++q) {
                const f32x4 ws = wsv[mi][q];
#pragma unroll
                for (int nt = 0; nt < 2; ++nt) {
                    const float rv = nt ? rs1 : rs0;
                    u32x2 o; o.x = pk_bf16((float)acc[mi][nt][4 * q] * rv * ws[0], (float)acc[mi][nt][4 * q + 1] * rv * ws[1]); o.y = pk_bf16((float)acc[mi][nt][4 * q + 2] * rv * ws[2], (float)acc[mi][nt][4 * q + 3] * rv * ws[3]);
                    *(LAS u32x2*)(eb + (nt * 32 + r) * 128 + (((4 * mi + q) ^ (r & 7)) * 16) + 8 * h) = o;
                }
            }
        wave_sync();
        {
            u32x4 ov[8];
#pragma unroll
            for (int k = 0; k < 8; ++k) { const int row = 8 * k + (lane >> 3); ov[k] = *(const LAS u32x4*)(eb + row * 128 + (((lane & 7) ^ (row & 7)) * 16)); }
            wave_sync();
#pragma unroll
            for (int k = 0; k < 8; ++k) { const int row = 8 * k + (lane >> 3); stg<u32x4>(prow0, (unsigned)(row * MIXIN + 32 * i0) * 2u + (unsigned)(lane & 7) * 16u, ov[k]); }
        }
        if (do_tab) tab_finish(p, vb, nb, wv, 4 * rdx, lane, tb);
    }
    if (do_tab) for (int i0 = 16; 8 * i0 < tab_rpb(nb); i0 += 4) { TabBatch tb; tab_issue(p, vb, nb, wv, i0, lane, tb); tab_finish(p, vb, nb, wv, i0, lane, tb); }
}
__device__ __forceinline__ void p1_meta(const Params& p, int mp, int lane) {
    const int r = lane & 31, h = lane >> 5;
    const u32x4* A = (const u32x4*)(p.winf) + (size_t)(2 * mp) * 32 * 64;
    const u32x4* B = (const u32x4*)(p.metaf);
    i32x16 acc0 = izero16(), acc1 = izero16();
#pragma unroll 4
    for (int s = 0; s < 32; ++s) { const u32x4 bf = ldg<u32x4>(B, (unsigned)(s * 64 + lane) * 16u);
        acc0 = mfma_i8(ldg<u32x4>(A, (unsigned)(s * 64 + lane) * 16u), bf, acc0); acc1 = mfma_i8(ldg<u32x4>(A, (unsigned)((32 + s) * 64 + lane) * 16u), bf, acc1); }
    if (r < NMETA) {
        const float rv = ((const float*)(p.rsm))[r];
#pragma unroll
        for (int q = 0; q < 4; ++q) {
            const f32x4 w0 = ldg<f32x4>(p.wsci, (unsigned)(64 * mp + 8 * q + 4 * h) * 4u), w1 = ldg<f32x4>(p.wsci, (unsigned)(64 * mp + 32 + 8 * q + 4 * h) * 4u);
            u32x2 o0, o1;
            o0.x = pk_bf16((float)acc0[4 * q] * rv * w0[0], (float)acc0[4 * q + 1] * rv * w0[1]); o0.y = pk_bf16((float)acc0[4 * q + 2] * rv * w0[2], (float)acc0[4 * q + 3] * rv * w0[3]);
            o1.x = pk_bf16((float)acc1[4 * q] * rv * w1[0], (float)acc1[4 * q + 1] * rv * w1[1]); o1.y = pk_bf16((float)acc1[4 * q + 2] * rv * w1[2], (float)acc1[4 * q + 3] * rv * w1[3]);
#pragma unroll
            for (int bb = 0; bb < BATCH; ++bb) {
                const unsigned ro = (unsigned)((bb * L + r) * MIXIN + 64 * mp + 4 * h) * 2u;
                stg<u32x2>(p.proj, ro + 16u * q, o0); stg<u32x2>(p.proj, ro + 64u + 16u * q, o1);
            }
        }
    }
}

template <int LOGN> __device__ __forceinline__ void bitonic_sort_desc(float* v) {
    constexpr int N = 1 << LOGN;
#pragma unroll
    for (int lk = 1; lk <= LOGN; ++lk) {
#pragma unroll
        for (int lj = lk - 1; lj >= 0; --lj) {
#pragma unroll
            for (int i = 0; i < N; ++i) {
                const int k = 1 << lk, j = 1 << lj, l = i ^ j;
                if (l > i) { const bool up = ((i & k) == 0); const float a = v[i], c = v[l]; const float hi = fmaxf(a, c), lo = fminf(a, c); v[i] = up ? hi : lo; v[l] = up ? lo : hi; }
            }
        }
    }
}
__device__ __forceinline__ void bitonic_merge16_desc(float* v) {
#pragma unroll
    for (int lj = 3; lj >= 0; --lj) {
#pragma unroll
        for (int i = 0; i < 16; ++i) { const int j = 1 << lj, l = i ^ j; if (l > i) { const float a = v[i], c = v[l]; v[i] = fmaxf(a, c); v[l] = fminf(a, c); } }
    }
}
__device__ __forceinline__ void merge_top16(float* a, const float* c) {
#pragma unroll
    for (int i = 0; i < 16; ++i) a[i] = fmaxf(a[i], c[15 - i]);
    bitonic_merge16_desc(a);
}
__device__ __forceinline__ void top16_of_64(float* v) {
    bitonic_sort_desc<4>(v); bitonic_sort_desc<4>(v + 16); bitonic_sort_desc<4>(v + 32); bitonic_sort_desc<4>(v + 48);
    merge_top16(v, v + 16); merge_top16(v + 32, v + 48); merge_top16(v, v + 32);
}
__device__ __forceinline__ float embed_bits(float x, unsigned mask, unsigned code) { return __builtin_bit_cast(float, (__builtin_bit_cast(unsigned, x) & ~mask) | code); }

template <int W>
__device__ __forceinline__ void pool_window(const unsigned char* pbat, int p0, int cp, LAS unsigned char* dst) {
    unsigned u[31 + W];
#pragma unroll
    for (int i = 0; i < 31 + W; ++i) u[i] = ldg<unsigned>(pbat + (size_t)(p0 - (W - 1) + i) * 4096u, cp * 4u);
    float sx = 0.f, sy = 0.f;
#pragma unroll
    for (int i = 0; i < W - 1; ++i) { sx += bf_lo(u[i]); sy += bf_hi(u[i]); }
    const float invw = 1.0f / (float)W;
#pragma unroll
    for (int tk = 0; tk < 32; ++tk) {
        const float lo = bf_lo(u[W - 1 + tk]), hi = bf_hi(u[W - 1 + tk]);
        sx += lo; sy += hi;
        *(LAS unsigned*)(dst + tk * TROW) = pk_bf16(sx * invw - lo, sy * invw - hi);
        sx -= bf_lo(u[tk]); sy -= bf_hi(u[tk]);
    }
}

template <int RB>
__device__ __forceinline__ void p2_xf_batch(const Params& p, int tile, int wv, int lane, LAS unsigned char* lds, unsigned char* ht, f32x4 (&f)[4][4], const u32x2 (&hq)[8][4], const f32x4 (&gg)[4]) {
    unsigned char* xqt = p.xq + (size_t)tile * 64 * D;
#pragma unroll
    for (int rr = 0; rr < 4; ++rr) {
        const int tk = 8 * wv + RB + rr;
        float ss = 0.f;
#pragma unroll
        for (int i = 0; i < 4; ++i) {
            const u32x2 hw = hq[RB + rr][i];
            f[rr][i][0] += bf_lo(hw.x); f[rr][i][1] += bf_hi(hw.x); f[rr][i][2] += bf_lo(hw.y); f[rr][i][3] += bf_hi(hw.y);
            u32x2 ho; ho.x = pk_bf16(f[rr][i][0], f[rr][i][1]); ho.y = pk_bf16(f[rr][i][2], f[rr][i][3]);
            stg<u32x2>(ht, (unsigned)(tk * D + i * 256 + 4 * lane) * 2u, ho);
            ss += f[rr][i][0] * f[rr][i][0] + f[rr][i][1] * f[rr][i][1] + f[rr][i][2] * f[rr][i][2] + f[rr][i][3] * f[rr][i][3];
        }
        ss = wave_sum(ss);
        const float rv = rsqrtf(ss * (1.0f / D) + EPS);
        float am = 0.f;
#pragma unroll
        for (int i = 0; i < 4; ++i)
#pragma unroll
            for (int e = 0; e < 4; ++e) { f[rr][i][e] *= rv * gg[i][e]; am = fmaxf(am, fabsf(f[rr][i][e])); }
#pragma unroll
        for (int o = 32; o > 0; o >>= 1) am = fmaxf(am, __shfl_xor(am, o));
        const float inv = am > 0.f ? 127.0f / am : 0.f;
#pragma unroll
        for (int i = 0; i < 4; ++i) {
            unsigned w = 0u;
#pragma unroll
            for (int e = 0; e < 4; ++e) w |= ((unsigned)(int)rintf(f[rr][i][e] * inv) & 255u) << (8 * e);
            stg<unsigned>(xqt, (unsigned)(tk * D + i * 256 + 4 * lane), w);
            *(LAS unsigned*)(lds + tk * TROWB + i * 256 + 4 * lane) = w;
        }
        if (lane == 0) { ((LAS float*)(lds + LDS_RS))[tk] = am * (1.0f / 127.0f); ((float*)p.sx)[tile * 64 + tk] = am * (1.0f / 127.0f); }
    }
}

__device__ __forceinline__ void p2_mix(const Params& p, int tile, int tid, LAS unsigned char* lds) {
    const int wv = __builtin_amdgcn_readfirstlane(tid >> 6);
    const int b = tile >> 6, s0 = (tile & 63) * 64;
    LAS float* ssa = (LAS float*)(lds + LDS_SSA);
    const unsigned char* pbat = p.proj + (size_t)b * L * (MIXIN * 2);
    const float* xt = p.x + (size_t)tile * 64 * D;
    unsigned char* ht = p.hb + (size_t)tile * 64 * D * 2;
    if (tid < 64) ssa[tid] = 0.f;
    {
        const int lane = launder(tid) & 63, r = lane & 31, h = lane >> 5; (void)r; (void)h;
        float cw[3][8], gbv[8], u1[8], u2[8];
#pragma unroll
        for (int k = 0; k < 3; ++k) { const f32x4 a = ldg<f32x4>(p.conv_w, (unsigned)(k * MIXB + 8 * lane) * 4u), c = ldg<f32x4>(p.conv_w, (unsigned)(k * MIXB + 8 * lane + 4) * 4u);
#pragma unroll
            for (int e = 0; e < 4; ++e) { cw[k][e] = a[e]; cw[k][4 + e] = c[e]; } }
        { const f32x4 a = ldg<f32x4>(p.g_b, (unsigned)(8 * lane) * 4u), c = ldg<f32x4>(p.g_b, (unsigned)(8 * lane + 4) * 4u);
#pragma unroll
            for (int e = 0; e < 4; ++e) { gbv[e] = a[e]; gbv[4 + e] = c[e]; } }
        const int p0 = NMETA + s0 + 8 * wv;
        u32x4 bvv[8], cvv[10], vvv[10];
#pragma unroll
        for (int i = 0; i < 10; ++i) { const unsigned ro = (unsigned)(p0 - 2 + i) * 4096u + lane * 16u; cvv[i] = ldg<u32x4>(pbat, ro + 2048u); vvv[i] = ldg<u32x4>(pbat, ro + 3072u); if (i >= 2) bvv[i - 2] = ldg<u32x4>(pbat, ro + 1024u); }
    {
        const int cp = tid & 255, th = __builtin_amdgcn_readfirstlane(tid >> 8), g = __builtin_amdgcn_readfirstlane(cp >> 6);
        const int p0 = NMETA + s0 + 32 * th;
        LAS unsigned char* dst = lds + (32 * th) * TROW + cp * 4;
        if (g == 0) pool_window<2>(pbat, p0, cp, dst); else if (g == 1) pool_window<4>(pbat, p0, cp, dst); else if (g == 2) pool_window<8>(pbat, p0, cp, dst); else pool_window<16>(pbat, p0, cp, dst);
    }
#pragma unroll
        for (int e = 0; e < 4; ++e) { u2[2 * e] = bf_lo(cvv[0][e]) * bf_lo(vvv[0][e]); u2[2 * e + 1] = bf_hi(cvv[0][e]) * bf_hi(vvv[0][e]); u1[2 * e] = bf_lo(cvv[1][e]) * bf_lo(vvv[1][e]); u1[2 * e + 1] = bf_hi(cvv[1][e]) * bf_hi(vvv[1][e]); }
#pragma unroll
        for (int tk = 0; tk < 8; ++tk) {
            const u32x4 bv = bvv[tk], cv = cvv[tk + 2], vv = vvv[tk + 2];
            float z[8], ss = 0.f;
#pragma unroll
            for (int e = 0; e < 8; ++e) {
                const float bb = (e & 1) ? bf_hi(bv[e >> 1]) : bf_lo(bv[e >> 1]);
                const float u0 = ((e & 1) ? bf_hi(cv[e >> 1]) : bf_lo(cv[e >> 1])) * ((e & 1) ? bf_hi(vv[e >> 1]) : bf_lo(vv[e >> 1]));
                const float conv = u2[e] * cw[0][e] + u1[e] * cw[1][e] + u0 * cw[2][e];
                z[e] = bb * conv; ss += z[e] * z[e];
                u2[e] = u1[e]; u1[e] = u0;
            }
            ss = wave_sum(ss);
            const float rsb = rsqrtf(ss * (1.0f / MIXB) + EPS);
            u32x4 o; o.x = pk_bf16(z[0] * rsb * gbv[0], z[1] * rsb * gbv[1]); o.y = pk_bf16(z[2] * rsb * gbv[2], z[3] * rsb * gbv[3]);
            o.z = pk_bf16(z[4] * rsb * gbv[4], z[5] * rsb * gbv[5]); o.w = pk_bf16(z[6] * rsb * gbv[6], z[7] * rsb * gbv[7]);
            *(LAS u32x4*)(lds + (8 * wv + tk) * TROW + (MIXA + 8 * lane) * 2) = o;
        }
    }
    __syncthreads();
    {
        const int lane = launder(tid) & 63, r = lane & 31, h = lane >> 5; (void)r; (void)h;
        const int g = wv >> 1, dh = wv & 1;
        const u32x4* PWF = (const u32x4*)(p.pwf);
        f32x16 acc[2][2]; acc[0][0] = zero16(); acc[0][1] = zero16(); acc[1][0] = zero16(); acc[1][1] = zero16();
        gemm22<8>(PWF + (size_t)((g * 4 + 2 * dh) * 8) * 64, lane, lds + r * TROW + g * 256 + h * 16, acc);
        float ss0 = 0.f, ss1 = 0.f;
#pragma unroll
        for (int mi = 0; mi < 2; ++mi)
#pragma unroll
            for (int q = 0; q < 4; ++q) {
                const int d = g * 128 + 32 * (2 * dh + mi) + 8 * q + 4 * h;
                const f32x4 sc = ldg<f32x4>(p.pool_scale, (unsigned)d * 4u);
#pragma unroll
                for (int e = 0; e < 4; ++e) { acc[mi][0][4 * q + e] *= sc[e]; acc[mi][1][4 * q + e] *= sc[e]; ss0 += acc[mi][0][4 * q + e] * acc[mi][0][4 * q + e]; ss1 += acc[mi][1][4 * q + e] * acc[mi][1][4 * q + e]; }
            }
        ss0 += __shfl_xor(ss0, 32); ss1 += __shfl_xor(ss1, 32);
        if (h == 0) { atomicAdd((float*)(ssa + r), ss0); atomicAdd((float*)(ssa + 32 + r), ss1); }
        __syncthreads();
        const float ra0 = rsqrtf(ssa[r] * (1.0f / MIXA) + EPS), ra1 = rsqrtf(ssa[32 + r] * (1.0f / MIXA) + EPS);
#pragma unroll
        for (int mi = 0; mi < 2; ++mi)
#pragma unroll
            for (int q = 0; q < 4; ++q) {
                const int d = g * 128 + 32 * (2 * dh + mi) + 8 * q + 4 * h;
                const f32x4 gg = ldg<f32x4>(p.g_a, (unsigned)d * 4u);
                u32x2 o0, o1;
                o0.x = pk_bf16(acc[mi][0][4 * q] * ra0 * gg[0], acc[mi][0][4 * q + 1] * ra0 * gg[1]); o0.y = pk_bf16(acc[mi][0][4 * q + 2] * ra0 * gg[2], acc[mi][0][4 * q + 3] * ra0 * gg[3]);
                o1.x = pk_bf16(acc[mi][1][4 * q] * ra1 * gg[0], acc[mi][1][4 * q + 1] * ra1 * gg[1]); o1.y = pk_bf16(acc[mi][1][4 * q + 2] * ra1 * gg[2], acc[mi][1][4 * q + 3] * ra1 * gg[3]);
                *(LAS u32x2*)(lds + r * TROW + d * 2) = o0;
                *(LAS u32x2*)(lds + (32 + r) * TROW + d * 2) = o1;
            }
    }
    __syncthreads();
    f32x4 xa[4][4];
    {
        const int lane = launder(tid) & 63, r = lane & 31, h = lane >> 5; (void)r; (void)h;
#pragma unroll
        for (int rr = 0; rr < 4; ++rr)
#pragma unroll
            for (int i = 0; i < 4; ++i) xa[rr][i] = ldg<f32x4>(xt, (unsigned)((8 * wv + rr) * D + i * 256 + 4 * lane) * 4u);
        const u32x4* WF = (const u32x4*)(p.woutf);
        const LAS unsigned char* bp = lds + r * TROW + h * 16;
#pragma unroll 1
        for (int rdx = 0; rdx < 2; ++rdx) {
            const int rd = (rdx + (tile >> 7)) & 1;
            const int i0 = 4 * wv + 2 * rd;
            f32x16 acc[2][2]; acc[0][0] = zero16(); acc[0][1] = zero16(); acc[1][0] = zero16(); acc[1][1] = zero16();
            gemm22<64>(WF + (size_t)i0 * 64 * 64, lane, bp, acc, (tile >> 3) & 15);
            LAS unsigned char* eb = lds + LDS_LUT + wv * 2048;
#pragma unroll
            for (int nt = 0; nt < 2; ++nt)
#pragma unroll
                for (int hf = 0; hf < 2; ++hf) {
                    if ((r >> 4) == hf) {
#pragma unroll
                        for (int mi = 0; mi < 2; ++mi)
#pragma unroll
                            for (int q = 0; q < 4; ++q) {
                                u32x2 hw; hw.x = pk_bf16(acc[mi][nt][4 * q], acc[mi][nt][4 * q + 1]); hw.y = pk_bf16(acc[mi][nt][4 * q + 2], acc[mi][nt][4 * q + 3]);
                                *(LAS u32x2*)(eb + (r & 15) * 128 + (((4 * mi + q) ^ (r & 7)) * 16) + 8 * h) = hw;
                            }
                    }
                    wave_sync();
                    u32x4 ov[2];
#pragma unroll
                    for (int k = 0; k < 2; ++k) { const int row = 8 * k + (lane >> 3); ov[k] = *(const LAS u32x4*)(eb + row * 128 + (((lane & 7) ^ (row & 7)) * 16)); }
                    wave_sync();
#pragma unroll
                    for (int k = 0; k < 2; ++k) { const int row = 8 * k + (lane >> 3); stg<u32x4>(ht, (unsigned)((nt * 32 + hf * 16 + row) * D + 32 * i0) * 2u + (unsigned)(lane & 7) * 16u, ov[k]); }
                }
        }
    }
    __syncthreads();
    {
        const int lane = launder(tid) & 63;
        f32x4 gg[4];
#pragma unroll
        for (int i = 0; i < 4; ++i) gg[i] = ldg<f32x4>(p.g_ffn, (unsigned)(i * 256 + 4 * lane) * 4u);
        f32x4 xb[4][4];
#pragma unroll
        for (int rr = 0; rr < 4; ++rr)
#pragma unroll
            for (int i = 0; i < 4; ++i) xb[rr][i] = ldg<f32x4>(xt, (unsigned)((8 * wv + 4 + rr) * D + i * 256 + 4 * lane) * 4u);
        u32x2 hq[8][4];
#pragma unroll
        for (int rr = 0; rr < 4; ++rr)
#pragma unroll
            for (int i = 0; i < 4; ++i) hq[rr][i] = ldg<u32x2>(ht, (unsigned)((8 * wv + rr) * D + i * 256 + 4 * lane) * 2u);
        p2_xf_batch<0>(p, tile, wv, lane, lds, ht, xa, hq, gg);
#pragma unroll
        for (int rr = 4; rr < 8; ++rr)
#pragma unroll
            for (int i = 0; i < 4; ++i) hq[rr][i] = ldg<u32x2>(ht, (unsigned)((8 * wv + rr) * D + i * 256 + 4 * lane) * 2u);
        p2_xf_batch<4>(p, tile, wv, lane, lds, ht, xb, hq, gg);
    }
    __syncthreads();
    {
        const int lane = launder(tid) & 63, r = lane & 31, h = lane >> 5; (void)r; (void)h;
        const int hd = wv;
        const u32x4* WQF = (const u32x4*)(p.wqf);
        const u32x4* KF = (const u32x4*)(p.kf);
        unsigned char* lstt = p.lst + (size_t)tile * 64 * (NH * 32 * 4);
        const LAS unsigned char* bp = lds + r * TROWB + h * 16;
        const float sx0 = ((const LAS float*)(lds + LDS_RS))[r], sx1 = ((const LAS float*)(lds + LDS_RS))[32 + r];
        LAS unsigned char* lut = lds + LDS_LUT + wv * 2048;
#pragma unroll
        for (int pp = 0; pp < 2; ++pp) {
            const int hp = hd * 2 + pp;
            u32x4 qb[8];
            LAS u32x4* qpark = (LAS u32x4*)(lds + 64 * TROWB + wv * 8192) + lane;
#pragma unroll
            for (int mh = 0; mh < 2; ++mh) {
                const int mt0 = hp * 4 + mh * 2;
                i32x16 acc[2][2]; acc[0][0] = izero16(); acc[0][1] = izero16(); acc[1][0] = izero16(); acc[1][1] = izero16();
                gemm22i<32, QCH>(WQF + (size_t)mt0 * 32 * 64, lane, bp, acc, (tile >> 3));
#pragma unroll
                for (int mi = 0; mi < 2; ++mi)
#pragma unroll
                    for (int s2 = 0; s2 < 2; ++s2) {
                        const f32x4 w0 = ldg<f32x4>(p.wscq, (unsigned)(32 * (mt0 + mi) + 16 * s2 + 4 * h) * 4u), w1 = ldg<f32x4>(p.wscq, (unsigned)(32 * (mt0 + mi) + 16 * s2 + 8 + 4 * h) * 4u);
#pragma unroll
                        for (int nt = 0; nt < 2; ++nt) {
                            const float xs = nt ? sx1 : sx0;
                            u32x4 o; o.x = pk_bf16((float)acc[mi][nt][8 * s2] * xs * w0[0], (float)acc[mi][nt][8 * s2 + 1] * xs * w0[1]); o.y = pk_bf16((float)acc[mi][nt][8 * s2 + 2] * xs * w0[2], (float)acc[mi][nt][8 * s2 + 3] * xs * w0[3]);
                            o.z = pk_bf16((float)acc[mi][nt][8 * s2 + 4] * xs * w1[0], (float)acc[mi][nt][8 * s2 + 5] * xs * w1[1]); o.w = pk_bf16((float)acc[mi][nt][8 * s2 + 6] * xs * w1[2], (float)acc[mi][nt][8 * s2 + 7] * xs * w1[3]);
                            if (nt == 0) qb[2 * (mh * 2 + mi) + s2] = o; else qpark[(2 * (mh * 2 + mi) + s2) * 64] = o;
                        }
                    }
            }
#pragma unroll
            for (int nt = 0; nt < 2; ++nt) {
                float top[16];
#pragma unroll
                for (int i = 0; i < 16; ++i) top[i] = -INFINITY;
                if (nt == 1) {
#pragma unroll
                    for (int ks = 0; ks < 8; ++ks) qb[ks] = qpark[ks * 64];
                }
                const u32x4* kfp = KF + (size_t)(hp * 4 * 8) * 64;
                u32x4 kf[8];
#pragma unroll
                for (int ks = 0; ks < 8; ++ks) kf[ks] = ldg<u32x4>(kfp, (unsigned)(ks * 64 + lane) * 16u);
#pragma unroll 1
                for (int kt = 0; kt < 4; ++kt) {
                    f32x16 sa = zero16();
#pragma unroll
                    for (int ks = 0; ks < 8; ++ks) sa = mfma32(kf[ks], qb[ks], sa);
                    __builtin_amdgcn_sched_barrier(0);
                    const int ktn = (kt + 1) & 3;
#pragma unroll
                    for (int ks = 0; ks < 8; ++ks) kf[ks] = ldg<u32x4>(kfp, (unsigned)((ktn * 8 + ks) * 64 + lane) * 16u);
                    __builtin_amdgcn_sched_barrier(0);
                    float v[16];
#pragma unroll
                    for (int i = 0; i < 16; ++i) v[i] = embed_bits(sa[i], 127u, (unsigned)(32 * kt + (i & 3) + 8 * (i >> 2) + 4 * h));
                    bitonic_sort_desc<4>(v); merge_top16(top, v);
                    __builtin_amdgcn_sched_barrier(0);
                }
                float o[16];
#pragma unroll
                for (int i = 0; i < 16; ++i) o[i] = __shfl_xor(top[i], 32);
                merge_top16(top, o);
                if (h == 0) {
                    const unsigned lo = (unsigned)((((nt * 32 + r) * NH + hd) * 2 + pp) * 16) * 4u;
#pragma unroll
                    for (int w4 = 0; w4 < 4; ++w4) { f32x4 tv; tv[0] = top[4 * w4]; tv[1] = top[4 * w4 + 1]; tv[2] = top[4 * w4 + 2]; tv[3] = top[4 * w4 + 3]; stg<f32x4>(lstt, lo + 16u * w4, tv); }
                    u32x4 kb;
#pragma unroll
                    for (int w4 = 0; w4 < 4; ++w4) kb[w4] = (__builtin_bit_cast(unsigned, top[4 * w4]) & 127u) | ((__builtin_bit_cast(unsigned, top[4 * w4 + 1]) & 127u) << 8) | ((__builtin_bit_cast(unsigned, top[4 * w4 + 2]) & 127u) << 16) | ((__builtin_bit_cast(unsigned, top[4 * w4 + 3]) & 127u) << 24);
                    *(LAS u32x4*)(lut + ((nt * 32 + r) * 2 + pp) * 16) = kb;
                }
            }
        }
#pragma unroll
        for (int nt = 0; nt < 2; ++nt) {
            float s1[16], s2[16];
            {
                const unsigned lo = (unsigned)(((nt * 32 + r) * NH + hd) * 32) * 4u;
#pragma unroll
                for (int w4 = 0; w4 < 4; ++w4) { const f32x4 a = ldg<f32x4>(lstt, lo + 16u * w4), c = ldg<f32x4>(lstt, lo + 64u + 16u * w4);
#pragma unroll
                    for (int e4 = 0; e4 < 4; ++e4) { s1[4 * w4 + e4] = a[e4]; s2[4 * w4 + e4] = c[e4]; } }
            }
            float top[16];
#pragma unroll
            for (int i = 0; i < 16; ++i) top[i] = -INFINITY;
            { float v[16]; v[0] = embed_bits(s1[0] + s2[0], 255u, 0u); v[1] = embed_bits(s1[0] + s2[1], 255u, 1u); v[2] = embed_bits(s1[0] + s2[2], 255u, 2u); v[3] = embed_bits(s1[0] + s2[3], 255u, 3u); v[4] = embed_bits(s1[0] + s2[4], 255u, 4u); v[5] = embed_bits(s1[0] + s2[5], 255u, 5u); v[6] = embed_bits(s1[0] + s2[6], 255u, 6u); v[7] = embed_bits(s1[0] + s2[7], 255u, 7u); v[8] = embed_bits(s1[0] + s2[8], 255u, 8u); v[9] = embed_bits(s1[0] + s2[9], 255u, 9u); v[10] = embed_bits(s1[0] + s2[10], 255u, 10u); v[11] = embed_bits(s1[0] + s2[11], 255u, 11u); v[12] = embed_bits(s1[0] + s2[12], 255u, 12u); v[13] = embed_bits(s1[0] + s2[13], 255u, 13u); v[14] = embed_bits(s1[0] + s2[14], 255u, 14u); v[15] = embed_bits(s1[0] + s2[15], 255u, 15u);
              bitonic_sort_desc<4>(v); merge_top16(top, v); }
            { float v[16]; v[0] = embed_bits(s1[1] + s2[0], 255u, 16u); v[1] = embed_bits(s1[1] + s2[1], 255u, 17u); v[2] = embed_bits(s1[1] + s2[2], 255u, 18u); v[3] = embed_bits(s1[1] + s2[3], 255u, 19u); v[4] = embed_bits(s1[1] + s2[4], 255u, 20u); v[5] = embed_bits(s1[1] + s2[5], 255u, 21u); v[6] = embed_bits(s1[1] + s2[6], 255u, 22u); v[7] = embed_bits(s1[1] + s2[7], 255u, 23u); v[8] = embed_bits(s1[2] + s2[0], 255u, 32u); v[9] = embed_bits(s1[2] + s2[1], 255u, 33u); v[10] = embed_bits(s1[2] + s2[2], 255u, 34u); v[11] = embed_bits(s1[2] + s2[3], 255u, 35u); v[12] = embed_bits(s1[2] + s2[4], 255u, 36u); v[13] = embed_bits(s1[3] + s2[0], 255u, 48u); v[14] = embed_bits(s1[3] + s2[1], 255u, 49u); v[15] = embed_bits(s1[3] + s2[2], 255u, 50u);
              bitonic_sort_desc<4>(v); merge_top16(top, v); }
            { float v[16]; v[0] = embed_bits(s1[3] + s2[3], 255u, 51u); v[1] = embed_bits(s1[4] + s2[0], 255u, 64u); v[2] = embed_bits(s1[4] + s2[1], 255u, 65u); v[3] = embed_bits(s1[4] + s2[2], 255u, 66u); v[4] = embed_bits(s1[5] + s2[0], 255u, 80u); v[5] = embed_bits(s1[5] + s2[1], 255u, 81u); v[6] = embed_bits(s1[6] + s2[0], 255u, 96u); v[7] = embed_bits(s1[6] + s2[1], 255u, 97u); v[8] = embed_bits(s1[7] + s2[0], 255u, 112u); v[9] = embed_bits(s1[7] + s2[1], 255u, 113u); v[10] = embed_bits(s1[8] + s2[0], 255u, 128u); v[11] = embed_bits(s1[9] + s2[0], 255u, 144u); v[12] = embed_bits(s1[10] + s2[0], 255u, 160u); v[13] = embed_bits(s1[11] + s2[0], 255u, 176u); v[14] = embed_bits(s1[12] + s2[0], 255u, 192u); v[15] = embed_bits(s1[13] + s2[0], 255u, 208u);
              bitonic_sort_desc<4>(v); merge_top16(top, v); }
            { float v[16]; v[0] = embed_bits(s1[14] + s2[0], 255u, 224u); v[1] = embed_bits(s1[15] + s2[0], 255u, 240u); v[2] = -INFINITY; v[3] = -INFINITY; v[4] = -INFINITY; v[5] = -INFINITY; v[6] = -INFINITY; v[7] = -INFINITY; v[8] = -INFINITY; v[9] = -INFINITY; v[10] = -INFINITY; v[11] = -INFINITY; v[12] = -INFINITY; v[13] = -INFINITY; v[14] = -INFINITY; v[15] = -INFINITY;
              bitonic_sort_desc<4>(v); merge_top16(top, v); }
            float e[16], sum = 0.f;
#pragma unroll
            for (int i = 0; i < 16; ++i) { e[i] = __expf(top[i] - top[0]); sum += e[i]; }
            const float inv = 1.0f / sum;
            const LAS unsigned char* lt = lut + (nt * 32 + r) * 32;
            LAS unsigned char* slot = lds + 64 * TROWB + wv * 8192 + (nt * 32 + r) * 32;
            if (h == 0) {
                int ids[16];
#pragma unroll
                for (int i = 0; i < 16; ++i) { const unsigned code = __builtin_bit_cast(unsigned, top[i]) & 255u; ids[i] = (int)lt[code >> 4] * NKEYS + (int)lt[16 + (code & 15u)]; }
                u32x4 w0, w1;
#pragma unroll
                for (int i = 0; i < 4; ++i) { w0[i] = (unsigned)ids[i] | ((unsigned)ids[i + 8] << 16); w1[i] = (unsigned)ids[i + 4] | ((unsigned)ids[i + 12] << 16); }
                *(LAS u32x4*)(slot) = w0; *(LAS u32x4*)(slot + 16) = w1;
            } else {
#pragma unroll
                for (int i = 0; i < 4; ++i) { f32x4 gv; gv[0] = e[2 * i] * inv; gv[1] = e[2 * i + 8] * inv; gv[2] = e[2 * i + 1] * inv; gv[3] = e[2 * i + 9] * inv; *(LAS f32x4*)(slot + 2048 + (nt * 32 + r) * 32 + 16 * i) = gv; }
            }
        }
    }
    __syncthreads();
    {
        const LAS unsigned char* sl = lds + 64 * TROWB;
        unsigned char* idxt = p.idx + (size_t)tile * 64 * (HK * 2);
        unsigned char* gatet = p.gate + (size_t)tile * 64 * (HK * 4);
        u32x4 iv[2]; f32x4 gv[4];
#pragma unroll
        for (int k = 0; k < 2; ++k) { const int ci = tid + 512 * k, tok = ci >> 4, c = ci & 15;
#pragma unroll
            for (int q = 0; q < 4; ++q) iv[k][q] = *(const LAS unsigned*)(sl + (4 * (c & 1) + q) * 8192 + tok * 32 + (c >> 1) * 4); }
#pragma unroll
        for (int k = 0; k < 4; ++k) { const int ci = tid + 512 * k, tok = ci >> 5, c = ci & 31;
            const f32x2 a = *(const LAS f32x2*)(sl + (2 * (c & 3)) * 8192 + 2048 + tok * 64 + (c >> 2) * 8), b = *(const LAS f32x2*)(sl + (2 * (c & 3) + 1) * 8192 + 2048 + tok * 64 + (c >> 2) * 8);
            gv[k][0] = a[0]; gv[k][1] = a[1]; gv[k][2] = b[0]; gv[k][3] = b[1]; }
#pragma unroll
        for (int k = 0; k < 2; ++k) stg<u32x4>(idxt, (unsigned)(tid + 512 * k) * 16u, iv[k]);
#pragma unroll
        for (int k = 0; k < 4; ++k) stg<f32x4>(gatet, (unsigned)(tid + 512 * k) * 16u, gv[k]);
    }
}

__device__ __forceinline__ int dot16_i8(u32x4 a, u32x4 b) {
    int d = __builtin_amdgcn_sdot4((int)a[0], (int)b[0], 0, false);
    d = __builtin_amdgcn_sdot4((int)a[1], (int)b[1], d, false); d = __builtin_amdgcn_sdot4((int)a[2], (int)b[2], d, false); d = __builtin_amdgcn_sdot4((int)a[3], (int)b[3], d, false);
    return d;
}
__device__ __forceinline__ float gelu_exact(float z) { return 0.5f * z * (1.0f + erff(z * 0.70710678118654752f)); }

struct GMeta { int ids[16]; u32x4 x; };
struct GRows { u32x4 v[16]; };
__device__ __forceinline__ void g_rows(const unsigned char* slice, const GMeta& m, int lane, GRows& r) {
    const unsigned co = (unsigned)(lane & 7) * 16u;
#pragma unroll
    for (int i = 0; i < 16; ++i) r.v[i] = ldg<u32x4>(slice, (unsigned)m.ids[i] * 128u + co);
}

constexpr int P3W_Z = 0, P3W_CQ = 4096, P3W_SC = 5120, P3W_SSQ = 5152, P3W_ID = 5184, P3W_X = 7232, P3W_BYTES = 15424;
__device__ __forceinline__ void p3_wave(const Params& p, int tb0, int tb1, int lt, int pos, int lane, LAS unsigned char* wl) {
    const int ntok = 1 << lt, nts = 8 << lt;
    auto tokf = [&](int q) { return (q < 4 ? tb0 : tb1) + (q & 3); };
    const int grp = lane >> 3, ch = lane & 7, i0 = ((ch >> 2) & 1) * 8 + ((ch >> 1) & 1) * 4 + (ch & 1) * 2;
    LAS int* zl = (LAS int*)(wl + P3W_Z);
    LAS float* scl = (LAS float*)(wl + P3W_SC);
    LAS float* ssl = (LAS float*)(wl + P3W_SSQ);
#pragma unroll
    for (int q = 0; q < 8; ++q) if (q < ntok) {
        const int t = tokf(q);
        *(LAS unsigned*)(wl + P3W_ID + q * 256 + lane * 4) = ldg<unsigned>(p.idx + (size_t)t * (HK * 2), (unsigned)lane * 4u);
        *(LAS u32x4*)(wl + P3W_X + q * 1024 + lane * 16) = ldg<u32x4>(p.xq + (size_t)t * D, (unsigned)lane * 16u);
    }
    wave_sync();
    auto ids_lds = [&](int q, GMeta& m) {
#pragma unroll
        for (int w = 0; w < 2; ++w) { const u32x4 a = *(const LAS u32x4*)(wl + P3W_ID + q * 256 + grp * 32 + 16 * w);
#pragma unroll
            for (int e = 0; e < 4; ++e) { m.ids[8 * w + 2 * e] = (int)(a[e] & 0xffffu); m.ids[8 * w + 2 * e + 1] = (int)(a[e] >> 16); } }
    };
#pragma unroll 1
    for (int st = 0; st < 8; ++st) {
        const int j = (pos + st) & 7;
        const unsigned char* slice = p.eut + (size_t)j * (16384 * 128);
        const unsigned xo = (unsigned)(128 * j + 16 * ch);
#pragma unroll 1
        for (int q = 0; q < ntok; ++q) {
            const int t = tokf(q);
            GMeta m; GRows r; ids_lds(q, m); m.x = *(const LAS u32x4*)(wl + P3W_X + q * 1024 + xo); g_rows(slice, m, lane, r); (void)t;
            int part[16];
#pragma unroll
            for (int i = 0; i < 16; ++i) part[i] = dot16_i8(r.v[i], m.x);
#pragma unroll
            for (int lv = 2; lv >= 0; --lv) {
                const int n = 2 << lv, off = 1 << lv;
                const bool up = (lane & off) != 0;
#pragma unroll
                for (int i = 0; i < n; ++i) { const int a = part[i], c = part[i + n]; const int send = up ? a : c, keep = up ? c : a; part[i] = keep + __shfl_xor(send, off); }
            }
            LAS int* zp = zl + q * 128 + 2 * lane;
            if (st == 0) { zp[0] = part[0]; zp[1] = part[1]; } else { zp[0] += part[0]; zp[1] += part[1]; }
        }
    }
    {
        const unsigned po = (unsigned)(grp * 16 + i0) * 4u, po2 = (unsigned)(grp * 16 + i0) * 2u;
        unsigned idw[8]; f32x2 g[8]; float sx[8];
#pragma unroll
        for (int q = 0; q < 8; ++q) { const int t = tokf(q < ntok ? q : 0); idw[q] = *(const LAS unsigned*)(wl + P3W_ID + (q < ntok ? q : 0) * 256 + po2); g[q] = ldg<f32x2>(p.gate + (size_t)t * (HK * 4), po); sx[q] = ((const float*)p.sx)[t]; }
        float su0[8], su1[8], sv0[8], sv1[8];
#pragma unroll
        for (int q = 0; q < 8; ++q) { const int a = (int)(idw[q] & 0xffffu), c = (int)(idw[q] >> 16); su0[q] = ((const float*)p.su)[a]; su1[q] = ((const float*)p.su)[c]; sv0[q] = ((const float*)p.sv)[a]; sv1[q] = ((const float*)p.sv)[c]; }
#pragma unroll
        for (int q = 0; q < 8; ++q) if (q < ntok) {
            const int z0 = zl[q * 128 + 2 * lane], z1 = zl[q * 128 + 2 * lane + 1];
            const float c0 = g[q][0] * gelu_exact((float)z0 * (sx[q] * su0[q])) * sv0[q];
            const float c1 = g[q][1] * gelu_exact((float)z1 * (sx[q] * su1[q])) * sv1[q];
            float am = fmaxf(fabsf(c0), fabsf(c1));
#pragma unroll
            for (int o = 32; o > 0; o >>= 1) am = fmaxf(am, __shfl_xor(am, o));
            const float inv = am > 0.f ? 127.0f / am : 0.f;
            const unsigned q0 = (unsigned)(int)rintf(c0 * inv) & 255u, q1 = (unsigned)(int)rintf(c1 * inv) & 255u;
            *(LAS unsigned short*)(wl + P3W_CQ + q * 128 + 16 * grp + i0) = (unsigned short)(q0 | (q1 << 8));
            if (lane == 0) { scl[q] = am * (1.0f / 127.0f); ssl[q] = 0.f; }
        }
    }
    wave_sync();
    {
        const int e0 = ((lane >> 5) & 1) * 8 + ((lane >> 4) & 1) * 4 + ((lane >> 3) & 1) * 2;
        auto meta = [&](int n, GMeta& m, float& sc, f32x2& hv) {
            const int nn = n < nts ? n : nts - 1, q = nn & (ntok - 1), j = (pos + (nn >> lt)) & 7, t = tokf(q);
            ids_lds(q, m);
            m.x = *(const LAS u32x4*)(wl + P3W_CQ + q * 128 + 16 * grp);
            sc = scl[q];
            { const unsigned hw = ldg<unsigned>(p.hb + (size_t)t * D * 2, (unsigned)(128 * j + 16 * ch + e0) * 2u); hv[0] = bf_lo(hw); hv[1] = bf_hi(hw); }
        };
        auto rows = [&](int n, const GMeta& m, GRows& r) { const int nn = n < nts ? n : nts - 1; g_rows(p.evt + (size_t)((pos + (nn >> lt)) & 7) * (16384 * 128), m, lane, r); };
        auto finish = [&](int n, const GMeta& m, const GRows& r, float sc, f32x2 hv) {
            const int q = n & (ntok - 1), j = (pos + (n >> lt)) & 7, t = tokf(q);
            int acc[16];
#pragma unroll
            for (int e = 0; e < 16; ++e) acc[e] = 0;
#pragma unroll
            for (int g = 0; g < 4; ++g)
#pragma unroll
                for (int e = 0; e < 4; ++e) {
                    const unsigned A = r.v[4 * g][e], B = r.v[4 * g + 1][e], C = r.v[4 * g + 2][e], Dd = r.v[4 * g + 3][e];
                    const unsigned t0 = __builtin_amdgcn_perm(B, A, 0x05010400u), t1 = __builtin_amdgcn_perm(B, A, 0x07030602u);
                    const unsigned t2 = __builtin_amdgcn_perm(Dd, C, 0x05010400u), t3 = __builtin_amdgcn_perm(Dd, C, 0x07030602u);
                    const unsigned r0 = __builtin_amdgcn_perm(t2, t0, 0x05040100u), r1 = __builtin_amdgcn_perm(t2, t0, 0x07060302u);
                    const unsigned r2 = __builtin_amdgcn_perm(t3, t1, 0x05040100u), r3 = __builtin_amdgcn_perm(t3, t1, 0x07060302u);
                    const int cq = (int)m.x[g];
                    acc[4 * e] = __builtin_amdgcn_sdot4((int)r0, cq, acc[4 * e], false); acc[4 * e + 1] = __builtin_amdgcn_sdot4((int)r1, cq, acc[4 * e + 1], false);
                    acc[4 * e + 2] = __builtin_amdgcn_sdot4((int)r2, cq, acc[4 * e + 2], false); acc[4 * e + 3] = __builtin_amdgcn_sdot4((int)r3, cq, acc[4 * e + 3], false);
                }
#pragma unroll
            for (int lv = 2; lv >= 0; --lv) {
                const int n2 = 2 << lv, off = 8 << lv;
                const bool up = (lane & off) != 0;
#pragma unroll
                for (int i = 0; i < n2; ++i) { const int a = acc[i], c = acc[i + n2]; const int send = up ? a : c, keep = up ? c : a; acc[i] = keep + __shfl_xor(send, off); }
            }
            f32x2 o; o[0] = (float)acc[0] * sc + hv[0]; o[1] = (float)acc[1] * sc + hv[1];
            const float ss = wave_sum(o[0] * o[0] + o[1] * o[1]);
            stg<f32x2>(p.out + (size_t)t * D, (unsigned)(128 * j + 16 * ch + e0) * 4u, o);
            if (lane == 0) ssl[q] += ss;
        };
        GMeta ma, mb; GRows ra, rb; float sa, sb; f32x2 ha, hb;
        meta(0, ma, sa, ha); meta(1, mb, sb, hb); rows(0, ma, ra);
#pragma unroll 1
        for (int n = 0; n < nts; n += 2) {
            GMeta mc; float scc; f32x2 hc;
            meta(n + 2, mc, scc, hc); rows(n + 1, mb, rb);
            __builtin_amdgcn_sched_barrier(0);
            finish(n, ma, ra, sa, ha);
            __builtin_amdgcn_sched_barrier(0);
            meta(n + 3, ma, sa, ha); rows(n + 2, mc, ra);
            __builtin_amdgcn_sched_barrier(0);
            finish(n + 1, mb, rb, sb, hb);
            __builtin_amdgcn_sched_barrier(0);
            mb = ma; sb = sa; hb = ha; ma = mc; sa = scc; ha = hc;
        }
    }
    asm volatile("s_waitcnt vmcnt(0)" ::: "memory");
    __builtin_amdgcn_fence(__ATOMIC_ACQUIRE, "agent");
    {
        f32x4 gg[4];
#pragma unroll
        for (int i = 0; i < 4; ++i) gg[i] = ldg<f32x4>(p.g_fin, (unsigned)(i * 256 + 4 * lane) * 4u);
#pragma unroll 1
        for (int qb = 0; qb < ntok; qb += 4) {
            f32x4 a[4][4];
#pragma unroll
            for (int b = 0; b < 4; ++b)
#pragma unroll
                for (int i = 0; i < 4; ++i) a[b][i] = ldg<f32x4>(p.out + (size_t)tokf(qb + b) * D, (unsigned)(i * 256 + 4 * lane) * 4u);
#pragma unroll
            for (int b = 0; b < 4; ++b) {
                const float rv = rsqrtf(ssl[qb + b] * (1.0f / D) + EPS);
#pragma unroll
                for (int i = 0; i < 4; ++i) { f32x4 ov;
#pragma unroll
                    for (int e = 0; e < 4; ++e) ov[e] = a[b][i][e] * rv * gg[i][e];
                    stg<f32x4>(p.out + (size_t)tokf(qb + b) * D, (unsigned)(i * 256 + 4 * lane) * 4u, ov); }
            }
        }
    }
}

#define XB_TMO      128
#define XB_XCNT(j)  (256  + 64 * (j))
#define XB_XSUB(j)  (1280 + 64 * (j))
#define XB_XGEN(j)  (2304 + 64 * (j))
#define XB_TOP      3328
#define XB_TOPGEN   3392
#define XCD_BAR_WORDS 3456
#define XB_SPIN_CAP (1u << 18)

__device__ __forceinline__ unsigned xb_ld(unsigned* p)              { return __hip_atomic_load(p, __ATOMIC_RELAXED, __HIP_MEMORY_SCOPE_AGENT); }
__device__ __forceinline__ unsigned xb_add(unsigned* p, unsigned v) { return __hip_atomic_fetch_add(p, v, __ATOMIC_RELAXED, __HIP_MEMORY_SCOPE_AGENT); }
__device__ __forceinline__ unsigned xb_xcc_id() { return (unsigned)__builtin_amdgcn_s_getreg((3 << 11) | 20) & 0xFu; }
#define XB_SPIN(cond, bar) do { unsigned _sp = 0; while (cond) { __builtin_amdgcn_s_sleep(1); \
    if ((++_sp & 255u) == 0u) { if (xb_ld(&(bar)[XB_TMO])) break; if (_sp > XB_SPIN_CAP) { atomicAdd(&(bar)[XB_TMO], 1u); break; } } } } while (0)

struct XcdBarrier {
    unsigned* bar; unsigned x;
    volatile LAS unsigned* st;
};

__device__ __forceinline__ XcdBarrier xcd_barrier_post(unsigned* bar, volatile LAS unsigned* st) {
    XcdBarrier b; b.bar = bar; b.x = xb_xcc_id(); b.st = st;
    if (threadIdx.x == 0) (void)xb_add(&bar[XB_XCNT(b.x)], 1u);
    return b;
}
__device__ __forceinline__ void xcd_barrier_complete(unsigned* bar, unsigned x, unsigned& nloc, unsigned& nx) {
    const unsigned G = gridDim.x * gridDim.y * gridDim.z;
    unsigned sum, cnt, mine, sp = 0u;
    for (;;) {
        sum = 0u; cnt = 0u; mine = 0u;
#pragma unroll
        for (unsigned j = 0; j < 16; ++j) { const unsigned c = xb_ld(&bar[XB_XCNT(j)]); sum += c; cnt += (c > 0u) ? 1u : 0u; mine = (j == x) ? c : mine; }
        if (sum == G) break;
        __builtin_amdgcn_s_sleep(1);
        if ((++sp & 255u) == 0u) { if (xb_ld(&bar[XB_TMO])) break; if (sp > XB_SPIN_CAP) { atomicAdd(&bar[XB_TMO], 1u); break; } }
    }
    nloc = mine > 0u ? mine : 1u; nx = cnt > 0u ? cnt : 1u;
}

__device__ __forceinline__ void xcd_barrier(const XcdBarrier& b) {
    asm volatile("s_waitcnt vmcnt(0)" ::: "memory");
    __syncthreads();
    if (threadIdx.x == 0) {
        unsigned* bar = b.bar;
        __builtin_amdgcn_s_waitcnt(0);
        unsigned nloc = b.st[0], nx = b.st[1];
        if (nloc == 0u) { xcd_barrier_complete(bar, b.x, nloc, nx); b.st[0] = nloc; b.st[1] = nx; }
        const unsigned old = xb_add(&bar[XB_XSUB(b.x)], 1u);
        const unsigned gen = old / nloc;
        if (old + 1u == (gen + 1u) * nloc) {
            __builtin_amdgcn_fence(__ATOMIC_RELEASE, "agent");
            asm volatile("s_waitcnt vmcnt(0)" ::: "memory");
            const unsigned og = xb_add(&bar[XB_TOP], 1u);
            const unsigned tg = og / nx;
            if (og + 1u == (tg + 1u) * nx) xb_add(&bar[XB_TOPGEN], 1u);
            else XB_SPIN(xb_ld(&bar[XB_TOPGEN]) == tg, bar);
            __builtin_amdgcn_fence(__ATOMIC_ACQUIRE, "agent");
            xb_add(&bar[XB_XGEN(b.x)], 1u);
            asm volatile("s_waitcnt vmcnt(0)" ::: "memory");
        } else {
            XB_SPIN(xb_ld(&bar[XB_XGEN(b.x)]) == gen, bar);
            __builtin_amdgcn_fence(__ATOMIC_ACQUIRE, "agent");
            asm volatile("s_waitcnt vmcnt(0)" ::: "memory");
        }
    }
    __syncthreads();
}


__global__ void __launch_bounds__(512) k_fwd(Params p) {
    __shared__ __attribute__((aligned(16))) unsigned char lds_raw[LDS_BYTES + 16];
    LAS unsigned char* lds = (LAS unsigned char*)lds_raw;
    const int tid = threadIdx.x, vb = blockIdx.x, nb = gridDim.x;
    volatile LAS unsigned* xbw = (volatile LAS unsigned*)(lds + LDS_BYTES);
    if (tid < 4) xbw[tid] = 0u;
    __syncthreads();
    XcdBarrier gb = xcd_barrier_post((unsigned*)p.bar, xbw);
    if (tid == 0) xbw[2] = xb_add(&((unsigned*)p.bar)[XCD_BAR_WORDS + 64 * gb.x], 1u);
    p0_prep(p, vb, nb, tid, lds);
    const bool early = vb >= 129 && vb < NTILES;
    if (early) p1_stage(p, vb, tid, lds);
    xcd_barrier(gb);
    for (int tile = vb; tile < NTILES; tile += nb) { if (!(early && tile == vb)) p1_stage(p, tile, tid, lds); p1_inproj(p, tile, tid, lds, vb, nb, tile == vb); __syncthreads(); }
    if ((tid >> 6) == 0) for (int mp = vb; mp < 32; mp += nb) p1_meta(p, mp, launder(tid) & 63);
    xcd_barrier(gb);
    for (int tile = vb; tile < NTILES; tile += nb) { p2_mix(p, tile, tid, lds); __syncthreads(); }
    xcd_barrier(gb);
    const int lane = launder(tid) & 63, wv = __builtin_amdgcn_readfirstlane(tid >> 6);
    int np = 0, mypos = 0, nloc = 1;
    {
        unsigned* bar = (unsigned*)p.bar;
        const int myx = (int)gb.x;
#pragma unroll
        for (int q = 0; q < 16; ++q) { const int c = (int)xb_ld(&bar[XB_XCNT(q)]); if (q == myx) { mypos = np; nloc = c > 0 ? c : 1; } np += (c > 0) ? 1 : 0; }
        if (np < 1) np = 1;
    }
    {
        const int rank = (int)xbw[2];
        LAS unsigned char* wl = lds + wv * P3W_BYTES;
#pragma unroll 1
        for (int k = rank; mypos + np * k < T / 32; k += 2 * nloc) {
            const int c0 = mypos + np * k, c1 = mypos + np * (k + nloc);
            p3_wave(p, 32 * c0 + 4 * wv, 32 * c1 + 4 * wv, c1 < T / 32 ? 3 : 2, mypos, lane, wl);
        }
    }
}
}

extern "C" void kernel_launch(void* const* d_in, const int* in_sizes, int n_in, void* d_out, int out_size, void* d_ws, size_t ws_size, hipStream_t stream) {
    static int grid_blocks = 0;
    if (n_in != 16 || out_size != T * D) { fprintf(stderr, "kernel_launch: unexpected sizes n_in %d out %d\n", n_in, out_size); return; }
    if (!grid_blocks) {
        int dev = 0, cus = 0, per_cu = 0;
        (void)hipGetDevice(&dev);
        (void)hipDeviceGetAttribute(&cus, hipDeviceAttributeMultiprocessorCount, dev);
        (void)hipOccupancyMaxActiveBlocksPerMultiprocessor(&per_cu, (const void*)k_fwd, 512, 0);
        if (per_cu < 1) { fprintf(stderr, "kernel_launch: occupancy query returned %d\n", per_cu); per_cu = 1; }
        grid_blocks = cus * 1;
    }
    Params p{};
    p.x = (const float*)d_in[0]; p.meta = (const float*)d_in[1]; p.g_mix = (const float*)d_in[2]; p.w_in = (const float*)d_in[3]; p.pool_w = (const float*)d_in[4];
    p.pool_scale = (const float*)d_in[5]; p.conv_w = (const float*)d_in[6]; p.g_a = (const float*)d_in[7]; p.g_b = (const float*)d_in[8]; p.w_out = (const float*)d_in[9];
    p.g_ffn = (const float*)d_in[10]; p.w_query = (const float*)d_in[11]; p.sub_keys = (const float*)d_in[12]; p.eu = (const float*)d_in[13]; p.ev = (const float*)d_in[14]; p.g_fin = (const float*)d_in[15];
    p.out = (float*)d_out;
    unsigned char* ws = (unsigned char*)d_ws;
    p.winf = ws; p.woutf = ws + (4u << 20); p.wqf = ws + (6u << 20); p.kf = ws + (10u << 20); p.pwf = p.kf + (512u << 10); p.metaf = p.pwf + (128u << 10); p.rsm = p.metaf + (64u << 10); p.bar = p.rsm + 256;
    p.eut = ws + (12u << 20); p.evt = p.eut + (32u << 20); p.proj = p.evt + (32u << 20); p.idx = p.proj + (size_t)TL * MIXIN * 2; p.gate = p.idx + (size_t)T * HK * 4; p.lst = p.gate + (size_t)T * HK * 4;
    p.su = p.lst + (size_t)T * NH * 32 * 4; p.sv = p.su + 65536; p.sx = p.sv + 65536; p.xq = p.sx + 65536; p.wsci = p.xq + (size_t)T * D; p.wscq = p.wsci + 8192; p.hb = p.wscq + 8192;
    if ((size_t)(p.hb - ws) + (size_t)T * D * 2 > ws_size) { fprintf(stderr, "kernel_launch: workspace too small\n"); return; }
    if (hipMemsetAsync(p.bar, 0, (XCD_BAR_WORDS + 64 * 16) * 4, stream) != hipSuccess) { fprintf(stderr, "kernel_launch: memset of the barrier words failed\n"); return; }
    hipLaunchKernelGGL(k_fwd, dim3(grid_blocks), dim3(512), 0, stream, p);
}
```

```cpp
#include <hip/hip_runtime.h>
#include <cstdio>
#include <cstdint>
#include <math.h>

namespace {
constexpr int D = 1024, BATCH = 4, SEQ = 4096, NMETA = 16, L = SEQ + NMETA;
constexpr int MIXA = 512, MIXB = 512, MIXIN = 2048;
constexpr int NH = 8, NKEYS = 128, DQH = 128, TOPK = 16, HK = 128;
constexpr int T = BATCH * SEQ;
constexpr int TL = BATCH * L;
constexpr float EPS = 1e-6f;

__device__ __forceinline__ float wave_sum(float v) {
#pragma unroll
    for (int o = 32; o > 0; o >>= 1) v += __shfl_xor(v, o);
    return v;
}
#define LAS __attribute__((address_space(3)))
typedef short bf16x8 __attribute__((ext_vector_type(8)));
typedef float f32x16 __attribute__((ext_vector_type(16)));
typedef float f32x4 __attribute__((ext_vector_type(4)));
typedef float f32x2 __attribute__((ext_vector_type(2)));
typedef __bf16 bf2_t __attribute__((ext_vector_type(2)));
typedef unsigned u32x4 __attribute__((ext_vector_type(4)));
typedef unsigned u32x2 __attribute__((ext_vector_type(2)));
typedef int i32x4 __attribute__((ext_vector_type(4)));
typedef int i32x16 __attribute__((ext_vector_type(16)));

constexpr int QCH = 2;
constexpr int NTILES = T / 64;
constexpr int TROW = 2064;
constexpr int TROWB = 1040;
constexpr int LDS_TILE = 64 * TROW;
constexpr int LDS_RS = LDS_TILE;
constexpr int LDS_SSA = LDS_RS + 256;
constexpr int LDS_LUT = LDS_SSA + 256;
constexpr int LDS_BYTES = LDS_LUT + 16384;

struct Params {
    const float* x; const float* meta; const float* g_mix; const float* w_in; const float* pool_w; const float* pool_scale; const float* conv_w;
    const float* g_a; const float* g_b; const float* w_out; const float* g_ffn; const float* w_query; const float* sub_keys; const float* eu; const float* ev; const float* g_fin;
    float* out;
    unsigned char *winf, *woutf, *wqf, *kf, *pwf, *metaf, *rsm, *eut, *evt, *proj, *idx, *gate, *bar, *lst, *su, *sv, *xq, *sx, *wsci, *wscq, *hb;
};

__device__ __forceinline__ unsigned pk_bf16(float lo, float hi) { f32x2 f = {lo, hi}; return __builtin_bit_cast(unsigned, __builtin_convertvector(f, bf2_t)); }
__device__ __forceinline__ float bf_lo(unsigned u) { return __builtin_bit_cast(float, u << 16); }
__device__ __forceinline__ float bf_hi(unsigned u) { return __builtin_bit_cast(float, u & 0xffff0000u); }
__device__ __forceinline__ f32x16 mfma32(u32x4 a, u32x4 b, f32x16 c) { return __builtin_amdgcn_mfma_f32_32x32x16_bf16(__builtin_bit_cast(bf16x8, a), __builtin_bit_cast(bf16x8, b), c, 0, 0, 0); }
__device__ __forceinline__ i32x16 mfma_i8(u32x4 a, u32x4 b, i32x16 c) { return __builtin_amdgcn_mfma_i32_32x32x32_i8(__builtin_bit_cast(i32x4, a), __builtin_bit_cast(i32x4, b), c, 0, 0, 0); }
__device__ __forceinline__ i32x16 izero16() { i32x16 z; for (int i = 0; i < 16; ++i) z[i] = 0; return z; }
__device__ __forceinline__ f32x16 zero16() { f32x16 z; for (int i = 0; i < 16; ++i) z[i] = 0.f; return z; }

__device__ __forceinline__ void wave_sync() { __builtin_amdgcn_fence(__ATOMIC_RELEASE, "wavefront"); __builtin_amdgcn_wave_barrier(); __builtin_amdgcn_fence(__ATOMIC_ACQUIRE, "wavefront"); }
__device__ __forceinline__ int launder(int x) { asm volatile("" : "+v"(x)); return x; }
template <class V> __device__ __forceinline__ V ldg(const void* base, unsigned off) { return *(const V*)((const unsigned char*)base + off); }
template <class V> __device__ __forceinline__ void stg(void* base, unsigned off, V v) { *(V*)((unsigned char*)base + off) = v; }

__device__ __forceinline__ void frag_from_kn(const float* __restrict__ W, int N, const float* __restrict__ g, int i, int s, int lane, u32x4* __restrict__ dst, int I8K = 0) {
    const int r = lane & 31, h = lane >> 5, k0 = 16 * s + 8 * h;
    const float* src = W + (size_t)k0 * N + 32 * i + r;
    float v[8];
#pragma unroll
    for (int j = 0; j < 8; ++j) v[j] = src[(size_t)j * N] * (g ? g[k0 + j] : 1.0f);
    u32x4 o; o.x = pk_bf16(v[0], v[1]); o.y = pk_bf16(v[2], v[3]); o.z = pk_bf16(v[4], v[5]); o.w = pk_bf16(v[6], v[7]);
    *dst = o;
}
__device__ __forceinline__ void frag2_from_kn(const float* __restrict__ W, int N, int i, int s, int lane, u32x4* __restrict__ dst) {
    const int r = lane & 31, h = lane >> 5, k0 = 16 * s + 8 * h;
    const float* src = W + (size_t)k0 * N + 32 * i + r;
    float v[16];
#pragma unroll
    for (int j = 0; j < 8; ++j) { v[j] = src[(size_t)j * N]; v[8 + j] = src[(size_t)(16 + j) * N]; }
    u32x4 o; o.x = pk_bf16(v[0], v[1]); o.y = pk_bf16(v[2], v[3]); o.z = pk_bf16(v[4], v[5]); o.w = pk_bf16(v[6], v[7]);
    u32x4 o2; o2.x = pk_bf16(v[8], v[9]); o2.y = pk_bf16(v[10], v[11]); o2.z = pk_bf16(v[12], v[13]); o2.w = pk_bf16(v[14], v[15]);
    dst[0] = o; dst[64] = o2;
}
constexpr int J_WOUT = 0, J_WQ = J_WOUT + 32 * 64, J_PW = J_WQ, J_KEY = J_PW + 128, J_END = J_KEY + 512;
__device__ __forceinline__ void mtile_i8_block(const float* __restrict__ W, const float* __restrict__ g, int i, int tid, LAS unsigned* lds_u, u32x4* __restrict__ dst, float* __restrict__ wsc) {
    const int lane = tid & 63, wv = tid >> 6, r = lane & 31, h = lane >> 5, col = 32 * i + r;
    if (tid < 32) lds_u[tid] = 0u;
    __syncthreads();
    {
        const int cg = lane & 7, ro = lane >> 3;
        f32x4 f[16];
#pragma unroll
        for (int q = 0; q < 16; ++q) f[q] = ldg<f32x4>(W, (unsigned)((128 * wv + 8 * q + ro) * 2048 + 32 * i + 4 * cg) * 4u);
        float m0 = 0.f, m1 = 0.f, m2 = 0.f, m3 = 0.f;
#pragma unroll
        for (int q = 0; q < 16; ++q) { const float gk = g ? g[128 * wv + 8 * q + ro] : 1.0f; m0 = fmaxf(m0, fabsf(f[q][0] * gk)); m1 = fmaxf(m1, fabsf(f[q][1] * gk)); m2 = fmaxf(m2, fabsf(f[q][2] * gk)); m3 = fmaxf(m3, fabsf(f[q][3] * gk)); }
#pragma unroll
        for (int o = 8; o < 64; o <<= 1) { m0 = fmaxf(m0, __shfl_xor(m0, o)); m1 = fmaxf(m1, __shfl_xor(m1, o)); m2 = fmaxf(m2, __shfl_xor(m2, o)); m3 = fmaxf(m3, __shfl_xor(m3, o)); }
        if (lane < 8) { atomicMax((unsigned*)(lds_u + 4 * cg), __builtin_bit_cast(unsigned, m0)); atomicMax((unsigned*)(lds_u + 4 * cg + 1), __builtin_bit_cast(unsigned, m1));
            atomicMax((unsigned*)(lds_u + 4 * cg + 2), __builtin_bit_cast(unsigned, m2)); atomicMax((unsigned*)(lds_u + 4 * cg + 3), __builtin_bit_cast(unsigned, m3)); }
    }
    __syncthreads();
    const float cm = __builtin_bit_cast(float, lds_u[r]);
    const float inv = cm > 0.f ? 127.0f / cm : 0.f;
    if (wv == 0 && h == 0) wsc[col] = cm * (1.0f / 127.0f);
#pragma unroll
    for (int sl = 0; sl < 4; ++sl) {
        const int s = 4 * wv + sl, k0 = 32 * s + 16 * h;
        u32x4 o;
#pragma unroll
        for (int q = 0; q < 4; ++q) {
            unsigned w = 0u;
#pragma unroll
            for (int e = 0; e < 4; ++e) { const int k = k0 + 4 * q + e; w |= ((unsigned)(int)rintf(ldg<float>(W, (unsigned)(k * 2048 + col) * 4u) * (g ? g[k] : 1.0f) * inv) & 255u) << (8 * e); }
            o[q] = w;
        }
        dst[(size_t)s * 64 + lane] = o;
    }
    __syncthreads();
}
__device__ __forceinline__ void meta_block(const Params& p, int tid, LAS float* lds_f) {
    const int lane = tid & 63, wv = tid >> 6;
#pragma unroll
    for (int q = 0; q < 2; ++q) {
        const int row = 2 * wv + q;
        float ss = 0.f, am = 0.f;
#pragma unroll
        for (int i = 0; i < 4; ++i) { const f32x4 f = *(const f32x4*)(p.meta + (size_t)row * D + i * 256 + 4 * lane); ss += f[0] * f[0] + f[1] * f[1] + f[2] * f[2] + f[3] * f[3];
            am = fmaxf(am, fmaxf(fmaxf(fabsf(f[0]), fabsf(f[1])), fmaxf(fabsf(f[2]), fabsf(f[3])))); }
        ss = wave_sum(ss);
#pragma unroll
        for (int o = 32; o > 0; o >>= 1) am = fmaxf(am, __shfl_xor(am, o));
        if (lane == 0) { ((float*)(p.rsm))[row] = rsqrtf(ss * (1.0f / D) + EPS) * am * (1.0f / 127.0f); lds_f[row] = am; }
    }
    __syncthreads();
    const int n = lane & 31, h = lane >> 5;
    const float am = n < NMETA ? lds_f[n] : 0.f;
    const float inv = am > 0.f ? 127.0f / am : 0.f;
#pragma unroll
    for (int sl = 0; sl < 4; ++sl) {
        const int s = 4 * wv + sl;
        u32x4 o = {0u, 0u, 0u, 0u};
        if (n < NMETA) {
            const float* row = p.meta + (size_t)n * D;
#pragma unroll
            for (int q = 0; q < 4; ++q) { const f32x4 f = *(const f32x4*)(row + 32 * s + 16 * h + 4 * q);
                o[q] = ((unsigned)(int)rintf(f[0] * inv) & 255u) | (((unsigned)(int)rintf(f[1] * inv) & 255u) << 8) | (((unsigned)(int)rintf(f[2] * inv) & 255u) << 16) | (((unsigned)(int)rintf(f[3] * inv) & 255u) << 24); }
        }
        ((u32x4*)(p.metaf))[(size_t)s * 64 + lane] = o;
    }
    __syncthreads();
}

__device__ __forceinline__ void p0_prep(const Params& p, int vb, int nb, int tid, LAS unsigned char* lds) {
    const int lane = tid & 63, wv = tid >> 6, gw = vb * 8 + wv, nw = nb * 8;
    for (int job = vb; job < 129; job += nb) {
        if (job < 64) mtile_i8_block(p.w_in, p.g_mix, job, tid, (LAS unsigned*)lds, (u32x4*)(p.winf) + (size_t)job * 32 * 64, (float*)p.wsci);
        else if (job < 128) mtile_i8_block(p.w_query, nullptr, job - 64, tid, (LAS unsigned*)lds, (u32x4*)(p.wqf) + (size_t)(job - 64) * 32 * 64, (float*)p.wscq);
        else meta_block(p, tid, (LAS float*)lds);
    }
    int jw = gw, jn = nw;
    if (nb >= 129 + 64) { jw = vb >= 129 ? (vb - 129) * 8 + wv : J_END; jn = (nb - 129) * 8; }
    for (int job = jw; job < J_END / 2; job += jn) {
        if (job < J_WQ / 2) { const int q = 2 * job, i = q >> 6, sA = q & 63; frag2_from_kn(p.w_out, 1024, i, sA, lane, (u32x4*)(p.woutf) + (size_t)q * 64 + lane); }
        else if (job < J_KEY / 2) { const int q = 2 * job - J_PW, g = q >> 5, mt = (q >> 3) & 3, sA = q & 7; frag2_from_kn(p.pool_w + (size_t)g * 128 * 128, 128, mt, sA, lane, (u32x4*)(p.pwf) + (size_t)q * 64 + lane); }
        else {
            const int q = 2 * job - J_KEY, hp = q >> 5, kt = (q >> 3) & 3, sA = q & 7, r = lane & 31, h = lane >> 5;
            const float* src = p.sub_keys + ((size_t)hp * 128 + 32 * kt + r) * 128 + 16 * sA + 4 * h;
            const f32x4 f0 = *(const f32x4*)src, f1 = *(const f32x4*)(src + 8), f2 = *(const f32x4*)(src + 16), f3 = *(const f32x4*)(src + 24);
            u32x4 o; o.x = pk_bf16(f0[0], f0[1]); o.y = pk_bf16(f0[2], f0[3]); o.z = pk_bf16(f1[0], f1[1]); o.w = pk_bf16(f1[2], f1[3]);
            u32x4 o2; o2.x = pk_bf16(f2[0], f2[1]); o2.y = pk_bf16(f2[2], f2[3]); o2.z = pk_bf16(f3[0], f3[1]); o2.w = pk_bf16(f3[2], f3[3]);
            ((u32x4*)(p.kf))[(size_t)q * 64 + lane] = o; ((u32x4*)(p.kf))[(size_t)(q + 1) * 64 + lane] = o2;
        }
    }
}

struct TabBatch { f32x4 f[4][4]; };
__device__ __forceinline__ int tab_rpb(int nb) { return ((2 * 16384 + nb - 1) / nb + 31) & ~31; }
__device__ __forceinline__ int tab_row(int vb, int nb, int wv, int i) { const int rpb = tab_rpb(nb), row = vb * rpb + 8 * i + wv; return (8 * i + wv < rpb && row < 2 * 16384) ? row : -1; }
__device__ __forceinline__ void tab_issue(const Params& p, int vb, int nb, int wv, int i0, int lane, TabBatch& t) {
#pragma unroll
    for (int q = 0; q < 4; ++q) {
        const int row = tab_row(vb, nb, wv, i0 + q);
        if (row >= 0) { const float* src = (row < 16384 ? p.eu : p.ev) + (size_t)(row & 16383) * D;
#pragma unroll
            for (int i = 0; i < 4; ++i) t.f[q][i] = ldg<f32x4>(src, (unsigned)(i * 256 + 4 * lane) * 4u); }
    }
}
__device__ __forceinline__ void tab_finish(const Params& p, int vb, int nb, int wv, int i0, int lane, const TabBatch& t) {
#pragma unroll
    for (int q = 0; q < 4; ++q) {
        const int row = tab_row(vb, nb, wv, i0 + q);
        if (row >= 0) {
            const bool isu = row < 16384; const int rr = row & 16383;
            float am = 0.f;
#pragma unroll
            for (int i = 0; i < 4; ++i) am = fmaxf(am, fmaxf(fmaxf(fabsf(t.f[q][i][0]), fabsf(t.f[q][i][1])), fmaxf(fabsf(t.f[q][i][2]), fabsf(t.f[q][i][3]))));
#pragma unroll
            for (int o = 32; o > 0; o >>= 1) am = fmaxf(am, __shfl_xor(am, o));
            if (isu) {
                const float inv = am > 0.f ? 127.0f / am : 0.f;
#pragma unroll
                for (int i = 0; i < 4; ++i) {
                    unsigned w = 0u;
#pragma unroll
                    for (int e = 0; e < 4; ++e) { const int qv = (int)rintf(t.f[q][i][e] * inv); w |= ((unsigned)qv & 255u) << (8 * e); }
                    const unsigned c = (unsigned)(i * 256 + 4 * lane);
                    stg<unsigned>(p.eut, (((c >> 7) * 16384u + (unsigned)rr) << 7) + (c & 127u), w);
                }
                if (lane == 0) ((float*)p.su)[rr] = am * (1.0f / 127.0f);
            } else {
                const float inv = am > 0.f ? 7.0f / am : 0.f;
#pragma unroll
                for (int i = 0; i < 4; ++i) {
                    unsigned w = 0u;
#pragma unroll
                    for (int e = 0; e < 4; ++e) { const int qv = (int)rintf(t.f[q][i][e] * inv) + 8; w |= ((unsigned)qv & 15u) << (8 * e); }
                    const unsigned o = (unsigned)__shfl_xor((int)w, 4);
                    if ((lane & 4) == 0) stg<unsigned>(p.evt, (((unsigned)i * 16384u + (unsigned)rr) << 7) + (unsigned)(lane >> 3) * 16u + (unsigned)(lane & 3) * 4u, w | (o << 4));
                }
                if (lane == 0) ((float*)p.sv)[rr] = am * (1.0f / 7.0f);
            }
        }
    }
}


template <int CH>
__device__ __forceinline__ void gemm22_chunk(const u32x4 (&a)[2][CH], const LAS unsigned char* b, int s0, f32x16 (&acc)[2][2]) {
#pragma unroll
    for (int u = 0; u < CH; ++u) {
        const u32x4 b0 = *(const LAS u32x4*)(b + (s0 + u) * 32), b1 = *(const LAS u32x4*)(b + 32 * TROW + (s0 + u) * 32);
        acc[0][0] = mfma32(a[0][u], b0, acc[0][0]); acc[0][1] = mfma32(a[0][u], b1, acc[0][1]);
        acc[1][0] = mfma32(a[1][u], b0, acc[1][0]); acc[1][1] = mfma32(a[1][u], b1, acc[1][1]);
    }
}
template <int KS, int CH = 4>
__device__ __forceinline__ void gemm22(const u32x4* abase, unsigned lane, const LAS unsigned char* b, f32x16 (&acc)[2][2], int kofs = 0) {
    constexpr int NC = KS / CH;
    static_assert(NC % 2 == 0 && (NC & (NC - 1)) == 0, "chunk count: even power of two");
    u32x4 pa[2][CH], pb[2][CH];
    const unsigned lo = lane * 16u;
    {
        const unsigned o0 = lo + (unsigned)((kofs & (NC - 1)) * CH) * 1024u;
#pragma unroll
        for (int u = 0; u < CH; ++u) { pa[0][u] = ldg<u32x4>(abase, o0 + u * 1024u); pa[1][u] = ldg<u32x4>(abase, o0 + (KS + u) * 1024u); }
    }
#pragma unroll 1
    for (int c = 0; c < NC; c += 2) {
        const int c0 = (c + kofs) & (NC - 1), c1 = (c + 1 + kofs) & (NC - 1), c2 = (c + 2 + kofs) & (NC - 1);
        const unsigned o1 = lo + (unsigned)(c1 * CH) * 1024u, o2 = lo + (unsigned)(c2 * CH) * 1024u;
#pragma unroll
        for (int u = 0; u < CH; ++u) { pb[0][u] = ldg<u32x4>(abase, o1 + u * 1024u); pb[1][u] = ldg<u32x4>(abase, o1 + (KS + u) * 1024u); }
        __builtin_amdgcn_sched_barrier(0);
        gemm22_chunk<CH>(pa, b, c0 * CH, acc);
        __builtin_amdgcn_sched_barrier(0);
#pragma unroll
        for (int u = 0; u < CH; ++u) { pa[0][u] = ldg<u32x4>(abase, o2 + u * 1024u); pa[1][u] = ldg<u32x4>(abase, o2 + (KS + u) * 1024u); }
        __builtin_amdgcn_sched_barrier(0);
        gemm22_chunk<CH>(pb, b, c1 * CH, acc);
        __builtin_amdgcn_sched_barrier(0);
    }
}

template <int CH>
__device__ __forceinline__ void gemm22i_chunk(const u32x4 (&a)[2][CH], const LAS unsigned char* b, int s0, i32x16 (&acc)[2][2]) {
#pragma unroll
    for (int u = 0; u < CH; ++u) {
        const u32x4 b0 = *(const LAS u32x4*)(b + (s0 + u) * 32), b1 = *(const LAS u32x4*)(b + 32 * TROWB + (s0 + u) * 32);
        acc[0][0] = mfma_i8(a[0][u], b0, acc[0][0]); acc[0][1] = mfma_i8(a[0][u], b1, acc[0][1]);
        acc[1][0] = mfma_i8(a[1][u], b0, acc[1][0]); acc[1][1] = mfma_i8(a[1][u], b1, acc[1][1]);
    }
}
template <int KS, int CH = 4>
__device__ __forceinline__ void gemm22i(const u32x4* abase, unsigned lane, const LAS unsigned char* b, i32x16 (&acc)[2][2], int kofs = 0) {
    constexpr int NC = KS / CH;
    static_assert(NC % 2 == 0 && (NC & (NC - 1)) == 0, "chunk count: even power of two");
    u32x4 pa[2][CH], pb[2][CH];
    const unsigned lo = lane * 16u;
    {
        const unsigned o0 = lo + (unsigned)((kofs & (NC - 1)) * CH) * 1024u;
#pragma unroll
        for (int u = 0; u < CH; ++u) { pa[0][u] = ldg<u32x4>(abase, o0 + u * 1024u); pa[1][u] = ldg<u32x4>(abase, o0 + (KS + u) * 1024u); }
    }
#pragma unroll 1
    for (int c = 0; c < NC; c += 2) {
        const int c0 = (c + kofs) & (NC - 1), c1 = (c + 1 + kofs) & (NC - 1), c2 = (c + 2 + kofs) & (NC - 1);
        const unsigned o1 = lo + (unsigned)(c1 * CH) * 1024u, o2 = lo + (unsigned)(c2 * CH) * 1024u;
#pragma unroll
        for (int u = 0; u < CH; ++u) { pb[0][u] = ldg<u32x4>(abase, o1 + u * 1024u); pb[1][u] = ldg<u32x4>(abase, o1 + (KS + u) * 1024u); }
        __builtin_amdgcn_sched_barrier(0);
        gemm22i_chunk<CH>(pa, b, c0 * CH, acc);
        __builtin_amdgcn_sched_barrier(0);
#pragma unroll
        for (int u = 0; u < CH; ++u) { pa[0][u] = ldg<u32x4>(abase, o2 + u * 1024u); pa[1][u] = ldg<u32x4>(abase, o2 + (KS + u) * 1024u); }
        __builtin_amdgcn_sched_barrier(0);
        gemm22i_chunk<CH>(pb, b, c1 * CH, acc);
        __builtin_amdgcn_sched_barrier(0);
    }
}

__device__ __forceinline__ void p1_stage(const Params& p, int tile, int tid, LAS unsigned char* lds) {
    const int lane = tid & 63, wv = __builtin_amdgcn_readfirstlane(tid >> 6);
    LAS float* rs = (LAS float*)(lds + LDS_RS);
    const float* xt = p.x + (size_t)tile * 64 * D;
#pragma unroll 4
    for (int rr = 0; rr < 8; ++rr) {
        const int tk = 8 * wv + rr;
        f32x4 f[4]; float ss = 0.f, am = 0.f;
#pragma unroll
        for (int i = 0; i < 4; ++i) { f[i] = ldg<f32x4>(xt, (unsigned)(tk * D + i * 256 + 4 * lane) * 4u); ss += f[i][0] * f[i][0] + f[i][1] * f[i][1] + f[i][2] * f[i][2] + f[i][3] * f[i][3];
            am = fmaxf(am, fmaxf(fmaxf(fabsf(f[i][0]), fabsf(f[i][1])), fmaxf(fabsf(f[i][2]), fabsf(f[i][3])))); }
        ss = wave_sum(ss);
#pragma unroll
        for (int o = 32; o > 0; o >>= 1) am = fmaxf(am, __shfl_xor(am, o));
        const float inv = am > 0.f ? 127.0f / am : 0.f;
        if (lane == 0) rs[tk] = rsqrtf(ss * (1.0f / D) + EPS) * am * (1.0f / 127.0f);
#pragma unroll
        for (int i = 0; i < 4; ++i) {
            unsigned w = 0u;
#pragma unroll
            for (int e = 0; e < 4; ++e) w |= ((unsigned)(int)rintf(f[i][e] * inv) & 255u) << (8 * e);
            *(LAS unsigned*)(lds + tk * TROWB + i * 256 + 4 * lane) = w;
        }
    }
    __syncthreads();
}
__device__ __forceinline__ void p1_inproj(const Params& p, int tile, int tid, LAS unsigned char* lds, int vb, int nb, bool do_tab) {
    const int lane = launder(tid) & 63, wv = __builtin_amdgcn_readfirstlane(tid >> 6), r = lane & 31, h = lane >> 5;
    const int b = tile >> 6, s0 = (tile & 63) * 64;
    LAS float* rs = (LAS float*)(lds + LDS_RS);
    const u32x4* WF = (const u32x4*)(p.winf);
    unsigned char* prow0 = p.proj + ((size_t)b * L + NMETA + s0) * (MIXIN * 2);
    const LAS unsigned char* bp = lds + r * TROWB + h * 16;
    const float rs0 = rs[r], rs1 = rs[32 + r];
    const int stg_k = (tile >> 3) & 7, stg_r = (tile >> 6) & 3;
#pragma unroll 1
    for (int rdx = 0; rdx < 4; ++rdx) {
        const int rd = (rdx + stg_r) & 3;
        const int i0 = 8 * wv + 2 * rd;
        TabBatch tb;
        if (do_tab) tab_issue(p, vb, nb, wv, 4 * rdx, lane, tb);
        __builtin_amdgcn_sched_barrier(0);
        i32x16 acc[2][2]; acc[0][0] = izero16(); acc[0][1] = izero16(); acc[1][0] = izero16(); acc[1][1] = izero16();
        gemm22i<32, 4>(WF + (size_t)i0 * 32 * 64, lane, bp, acc, stg_k);
        f32x4 wsv[2][4];
#pragma unroll
        for (int mi = 0; mi < 2; ++mi)
#pragma unroll
            for (int q = 0; q < 4; ++q) wsv[mi][q] = ldg<f32x4>(p.wsci, (unsigned)(32 * (i0 + mi) + 8 * q + 4 * h) * 4u);
        LAS unsigned char* eb = lds + 64 * TROWB + wv * 8192;
#pragma unroll
        for (int mi = 0; mi < 2; ++mi)
#pragma unroll
            for (int q = 0; q < 4; ++q) {
                const f32x4 ws = wsv[mi][q];
#pragma unroll
                for (int nt = 0; nt < 2; ++nt) {
                    const float rv = nt ? rs1 : rs0;
                    u32x2 o; o.x = pk_bf16((float)acc[mi][nt][4 * q] * rv * ws[0], (float)acc[mi][nt][4 * q + 1] * rv * ws[1]); o.y = pk_bf16((float)acc[mi][nt][4 * q + 2] * rv * ws[2], (float)acc[mi][nt][4 * q + 3] * rv * ws[3]);
                    *(LAS u32x2*)(eb + (nt * 32 + r) * 128 + (((4 * mi + q) ^ (r & 7)) * 16) + 8 * h) = o;
                }
            }
        wave_sync();
        {
            u32x4 ov[8];
#pragma unroll
            for (int k = 0; k < 8; ++k) { const int row = 8 * k + (lane >> 3); ov[k] = *(const LAS u32x4*)(eb + row * 128 + (((lane & 7) ^ (row & 7)) * 16)); }
            wave_sync();
#pragma unroll
            for (int k = 0; k < 8; ++k) { const int row = 8 * k + (lane >> 3); stg<u32x4>(prow0, (unsigned)(row * MIXIN + 32 * i0) * 2u + (unsigned)(lane & 7) * 16u, ov[k]); }
        }
        if (do_tab) tab_finish(p, vb, nb, wv, 4 * rdx, lane, tb);
    }
    if (do_tab) for (int i0 = 16; 8 * i0 < tab_rpb(nb); i0 += 4) { TabBatch tb; tab_issue(p, vb, nb, wv, i0, lane, tb); tab_finish(p, vb, nb, wv, i0, lane, tb); }
}
__device__ __forceinline__ void p1_meta(const Params& p, int mp, int lane) {
    const int r = lane & 31, h = lane >> 5;
    const u32x4* A = (const u32x4*)(p.winf) + (size_t)(2 * mp) * 32 * 64;
    const u32x4* B = (const u32x4*)(p.metaf);
    i32x16 acc0 = izero16(), acc1 = izero16();
#pragma unroll 4
    for (int s = 0; s < 32; ++s) { const u32x4 bf = ldg<u32x4>(B, (unsigned)(s * 64 + lane) * 16u);
        acc0 = mfma_i8(ldg<u32x4>(A, (unsigned)(s * 64 + lane) * 16u), bf, acc0); acc1 = mfma_i8(ldg<u32x4>(A, (unsigned)((32 + s) * 64 + lane) * 16u), bf, acc1); }
    if (r < NMETA) {
        const float rv = ((const float*)(p.rsm))[r];
#pragma unroll
        for (int q = 0; q < 4; ++q) {
            const f32x4 w0 = ldg<f32x4>(p.wsci, (unsigned)(64 * mp + 8 * q + 4 * h) * 4u), w1 = ldg<f32x4>(p.wsci, (unsigned)(64 * mp + 32 + 8 * q + 4 * h) * 4u);
            u32x2 o0, o1;
            o0.x = pk_bf16((float)acc0[4 * q] * rv * w0[0], (float)acc0[4 * q + 1] * rv * w0[1]); o0.y = pk_bf16((float)acc0[4 * q + 2] * rv * w0[2], (float)acc0[4 * q + 3] * rv * w0[3]);
            o1.x = pk_bf16((float)acc1[4 * q] * rv * w1[0], (float)acc1[4 * q + 1] * rv * w1[1]); o1.y = pk_bf16((float)acc1[4 * q + 2] * rv * w1[2], (float)acc1[4 * q + 3] * rv * w1[3]);
#pragma unroll
            for (int bb = 0; bb < BATCH; ++bb) {
                const unsigned ro = (unsigned)((bb * L + r) * MIXIN + 64 * mp + 4 * h) * 2u;
                stg<u32x2>(p.proj, ro + 16u * q, o0); stg<u32x2>(p.proj, ro + 64u + 16u * q, o1);
            }
        }
    }
}

template <int LOGN> __device__ __forceinline__ void bitonic_sort_desc(float* v) {
    constexpr int N = 1 << LOGN;
#pragma unroll
    for (int lk = 1; lk <= LOGN; ++lk) {
#pragma unroll
        for (int lj = lk - 1; lj >= 0; --lj) {
#pragma unroll
            for (int i = 0; i < N; ++i) {
                const int k = 1 << lk, j = 1 << lj, l = i ^ j;
                if (l > i) { const bool up = ((i & k) == 0); const float a = v[i], c = v[l]; const float hi = fmaxf(a, c), lo = fminf(a, c); v[i] = up ? hi : lo; v[l] = up ? lo : hi; }
            }
        }
    }
}
__device__ __forceinline__ void bitonic_merge16_desc(float* v) {
#pragma unroll
    for (int lj = 3; lj >= 0; --lj) {
#pragma unroll
        for (int i = 0; i < 16; ++i) { const int j = 1 << lj, l = i ^ j; if (l > i) { const float a = v[i], c = v[l]; v[i] = fmaxf(a, c); v[l] = fminf(a, c); } }
    }
}
__device__ __forceinline__ void merge_top16(float* a, const float* c) {
#pragma unroll
    for (int i = 0; i < 16; ++i) a[i] = fmaxf(a[i], c[15 - i]);
    bitonic_merge16_desc(a);
}
__device__ __forceinline__ void top16_of_64(float* v) {
    bitonic_sort_desc<4>(v); bitonic_sort_desc<4>(v + 16); bitonic_sort_desc<4>(v + 32); bitonic_sort_desc<4>(v + 48);
    merge_top16(v, v + 16); merge_top16(v + 32, v + 48); merge_top16(v, v + 32);
}
__device__ __forceinline__ float embed_bits(float x, unsigned mask, unsigned code) { return __builtin_bit_cast(float, (__builtin_bit_cast(unsigned, x) & ~mask) | code); }

template <int W>
__device__ __forceinline__ void pool_window(const unsigned char* pbat, int p0, int cp, LAS unsigned char* dst) {
    unsigned u[31 + W];
#pragma unroll
    for (int i = 0; i < 31 + W; ++i) u[i] = ldg<unsigned>(pbat + (size_t)(p0 - (W - 1) + i) * 4096u, cp * 4u);
    float sx = 0.f, sy = 0.f;
#pragma unroll
    for (int i = 0; i < W - 1; ++i) { sx += bf_lo(u[i]); sy += bf_hi(u[i]); }
    const float invw = 1.0f / (float)W;
#pragma unroll
    for (int tk = 0; tk < 32; ++tk) {
        const float lo = bf_lo(u[W - 1 + tk]), hi = bf_hi(u[W - 1 + tk]);
        sx += lo; sy += hi;
        *(LAS unsigned*)(dst + tk * TROW) = pk_bf16(sx * invw - lo, sy * invw - hi);
        sx -= bf_lo(u[tk]); sy -= bf_hi(u[tk]);
    }
}

template <int RB>
__device__ __forceinline__ void p2_xf_batch(const Params& p, int tile, int wv, int lane, LAS unsigned char* lds, unsigned char* ht, f32x4 (&f)[4][4], const u32x2 (&hq)[8][4], const f32x4 (&gg)[4]) {
    unsigned char* xqt = p.xq + (size_t)tile * 64 * D;
#pragma unroll
    for (int rr = 0; rr < 4; ++rr) {
        const int tk = 8 * wv + RB + rr;
        float ss = 0.f;
#pragma unroll
        for (int i = 0; i < 4; ++i) {
            const u32x2 hw = hq[RB + rr][i];
            f[rr][i][0] += bf_lo(hw.x); f[rr][i][1] += bf_hi(hw.x); f[rr][i][2] += bf_lo(hw.y); f[rr][i][3] += bf_hi(hw.y);
            u32x2 ho; ho.x = pk_bf16(f[rr][i][0], f[rr][i][1]); ho.y = pk_bf16(f[rr][i][2], f[rr][i][3]);
            stg<u32x2>(ht, (unsigned)(tk * D + i * 256 + 4 * lane) * 2u, ho);
            ss += f[rr][i][0] * f[rr][i][0] + f[rr][i][1] * f[rr][i][1] + f[rr][i][2] * f[rr][i][2] + f[rr][i][3] * f[rr][i][3];
        }
        ss = wave_sum(ss);
        const float rv = rsqrtf(ss * (1.0f / D) + EPS);
        float am = 0.f;
#pragma unroll
        for (int i = 0; i < 4; ++i)
#pragma unroll
            for (int e = 0; e < 4; ++e) { f[rr][i][e] *= rv * gg[i][e]; am = fmaxf(am, fabsf(f[rr][i][e])); }
#pragma unroll
        for (int o = 32; o > 0; o >>= 1) am = fmaxf(am, __shfl_xor(am, o));
        const float inv = am > 0.f ? 127.0f / am : 0.f;
#pragma unroll
        for (int i = 0; i < 4; ++i) {
            unsigned w = 0u;
#pragma unroll
            for (int e = 0; e < 4; ++e) w |= ((unsigned)(int)rintf(f[rr][i][e] * inv) & 255u) << (8 * e);
            stg<unsigned>(xqt, (unsigned)(tk * D + i * 256 + 4 * lane), w);
            *(LAS unsigned*)(lds + tk * TROWB + i * 256 + 4 * lane) = w;
        }
        if (lane == 0) { ((LAS float*)(lds + LDS_RS))[tk] = am * (1.0f / 127.0f); ((float*)p.sx)[tile * 64 + tk] = am * (1.0f / 127.0f); }
    }
}

__device__ __forceinline__ void p2_mix(const Params& p, int tile, int tid, LAS unsigned char* lds) {
    const int wv = __builtin_amdgcn_readfirstlane(tid >> 6);
    const int b = tile >> 6, s0 = (tile & 63) * 64;
    LAS float* ssa = (LAS float*)(lds + LDS_SSA);
    const unsigned char* pbat = p.proj + (size_t)b * L * (MIXIN * 2);
    const float* xt = p.x + (size_t)tile * 64 * D;
    unsigned char* ht = p.hb + (size_t)tile * 64 * D * 2;
    if (tid < 64) ssa[tid] = 0.f;
    {
        const int lane = launder(tid) & 63, r = lane & 31, h = lane >> 5; (void)r; (void)h;
        float cw[3][8], gbv[8], u1[8], u2[8];
#pragma unroll
        for (int k = 0; k < 3; ++k) { const f32x4 a = ldg<f32x4>(p.conv_w, (unsigned)(k * MIXB + 8 * lane) * 4u), c = ldg<f32x4>(p.conv_w, (unsigned)(k * MIXB + 8 * lane + 4) * 4u);
#pragma unroll
            for (int e = 0; e < 4; ++e) { cw[k][e] = a[e]; cw[k][4 + e] = c[e]; } }
        { const f32x4 a = ldg<f32x4>(p.g_b, (unsigned)(8 * lane) * 4u), c = ldg<f32x4>(p.g_b, (unsigned)(8 * lane + 4) * 4u);
#pragma unroll
            for (int e = 0; e < 4; ++e) { gbv[e] = a[e]; gbv[4 + e] = c[e]; } }
        const int p0 = NMETA + s0 + 8 * wv;
        u32x4 bvv[8], cvv[10], vvv[10];
#pragma unroll
        for (int i = 0; i < 10; ++i) { const unsigned ro = (unsigned)(p0 - 2 + i) * 4096u + lane * 16u; cvv[i] = ldg<u32x4>(pbat, ro + 2048u); vvv[i] = ldg<u32x4>(pbat, ro + 3072u); if (i >= 2) bvv[i - 2] = ldg<u32x4>(pbat, ro + 1024u); }
    {
        const int cp = tid & 255, th = __builtin_amdgcn_readfirstlane(tid >> 8), g = __builtin_amdgcn_readfirstlane(cp >> 6);
        const int p0 = NMETA + s0 + 32 * th;
        LAS unsigned char* dst = lds + (32 * th) * TROW + cp * 4;
        if (g == 0) pool_window<2>(pbat, p0, cp, dst); else if (g == 1) pool_window<4>(pbat, p0, cp, dst); else if (g == 2) pool_window<8>(pbat, p0, cp, dst); else pool_window<16>(pbat, p0, cp, dst);
    }
#pragma unroll
        for (int e = 0; e < 4; ++e) { u2[2 * e] = bf_lo(cvv[0][e]) * bf_lo(vvv[0][e]); u2[2 * e + 1] = bf_hi(cvv[0][e]) * bf_hi(vvv[0][e]); u1[2 * e] = bf_lo(cvv[1][e]) * bf_lo(vvv[1][e]); u1[2 * e + 1] = bf_hi(cvv[1][e]) * bf_hi(vvv[1][e]); }
#pragma unroll
        for (int tk = 0; tk < 8; ++tk) {
            const u32x4 bv = bvv[tk], cv = cvv[tk + 2], vv = vvv[tk + 2];
            float z[8], ss = 0.f;
#pragma unroll
            for (int e = 0; e < 8; ++e) {
                const float bb = (e & 1) ? bf_hi(bv[e >> 1]) : bf_lo(bv[e >> 1]);
                const float u0 = ((e & 1) ? bf_hi(cv[e >> 1]) : bf_lo(cv[e >> 1])) * ((e & 1) ? bf_hi(vv[e >> 1]) : bf_lo(vv[e >> 1]));
                const float conv = u2[e] * cw[0][e] + u1[e] * cw[1][e] + u0 * cw[2][e];
                z[e] = bb * conv; ss += z[e] * z[e];
                u2[e] = u1[e]; u1[e] = u0;
            }
            ss = wave_sum(ss);
            const float rsb = rsqrtf(ss * (1.0f / MIXB) + EPS);
            u32x4 o; o.x = pk_bf16(z[0] * rsb * gbv[0], z[1] * rsb * gbv[1]); o.y = pk_bf16(z[2] * rsb * gbv[2], z[3] * rsb * gbv[3]);
            o.z = pk_bf16(z[4] * rsb * gbv[4], z[5] * rsb * gbv[5]); o.w = pk_bf16(z[6] * rsb * gbv[6], z[7] * rsb * gbv[7]);
            *(LAS u32x4*)(lds + (8 * wv + tk) * TROW + (MIXA + 8 * lane) * 2) = o;
        }
    }
    __syncthreads();
    {
        const int lane = launder(tid) & 63, r = lane & 31, h = lane >> 5; (void)r; (void)h;
        const int g = wv >> 1, dh = wv & 1;
        const u32x4* PWF = (const u32x4*)(p.pwf);
        f32x16 acc[2][2]; acc[0][0] = zero16(); acc[0][1] = zero16(); acc[1][0] = zero16(); acc[1][1] = zero16();
        gemm22<8>(PWF + (size_t)((g * 4 + 2 * dh) * 8) * 64, lane, lds + r * TROW + g * 256 + h * 16, acc);
        float ss0 = 0.f, ss1 = 0.f;
#pragma unroll
        for (int mi = 0; mi < 2; ++mi)
#pragma unroll
            for (int q = 0; q < 4; ++q) {
                const int d = g * 128 + 32 * (2 * dh + mi) + 8 * q + 4 * h;
                const f32x4 sc = ldg<f32x4>(p.pool_scale, (unsigned)d * 4u);
#pragma unroll
                for (int e = 0; e < 4; ++e) { acc[mi][0][4 * q + e] *= sc[e]; acc[mi][1][4 * q + e] *= sc[e]; ss0 += acc[mi][0][4 * q + e] * acc[mi][0][4 * q + e]; ss1 += acc[mi][1][4 * q + e] * acc[mi][1][4 * q + e]; }
            }
        ss0 += __shfl_xor(ss0, 32); ss1 += __shfl_xor(ss1, 32);
        if (h == 0) { atomicAdd((float*)(ssa + r), ss0); atomicAdd((float*)(ssa + 32 + r), ss1); }
        __syncthreads();
        const float ra0 = rsqrtf(ssa[r] * (1.0f / MIXA) + EPS), ra1 = rsqrtf(ssa[32 + r] * (1.0f / MIXA) + EPS);
#pragma unroll
        for (int mi = 0; mi < 2; ++mi)
#pragma unroll
            for (int q = 0; q < 4; ++q) {
                const int d = g * 128 + 32 * (2 * dh + mi) + 8 * q + 4 * h;
                const f32x4 gg = ldg<f32x4>(p.g_a, (unsigned)d * 4u);
                u32x2 o0, o1;
                o0.x = pk_bf16(acc[mi][0][4 * q] * ra0 * gg[0], acc[mi][0][4 * q + 1] * ra0 * gg[1]); o0.y = pk_bf16(acc[mi][0][4 * q + 2] * ra0 * gg[2], acc[mi][0][4 * q + 3] * ra0 * gg[3]);
                o1.x = pk_bf16(acc[mi][1][4 * q] * ra1 * gg[0], acc[mi][1][4 * q + 1] * ra1 * gg[1]); o1.y = pk_bf16(acc[mi][1][4 * q + 2] * ra1 * gg[2], acc[mi][1][4 * q + 3] * ra1 * gg[3]);
                *(LAS u32x2*)(lds + r * TROW + d * 2) = o0;
                *(LAS u32x2*)(lds + (32 + r) * TROW + d * 2) = o1;
            }
    }
    __syncthreads();
    f32x4 xa[4][4];
    {
        const int lane = launder(tid) & 63, r = lane & 31, h = lane >> 5; (void)r; (void)h;
#pragma unroll
        for (int rr = 0; rr < 4; ++rr)
#pragma unroll
            for (int i = 0; i < 4; ++i) xa[rr][i] = ldg<f32x4>(xt, (unsigned)((8 * wv + rr) * D + i * 256 + 4 * lane) * 4u);
        const u32x4* WF = (const u32x4*)(p.woutf);
        const LAS unsigned char* bp = lds + r * TROW + h * 16;
#pragma unroll 1
        for (int rdx = 0; rdx < 2; ++rdx) {
            const int rd = (rdx + (tile >> 7)) & 1;
            const int i0 = 4 * wv + 2 * rd;
            f32x16 acc[2][2]; acc[0][0] = zero16(); acc[0][1] = zero16(); acc[1][0] = zero16(); acc[1][1] = zero16();
            gemm22<64>(WF + (size_t)i0 * 64 * 64, lane, bp, acc, (tile >> 3) & 15);
            LAS unsigned char* eb = lds + LDS_LUT + wv * 2048;
#pragma unroll
            for (int nt = 0; nt < 2; ++nt)
#pragma unroll
                for (int hf = 0; hf < 2; ++hf) {
                    if ((r >> 4) == hf) {
#pragma unroll
                        for (int mi = 0; mi < 2; ++mi)
#pragma unroll
                            for (int q = 0; q < 4; ++q) {
                                u32x2 hw; hw.x = pk_bf16(acc[mi][nt][4 * q], acc[mi][nt][4 * q + 1]); hw.y = pk_bf16(acc[mi][nt][4 * q + 2], acc[mi][nt][4 * q + 3]);
                                *(LAS u32x2*)(eb + (r & 15) * 128 + (((4 * mi + q) ^ (r & 7)) * 16) + 8 * h) = hw;
                            }
                    }
                    wave_sync();
                    u32x4 ov[2];
#pragma unroll
                    for (int k = 0; k < 2; ++k) { const int row = 8 * k + (lane >> 3); ov[k] = *(const LAS u32x4*)(eb + row * 128 + (((lane & 7) ^ (row & 7)) * 16)); }
                    wave_sync();
#pragma unroll
                    for (int k = 0; k < 2; ++k) { const int row = 8 * k + (lane >> 3); stg<u32x4>(ht, (unsigned)((nt * 32 + hf * 16 + row) * D + 32 * i0) * 2u + (unsigned)(lane & 7) * 16u, ov[k]); }
                }
        }
    }
    __syncthreads();
    {
        const int lane = launder(tid) & 63;
        f32x4 gg[4];
#pragma unroll
        for (int i = 0; i < 4; ++i) gg[i] = ldg<f32x4>(p.g_ffn, (unsigned)(i * 256 + 4 * lane) * 4u);
        f32x4 xb[4][4];
#pragma unroll
        for (int rr = 0; rr < 4; ++rr)
#pragma unroll
            for (int i = 0; i < 4; ++i) xb[rr][i] = ldg<f32x4>(xt, (unsigned)((8 * wv + 4 + rr) * D + i * 256 + 4 * lane) * 4u);
        u32x2 hq[8][4];
#pragma unroll
        for (int rr = 0; rr < 4; ++rr)
#pragma unroll
            for (int i = 0; i < 4; ++i) hq[rr][i] = ldg<u32x2>(ht, (unsigned)((8 * wv + rr) * D + i * 256 + 4 * lane) * 2u);
        p2_xf_batch<0>(p, tile, wv, lane, lds, ht, xa, hq, gg);
#pragma unroll
        for (int rr = 4; rr < 8; ++rr)
#pragma unroll
            for (int i = 0; i < 4; ++i) hq[rr][i] = ldg<u32x2>(ht, (unsigned)((8 * wv + rr) * D + i * 256 + 4 * lane) * 2u);
        p2_xf_batch<4>(p, tile, wv, lane, lds, ht, xb, hq, gg);
    }
    __syncthreads();
    {
        const int lane = launder(tid) & 63, r = lane & 31, h = lane >> 5; (void)r; (void)h;
        const int hd = wv;
        const u32x4* WQF = (const u32x4*)(p.wqf);
        const u32x4* KF = (const u32x4*)(p.kf);
        unsigned char* lstt = p.lst + (size_t)tile * 64 * (NH * 32 * 4);
        const LAS unsigned char* bp = lds + r * TROWB + h * 16;
        const float sx0 = ((const LAS float*)(lds + LDS_RS))[r], sx1 = ((const LAS float*)(lds + LDS_RS))[32 + r];
        LAS unsigned char* lut = lds + LDS_LUT + wv * 2048;
#pragma unroll
        for (int pp = 0; pp < 2; ++pp) {
            const int hp = hd * 2 + pp;
            u32x4 qb[8];
            LAS u32x4* qpark = (LAS u32x4*)(lds + 64 * TROWB + wv * 8192) + lane;
#pragma unroll
            for (int mh = 0; mh < 2; ++mh) {
                const int mt0 = hp * 4 + mh * 2;
                i32x16 acc[2][2]; acc[0][0] = izero16(); acc[0][1] = izero16(); acc[1][0] = izero16(); acc[1][1] = izero16();
                gemm22i<32, QCH>(WQF + (size_t)mt0 * 32 * 64, lane, bp, acc, (tile >> 3));
#pragma unroll
                for (int mi = 0; mi < 2; ++mi)
#pragma unroll
                    for (int s2 = 0; s2 < 2; ++s2) {
                        const f32x4 w0 = ldg<f32x4>(p.wscq, (unsigned)(32 * (mt0 + mi) + 16 * s2 + 4 * h) * 4u), w1 = ldg<f32x4>(p.wscq, (unsigned)(32 * (mt0 + mi) + 16 * s2 + 8 + 4 * h) * 4u);
#pragma unroll
                        for (int nt = 0; nt < 2; ++nt) {
                            const float xs = nt ? sx1 : sx0;
                            u32x4 o; o.x = pk_bf16((float)acc[mi][nt][8 * s2] * xs * w0[0], (float)acc[mi][nt][8 * s2 + 1] * xs * w0[1]); o.y = pk_bf16((float)acc[mi][nt][8 * s2 + 2] * xs * w0[2], (float)acc[mi][nt][8 * s2 + 3] * xs * w0[3]);
                            o.z = pk_bf16((float)acc[mi][nt][8 * s2 + 4] * xs * w1[0], (float)acc[mi][nt][8 * s2 + 5] * xs * w1[1]); o.w = pk_bf16((float)acc[mi][nt][8 * s2 + 6] * xs * w1[2], (float)acc[mi][nt][8 * s2 + 7] * xs * w1[3]);
                            if (nt == 0) qb[2 * (mh * 2 + mi) + s2] = o; else qpark[(2 * (mh * 2 + mi) + s2) * 64] = o;
                        }
                    }
            }
#pragma unroll
            for (int nt = 0; nt < 2; ++nt) {
                float top[16];
#pragma unroll
                for (int i = 0; i < 16; ++i) top[i] = -INFINITY;
                if (nt == 1) {
#pragma unroll
                    for (int ks = 0; ks < 8; ++ks) qb[ks] = qpark[ks * 64];
                }
                const u32x4* kfp = KF + (size_t)(hp * 4 * 8) * 64;
                u32x4 kf[8];
#pragma unroll
                for (int ks = 0; ks < 8; ++ks) kf[ks] = ldg<u32x4>(kfp, (unsigned)(ks * 64 + lane) * 16u);
#pragma unroll 1
                for (int kt = 0; kt < 4; ++kt) {
                    f32x16 sa = zero16();
#pragma unroll
                    for (int ks = 0; ks < 8; ++ks) sa = mfma32(kf[ks], qb[ks], sa);
                    __builtin_amdgcn_sched_barrier(0);
                    const int ktn = (kt + 1) & 3;
#pragma unroll
                    for (int ks = 0; ks < 8; ++ks) kf[ks] = ldg<u32x4>(kfp, (unsigned)((ktn * 8 + ks) * 64 + lane) * 16u);
                    __builtin_amdgcn_sched_barrier(0);
                    float v[16];
#pragma unroll
                    for (int i = 0; i < 16; ++i) v[i] = embed_bits(sa[i], 127u, (unsigned)(32 * kt + (i & 3) + 8 * (i >> 2) + 4 * h));
                    bitonic_sort_desc<4>(v); merge_top16(top, v);
                    __builtin_amdgcn_sched_barrier(0);
                }
                float o[16];
#pragma unroll
                for (int i = 0; i < 16; ++i) o[i] = __shfl_xor(top[i], 32);
                merge_top16(top, o);
                if (h == 0) {
                    const unsigned lo = (unsigned)((((nt * 32 + r) * NH + hd) * 2 + pp) * 16) * 4u;
#pragma unroll
                    for (int w4 = 0; w4 < 4; ++w4) { f32x4 tv; tv[0] = top[4 * w4]; tv[1] = top[4 * w4 + 1]; tv[2] = top[4 * w4 + 2]; tv[3] = top[4 * w4 + 3]; stg<f32x4>(lstt, lo + 16u * w4, tv); }
                    u32x4 kb;
#pragma unroll
                    for (int w4 = 0; w4 < 4; ++w4) kb[w4] = (__builtin_bit_cast(unsigned, top[4 * w4]) & 127u) | ((__builtin_bit_cast(unsigned, top[4 * w4 + 1]) & 127u) << 8) | ((__builtin_bit_cast(unsigned, top[4 * w4 + 2]) & 127u) << 16) | ((__builtin_bit_cast(unsigned, top[4 * w4 + 3]) & 127u) << 24);
                    *(LAS u32x4*)(lut + ((nt * 32 + r) * 2 + pp) * 16) = kb;
                }
            }
        }
#pragma unroll
        for (int nt = 0; nt < 2; ++nt) {
            float s1[16], s2[16];
            {
                const unsigned lo = (unsigned)(((nt * 32 + r) * NH + hd) * 32) * 4u;
#pragma unroll
                for (int w4 = 0; w4 < 4; ++w4) { const f32x4 a = ldg<f32x4>(lstt, lo + 16u * w4), c = ldg<f32x4>(lstt, lo + 64u + 16u * w4);
#pragma unroll
                    for (int e4 = 0; e4 < 4; ++e4) { s1[4 * w4 + e4] = a[e4]; s2[4 * w4 + e4] = c[e4]; } }
            }
            float top[16];
#pragma unroll
            for (int i = 0; i < 16; ++i) top[i] = -INFINITY;
            { float v[16]; v[0] = embed_bits(s1[0] + s2[0], 255u, 0u); v[1] = embed_bits(s1[0] + s2[1], 255u, 1u); v[2] = embed_bits(s1[0] + s2[2], 255u, 2u); v[3] = embed_bits(s1[0] + s2[3], 255u, 3u); v[4] = embed_bits(s1[0] + s2[4], 255u, 4u); v[5] = embed_bits(s1[0] + s2[5], 255u, 5u); v[6] = embed_bits(s1[0] + s2[6], 255u, 6u); v[7] = embed_bits(s1[0] + s2[7], 255u, 7u); v[8] = embed_bits(s1[0] + s2[8], 255u, 8u); v[9] = embed_bits(s1[0] + s2[9], 255u, 9u); v[10] = embed_bits(s1[0] + s2[10], 255u, 10u); v[11] = embed_bits(s1[0] + s2[11], 255u, 11u); v[12] = embed_bits(s1[0] + s2[12], 255u, 12u); v[13] = embed_bits(s1[0] + s2[13], 255u, 13u); v[14] = embed_bits(s1[0] + s2[14], 255u, 14u); v[15] = embed_bits(s1[0] + s2[15], 255u, 15u);
              bitonic_sort_desc<4>(v); merge_top16(top, v); }
            { float v[16]; v[0] = embed_bits(s1[1] + s2[0], 255u, 16u); v[1] = embed_bits(s1[1] + s2[1], 255u, 17u); v[2] = embed_bits(s1[1] + s2[2], 255u, 18u); v[3] = embed_bits(s1[1] + s2[3], 255u, 19u); v[4] = embed_bits(s1[1] + s2[4], 255u, 20u); v[5] = embed_bits(s1[1] + s2[5], 255u, 21u); v[6] = embed_bits(s1[1] + s2[6], 255u, 22u); v[7] = embed_bits(s1[1] + s2[7], 255u, 23u); v[8] = embed_bits(s1[2] + s2[0], 255u, 32u); v[9] = embed_bits(s1[2] + s2[1], 255u, 33u); v[10] = embed_bits(s1[2] + s2[2], 255u, 34u); v[11] = embed_bits(s1[2] + s2[3], 255u, 35u); v[12] = embed_bits(s1[2] + s2[4], 255u, 36u); v[13] = embed_bits(s1[3] + s2[0], 255u, 48u); v[14] = embed_bits(s1[3] + s2[1], 255u, 49u); v[15] = embed_bits(s1[3] + s2[2], 255u, 50u);
              bitonic_sort_desc<4>(v); merge_top16(top, v); }
            { float v[16]; v[0] = embed_bits(s1[3] + s2[3], 255u, 51u); v[1] = embed_bits(s1[4] + s2[0], 255u, 64u); v[2] = embed_bits(s1[4] + s2[1], 255u, 65u); v[3] = embed_bits(s1[4] + s2[2], 255u, 66u); v[4] = embed_bits(s1[5] + s2[0], 255u, 80u); v[5] = embed_bits(s1[5] + s2[1], 255u, 81u); v[6] = embed_bits(s1[6] + s2[0], 255u, 96u); v[7] = embed_bits(s1[6] + s2[1], 255u, 97u); v[8] = embed_bits(s1[7] + s2[0], 255u, 112u); v[9] = embed_bits(s1[7] + s2[1], 255u, 113u); v[10] = embed_bits(s1[8] + s2[0], 255u, 128u); v[11] = embed_bits(s1[9] + s2[0], 255u, 144u); v[12] = embed_bits(s1[10] + s2[0], 255u, 160u); v[13] = embed_bits(s1[11] + s2[0], 255u, 176u); v[14] = embed_bits(s1[12] + s2[0], 255u, 192u); v[15] = embed_bits(s1[13] + s2[0], 255u, 208u);
              bitonic_sort_desc<4>(v); merge_top16(top, v); }
            { float v[16]; v[0] = embed_bits(s1[14] + s2[0], 255u, 224u); v[1] = embed_bits(s1[15] + s2[0], 255u, 240u); v[2] = -INFINITY; v[3] = -INFINITY; v[4] = -INFINITY; v[5] = -INFINITY; v[6] = -INFINITY; v[7] = -INFINITY; v[8] = -INFINITY; v[9] = -INFINITY; v[10] = -INFINITY; v[11] = -INFINITY; v[12] = -INFINITY; v[13] = -INFINITY; v[14] = -INFINITY; v[15] = -INFINITY;
              bitonic_sort_desc<4>(v); merge_top16(top, v); }
            float e[16], sum = 0.f;
#pragma unroll
            for (int i = 0; i < 16; ++i) { e[i] = __expf(top[i] - top[0]); sum += e[i]; }
            const float inv = 1.0f / sum;
            const LAS unsigned char* lt = lut + (nt * 32 + r) * 32;
            LAS unsigned char* slot = lds + 64 * TROWB + wv * 8192 + (nt * 32 + r) * 32;
            if (h == 0) {
                int ids[16];
#pragma unroll
                for (int i = 0; i < 16; ++i) { const unsigned code = __builtin_bit_cast(unsigned, top[i]) & 255u; ids[i] = (int)lt[code >> 4] * NKEYS + (int)lt[16 + (code & 15u)]; }
                u32x4 w0, w1;
#pragma unroll
                for (int i = 0; i < 4; ++i) { w0[i] = (unsigned)ids[i] | ((unsigned)ids[i + 8] << 16); w1[i] = (unsigned)ids[i + 4] | ((unsigned)ids[i + 12] << 16); }
                *(LAS u32x4*)(slot) = w0; *(LAS u32x4*)(slot + 16) = w1;
            } else {
#pragma unroll
                for (int i = 0; i < 4; ++i) { f32x4 gv; gv[0] = e[2 * i] * inv; gv[1] = e[2 * i + 8] * inv; gv[2] = e[2 * i + 1] * inv; gv[3] = e[2 * i + 9] * inv; *(LAS f32x4*)(slot + 2048 + (nt * 32 + r) * 32 + 16 * i) = gv; }
            }
        }
    }
    __syncthreads();
    {
        const LAS unsigned char* sl = lds + 64 * TROWB;
        unsigned char* idxt = p.idx + (size_t)tile * 64 * (HK * 2);
        unsigned char* gatet = p.gate + (size_t)tile * 64 * (HK * 4);
        u32x4 iv[2]; f32x4 gv[4];
#pragma unroll
        for (int k = 0; k < 2; ++k) { const int ci = tid + 512 * k, tok = ci >> 4, c = ci & 15;
#pragma unroll
            for (int q = 0; q < 4; ++q) iv[k][q] = *(const LAS unsigned*)(sl + (4 * (c & 1) + q) * 8192 + tok * 32 + (c >> 1) * 4); }
#pragma unroll
        for (int k = 0; k < 4; ++k) { const int ci = tid + 512 * k, tok = ci >> 5, c = ci & 31;
            const f32x2 a = *(const LAS f32x2*)(sl + (2 * (c & 3)) * 8192 + 2048 + tok * 64 + (c >> 2) * 8), b = *(const LAS f32x2*)(sl + (2 * (c & 3) + 1) * 8192 + 2048 + tok * 64 + (c >> 2) * 8);
            gv[k][0] = a[0]; gv[k][1] = a[1]; gv[k][2] = b[0]; gv[k][3] = b[1]; }
#pragma unroll
        for (int k = 0; k < 2; ++k) stg<u32x4>(idxt, (unsigned)(tid + 512 * k) * 16u, iv[k]);
#pragma unroll
        for (int k = 0; k < 4; ++k) stg<f32x4>(gatet, (unsigned)(tid + 512 * k) * 16u, gv[k]);
    }
}

__device__ __forceinline__ int dot16_i8(u32x4 a, u32x4 b) {
    int d = __builtin_amdgcn_sdot4((int)a[0], (int)b[0], 0, false);
    d = __builtin_amdgcn_sdot4((int)a[1], (int)b[1], d, false); d = __builtin_amdgcn_sdot4((int)a[2], (int)b[2], d, false); d = __builtin_amdgcn_sdot4((int)a[3], (int)b[3], d, false);
    return d;
}
__device__ __forceinline__ float gelu_exact(float z) { return 0.5f * z * (1.0f + erff(z * 0.70710678118654752f)); }

struct GMeta { int ids[16]; u32x4 x; };
struct GRows { u32x4 v[16]; };
__device__ __forceinline__ void g_rows(const unsigned char* slice, const GMeta& m, int lane, GRows& r) {
    const unsigned co = (unsigned)(lane & 7) * 16u;
#pragma unroll
    for (int i = 0; i < 16; ++i) r.v[i] = ldg<u32x4>(slice, (unsigned)m.ids[i] * 128u + co);
}

constexpr int P3W_Z = 0, P3W_CQ = 4096, P3W_SC = 5120, P3W_SSQ = 5152, P3W_CS = 5184, P3W_ID = 5216, P3W_X = 7264, P3W_BYTES = 15456;
__device__ __forceinline__ void p3_wave(const Params& p, int tb0, int tb1, int lt, int pos, int lane, LAS unsigned char* wl) {
    const int ntok = 1 << lt;
    auto tokf = [&](int q) { return (q < 4 ? tb0 : tb1) + (q & 3); };
    const int grp = lane >> 3, ch = lane & 7, i0 = ((ch >> 2) & 1) * 8 + ((ch >> 1) & 1) * 4 + (ch & 1) * 2;
    LAS int* zl = (LAS int*)(wl + P3W_Z);
    LAS float* scl = (LAS float*)(wl + P3W_SC);
    LAS float* ssl = (LAS float*)(wl + P3W_SSQ);
#pragma unroll
    for (int q = 0; q < 8; ++q) if (q < ntok) {
        const int t = tokf(q);
        *(LAS unsigned*)(wl + P3W_ID + q * 256 + lane * 4) = ldg<unsigned>(p.idx + (size_t)t * (HK * 2), (unsigned)lane * 4u);
        *(LAS u32x4*)(wl + P3W_X + q * 1024 + lane * 16) = ldg<u32x4>(p.xq + (size_t)t * D, (unsigned)lane * 16u);
    }
    wave_sync();
    auto ids_lds = [&](int q, GMeta& m) {
#pragma unroll
        for (int w = 0; w < 2; ++w) { const u32x4 a = *(const LAS u32x4*)(wl + P3W_ID + q * 256 + grp * 32 + 16 * w);
#pragma unroll
            for (int e = 0; e < 4; ++e) { m.ids[8 * w + 2 * e] = (int)(a[e] & 0xffffu); m.ids[8 * w + 2 * e + 1] = (int)(a[e] >> 16); } }
    };
#pragma unroll 1
    for (int st = 0; st < 8; ++st) {
        const int j = (pos + st) & 7;
        const unsigned char* slice = p.eut + (size_t)j * (16384 * 128);
        const unsigned xo = (unsigned)(128 * j + 16 * ch);
#pragma unroll 1
        for (int q = 0; q < ntok; ++q) {
            const int t = tokf(q);
            GMeta m; GRows r; ids_lds(q, m); m.x = *(const LAS u32x4*)(wl + P3W_X + q * 1024 + xo); g_rows(slice, m, lane, r); (void)t;
            int part[16];
#pragma unroll
            for (int i = 0; i < 16; ++i) part[i] = dot16_i8(r.v[i], m.x);
#pragma unroll
            for (int lv = 2; lv >= 0; --lv) {
                const int n = 2 << lv, off = 1 << lv;
                const bool up = (lane & off) != 0;
#pragma unroll
                for (int i = 0; i < n; ++i) { const int a = part[i], c = part[i + n]; const int send = up ? a : c, keep = up ? c : a; part[i] = keep + __shfl_xor(send, off); }
            }
            LAS int* zp = zl + q * 128 + 2 * lane;
            if (st == 0) { zp[0] = part[0]; zp[1] = part[1]; } else { zp[0] += part[0]; zp[1] += part[1]; }
        }
    }
    {
        const unsigned po = (unsigned)(grp * 16 + i0) * 4u, po2 = (unsigned)(grp * 16 + i0) * 2u;
        unsigned idw[8]; f32x2 g[8]; float sx[8];
#pragma unroll
        for (int q = 0; q < 8; ++q) { const int t = tokf(q < ntok ? q : 0); idw[q] = *(const LAS unsigned*)(wl + P3W_ID + (q < ntok ? q : 0) * 256 + po2); g[q] = ldg<f32x2>(p.gate + (size_t)t * (HK * 4), po); sx[q] = ((const float*)p.sx)[t]; }
        float su0[8], su1[8], sv0[8], sv1[8];
#pragma unroll
        for (int q = 0; q < 8; ++q) { const int a = (int)(idw[q] & 0xffffu), c = (int)(idw[q] >> 16); su0[q] = ((const float*)p.su)[a]; su1[q] = ((const float*)p.su)[c]; sv0[q] = ((const float*)p.sv)[a]; sv1[q] = ((const float*)p.sv)[c]; }
#pragma unroll
        for (int q = 0; q < 8; ++q) if (q < ntok) {
            const int z0 = zl[q * 128 + 2 * lane], z1 = zl[q * 128 + 2 * lane + 1];
            const float c0 = g[q][0] * gelu_exact((float)z0 * (sx[q] * su0[q])) * sv0[q];
            const float c1 = g[q][1] * gelu_exact((float)z1 * (sx[q] * su1[q])) * sv1[q];
            float am = fmaxf(fabsf(c0), fabsf(c1));
#pragma unroll
            for (int o = 32; o > 0; o >>= 1) am = fmaxf(am, __shfl_xor(am, o));
            const float inv = am > 0.f ? 127.0f / am : 0.f;
            const unsigned q0 = (unsigned)(int)rintf(c0 * inv) & 255u, q1 = (unsigned)(int)rintf(c1 * inv) & 255u;
            *(LAS unsigned short*)(wl + P3W_CQ + q * 128 + 16 * grp + i0) = (unsigned short)(q0 | (q1 << 8));
            int cs = (int)rintf(c0 * inv) + (int)rintf(c1 * inv);
#pragma unroll
            for (int o = 32; o > 0; o >>= 1) cs += __shfl_xor(cs, o);
            if (lane == 0) { scl[q] = am * (1.0f / 127.0f); ssl[q] = 0.f; ((LAS int*)(wl + P3W_CS))[q] = cs; }
        }
    }
    wave_sync();
    {
        const int nvs = 4 << lt;
        auto meta = [&](int n, GMeta& m, float& sc, u32x2& hv) {
            const int nn = n < nvs ? n : nvs - 1, q = nn & (ntok - 1), j = (pos + (nn >> lt)) & 3, t = tokf(q);
            ids_lds(q, m);
            m.x = *(const LAS u32x4*)(wl + P3W_CQ + q * 128 + 16 * grp);
            sc = scl[q];
            hv = ldg<u32x2>(p.hb + (size_t)t * D * 2, (unsigned)(256 * j + 32 * ch + 4 * grp) * 2u);
        };
        auto rows = [&](int n, const GMeta& m, GRows& r) { const int nn = n < nvs ? n : nvs - 1; g_rows(p.evt + (size_t)((pos + (nn >> lt)) & 3) * (16384 * 128), m, lane, r); };
        auto finish = [&](int n, const GMeta& m, const GRows& r, float sc, u32x2 hv) {
            const int q = n & (ntok - 1), j = (pos + (n >> lt)) & 3, t = tokf(q);
            int acc[32];
#pragma unroll
            for (int e = 0; e < 32; ++e) acc[e] = 0;
#pragma unroll
            for (int g = 0; g < 4; ++g)
#pragma unroll
                for (int e = 0; e < 4; ++e) {
                    const int cq = (int)m.x[g];
#pragma unroll
                    for (int nb2 = 0; nb2 < 2; ++nb2) {
                        const unsigned A = (r.v[4 * g][e] >> (4 * nb2)) & 0x0f0f0f0fu, B = (r.v[4 * g + 1][e] >> (4 * nb2)) & 0x0f0f0f0fu, C = (r.v[4 * g + 2][e] >> (4 * nb2)) & 0x0f0f0f0fu, Dd = (r.v[4 * g + 3][e] >> (4 * nb2)) & 0x0f0f0f0fu;
                        const unsigned t0 = __builtin_amdgcn_perm(B, A, 0x05010400u), t1 = __builtin_amdgcn_perm(B, A, 0x07030602u);
                        const unsigned t2 = __builtin_amdgcn_perm(Dd, C, 0x05010400u), t3 = __builtin_amdgcn_perm(Dd, C, 0x07030602u);
                        const unsigned r0 = __builtin_amdgcn_perm(t2, t0, 0x05040100u), r1 = __builtin_amdgcn_perm(t2, t0, 0x07060302u);
                        const unsigned r2 = __builtin_amdgcn_perm(t3, t1, 0x05040100u), r3 = __builtin_amdgcn_perm(t3, t1, 0x07060302u);
                        int* a4 = acc + 16 * nb2 + 4 * e;
                        a4[0] = __builtin_amdgcn_sdot4((int)r0, cq, a4[0], false); a4[1] = __builtin_amdgcn_sdot4((int)r1, cq, a4[1], false);
                        a4[2] = __builtin_amdgcn_sdot4((int)r2, cq, a4[2], false); a4[3] = __builtin_amdgcn_sdot4((int)r3, cq, a4[3], false);
                    }
                }
#pragma unroll
            for (int lv = 2; lv >= 0; --lv) {
                const int n2 = 4 << lv, off = 8 << lv;
                const bool up = (lane & off) != 0;
#pragma unroll
                for (int i = 0; i < n2; ++i) { const int a = acc[i], c = acc[i + n2]; const int send = up ? a : c, keep = up ? c : a; acc[i] = keep + __shfl_xor(send, off); }
            }
            const int c8 = 8 * ((const LAS int*)(wl + P3W_CS))[q];
            f32x4 o; o[0] = (float)(acc[0] - c8) * sc + bf_lo(hv.x); o[1] = (float)(acc[1] - c8) * sc + bf_hi(hv.x); o[2] = (float)(acc[2] - c8) * sc + bf_lo(hv.y); o[3] = (float)(acc[3] - c8) * sc + bf_hi(hv.y);
            const float ss = wave_sum(o[0] * o[0] + o[1] * o[1] + o[2] * o[2] + o[3] * o[3]);
            stg<f32x4>(p.out + (size_t)t * D, (unsigned)(256 * j + 32 * ch + 4 * grp) * 4u, o);
            if (lane == 0) ssl[q] += ss;
        };
        GMeta ma, mb; GRows ra, rb; float sa, sb; u32x2 ha, hb;
        meta(0, ma, sa, ha); meta(1, mb, sb, hb); rows(0, ma, ra);
#pragma unroll 1
        for (int n = 0; n < nvs; n += 2) {
            GMeta mc; float scc; u32x2 hc;
            meta(n + 2, mc, scc, hc); rows(n + 1, mb, rb);
            __builtin_amdgcn_sched_barrier(0);
            finish(n, ma, ra, sa, ha);
            __builtin_amdgcn_sched_barrier(0);
            meta(n + 3, ma, sa, ha); rows(n + 2, mc, ra);
            __builtin_amdgcn_sched_barrier(0);
            finish(n + 1, mb, rb, sb, hb);
            __builtin_amdgcn_sched_barrier(0);
            mb = ma; sb = sa; hb = ha; ma = mc; sa = scc; ha = hc;
        }
    }
    asm volatile("s_waitcnt vmcnt(0)" ::: "memory");
    __builtin_amdgcn_fence(__ATOMIC_ACQUIRE, "agent");
    {
        f32x4 gg[4];
#pragma unroll
        for (int i = 0; i < 4; ++i) gg[i] = ldg<f32x4>(p.g_fin, (unsigned)(i * 256 + 4 * lane) * 4u);
#pragma unroll 1
        for (int qb = 0; qb < ntok; qb += 4) {
            f32x4 a[4][4];
#pragma unroll
            for (int b = 0; b < 4; ++b)
#pragma unroll
                for (int i = 0; i < 4; ++i) a[b][i] = ldg<f32x4>(p.out + (size_t)tokf(qb + b) * D, (unsigned)(i * 256 + 4 * lane) * 4u);
#pragma unroll
            for (int b = 0; b < 4; ++b) {
                const float rv = rsqrtf(ssl[qb + b] * (1.0f / D) + EPS);
#pragma unroll
                for (int i = 0; i < 4; ++i) { f32x4 ov;
#pragma unroll
                    for (int e = 0; e < 4; ++e) ov[e] = a[b][i][e] * rv * gg[i][e];
                    stg<f32x4>(p.out + (size_t)tokf(qb + b) * D, (unsigned)(i * 256 + 4 * lane) * 4u, ov); }
            }
        }
    }
}

#define XB_TMO      128
#define XB_XCNT(j)  (256  + 64 * (j))
#define XB_XSUB(j)  (1280 + 64 * (j))
#define XB_XGEN(j)  (2304 + 64 * (j))
#define XB_TOP      3328
#define XB_TOPGEN   3392
#define XCD_BAR_WORDS 3456
#define XB_SPIN_CAP (1u << 18)

__device__ __forceinline__ unsigned xb_ld(unsigned* p)              { return __hip_atomic_load(p, __ATOMIC_RELAXED, __HIP_MEMORY_SCOPE_AGENT); }
__device__ __forceinline__ unsigned xb_add(unsigned* p, unsigned v) { return __hip_atomic_fetch_add(p, v, __ATOMIC_RELAXED, __HIP_MEMORY_SCOPE_AGENT); }
__device__ __forceinline__ unsigned xb_xcc_id() { return (unsigned)__builtin_amdgcn_s_getreg((3 << 11) | 20) & 0xFu; }
#define XB_SPIN(cond, bar) do { unsigned _sp = 0; while (cond) { __builtin_amdgcn_s_sleep(1); \
    if ((++_sp & 255u) == 0u) { if (xb_ld(&(bar)[XB_TMO])) break; if (_sp > XB_SPIN_CAP) { atomicAdd(&(bar)[XB_TMO], 1u); break; } } } } while (0)

struct XcdBarrier {
    unsigned* bar; unsigned x;
    volatile LAS unsigned* st;
};

__device__ __forceinline__ XcdBarrier xcd_barrier_post(unsigned* bar, volatile LAS unsigned* st) {
    XcdBarrier b; b.bar = bar; b.x = xb_xcc_id(); b.st = st;
    if (threadIdx.x == 0) (void)xb_add(&bar[XB_XCNT(b.x)], 1u);
    return b;
}
__device__ __forceinline__ void xcd_barrier_complete(unsigned* bar, unsigned x, unsigned& nloc, unsigned& nx) {
    const unsigned G = gridDim.x * gridDim.y * gridDim.z;
    unsigned sum, cnt, mine, sp = 0u;
    for (;;) {
        sum = 0u; cnt = 0u; mine = 0u;
#pragma unroll
        for (unsigned j = 0; j < 16; ++j) { const unsigned c = xb_ld(&bar[XB_XCNT(j)]); sum += c; cnt += (c > 0u) ? 1u : 0u; mine = (j == x) ? c : mine; }
        if (sum == G) break;
        __builtin_amdgcn_s_sleep(1);
        if ((++sp & 255u) == 0u) { if (xb_ld(&bar[XB_TMO])) break; if (sp > XB_SPIN_CAP) { atomicAdd(&bar[XB_TMO], 1u); break; } }
    }
    nloc = mine > 0u ? mine : 1u; nx = cnt > 0u ? cnt : 1u;
}

__device__ __forceinline__ void xcd_barrier(const XcdBarrier& b) {
    asm volatile("s_waitcnt vmcnt(0)" ::: "memory");
    __syncthreads();
    if (threadIdx.x == 0) {
        unsigned* bar = b.bar;
        __builtin_amdgcn_s_waitcnt(0);
        unsigned nloc = b.st[0], nx = b.st[1];
        if (nloc == 0u) { xcd_barrier_complete(bar, b.x, nloc, nx); b.st[0] = nloc; b.st[1] = nx; }
        const unsigned old = xb_add(&bar[XB_XSUB(b.x)], 1u);
        const unsigned gen = old / nloc;
        if (old + 1u == (gen + 1u) * nloc) {
            __builtin_amdgcn_fence(__ATOMIC_RELEASE, "agent");
            asm volatile("s_waitcnt vmcnt(0)" ::: "memory");
            const unsigned og = xb_add(&bar[XB_TOP], 1u);
            const unsigned tg = og / nx;
            if (og + 1u == (tg + 1u) * nx) xb_add(&bar[XB_TOPGEN], 1u);
            else XB_SPIN(xb_ld(&bar[XB_TOPGEN]) == tg, bar);
            __builtin_amdgcn_fence(__ATOMIC_ACQUIRE, "agent");
            xb_add(&bar[XB_XGEN(b.x)], 1u);
            asm volatile("s_waitcnt vmcnt(0)" ::: "memory");
        } else {
            XB_SPIN(xb_ld(&bar[XB_XGEN(b.x)]) == gen, bar);
            __builtin_amdgcn_fence(__ATOMIC_ACQUIRE, "agent");
            asm volatile("s_waitcnt vmcnt(0)" ::: "memory");
        }
    }
    __syncthreads();
}


__global__ void __launch_bounds__(512) k_fwd(Params p) {
    __shared__ __attribute__((aligned(16))) unsigned char lds_raw[LDS_BYTES + 16];
    LAS unsigned char* lds = (LAS unsigned char*)lds_raw;
    const int tid = threadIdx.x, vb = blockIdx.x, nb = gridDim.x;
    volatile LAS unsigned* xbw = (volatile LAS unsigned*)(lds + LDS_BYTES);
    if (tid < 4) xbw[tid] = 0u;
    __syncthreads();
    XcdBarrier gb = xcd_barrier_post((unsigned*)p.bar, xbw);
    if (tid == 0) xbw[2] = xb_add(&((unsigned*)p.bar)[XCD_BAR_WORDS + 64 * gb.x], 1u);
    p0_prep(p, vb, nb, tid, lds);
    const bool early = vb >= 129 && vb < NTILES;
    if (early) p1_stage(p, vb, tid, lds);
    xcd_barrier(gb);
    for (int tile = vb; tile < NTILES; tile += nb) { if (!(early && tile == vb)) p1_stage(p, tile, tid, lds); p1_inproj(p, tile, tid, lds, vb, nb, tile == vb); __syncthreads(); }
    if ((tid >> 6) == 0) for (int mp = vb; mp < 32; mp += nb) p1_meta(p, mp, launder(tid) & 63);
    xcd_barrier(gb);
    for (int tile = vb; tile < NTILES; tile += nb) { p2_mix(p, tile, tid, lds); __syncthreads(); }
    xcd_barrier(gb);
    const int lane = launder(tid) & 63, wv = __builtin_amdgcn_readfirstlane(tid >> 6);
    int np = 0, mypos = 0, nloc = 1;
    {
        unsigned* bar = (unsigned*)p.bar;
        const int myx = (int)gb.x;
#pragma unroll
        for (int q = 0; q < 16; ++q) { const int c = (int)xb_ld(&bar[XB_XCNT(q)]); if (q == myx) { mypos = np; nloc = c > 0 ? c : 1; } np += (c > 0) ? 1 : 0; }
        if (np < 1) np = 1;
    }
    {
        const int rank = (int)xbw[2];
        LAS unsigned char* wl = lds + wv * P3W_BYTES;
#pragma unroll 1
        for (int k = rank; mypos + np * k < T / 32; k += 2 * nloc) {
            const int c0 = mypos + np * k, c1 = mypos + np * (k + nloc);
            p3_wave(p, 32 * c0 + 4 * wv, 32 * c1 + 4 * wv, c1 < T / 32 ? 3 : 2, mypos, lane, wl);
        }
    }
}
}

extern "C" void kernel_launch(void* const* d_in, const int* in_sizes, int n_in, void* d_out, int out_size, void* d_ws, size_t ws_size, hipStream_t stream) {
    static int grid_blocks = 0;
    if (n_in != 16 || out_size != T * D) { fprintf(stderr, "kernel_launch: unexpected sizes n_in %d out %d\n", n_in, out_size); return; }
    if (!grid_blocks) {
        int dev = 0, cus = 0, per_cu = 0;
        (void)hipGetDevice(&dev);
        (void)hipDeviceGetAttribute(&cus, hipDeviceAttributeMultiprocessorCount, dev);
        (void)hipOccupancyMaxActiveBlocksPerMultiprocessor(&per_cu, (const void*)k_fwd, 512, 0);
        if (per_cu < 1) { fprintf(stderr, "kernel_launch: occupancy query returned %d\n", per_cu); per_cu = 1; }
        grid_blocks = cus * 1;
    }
    Params p{};
    p.x = (const float*)d_in[0]; p.meta = (const float*)d_in[1]; p.g_mix = (const float*)d_in[2]; p.w_in = (const float*)d_in[3]; p.pool_w = (const float*)d_in[4];
    p.pool_scale = (const float*)d_in[5]; p.conv_w = (const float*)d_in[6]; p.g_a = (const float*)d_in[7]; p.g_b = (const float*)d_in[8]; p.w_out = (const float*)d_in[9];
    p.g_ffn = (const float*)d_in[10]; p.w_query = (const float*)d_in[11]; p.sub_keys = (const float*)d_in[12]; p.eu = (const float*)d_in[13]; p.ev = (const float*)d_in[14]; p.g_fin = (const float*)d_in[15];
    p.out = (float*)d_out;
    unsigned char* ws = (unsigned char*)d_ws;
    p.winf = ws; p.woutf = ws + (4u << 20); p.wqf = ws + (6u << 20); p.kf = ws + (10u << 20); p.pwf = p.kf + (512u << 10); p.metaf = p.pwf + (128u << 10); p.rsm = p.metaf + (64u << 10); p.bar = p.rsm + 256;
    p.eut = ws + (12u << 20); p.evt = p.eut + (32u << 20); p.proj = p.evt + (32u << 20); p.idx = p.proj + (size_t)TL * MIXIN * 2; p.gate = p.idx + (size_t)T * HK * 4; p.lst = p.gate + (size_t)T * HK * 4;
    p.su = p.lst + (size_t)T * NH * 32 * 4; p.sv = p.su + 65536; p.sx = p.sv + 65536; p.xq = p.sx + 65536; p.wsci = p.xq + (size_t)T * D; p.wscq = p.wsci + 8192; p.hb = p.wscq + 8192;
    if ((size_t)(p.hb - ws) + (size_t)T * D * 2 > ws_size) { fprintf(stderr, "kernel_launch: workspace too small\n"); return; }
    if (hipMemsetAsync(p.bar, 0, (XCD_BAR_WORDS + 64 * 16) * 4, stream) != hipSuccess) { fprintf(stderr, "kernel_launch: memset of the barrier words failed\n"); return; }
    hipLaunchKernelGGL(k_fwd, dim3(grid_blocks), dim3(512), 0, stream, p);
}
```

```cpp
#include <hip/hip_runtime.h>
#include <cstdio>
#include <cstdint>
#include <math.h>

namespace {
constexpr int D = 1024, BATCH = 4, SEQ = 4096, NMETA = 16, L = SEQ + NMETA;
constexpr int MIXA = 512, MIXB = 512, MIXIN = 2048;
constexpr int NH = 8, NKEYS = 128, DQH = 128, TOPK = 16, HK = 128;
constexpr int T = BATCH * SEQ;
constexpr int TL = BATCH * L;
constexpr float EPS = 1e-6f;

__device__ __forceinline__ float wave_sum(float v) {
#pragma unroll
    for (int o = 32; o > 0; o >>= 1) v += __shfl_xor(v, o);
    return v;
}
#define LAS __attribute__((address_space(3)))
typedef short bf16x8 __attribute__((ext_vector_type(8)));
typedef float f32x16 __attribute__((ext_vector_type(16)));
typedef float f32x4 __attribute__((ext_vector_type(4)));
typedef float f32x2 __attribute__((ext_vector_type(2)));
typedef __bf16 bf2_t __attribute__((ext_vector_type(2)));
typedef unsigned u32x4 __attribute__((ext_vector_type(4)));
typedef unsigned u32x2 __attribute__((ext_vector_type(2)));
typedef int i32x4 __attribute__((ext_vector_type(4)));
typedef int i32x16 __attribute__((ext_vector_type(16)));

constexpr int QCH = 2;
constexpr int NTILES = T / 64;
constexpr int TROW = 2064;
constexpr int TROWB = 1040;
constexpr int LDS_TILE = 64 * TROW;
constexpr int LDS_RS = LDS_TILE;
constexpr int LDS_SSA = LDS_RS + 256;
constexpr int LDS_LUT = LDS_SSA + 256;
constexpr int LDS_BYTES = LDS_LUT + 16384;

struct Params {
    const float* x; const float* meta; const float* g_mix; const float* w_in; const float* pool_w; const float* pool_scale; const float* conv_w;
    const float* g_a; const float* g_b; const float* w_out; const float* g_ffn; const float* w_query; const float* sub_keys; const float* eu; const float* ev; const float* g_fin;
    float* out;
    unsigned char *winf, *woutf, *wqf, *kf, *pwf, *metaf, *rsm, *eut, *evt, *proj, *idx, *gate, *bar, *lst, *su, *sv, *xq, *sx, *wsci, *wscq, *hb;
};

__device__ __forceinline__ unsigned pk_bf16(float lo, float hi) { f32x2 f = {lo, hi}; return __builtin_bit_cast(unsigned, __builtin_convertvector(f, bf2_t)); }
__device__ __forceinline__ float bf_lo(unsigned u) { return __builtin_bit_cast(float, u << 16); }
__device__ __forceinline__ float bf_hi(unsigned u) { return __builtin_bit_cast(float, u & 0xffff0000u); }
__device__ __forceinline__ f32x16 mfma32(u32x4 a, u32x4 b, f32x16 c) { return __builtin_amdgcn_mfma_f32_32x32x16_bf16(__builtin_bit_cast(bf16x8, a), __builtin_bit_cast(bf16x8, b), c, 0, 0, 0); }
__device__ __forceinline__ i32x16 mfma_i8(u32x4 a, u32x4 b, i32x16 c) { return __builtin_amdgcn_mfma_i32_32x32x32_i8(__builtin_bit_cast(i32x4, a), __builtin_bit_cast(i32x4, b), c, 0, 0, 0); }
__device__ __forceinline__ i32x16 izero16() { i32x16 z; for (int i = 0; i < 16; ++i) z[i] = 0; return z; }
__device__ __forceinline__ f32x16 zero16() { f32x16 z; for (int i = 0; i < 16; ++i) z[i] = 0.f; return z; }

__device__ __forceinline__ void wave_sync() { __builtin_amdgcn_fence(__ATOMIC_RELEASE, "wavefront"); __builtin_amdgcn_wave_barrier(); __builtin_amdgcn_fence(__ATOMIC_ACQUIRE, "wavefront"); }
__device__ __forceinline__ int launder(int x) { asm volatile("" : "+v"(x)); return x; }
template <class V> __device__ __forceinline__ V ldg(const void* base, unsigned off) { return *(const V*)((const unsigned char*)base + off); }
template <class V> __device__ __forceinline__ void stg(void* base, unsigned off, V v) { *(V*)((unsigned char*)base + off) = v; }

__device__ __forceinline__ void frag_from_kn(const float* __restrict__ W, int N, const float* __restrict__ g, int i, int s, int lane, u32x4* __restrict__ dst, int I8K = 0) {
    const int r = lane & 31, h = lane >> 5, k0 = 16 * s + 8 * h;
    const float* src = W + (size_t)k0 * N + 32 * i + r;
    float v[8];
#pragma unroll
    for (int j = 0; j < 8; ++j) v[j] = src[(size_t)j * N] * (g ? g[k0 + j] : 1.0f);
    u32x4 o; o.x = pk_bf16(v[0], v[1]); o.y = pk_bf16(v[2], v[3]); o.z = pk_bf16(v[4], v[5]); o.w = pk_bf16(v[6], v[7]);
    *dst = o;
}
__device__ __forceinline__ void frag2_from_kn(const float* __restrict__ W, int N, int i, int s, int lane, u32x4* __restrict__ dst) {
    const int r = lane & 31, h = lane >> 5, k0 = 16 * s + 8 * h;
    const float* src = W + (size_t)k0 * N + 32 * i + r;
    float v[16];
#pragma unroll
    for (int j = 0; j < 8; ++j) { v[j] = src[(size_t)j * N]; v[8 + j] = src[(size_t)(16 + j) * N]; }
    u32x4 o; o.x = pk_bf16(v[0], v[1]); o.y = pk_bf16(v[2], v[3]); o.z = pk_bf16(v[4], v[5]); o.w = pk_bf16(v[6], v[7]);
    u32x4 o2; o2.x = pk_bf16(v[8], v[9]); o2.y = pk_bf16(v[10], v[11]); o2.z = pk_bf16(v[12], v[13]); o2.w = pk_bf16(v[14], v[15]);
    dst[0] = o; dst[64] = o2;
}
constexpr int J_WOUT = 0, J_WQ = J_WOUT + 32 * 64, J_PW = J_WQ, J_KEY = J_PW + 128, J_END = J_KEY + 512;
__device__ __forceinline__ void mtile_i8_block(const float* __restrict__ W, const float* __restrict__ g, int i, int tid, LAS unsigned* lds_u, u32x4* __restrict__ dst, float* __restrict__ wsc) {
    const int lane = tid & 63, wv = tid >> 6, r = lane & 31, h = lane >> 5, col = 32 * i + r;
    if (tid < 32) lds_u[tid] = 0u;
    __syncthreads();
    {
        const int cg = lane & 7, ro = lane >> 3;
        f32x4 f[16];
#pragma unroll
        for (int q = 0; q < 16; ++q) f[q] = ldg<f32x4>(W, (unsigned)((128 * wv + 8 * q + ro) * 2048 + 32 * i + 4 * cg) * 4u);
        float m0 = 0.f, m1 = 0.f, m2 = 0.f, m3 = 0.f;
#pragma unroll
        for (int q = 0; q < 16; ++q) { const float gk = g ? g[128 * wv + 8 * q + ro] : 1.0f; m0 = fmaxf(m0, fabsf(f[q][0] * gk)); m1 = fmaxf(m1, fabsf(f[q][1] * gk)); m2 = fmaxf(m2, fabsf(f[q][2] * gk)); m3 = fmaxf(m3, fabsf(f[q][3] * gk)); }
#pragma unroll
        for (int o = 8; o < 64; o <<= 1) { m0 = fmaxf(m0, __shfl_xor(m0, o)); m1 = fmaxf(m1, __shfl_xor(m1, o)); m2 = fmaxf(m2, __shfl_xor(m2, o)); m3 = fmaxf(m3, __shfl_xor(m3, o)); }
        if (lane < 8) { atomicMax((unsigned*)(lds_u + 4 * cg), __builtin_bit_cast(unsigned, m0)); atomicMax((unsigned*)(lds_u + 4 * cg + 1), __builtin_bit_cast(unsigned, m1));
            atomicMax((unsigned*)(lds_u + 4 * cg + 2), __builtin_bit_cast(unsigned, m2)); atomicMax((unsigned*)(lds_u + 4 * cg + 3), __builtin_bit_cast(unsigned, m3)); }
    }
    __syncthreads();
    const float cm = __builtin_bit_cast(float, lds_u[r]);
    const float inv = cm > 0.f ? 127.0f / cm : 0.f;
    if (wv == 0 && h == 0) wsc[col] = cm * (1.0f / 127.0f);
#pragma unroll
    for (int sl = 0; sl < 4; ++sl) {
        const int s = 4 * wv + sl, k0 = 32 * s + 16 * h;
        u32x4 o;
#pragma unroll
        for (int q = 0; q < 4; ++q) {
            unsigned w = 0u;
#pragma unroll
            for (int e = 0; e < 4; ++e) { const int k = k0 + 4 * q + e; w |= ((unsigned)(int)rintf(ldg<float>(W, (unsigned)(k * 2048 + col) * 4u) * (g ? g[k] : 1.0f) * inv) & 255u) << (8 * e); }
            o[q] = w;
        }
        dst[(size_t)s * 64 + lane] = o;
    }
    __syncthreads();
}
__device__ __forceinline__ void meta_block(const Params& p, int tid, LAS float* lds_f) {
    const int lane = tid & 63, wv = tid >> 6;
#pragma unroll
    for (int q = 0; q < 2; ++q) {
        const int row = 2 * wv + q;
        float ss = 0.f, am = 0.f;
#pragma unroll
        for (int i = 0; i < 4; ++i) { const f32x4 f = *(const f32x4*)(p.meta + (size_t)row * D + i * 256 + 4 * lane); ss += f[0] * f[0] + f[1] * f[1] + f[2] * f[2] + f[3] * f[3];
            am = fmaxf(am, fmaxf(fmaxf(fabsf(f[0]), fabsf(f[1])), fmaxf(fabsf(f[2]), fabsf(f[3])))); }
        ss = wave_sum(ss);
#pragma unroll
        for (int o = 32; o > 0; o >>= 1) am = fmaxf(am, __shfl_xor(am, o));
        if (lane == 0) { ((float*)(p.rsm))[row] = rsqrtf(ss * (1.0f / D) + EPS) * am * (1.0f / 127.0f); lds_f[row] = am; }
    }
    __syncthreads();
    const int n = lane & 31, h = lane >> 5;
    const float am = n < NMETA ? lds_f[n] : 0.f;
    const float inv = am > 0.f ? 127.0f / am : 0.f;
#pragma unroll
    for (int sl = 0; sl < 4; ++sl) {
        const int s = 4 * wv + sl;
        u32x4 o = {0u, 0u, 0u, 0u};
        if (n < NMETA) {
            const float* row = p.meta + (size_t)n * D;
#pragma unroll
            for (int q = 0; q < 4; ++q) { const f32x4 f = *(const f32x4*)(row + 32 * s + 16 * h + 4 * q);
                o[q] = ((unsigned)(int)rintf(f[0] * inv) & 255u) | (((unsigned)(int)rintf(f[1] * inv) & 255u) << 8) | (((unsigned)(int)rintf(f[2] * inv) & 255u) << 16) | (((unsigned)(int)rintf(f[3] * inv) & 255u) << 24); }
        }
        ((u32x4*)(p.metaf))[(size_t)s * 64 + lane] = o;
    }
    __syncthreads();
}

__device__ __forceinline__ void p0_prep(const Params& p, int vb, int nb, int tid, LAS unsigned char* lds) {
    const int lane = tid & 63, wv = tid >> 6, gw = vb * 8 + wv, nw = nb * 8;
    for (int job = vb; job < 129; job += nb) {
        if (job < 64) mtile_i8_block(p.w_in, p.g_mix, job, tid, (LAS unsigned*)lds, (u32x4*)(p.winf) + (size_t)job * 32 * 64, (float*)p.wsci);
        else if (job < 128) mtile_i8_block(p.w_query, nullptr, job - 64, tid, (LAS unsigned*)lds, (u32x4*)(p.wqf) + (size_t)(job - 64) * 32 * 64, (float*)p.wscq);
        else meta_block(p, tid, (LAS float*)lds);
    }
    int jw = gw, jn = nw;
    if (nb >= 129 + 64) { jw = vb >= 129 ? (vb - 129) * 8 + wv : J_END; jn = (nb - 129) * 8; }
    for (int job = jw; job < J_END / 2; job += jn) {
        if (job < J_WQ / 2) { const int q = 2 * job, i = q >> 6, sA = q & 63; frag2_from_kn(p.w_out, 1024, i, sA, lane, (u32x4*)(p.woutf) + (size_t)q * 64 + lane); }
        else if (job < J_KEY / 2) { const int q = 2 * job - J_PW, g = q >> 5, mt = (q >> 3) & 3, sA = q & 7; frag2_from_kn(p.pool_w + (size_t)g * 128 * 128, 128, mt, sA, lane, (u32x4*)(p.pwf) + (size_t)q * 64 + lane); }
        else {
            const int q = 2 * job - J_KEY, hp = q >> 5, kt = (q >> 3) & 3, sA = q & 7, r = lane & 31, h = lane >> 5;
            const float* src = p.sub_keys + ((size_t)hp * 128 + 32 * kt + r) * 128 + 16 * sA + 4 * h;
            const f32x4 f0 = *(const f32x4*)src, f1 = *(const f32x4*)(src + 8), f2 = *(const f32x4*)(src + 16), f3 = *(const f32x4*)(src + 24);
            u32x4 o; o.x = pk_bf16(f0[0], f0[1]); o.y = pk_bf16(f0[2], f0[3]); o.z = pk_bf16(f1[0], f1[1]); o.w = pk_bf16(f1[2], f1[3]);
            u32x4 o2; o2.x = pk_bf16(f2[0], f2[1]); o2.y = pk_bf16(f2[2], f2[3]); o2.z = pk_bf16(f3[0], f3[1]); o2.w = pk_bf16(f3[2], f3[3]);
            ((u32x4*)(p.kf))[(size_t)q * 64 + lane] = o; ((u32x4*)(p.kf))[(size_t)(q + 1) * 64 + lane] = o2;
        }
    }
}

struct TabBatch { f32x4 f[4][4]; };
__device__ __forceinline__ int tab_rpb(int nb) { return ((2 * 16384 + nb - 1) / nb + 31) & ~31; }
__device__ __forceinline__ int tab_row(int vb, int nb, int wv, int i) { const int rpb = tab_rpb(nb), row = vb * rpb + 8 * i + wv; return (8 * i + wv < rpb && row < 2 * 16384) ? row : -1; }
__device__ __forceinline__ void tab_issue(const Params& p, int vb, int nb, int wv, int i0, int lane, TabBatch& t) {
#pragma unroll
    for (int q = 0; q < 4; ++q) {
        const int row = tab_row(vb, nb, wv, i0 + q);
        if (row >= 0) { const float* src = (row < 16384 ? p.eu : p.ev) + (size_t)(row & 16383) * D;
#pragma unroll
            for (int i = 0; i < 4; ++i) t.f[q][i] = ldg<f32x4>(src, (unsigned)(i * 256 + 4 * lane) * 4u); }
    }
}
__device__ __forceinline__ void tab_finish(const Params& p, int vb, int nb, int wv, int i0, int lane, const TabBatch& t) {
#pragma unroll
    for (int q = 0; q < 4; ++q) {
        const int row = tab_row(vb, nb, wv, i0 + q);
        if (row >= 0) {
            const bool isu = row < 16384; const int rr = row & 16383;
            float am = 0.f;
#pragma unroll
            for (int i = 0; i < 4; ++i) am = fmaxf(am, fmaxf(fmaxf(fabsf(t.f[q][i][0]), fabsf(t.f[q][i][1])), fmaxf(fabsf(t.f[q][i][2]), fabsf(t.f[q][i][3]))));
#pragma unroll
            for (int o = 32; o > 0; o >>= 1) am = fmaxf(am, __shfl_xor(am, o));
            if (isu) {
                const float inv = am > 0.f ? 127.0f / am : 0.f;
#pragma unroll
                for (int i = 0; i < 4; ++i) {
                    unsigned w = 0u;
#pragma unroll
                    for (int e = 0; e < 4; ++e) { const int qv = (int)rintf(t.f[q][i][e] * inv); w |= ((unsigned)qv & 255u) << (8 * e); }
                    const unsigned c = (unsigned)(i * 256 + 4 * lane);
                    stg<unsigned>(p.eut, (((c >> 7) * 16384u + (unsigned)rr) << 7) + (c & 127u), w);
                }
                if (lane == 0) ((float*)p.su)[rr] = am * (1.0f / 127.0f);
            } else {
                const float inv = am > 0.f ? 7.0f / am : 0.f;
#pragma unroll
                for (int i = 0; i < 4; ++i) {
                    unsigned w = 0u;
#pragma unroll
                    for (int e = 0; e < 4; ++e) { const int qv = (int)rintf(t.f[q][i][e] * inv) + ((lane & 4) ? 0 : 8); w |= ((unsigned)qv & 15u) << (8 * e); }
                    const unsigned o = (unsigned)__shfl_xor((int)w, 4);
                    if ((lane & 4) == 0) stg<unsigned>(p.evt, (((unsigned)i * 16384u + (unsigned)rr) << 7) + (unsigned)(lane >> 3) * 16u + (unsigned)(lane & 3) * 4u, w | (o << 4));
                }
                if (lane == 0) ((float*)p.sv)[rr] = am * (1.0f / 7.0f);
            }
        }
    }
}


template <int CH>
__device__ __forceinline__ void gemm22_chunk(const u32x4 (&a)[2][CH], const LAS unsigned char* b, int s0, f32x16 (&acc)[2][2]) {
#pragma unroll
    for (int u = 0; u < CH; ++u) {
        const u32x4 b0 = *(const LAS u32x4*)(b + (s0 + u) * 32), b1 = *(const LAS u32x4*)(b + 32 * TROW + (s0 + u) * 32);
        acc[0][0] = mfma32(a[0][u], b0, acc[0][0]); acc[0][1] = mfma32(a[0][u], b1, acc[0][1]);
        acc[1][0] = mfma32(a[1][u], b0, acc[1][0]); acc[1][1] = mfma32(a[1][u], b1, acc[1][1]);
    }
}
template <int KS, int CH = 4>
__device__ __forceinline__ void gemm22(const u32x4* abase, unsigned lane, const LAS unsigned char* b, f32x16 (&acc)[2][2], int kofs = 0) {
    constexpr int NC = KS / CH;
    static_assert(NC % 2 == 0 && (NC & (NC - 1)) == 0, "chunk count: even power of two");
    u32x4 pa[2][CH], pb[2][CH];
    const unsigned lo = lane * 16u;
    {
        const unsigned o0 = lo + (unsigned)((kofs & (NC - 1)) * CH) * 1024u;
#pragma unroll
        for (int u = 0; u < CH; ++u) { pa[0][u] = ldg<u32x4>(abase, o0 + u * 1024u); pa[1][u] = ldg<u32x4>(abase, o0 + (KS + u) * 1024u); }
    }
#pragma unroll 1
    for (int c = 0; c < NC; c += 2) {
        const int c0 = (c + kofs) & (NC - 1), c1 = (c + 1 + kofs) & (NC - 1), c2 = (c + 2 + kofs) & (NC - 1);
        const unsigned o1 = lo + (unsigned)(c1 * CH) * 1024u, o2 = lo + (unsigned)(c2 * CH) * 1024u;
#pragma unroll
        for (int u = 0; u < CH; ++u) { pb[0][u] = ldg<u32x4>(abase, o1 + u * 1024u); pb[1][u] = ldg<u32x4>(abase, o1 + (KS + u) * 1024u); }
        __builtin_amdgcn_sched_barrier(0);
        gemm22_chunk<CH>(pa, b, c0 * CH, acc);
        __builtin_amdgcn_sched_barrier(0);
#pragma unroll
        for (int u = 0; u < CH; ++u) { pa[0][u] = ldg<u32x4>(abase, o2 + u * 1024u); pa[1][u] = ldg<u32x4>(abase, o2 + (KS + u) * 1024u); }
        __builtin_amdgcn_sched_barrier(0);
        gemm22_chunk<CH>(pb, b, c1 * CH, acc);
        __builtin_amdgcn_sched_barrier(0);
    }
}

template <int CH>
__device__ __forceinline__ void gemm22i_chunk(const u32x4 (&a)[2][CH], const LAS unsigned char* b, int s0, i32x16 (&acc)[2][2]) {
#pragma unroll
    for (int u = 0; u < CH; ++u) {
        const u32x4 b0 = *(const LAS u32x4*)(b + (s0 + u) * 32), b1 = *(const LAS u32x4*)(b + 32 * TROWB + (s0 + u) * 32);
        acc[0][0] = mfma_i8(a[0][u], b0, acc[0][0]); acc[0][1] = mfma_i8(a[0][u], b1, acc[0][1]);
        acc[1][0] = mfma_i8(a[1][u], b0, acc[1][0]); acc[1][1] = mfma_i8(a[1][u], b1, acc[1][1]);
    }
}
template <int KS, int CH = 4>
__device__ __forceinline__ void gemm22i(const u32x4* abase, unsigned lane, const LAS unsigned char* b, i32x16 (&acc)[2][2], int kofs = 0) {
    constexpr int NC = KS / CH;
    static_assert(NC % 2 == 0 && (NC & (NC - 1)) == 0, "chunk count: even power of two");
    u32x4 pa[2][CH], pb[2][CH];
    const unsigned lo = lane * 16u;
    {
        const unsigned o0 = lo + (unsigned)((kofs & (NC - 1)) * CH) * 1024u;
#pragma unroll
        for (int u = 0; u < CH; ++u) { pa[0][u] = ldg<u32x4>(abase, o0 + u * 1024u); pa[1][u] = ldg<u32x4>(abase, o0 + (KS + u) * 1024u); }
    }
#pragma unroll 1
    for (int c = 0; c < NC; c += 2) {
        const int c0 = (c + kofs) & (NC - 1), c1 = (c + 1 + kofs) & (NC - 1), c2 = (c + 2 + kofs) & (NC - 1);
        const unsigned o1 = lo + (unsigned)(c1 * CH) * 1024u, o2 = lo + (unsigned)(c2 * CH) * 1024u;
#pragma unroll
        for (int u = 0; u < CH; ++u) { pb[0][u] = ldg<u32x4>(abase, o1 + u * 1024u); pb[1][u] = ldg<u32x4>(abase, o1 + (KS + u) * 1024u); }
        __builtin_amdgcn_sched_barrier(0);
        gemm22i_chunk<CH>(pa, b, c0 * CH, acc);
        __builtin_amdgcn_sched_barrier(0);
#pragma unroll
        for (int u = 0; u < CH; ++u) { pa[0][u] = ldg<u32x4>(abase, o2 + u * 1024u); pa[1][u] = ldg<u32x4>(abase, o2 + (KS + u) * 1024u); }
        __builtin_amdgcn_sched_barrier(0);
        gemm22i_chunk<CH>(pb, b, c1 * CH, acc);
        __builtin_amdgcn_sched_barrier(0);
    }
}

__device__ __forceinline__ void p1_stage(const Params& p, int tile, int tid, LAS unsigned char* lds) {
    const int lane = tid & 63, wv = __builtin_amdgcn_readfirstlane(tid >> 6);
    LAS float* rs = (LAS float*)(lds + LDS_RS);
    const float* xt = p.x + (size_t)tile * 64 * D;
#pragma unroll 4
    for (int rr = 0; rr < 8; ++rr) {
        const int tk = 8 * wv + rr;
        f32x4 f[4]; float ss = 0.f, am = 0.f;
#pragma unroll
        for (int i = 0; i < 4; ++i) { f[i] = ldg<f32x4>(xt, (unsigned)(tk * D + i * 256 + 4 * lane) * 4u); ss += f[i][0] * f[i][0] + f[i][1] * f[i][1] + f[i][2] * f[i][2] + f[i][3] * f[i][3];
            am = fmaxf(am, fmaxf(fmaxf(fabsf(f[i][0]), fabsf(f[i][1])), fmaxf(fabsf(f[i][2]), fabsf(f[i][3])))); }
        ss = wave_sum(ss);
#pragma unroll
        for (int o = 32; o > 0; o >>= 1) am = fmaxf(am, __shfl_xor(am, o));
        const float inv = am > 0.f ? 127.0f / am : 0.f;
        if (lane == 0) rs[tk] = rsqrtf(ss * (1.0f / D) + EPS) * am * (1.0f / 127.0f);
#pragma unroll
        for (int i = 0; i < 4; ++i) {
            unsigned w = 0u;
#pragma unroll
            for (int e = 0; e < 4; ++e) w |= ((unsigned)(int)rintf(f[i][e] * inv) & 255u) << (8 * e);
            *(LAS unsigned*)(lds + tk * TROWB + i * 256 + 4 * lane) = w;
        }
    }
    __syncthreads();
}
__device__ __forceinline__ void p1_inproj(const Params& p, int tile, int tid, LAS unsigned char* lds, int vb, int nb, bool do_tab) {
    const int lane = launder(tid) & 63, wv = __builtin_amdgcn_readfirstlane(tid >> 6), r = lane & 31, h = lane >> 5;
    const int b = tile >> 6, s0 = (tile & 63) * 64;
    LAS float* rs = (LAS float*)(lds + LDS_RS);
    const u32x4* WF = (const u32x4*)(p.winf);
    unsigned char* prow0 = p.proj + ((size_t)b * L + NMETA + s0) * (MIXIN * 2);
    const LAS unsigned char* bp = lds + r * TROWB + h * 16;
    const float rs0 = rs[r], rs1 = rs[32 + r];
    const int stg_k = (tile >> 3) & 7, stg_r = (tile >> 6) & 3;
#pragma unroll 1
    for (int rdx = 0; rdx < 4; ++rdx) {
        const int rd = (rdx + stg_r) & 3;
        const int i0 = 8 * wv + 2 * rd;
        TabBatch tb;
        if (do_tab) tab_issue(p, vb, nb, wv, 4 * rdx, lane, tb);
        __builtin_amdgcn_sched_barrier(0);
        i32x16 acc[2][2]; acc[0][0] = izero16(); acc[0][1] = izero16(); acc[1][0] = izero16(); acc[1][1] = izero16();
        gemm22i<32, 4>(WF + (size_t)i0 * 32 * 64, lane, bp, acc, stg_k);
        f32x4 wsv[2][4];
#pragma unroll
        for (int mi = 0; mi < 2; ++mi)
#pragma unroll
            for (int q = 0; q < 4; ++q) wsv[mi][q] = ldg<f32x4>(p.wsci, (unsigned)(32 * (i0 + mi) + 8 * q + 4 * h) * 4u);
        LAS unsigned char* eb = lds + 64 * TROWB + wv * 8192;
#pragma unroll
        for (int mi = 0; mi < 2; ++mi)
#pragma unroll
            for (int q = 0; q < 4; ++q) {
                const f32x4 ws = wsv[mi][q];
#pragma unroll
                for (int nt = 0; nt < 2; ++nt) {
                    const float rv = nt ? rs1 : rs0;
                    u32x2 o; o.x = pk_bf16((float)acc[mi][nt][4 * q] * rv * ws[0], (float)acc[mi][nt][4 * q + 1] * rv * ws[1]); o.y = pk_bf16((float)acc[mi][nt][4 * q + 2] * rv * ws[2], (float)acc[mi][nt][4 * q + 3] * rv * ws[3]);
                    *(LAS u32x2*)(eb + (nt * 32 + r) * 128 + (((4 * mi + q) ^ (r & 7)) * 16) + 8 * h) = o;
                }
            }
        wave_sync();
        {
            u32x4 ov[8];
#pragma unroll
            for (int k = 0; k < 8; ++k) { const int row = 8 * k + (lane >> 3); ov[k] = *(const LAS u32x4*)(eb + row * 128 + (((lane & 7) ^ (row & 7)) * 16)); }
            wave_sync();
#pragma unroll
            for (int k = 0; k < 8; ++k) { const int row = 8 * k + (lane >> 3); stg<u32x4>(prow0, (unsigned)(row * MIXIN + 32 * i0) * 2u + (unsigned)(lane & 7) * 16u, ov[k]); }
        }
        if (do_tab) tab_finish(p, vb, nb, wv, 4 * rdx, lane, tb);
    }
    if (do_tab) for (int i0 = 16; 8 * i0 < tab_rpb(nb); i0 += 4) { TabBatch tb; tab_issue(p, vb, nb, wv, i0, lane, tb); tab_finish(p, vb, nb, wv, i0, lane, tb); }
}
__device__ __forceinline__ void p1_meta(const Params& p, int mp, int lane) {
    const int r = lane & 31, h = lane >> 5;
    const u32x4* A = (const u32x4*)(p.winf) + (size_t)(2 * mp) * 32 * 64;
    const u32x4* B = (const u32x4*)(p.metaf);
    i32x16 acc0 = izero16(), acc1 = izero16();
#pragma unroll 4
    for (int s = 0; s < 32; ++s) { const u32x4 bf = ldg<u32x4>(B, (unsigned)(s * 64 + lane) * 16u);
        acc0 = mfma_i8(ldg<u32x4>(A, (unsigned)(s * 64 + lane) * 16u), bf, acc0); acc1 = mfma_i8(ldg<u32x4>(A, (unsigned)((32 + s) * 64 + lane) * 16u), bf, acc1); }
    if (r < NMETA) {
        const float rv = ((const float*)(p.rsm))[r];
#pragma unroll
        for (int q = 0; q < 4; ++q) {
            const f32x4 w0 = ldg<f32x4>(p.wsci, (unsigned)(64 * mp + 8 * q + 4 * h) * 4u), w1 = ldg<f32x4>(p.wsci, (unsigned)(64 * mp + 32 + 8 * q + 4 * h) * 4u);
            u32x2 o0, o1;
            o0.x = pk_bf16((float)acc0[4 * q] * rv * w0[0], (float)acc0[4 * q + 1] * rv * w0[1]); o0.y = pk_bf16((float)acc0[4 * q + 2] * rv * w0[2], (float)acc0[4 * q + 3] * rv * w0[3]);
            o1.x = pk_bf16((float)acc1[4 * q] * rv * w1[0], (float)acc1[4 * q + 1] * rv * w1[1]); o1.y = pk_bf16((float)acc1[4 * q + 2] * rv * w1[2], (float)acc1[4 * q + 3] * rv * w1[3]);
#pragma unroll
            for (int bb = 0; bb < BATCH; ++bb) {
                const unsigned ro = (unsigned)((bb * L + r) * MIXIN + 64 * mp + 4 * h) * 2u;
                stg<u32x2>(p.proj, ro + 16u * q, o0); stg<u32x2>(p.proj, ro + 64u + 16u * q, o1);
            }
        }
    }
}

template <int LOGN> __device__ __forceinline__ void bitonic_sort_desc(float* v) {
    constexpr int N = 1 << LOGN;
#pragma unroll
    for (int lk = 1; lk <= LOGN; ++lk) {
#pragma unroll
        for (int lj = lk - 1; lj >= 0; --lj) {
#pragma unroll
            for (int i = 0; i < N; ++i) {
                const int k = 1 << lk, j = 1 << lj, l = i ^ j;
                if (l > i) { const bool up = ((i & k) == 0); const float a = v[i], c = v[l]; const float hi = fmaxf(a, c), lo = fminf(a, c); v[i] = up ? hi : lo; v[l] = up ? lo : hi; }
            }
        }
    }
}
__device__ __forceinline__ void bitonic_merge16_desc(float* v) {
#pragma unroll
    for (int lj = 3; lj >= 0; --lj) {
#pragma unroll
        for (int i = 0; i < 16; ++i) { const int j = 1 << lj, l = i ^ j; if (l > i) { const float a = v[i], c = v[l]; v[i] = fmaxf(a, c); v[l] = fminf(a, c); } }
    }
}
__device__ __forceinline__ void merge_top16(float* a, const float* c) {
#pragma unroll
    for (int i = 0; i < 16; ++i) a[i] = fmaxf(a[i], c[15 - i]);
    bitonic_merge16_desc(a);
}
__device__ __forceinline__ void top16_of_64(float* v) {
    bitonic_sort_desc<4>(v); bitonic_sort_desc<4>(v + 16); bitonic_sort_desc<4>(v + 32); bitonic_sort_desc<4>(v + 48);
    merge_top16(v, v + 16); merge_top16(v + 32, v + 48); merge_top16(v, v + 32);
}
__device__ __forceinline__ float embed_bits(float x, unsigned mask, unsigned code) { return __builtin_bit_cast(float, (__builtin_bit_cast(unsigned, x) & ~mask) | code); }

template <int W>
__device__ __forceinline__ void pool_window(const unsigned char* pbat, int p0, int cp, LAS unsigned char* dst) {
    unsigned u[31 + W];
#pragma unroll
    for (int i = 0; i < 31 + W; ++i) u[i] = ldg<unsigned>(pbat + (size_t)(p0 - (W - 1) + i) * 4096u, cp * 4u);
    float sx = 0.f, sy = 0.f;
#pragma unroll
    for (int i = 0; i < W - 1; ++i) { sx += bf_lo(u[i]); sy += bf_hi(u[i]); }
    const float invw = 1.0f / (float)W;
#pragma unroll
    for (int tk = 0; tk < 32; ++tk) {
        const float lo = bf_lo(u[W - 1 + tk]), hi = bf_hi(u[W - 1 + tk]);
        sx += lo; sy += hi;
        *(LAS unsigned*)(dst + tk * TROW) = pk_bf16(sx * invw - lo, sy * invw - hi);
        sx -= bf_lo(u[tk]); sy -= bf_hi(u[tk]);
    }
}

template <int RB>
__device__ __forceinline__ void p2_xf_batch(const Params& p, int tile, int wv, int lane, LAS unsigned char* lds, unsigned char* ht, f32x4 (&f)[4][4], const u32x2 (&hq)[8][4], const f32x4 (&gg)[4]) {
    unsigned char* xqt = p.xq + (size_t)tile * 64 * D;
#pragma unroll
    for (int rr = 0; rr < 4; ++rr) {
        const int tk = 8 * wv + RB + rr;
        float ss = 0.f;
#pragma unroll
        for (int i = 0; i < 4; ++i) {
            const u32x2 hw = hq[RB + rr][i];
            f[rr][i][0] += bf_lo(hw.x); f[rr][i][1] += bf_hi(hw.x); f[rr][i][2] += bf_lo(hw.y); f[rr][i][3] += bf_hi(hw.y);
            u32x2 ho; ho.x = pk_bf16(f[rr][i][0], f[rr][i][1]); ho.y = pk_bf16(f[rr][i][2], f[rr][i][3]);
            stg<u32x2>(ht, (unsigned)(tk * D + i * 256 + 4 * lane) * 2u, ho);
            ss += f[rr][i][0] * f[rr][i][0] + f[rr][i][1] * f[rr][i][1] + f[rr][i][2] * f[rr][i][2] + f[rr][i][3] * f[rr][i][3];
        }
        ss = wave_sum(ss);
        const float rv = rsqrtf(ss * (1.0f / D) + EPS);
        float am = 0.f;
#pragma unroll
        for (int i = 0; i < 4; ++i)
#pragma unroll
            for (int e = 0; e < 4; ++e) { f[rr][i][e] *= rv * gg[i][e]; am = fmaxf(am, fabsf(f[rr][i][e])); }
#pragma unroll
        for (int o = 32; o > 0; o >>= 1) am = fmaxf(am, __shfl_xor(am, o));
        const float inv = am > 0.f ? 127.0f / am : 0.f;
#pragma unroll
        for (int i = 0; i < 4; ++i) {
            unsigned w = 0u;
#pragma unroll
            for (int e = 0; e < 4; ++e) w |= ((unsigned)(int)rintf(f[rr][i][e] * inv) & 255u) << (8 * e);
            stg<unsigned>(xqt, (unsigned)(tk * D + i * 256 + 4 * lane), w);
            *(LAS unsigned*)(lds + tk * TROWB + i * 256 + 4 * lane) = w;
        }
        if (lane == 0) { ((LAS float*)(lds + LDS_RS))[tk] = am * (1.0f / 127.0f); ((float*)p.sx)[tile * 64 + tk] = am * (1.0f / 127.0f); }
    }
}

__device__ __forceinline__ void p2_mix(const Params& p, int tile, int tid, LAS unsigned char* lds) {
    const int wv = __builtin_amdgcn_readfirstlane(tid >> 6);
    const int b = tile >> 6, s0 = (tile & 63) * 64;
    LAS float* ssa = (LAS float*)(lds + LDS_SSA);
    const unsigned char* pbat = p.proj + (size_t)b * L * (MIXIN * 2);
    const float* xt = p.x + (size_t)tile * 64 * D;
    unsigned char* ht = p.hb + (size_t)tile * 64 * D * 2;
    if (tid < 64) ssa[tid] = 0.f;
    {
        const int lane = launder(tid) & 63, r = lane & 31, h = lane >> 5; (void)r; (void)h;
        float cw[3][8], gbv[8], u1[8], u2[8];
#pragma unroll
        for (int k = 0; k < 3; ++k) { const f32x4 a = ldg<f32x4>(p.conv_w, (unsigned)(k * MIXB + 8 * lane) * 4u), c = ldg<f32x4>(p.conv_w, (unsigned)(k * MIXB + 8 * lane + 4) * 4u);
#pragma unroll
            for (int e = 0; e < 4; ++e) { cw[k][e] = a[e]; cw[k][4 + e] = c[e]; } }
        { const f32x4 a = ldg<f32x4>(p.g_b, (unsigned)(8 * lane) * 4u), c = ldg<f32x4>(p.g_b, (unsigned)(8 * lane + 4) * 4u);
#pragma unroll
            for (int e = 0; e < 4; ++e) { gbv[e] = a[e]; gbv[4 + e] = c[e]; } }
        const int p0 = NMETA + s0 + 8 * wv;
        u32x4 bvv[8], cvv[10], vvv[10];
#pragma unroll
        for (int i = 0; i < 10; ++i) { const unsigned ro = (unsigned)(p0 - 2 + i) * 4096u + lane * 16u; cvv[i] = ldg<u32x4>(pbat, ro + 2048u); vvv[i] = ldg<u32x4>(pbat, ro + 3072u); if (i >= 2) bvv[i - 2] = ldg<u32x4>(pbat, ro + 1024u); }
    {
        const int cp = tid & 255, th = __builtin_amdgcn_readfirstlane(tid >> 8), g = __builtin_amdgcn_readfirstlane(cp >> 6);
        const int p0 = NMETA + s0 + 32 * th;
        LAS unsigned char* dst = lds + (32 * th) * TROW + cp * 4;
        if (g == 0) pool_window<2>(pbat, p0, cp, dst); else if (g == 1) pool_window<4>(pbat, p0, cp, dst); else if (g == 2) pool_window<8>(pbat, p0, cp, dst); else pool_window<16>(pbat, p0, cp, dst);
    }
#pragma unroll
        for (int e = 0; e < 4; ++e) { u2[2 * e] = bf_lo(cvv[0][e]) * bf_lo(vvv[0][e]); u2[2 * e + 1] = bf_hi(cvv[0][e]) * bf_hi(vvv[0][e]); u1[2 * e] = bf_lo(cvv[1][e]) * bf_lo(vvv[1][e]); u1[2 * e + 1] = bf_hi(cvv[1][e]) * bf_hi(vvv[1][e]); }
#pragma unroll
        for (int tk = 0; tk < 8; ++tk) {
            const u32x4 bv = bvv[tk], cv = cvv[tk + 2], vv = vvv[tk + 2];
            float z[8], ss = 0.f;
#pragma unroll
            for (int e = 0; e < 8; ++e) {
                const float bb = (e & 1) ? bf_hi(bv[e >> 1]) : bf_lo(bv[e >> 1]);
                const float u0 = ((e & 1) ? bf_hi(cv[e >> 1]) : bf_lo(cv[e >> 1])) * ((e & 1) ? bf_hi(vv[e >> 1]) : bf_lo(vv[e >> 1]));
                const float conv = u2[e] * cw[0][e] + u1[e] * cw[1][e] + u0 * cw[2][e];
                z[e] = bb * conv; ss += z[e] * z[e];
                u2[e] = u1[e]; u1[e] = u0;
            }
            ss = wave_sum(ss);
            const float rsb = rsqrtf(ss * (1.0f / MIXB) + EPS);
            u32x4 o; o.x = pk_bf16(z[0] * rsb * gbv[0], z[1] * rsb * gbv[1]); o.y = pk_bf16(z[2] * rsb * gbv[2], z[3] * rsb * gbv[3]);
            o.z = pk_bf16(z[4] * rsb * gbv[4], z[5] * rsb * gbv[5]); o.w = pk_bf16(z[6] * rsb * gbv[6], z[7] * rsb * gbv[7]);
            *(LAS u32x4*)(lds + (8 * wv + tk) * TROW + (MIXA + 8 * lane) * 2) = o;
        }
    }
    __syncthreads();
    {
        const int lane = launder(tid) & 63, r = lane & 31, h = lane >> 5; (void)r; (void)h;
        const int g = wv >> 1, dh = wv & 1;
        const u32x4* PWF = (const u32x4*)(p.pwf);
        f32x16 acc[2][2]; acc[0][0] = zero16(); acc[0][1] = zero16(); acc[1][0] = zero16(); acc[1][1] = zero16();
        gemm22<8>(PWF + (size_t)((g * 4 + 2 * dh) * 8) * 64, lane, lds + r * TROW + g * 256 + h * 16, acc);
        float ss0 = 0.f, ss1 = 0.f;
#pragma unroll
        for (int mi = 0; mi < 2; ++mi)
#pragma unroll
            for (int q = 0; q < 4; ++q) {
                const int d = g * 128 + 32 * (2 * dh + mi) + 8 * q + 4 * h;
                const f32x4 sc = ldg<f32x4>(p.pool_scale, (unsigned)d * 4u);
#pragma unroll
                for (int e = 0; e < 4; ++e) { acc[mi][0][4 * q + e] *= sc[e]; acc[mi][1][4 * q + e] *= sc[e]; ss0 += acc[mi][0][4 * q + e] * acc[mi][0][4 * q + e]; ss1 += acc[mi][1][4 * q + e] * acc[mi][1][4 * q + e]; }
            }
        ss0 += __shfl_xor(ss0, 32); ss1 += __shfl_xor(ss1, 32);
        if (h == 0) { atomicAdd((float*)(ssa + r), ss0); atomicAdd((float*)(ssa + 32 + r), ss1); }
        __syncthreads();
        const float ra0 = rsqrtf(ssa[r] * (1.0f / MIXA) + EPS), ra1 = rsqrtf(ssa[32 + r] * (1.0f / MIXA) + EPS);
#pragma unroll
        for (int mi = 0; mi < 2; ++mi)
#pragma unroll
            for (int q = 0; q < 4; ++q) {
                const int d = g * 128 + 32 * (2 * dh + mi) + 8 * q + 4 * h;
                const f32x4 gg = ldg<f32x4>(p.g_a, (unsigned)d * 4u);
                u32x2 o0, o1;
                o0.x = pk_bf16(acc[mi][0][4 * q] * ra0 * gg[0], acc[mi][0][4 * q + 1] * ra0 * gg[1]); o0.y = pk_bf16(acc[mi][0][4 * q + 2] * ra0 * gg[2], acc[mi][0][4 * q + 3] * ra0 * gg[3]);
                o1.x = pk_bf16(acc[mi][1][4 * q] * ra1 * gg[0], acc[mi][1][4 * q + 1] * ra1 * gg[1]); o1.y = pk_bf16(acc[mi][1][4 * q + 2] * ra1 * gg[2], acc[mi][1][4 * q + 3] * ra1 * gg[3]);
                *(LAS u32x2*)(lds + r * TROW + d * 2) = o0;
                *(LAS u32x2*)(lds + (32 + r) * TROW + d * 2) = o1;
            }
    }
    __syncthreads();
    f32x4 xa[4][4];
    {
        const int lane = launder(tid) & 63, r = lane & 31, h = lane >> 5; (void)r; (void)h;
#pragma unroll
        for (int rr = 0; rr < 4; ++rr)
#pragma unroll
            for (int i = 0; i < 4; ++i) xa[rr][i] = ldg<f32x4>(xt, (unsigned)((8 * wv + rr) * D + i * 256 + 4 * lane) * 4u);
        const u32x4* WF = (const u32x4*)(p.woutf);
        const LAS unsigned char* bp = lds + r * TROW + h * 16;
#pragma unroll 1
        for (int rdx = 0; rdx < 2; ++rdx) {
            const int rd = (rdx + (tile >> 7)) & 1;
            const int i0 = 4 * wv + 2 * rd;
            f32x16 acc[2][2]; acc[0][0] = zero16(); acc[0][1] = zero16(); acc[1][0] = zero16(); acc[1][1] = zero16();
            gemm22<64>(WF + (size_t)i0 * 64 * 64, lane, bp, acc, (tile >> 3) & 15);
            LAS unsigned char* eb = lds + LDS_LUT + wv * 2048;
#pragma unroll
            for (int nt = 0; nt < 2; ++nt)
#pragma unroll
                for (int hf = 0; hf < 2; ++hf) {
                    if ((r >> 4) == hf) {
#pragma unroll
                        for (int mi = 0; mi < 2; ++mi)
#pragma unroll
                            for (int q = 0; q < 4; ++q) {
                                u32x2 hw; hw.x = pk_bf16(acc[mi][nt][4 * q], acc[mi][nt][4 * q + 1]); hw.y = pk_bf16(acc[mi][nt][4 * q + 2], acc[mi][nt][4 * q + 3]);
                                *(LAS u32x2*)(eb + (r & 15) * 128 + (((4 * mi + q) ^ (r & 7)) * 16) + 8 * h) = hw;
                            }
                    }
                    wave_sync();
                    u32x4 ov[2];
#pragma unroll
                    for (int k = 0; k < 2; ++k) { const int row = 8 * k + (lane >> 3); ov[k] = *(const LAS u32x4*)(eb + row * 128 + (((lane & 7) ^ (row & 7)) * 16)); }
                    wave_sync();
#pragma unroll
                    for (int k = 0; k < 2; ++k) { const int row = 8 * k + (lane >> 3); stg<u32x4>(ht, (unsigned)((nt * 32 + hf * 16 + row) * D + 32 * i0) * 2u + (unsigned)(lane & 7) * 16u, ov[k]); }
                }
        }
    }
    __syncthreads();
    {
        const int lane = launder(tid) & 63;
        f32x4 gg[4];
#pragma unroll
        for (int i = 0; i < 4; ++i) gg[i] = ldg<f32x4>(p.g_ffn, (unsigned)(i * 256 + 4 * lane) * 4u);
        f32x4 xb[4][4];
#pragma unroll
        for (int rr = 0; rr < 4; ++rr)
#pragma unroll
            for (int i = 0; i < 4; ++i) xb[rr][i] = ldg<f32x4>(xt, (unsigned)((8 * wv + 4 + rr) * D + i * 256 + 4 * lane) * 4u);
        u32x2 hq[8][4];
#pragma unroll
        for (int rr = 0; rr < 4; ++rr)
#pragma unroll
            for (int i = 0; i < 4; ++i) hq[rr][i] = ldg<u32x2>(ht, (unsigned)((8 * wv + rr) * D + i * 256 + 4 * lane) * 2u);
        p2_xf_batch<0>(p, tile, wv, lane, lds, ht, xa, hq, gg);
#pragma unroll
        for (int rr = 4; rr < 8; ++rr)
#pragma unroll
            for (int i = 0; i < 4; ++i) hq[rr][i] = ldg<u32x2>(ht, (unsigned)((8 * wv + rr) * D + i * 256 + 4 * lane) * 2u);
        p2_xf_batch<4>(p, tile, wv, lane, lds, ht, xb, hq, gg);
    }
    __syncthreads();
    {
        const int lane = launder(tid) & 63, r = lane & 31, h = lane >> 5; (void)r; (void)h;
        const int hd = wv;
        const u32x4* WQF = (const u32x4*)(p.wqf);
        const u32x4* KF = (const u32x4*)(p.kf);
        unsigned char* lstt = p.lst + (size_t)tile * 64 * (NH * 32 * 4);
        const LAS unsigned char* bp = lds + r * TROWB + h * 16;
        const float sx0 = ((const LAS float*)(lds + LDS_RS))[r], sx1 = ((const LAS float*)(lds + LDS_RS))[32 + r];
        LAS unsigned char* lut = lds + LDS_LUT + wv * 2048;
#pragma unroll
        for (int pp = 0; pp < 2; ++pp) {
            const int hp = hd * 2 + pp;
            u32x4 qb[8];
            LAS u32x4* qpark = (LAS u32x4*)(lds + 64 * TROWB + wv * 8192) + lane;
#pragma unroll
            for (int mh = 0; mh < 2; ++mh) {
                const int mt0 = hp * 4 + mh * 2;
                i32x16 acc[2][2]; acc[0][0] = izero16(); acc[0][1] = izero16(); acc[1][0] = izero16(); acc[1][1] = izero16();
                gemm22i<32, QCH>(WQF + (size_t)mt0 * 32 * 64, lane, bp, acc, (tile >> 3));
#pragma unroll
                for (int mi = 0; mi < 2; ++mi)
#pragma unroll
                    for (int s2 = 0; s2 < 2; ++s2) {
                        const f32x4 w0 = ldg<f32x4>(p.wscq, (unsigned)(32 * (mt0 + mi) + 16 * s2 + 4 * h) * 4u), w1 = ldg<f32x4>(p.wscq, (unsigned)(32 * (mt0 + mi) + 16 * s2 + 8 + 4 * h) * 4u);
#pragma unroll
                        for (int nt = 0; nt < 2; ++nt) {
                            const float xs = nt ? sx1 : sx0;
                            u32x4 o; o.x = pk_bf16((float)acc[mi][nt][8 * s2] * xs * w0[0], (float)acc[mi][nt][8 * s2 + 1] * xs * w0[1]); o.y = pk_bf16((float)acc[mi][nt][8 * s2 + 2] * xs * w0[2], (float)acc[mi][nt][8 * s2 + 3] * xs * w0[3]);
                            o.z = pk_bf16((float)acc[mi][nt][8 * s2 + 4] * xs * w1[0], (float)acc[mi][nt][8 * s2 + 5] * xs * w1[1]); o.w = pk_bf16((float)acc[mi][nt][8 * s2 + 6] * xs * w1[2], (float)acc[mi][nt][8 * s2 + 7] * xs * w1[3]);
                            if (nt == 0) qb[2 * (mh * 2 + mi) + s2] = o; else qpark[(2 * (mh * 2 + mi) + s2) * 64] = o;
                        }
                    }
            }
#pragma unroll
            for (int nt = 0; nt < 2; ++nt) {
                float top[16];
#pragma unroll
                for (int i = 0; i < 16; ++i) top[i] = -INFINITY;
                if (nt == 1) {
#pragma unroll
                    for (int ks = 0; ks < 8; ++ks) qb[ks] = qpark[ks * 64];
                }
                const u32x4* kfp = KF + (size_t)(hp * 4 * 8) * 64;
                u32x4 kf[8];
#pragma unroll
                for (int ks = 0; ks < 8; ++ks) kf[ks] = ldg<u32x4>(kfp, (unsigned)(ks * 64 + lane) * 16u);
#pragma unroll 1
                for (int kt = 0; kt < 4; ++kt) {
                    f32x16 sa = zero16();
#pragma unroll
                    for (int ks = 0; ks < 8; ++ks) sa = mfma32(kf[ks], qb[ks], sa);
                    __builtin_amdgcn_sched_barrier(0);
                    const int ktn = (kt + 1) & 3;
#pragma unroll
                    for (int ks = 0; ks < 8; ++ks) kf[ks] = ldg<u32x4>(kfp, (unsigned)((ktn * 8 + ks) * 64 + lane) * 16u);
                    __builtin_amdgcn_sched_barrier(0);
                    float v[16];
#pragma unroll
                    for (int i = 0; i < 16; ++i) v[i] = embed_bits(sa[i], 127u, (unsigned)(32 * kt + (i & 3) + 8 * (i >> 2) + 4 * h));
                    bitonic_sort_desc<4>(v); merge_top16(top, v);
                    __builtin_amdgcn_sched_barrier(0);
                }
                float o[16];
#pragma unroll
                for (int i = 0; i < 16; ++i) o[i] = __shfl_xor(top[i], 32);
                merge_top16(top, o);
                if (h == 0) {
                    const unsigned lo = (unsigned)((((nt * 32 + r) * NH + hd) * 2 + pp) * 16) * 4u;
#pragma unroll
                    for (int w4 = 0; w4 < 4; ++w4) { f32x4 tv; tv[0] = top[4 * w4]; tv[1] = top[4 * w4 + 1]; tv[2] = top[4 * w4 + 2]; tv[3] = top[4 * w4 + 3]; stg<f32x4>(lstt, lo + 16u * w4, tv); }
                    u32x4 kb;
#pragma unroll
                    for (int w4 = 0; w4 < 4; ++w4) kb[w4] = (__builtin_bit_cast(unsigned, top[4 * w4]) & 127u) | ((__builtin_bit_cast(unsigned, top[4 * w4 + 1]) & 127u) << 8) | ((__builtin_bit_cast(unsigned, top[4 * w4 + 2]) & 127u) << 16) | ((__builtin_bit_cast(unsigned, top[4 * w4 + 3]) & 127u) << 24);
                    *(LAS u32x4*)(lut + ((nt * 32 + r) * 2 + pp) * 16) = kb;
                }
            }
        }
#pragma unroll
        for (int nt = 0; nt < 2; ++nt) {
            float s1[16], s2[16];
            {
                const unsigned lo = (unsigned)(((nt * 32 + r) * NH + hd) * 32) * 4u;
#pragma unroll
                for (int w4 = 0; w4 < 4; ++w4) { const f32x4 a = ldg<f32x4>(lstt, lo + 16u * w4), c = ldg<f32x4>(lstt, lo + 64u + 16u * w4);
#pragma unroll
                    for (int e4 = 0; e4 < 4; ++e4) { s1[4 * w4 + e4] = a[e4]; s2[4 * w4 + e4] = c[e4]; } }
            }
            float top[16];
#pragma unroll
            for (int i = 0; i < 16; ++i) top[i] = -INFINITY;
            { float v[16]; v[0] = embed_bits(s1[0] + s2[0], 255u, 0u); v[1] = embed_bits(s1[0] + s2[1], 255u, 1u); v[2] = embed_bits(s1[0] + s2[2], 255u, 2u); v[3] = embed_bits(s1[0] + s2[3], 255u, 3u); v[4] = embed_bits(s1[0] + s2[4], 255u, 4u); v[5] = embed_bits(s1[0] + s2[5], 255u, 5u); v[6] = embed_bits(s1[0] + s2[6], 255u, 6u); v[7] = embed_bits(s1[0] + s2[7], 255u, 7u); v[8] = embed_bits(s1[0] + s2[8], 255u, 8u); v[9] = embed_bits(s1[0] + s2[9], 255u, 9u); v[10] = embed_bits(s1[0] + s2[10], 255u, 10u); v[11] = embed_bits(s1[0] + s2[11], 255u, 11u); v[12] = embed_bits(s1[0] + s2[12], 255u, 12u); v[13] = embed_bits(s1[0] + s2[13], 255u, 13u); v[14] = embed_bits(s1[0] + s2[14], 255u, 14u); v[15] = embed_bits(s1[0] + s2[15], 255u, 15u);
              bitonic_sort_desc<4>(v); merge_top16(top, v); }
            { float v[16]; v[0] = embed_bits(s1[1] + s2[0], 255u, 16u); v[1] = embed_bits(s1[1] + s2[1], 255u, 17u); v[2] = embed_bits(s1[1] + s2[2], 255u, 18u); v[3] = embed_bits(s1[1] + s2[3], 255u, 19u); v[4] = embed_bits(s1[1] + s2[4], 255u, 20u); v[5] = embed_bits(s1[1] + s2[5], 255u, 21u); v[6] = embed_bits(s1[1] + s2[6], 255u, 22u); v[7] = embed_bits(s1[1] + s2[7], 255u, 23u); v[8] = embed_bits(s1[2] + s2[0], 255u, 32u); v[9] = embed_bits(s1[2] + s2[1], 255u, 33u); v[10] = embed_bits(s1[2] + s2[2], 255u, 34u); v[11] = embed_bits(s1[2] + s2[3], 255u, 35u); v[12] = embed_bits(s1[2] + s2[4], 255u, 36u); v[13] = embed_bits(s1[3] + s2[0], 255u, 48u); v[14] = embed_bits(s1[3] + s2[1], 255u, 49u); v[15] = embed_bits(s1[3] + s2[2], 255u, 50u);
              bitonic_sort_desc<4>(v); merge_top16(top, v); }
            { float v[16]; v[0] = embed_bits(s1[3] + s2[3], 255u, 51u); v[1] = embed_bits(s1[4] + s2[0], 255u, 64u); v[2] = embed_bits(s1[4] + s2[1], 255u, 65u); v[3] = embed_bits(s1[4] + s2[2], 255u, 66u); v[4] = embed_bits(s1[5] + s2[0], 255u, 80u); v[5] = embed_bits(s1[5] + s2[1], 255u, 81u); v[6] = embed_bits(s1[6] + s2[0], 255u, 96u); v[7] = embed_bits(s1[6] + s2[1], 255u, 97u); v[8] = embed_bits(s1[7] + s2[0], 255u, 112u); v[9] = embed_bits(s1[7] + s2[1], 255u, 113u); v[10] = embed_bits(s1[8] + s2[0], 255u, 128u); v[11] = embed_bits(s1[9] + s2[0], 255u, 144u); v[12] = embed_bits(s1[10] + s2[0], 255u, 160u); v[13] = embed_bits(s1[11] + s2[0], 255u, 176u); v[14] = embed_bits(s1[12] + s2[0], 255u, 192u); v[15] = embed_bits(s1[13] + s2[0], 255u, 208u);
              bitonic_sort_desc<4>(v); merge_top16(top, v); }
            { float v[16]; v[0] = embed_bits(s1[14] + s2[0], 255u, 224u); v[1] = embed_bits(s1[15] + s2[0], 255u, 240u); v[2] = -INFINITY; v[3] = -INFINITY; v[4] = -INFINITY; v[5] = -INFINITY; v[6] = -INFINITY; v[7] = -INFINITY; v[8] = -INFINITY; v[9] = -INFINITY; v[10] = -INFINITY; v[11] = -INFINITY; v[12] = -INFINITY; v[13] = -INFINITY; v[14] = -INFINITY; v[15] = -INFINITY;
              bitonic_sort_desc<4>(v); merge_top16(top, v); }
            float e[16], sum = 0.f;
#pragma unroll
            for (int i = 0; i < 16; ++i) { e[i] = __expf(top[i] - top[0]); sum += e[i]; }
            const float inv = 1.0f / sum;
            const LAS unsigned char* lt = lut + (nt * 32 + r) * 32;
            LAS unsigned char* slot = lds + 64 * TROWB + wv * 8192 + (nt * 32 + r) * 32;
            if (h == 0) {
                int ids[16];
#pragma unroll
                for (int i = 0; i < 16; ++i) { const unsigned code = __builtin_bit_cast(unsigned, top[i]) & 255u; ids[i] = (int)lt[code >> 4] * NKEYS + (int)lt[16 + (code & 15u)]; }
                u32x4 w0, w1;
#pragma unroll
                for (int i = 0; i < 4; ++i) { w0[i] = (unsigned)ids[i] | ((unsigned)ids[i + 8] << 16); w1[i] = (unsigned)ids[i + 4] | ((unsigned)ids[i + 12] << 16); }
                *(LAS u32x4*)(slot) = w0; *(LAS u32x4*)(slot + 16) = w1;
            } else {
#pragma unroll
                for (int i = 0; i < 4; ++i) { f32x4 gv; gv[0] = e[2 * i] * inv; gv[1] = e[2 * i + 8] * inv; gv[2] = e[2 * i + 1] * inv; gv[3] = e[2 * i + 9] * inv; *(LAS f32x4*)(slot + 2048 + (nt * 32 + r) * 32 + 16 * i) = gv; }
            }
        }
    }
    __syncthreads();
    {
        const LAS unsigned char* sl = lds + 64 * TROWB;
        unsigned char* idxt = p.idx + (size_t)tile * 64 * (HK * 2);
        unsigned char* gatet = p.gate + (size_t)tile * 64 * (HK * 4);
        u32x4 iv[2]; f32x4 gv[4];
#pragma unroll
        for (int k = 0; k < 2; ++k) { const int ci = tid + 512 * k, tok = ci >> 4, c = ci & 15;
#pragma unroll
            for (int q = 0; q < 4; ++q) iv[k][q] = *(const LAS unsigned*)(sl + (4 * (c & 1) + q) * 8192 + tok * 32 + (c >> 1) * 4); }
#pragma unroll
        for (int k = 0; k < 4; ++k) { const int ci = tid + 512 * k, tok = ci >> 5, c = ci & 31;
            const f32x2 a = *(const LAS f32x2*)(sl + (2 * (c & 3)) * 8192 + 2048 + tok * 64 + (c >> 2) * 8), b = *(const LAS f32x2*)(sl + (2 * (c & 3) + 1) * 8192 + 2048 + tok * 64 + (c >> 2) * 8);
            gv[k][0] = a[0]; gv[k][1] = a[1]; gv[k][2] = b[0]; gv[k][3] = b[1]; }
#pragma unroll
        for (int k = 0; k < 2; ++k) stg<u32x4>(idxt, (unsigned)(tid + 512 * k) * 16u, iv[k]);
#pragma unroll
        for (int k = 0; k < 4; ++k) stg<f32x4>(gatet, (unsigned)(tid + 512 * k) * 16u, gv[k]);
    }
}

__device__ __forceinline__ int dot16_i8(u32x4 a, u32x4 b) {
    int d = __builtin_amdgcn_sdot4((int)a[0], (int)b[0], 0, false);
    d = __builtin_amdgcn_sdot4((int)a[1], (int)b[1], d, false); d = __builtin_amdgcn_sdot4((int)a[2], (int)b[2], d, false); d = __builtin_amdgcn_sdot4((int)a[3], (int)b[3], d, false);
    return d;
}
__device__ __forceinline__ float gelu_exact(float z) { return 0.5f * z * (1.0f + erff(z * 0.70710678118654752f)); }

struct GMeta { int ids[16]; u32x4 x; };
struct GRows { u32x4 v[16]; };
__device__ __forceinline__ void g_rows(const unsigned char* slice, const GMeta& m, int lane, GRows& r) {
    const unsigned co = (unsigned)(lane & 7) * 16u;
#pragma unroll
    for (int i = 0; i < 16; ++i) r.v[i] = ldg<u32x4>(slice, (unsigned)m.ids[i] * 128u + co);
}

constexpr int P3W_Z = 0, P3W_CQ = 4096, P3W_SC = 5120, P3W_CS = 5152, P3W_ID = 5184, P3W_X = 7232, P3W_SSQ = 15424, P3W_BYTES = 17472;
__device__ __forceinline__ void p3_wave(const Params& p, int tb0, int tb1, int lt, int pos, int lane, LAS unsigned char* wl) {
    const int ntok = 1 << lt;
    auto tokf = [&](int q) { return (q < 4 ? tb0 : tb1) + (q & 3); };
    const int grp = lane >> 3, ch = lane & 7, i0 = ((ch >> 2) & 1) * 8 + ((ch >> 1) & 1) * 4 + (ch & 1) * 2;
    LAS int* zl = (LAS int*)(wl + P3W_Z);
    LAS float* scl = (LAS float*)(wl + P3W_SC);
    LAS float* ssl = (LAS float*)(wl + P3W_SSQ);
#pragma unroll
    for (int q = 0; q < 8; ++q) if (q < ntok) {
        const int t = tokf(q);
        *(LAS unsigned*)(wl + P3W_ID + q * 256 + lane * 4) = ldg<unsigned>(p.idx + (size_t)t * (HK * 2), (unsigned)lane * 4u);
        *(LAS u32x4*)(wl + P3W_X + q * 1024 + lane * 16) = ldg<u32x4>(p.xq + (size_t)t * D, (unsigned)lane * 16u);
    }
    wave_sync();
    auto ids_lds = [&](int q, GMeta& m) {
#pragma unroll
        for (int w = 0; w < 2; ++w) { const u32x4 a = *(const LAS u32x4*)(wl + P3W_ID + q * 256 + grp * 32 + 16 * w);
#pragma unroll
            for (int e = 0; e < 4; ++e) { m.ids[8 * w + 2 * e] = (int)(a[e] & 0xffffu); m.ids[8 * w + 2 * e + 1] = (int)(a[e] >> 16); } }
    };
#pragma unroll 1
    for (int st = 0; st < 8; ++st) {
        const int j = (pos + st) & 7;
        const unsigned char* slice = p.eut + (size_t)j * (16384 * 128);
        const unsigned xo = (unsigned)(128 * j + 16 * ch);
#pragma unroll 1
        for (int q = 0; q < ntok; ++q) {
            const int t = tokf(q);
            GMeta m; GRows r; ids_lds(q, m); m.x = *(const LAS u32x4*)(wl + P3W_X + q * 1024 + xo); g_rows(slice, m, lane, r); (void)t;
            int part[16];
#pragma unroll
            for (int i = 0; i < 16; ++i) part[i] = dot16_i8(r.v[i], m.x);
#pragma unroll
            for (int lv = 2; lv >= 0; --lv) {
                const int n = 2 << lv, off = 1 << lv;
                const bool up = (lane & off) != 0;
#pragma unroll
                for (int i = 0; i < n; ++i) { const int a = part[i], c = part[i + n]; const int send = up ? a : c, keep = up ? c : a; part[i] = keep + __shfl_xor(send, off); }
            }
            LAS int* zp = zl + q * 128 + 2 * lane;
            if (st == 0) { zp[0] = part[0]; zp[1] = part[1]; } else { zp[0] += part[0]; zp[1] += part[1]; }
        }
    }
    {
        const unsigned po = (unsigned)(grp * 16 + i0) * 4u, po2 = (unsigned)(grp * 16 + i0) * 2u;
        unsigned idw[8]; f32x2 g[8]; float sx[8];
#pragma unroll
        for (int q = 0; q < 8; ++q) { const int t = tokf(q < ntok ? q : 0); idw[q] = *(const LAS unsigned*)(wl + P3W_ID + (q < ntok ? q : 0) * 256 + po2); g[q] = ldg<f32x2>(p.gate + (size_t)t * (HK * 4), po); sx[q] = ((const float*)p.sx)[t]; }
        float su0[8], su1[8], sv0[8], sv1[8];
#pragma unroll
        for (int q = 0; q < 8; ++q) { const int a = (int)(idw[q] & 0xffffu), c = (int)(idw[q] >> 16); su0[q] = ((const float*)p.su)[a]; su1[q] = ((const float*)p.su)[c]; sv0[q] = ((const float*)p.sv)[a]; sv1[q] = ((const float*)p.sv)[c]; }
#pragma unroll
        for (int q = 0; q < 8; ++q) if (q < ntok) {
            const int z0 = zl[q * 128 + 2 * lane], z1 = zl[q * 128 + 2 * lane + 1];
            const float c0 = g[q][0] * gelu_exact((float)z0 * (sx[q] * su0[q])) * sv0[q];
            const float c1 = g[q][1] * gelu_exact((float)z1 * (sx[q] * su1[q])) * sv1[q];
            float am = fmaxf(fabsf(c0), fabsf(c1));
#pragma unroll
            for (int o = 32; o > 0; o >>= 1) am = fmaxf(am, __shfl_xor(am, o));
            const float inv = am > 0.f ? 127.0f / am : 0.f;
            const unsigned q0 = (unsigned)(int)rintf(c0 * inv) & 255u, q1 = (unsigned)(int)rintf(c1 * inv) & 255u;
            *(LAS unsigned short*)(wl + P3W_CQ + q * 128 + 16 * grp + i0) = (unsigned short)(q0 | (q1 << 8));
            int cs = (int)rintf(c0 * inv) + (int)rintf(c1 * inv);
#pragma unroll
            for (int o = 32; o > 0; o >>= 1) cs += __shfl_xor(cs, o);
            ssl[q * 64 + lane] = 0.f;
            if (lane == 0) { scl[q] = am * (1.0f / 127.0f); ((LAS int*)(wl + P3W_CS))[q] = cs; }
        }
    }
    wave_sync();
    {
        const int nvs = 4 << lt;
        auto meta = [&](int n, GMeta& m, float& sc, u32x2& hv) {
            const int nn = n < nvs ? n : nvs - 1, q = nn & (ntok - 1), j = (pos + (nn >> lt)) & 3, t = tokf(q);
            ids_lds(q, m);
            m.x = *(const LAS u32x4*)(wl + P3W_CQ + q * 128 + 16 * grp);
            sc = scl[q];
            hv = ldg<u32x2>(p.hb + (size_t)t * D * 2, (unsigned)(256 * j + 32 * ch + 4 * grp) * 2u);
        };
        auto rows = [&](int n, const GMeta& m, GRows& r) { const int nn = n < nvs ? n : nvs - 1; g_rows(p.evt + (size_t)((pos + (nn >> lt)) & 3) * (16384 * 128), m, lane, r); };
        auto finish = [&](int n, const GMeta& m, const GRows& r, float sc, u32x2 hv) {
            const int q = n & (ntok - 1), j = (pos + (n >> lt)) & 3, t = tokf(q);
            int acc[32];
#pragma unroll
            for (int e = 0; e < 32; ++e) acc[e] = 0;
#pragma unroll
            for (int g = 0; g < 4; ++g)
#pragma unroll
                for (int e = 0; e < 4; ++e) {
                    const int cq = (int)m.x[g];
                    const unsigned A = r.v[4 * g][e], B = r.v[4 * g + 1][e], C = r.v[4 * g + 2][e], Dd = r.v[4 * g + 3][e];
                    const unsigned t0 = __builtin_amdgcn_perm(B, A, 0x05010400u), t1 = __builtin_amdgcn_perm(B, A, 0x07030602u);
                    const unsigned t2 = __builtin_amdgcn_perm(Dd, C, 0x05010400u), t3 = __builtin_amdgcn_perm(Dd, C, 0x07030602u);
                    const unsigned r0 = __builtin_amdgcn_perm(t2, t0, 0x05040100u), r1 = __builtin_amdgcn_perm(t2, t0, 0x07060302u);
                    const unsigned r2 = __builtin_amdgcn_perm(t3, t1, 0x05040100u), r3 = __builtin_amdgcn_perm(t3, t1, 0x07060302u);
                    int* a4 = acc + 4 * e;
                    a4[0] = __builtin_amdgcn_sdot4((int)(r0 & 0x0f0f0f0fu), cq, a4[0], false); a4[1] = __builtin_amdgcn_sdot4((int)(r1 & 0x0f0f0f0fu), cq, a4[1], false);
                    a4[2] = __builtin_amdgcn_sdot4((int)(r2 & 0x0f0f0f0fu), cq, a4[2], false); a4[3] = __builtin_amdgcn_sdot4((int)(r3 & 0x0f0f0f0fu), cq, a4[3], false);
                    a4[16] = __builtin_amdgcn_sdot4((int)r0, cq, a4[16], false); a4[17] = __builtin_amdgcn_sdot4((int)r1, cq, a4[17], false);
                    a4[18] = __builtin_amdgcn_sdot4((int)r2, cq, a4[18], false); a4[19] = __builtin_amdgcn_sdot4((int)r3, cq, a4[19], false);
                }
#pragma unroll
            for (int e = 0; e < 16; ++e) acc[16 + e] = (acc[16 + e] - acc[e]) >> 4;
#pragma unroll
            for (int i = 0; i < 16; ++i) { const auto sw = __builtin_amdgcn_permlane32_swap((unsigned)acc[i], (unsigned)acc[i + 16], false, false); acc[i] = (int)(sw[0] + sw[1]); }
#pragma unroll
            for (int i = 0; i < 8; ++i) { const auto sw = __builtin_amdgcn_permlane16_swap((unsigned)acc[i], (unsigned)acc[i + 8], false, false); acc[i] = (int)(sw[0] + sw[1]); }
            {
                const bool up = (lane & 8) != 0;
#pragma unroll
                for (int i = 0; i < 4; ++i) {
                    const int xs = acc[i] + __builtin_amdgcn_update_dpp(0, acc[i], 0x128, 0xf, 0xf, false), ys = acc[i + 4] + __builtin_amdgcn_update_dpp(0, acc[i + 4], 0x128, 0xf, 0xf, false);
                    acc[i] = up ? ys : xs;
                }
            }
            const int c8 = (lane & 32) ? 0 : 8 * ((const LAS int*)(wl + P3W_CS))[q];
            f32x4 o; o[0] = (float)(acc[0] - c8) * sc + bf_lo(hv.x); o[1] = (float)(acc[1] - c8) * sc + bf_hi(hv.x); o[2] = (float)(acc[2] - c8) * sc + bf_lo(hv.y); o[3] = (float)(acc[3] - c8) * sc + bf_hi(hv.y);
            stg<f32x4>(p.out + (size_t)t * D, (unsigned)(256 * j + 32 * ch + 4 * grp) * 4u, o);
            atomicAdd((float*)(ssl + q * 64 + lane), o[0] * o[0] + o[1] * o[1] + o[2] * o[2] + o[3] * o[3]);
        };
        GMeta ma, mb; GRows ra, rb; float sa, sb; u32x2 ha, hb;
        meta(0, ma, sa, ha); meta(1, mb, sb, hb); rows(0, ma, ra);
#pragma unroll 1
        for (int n = 0; n < nvs; n += 2) {
            GMeta mc; float scc; u32x2 hc;
            meta(n + 2, mc, scc, hc); rows(n + 1, mb, rb);
            __builtin_amdgcn_sched_barrier(0);
            finish(n, ma, ra, sa, ha);
            __builtin_amdgcn_sched_barrier(0);
            meta(n + 3, ma, sa, ha); rows(n + 2, mc, ra);
            __builtin_amdgcn_sched_barrier(0);
            finish(n + 1, mb, rb, sb, hb);
            __builtin_amdgcn_sched_barrier(0);
            mb = ma; sb = sa; hb = ha; ma = mc; sa = scc; ha = hc;
        }
    }
    asm volatile("s_waitcnt vmcnt(0)" ::: "memory");
    __builtin_amdgcn_fence(__ATOMIC_ACQUIRE, "agent");
    {
        f32x4 gg[4];
#pragma unroll
        for (int i = 0; i < 4; ++i) gg[i] = ldg<f32x4>(p.g_fin, (unsigned)(i * 256 + 4 * lane) * 4u);
#pragma unroll 1
        for (int qb = 0; qb < ntok; qb += 4) {
            f32x4 a[4][4];
#pragma unroll
            for (int b = 0; b < 4; ++b)
#pragma unroll
                for (int i = 0; i < 4; ++i) a[b][i] = ldg<f32x4>(p.out + (size_t)tokf(qb + b) * D, (unsigned)(i * 256 + 4 * lane) * 4u);
#pragma unroll
            for (int b = 0; b < 4; ++b) {
                const float rv = rsqrtf(wave_sum(ssl[(qb + b) * 64 + lane]) * (1.0f / D) + EPS);
#pragma unroll
                for (int i = 0; i < 4; ++i) { f32x4 ov;
#pragma unroll
                    for (int e = 0; e < 4; ++e) ov[e] = a[b][i][e] * rv * gg[i][e];
                    stg<f32x4>(p.out + (size_t)tokf(qb + b) * D, (unsigned)(i * 256 + 4 * lane) * 4u, ov); }
            }
        }
    }
}

#define XB_TMO      128
#define XB_XCNT(j)  (256  + 64 * (j))
#define XB_XSUB(j)  (1280 + 64 * (j))
#define XB_XGEN(j)  (2304 + 64 * (j))
#define XB_TOP      3328
#define XB_TOPGEN   3392
#define XCD_BAR_WORDS 3456
#define XB_SPIN_CAP (1u << 18)

__device__ __forceinline__ unsigned xb_ld(unsigned* p)              { return __hip_atomic_load(p, __ATOMIC_RELAXED, __HIP_MEMORY_SCOPE_AGENT); }
__device__ __forceinline__ unsigned xb_add(unsigned* p, unsigned v) { return __hip_atomic_fetch_add(p, v, __ATOMIC_RELAXED, __HIP_MEMORY_SCOPE_AGENT); }
__device__ __forceinline__ unsigned xb_xcc_id() { return (unsigned)__builtin_amdgcn_s_getreg((3 << 11) | 20) & 0xFu; }
#define XB_SPIN(cond, bar) do { unsigned _sp = 0; while (cond) { __builtin_amdgcn_s_sleep(1); \
    if ((++_sp & 255u) == 0u) { if (xb_ld(&(bar)[XB_TMO])) break; if (_sp > XB_SPIN_CAP) { atomicAdd(&(bar)[XB_TMO], 1u); break; } } } } while (0)

struct XcdBarrier {
    unsigned* bar; unsigned x;
    volatile LAS unsigned* st;
};

__device__ __forceinline__ XcdBarrier xcd_barrier_post(unsigned* bar, volatile LAS unsigned* st) {
    XcdBarrier b; b.bar = bar; b.x = xb_xcc_id(); b.st = st;
    if (threadIdx.x == 0) (void)xb_add(&bar[XB_XCNT(b.x)], 1u);
    return b;
}
__device__ __forceinline__ void xcd_barrier_complete(unsigned* bar, unsigned x, unsigned& nloc, unsigned& nx) {
    const unsigned G = gridDim.x * gridDim.y * gridDim.z;
    unsigned sum, cnt, mine, sp = 0u;
    for (;;) {
        sum = 0u; cnt = 0u; mine = 0u;
#pragma unroll
        for (unsigned j = 0; j < 16; ++j) { const unsigned c = xb_ld(&bar[XB_XCNT(j)]); sum += c; cnt += (c > 0u) ? 1u : 0u; mine = (j == x) ? c : mine; }
        if (sum == G) break;
        __builtin_amdgcn_s_sleep(1);
        if ((++sp & 255u) == 0u) { if (xb_ld(&bar[XB_TMO])) break; if (sp > XB_SPIN_CAP) { atomicAdd(&bar[XB_TMO], 1u); break; } }
    }
    nloc = mine > 0u ? mine : 1u; nx = cnt > 0u ? cnt : 1u;
}

__device__ __forceinline__ void xcd_barrier(const XcdBarrier& b) {
    asm volatile("s_waitcnt vmcnt(0)" ::: "memory");
    __syncthreads();
    if (threadIdx.x == 0) {
        unsigned* bar = b.bar;
        __builtin_amdgcn_s_waitcnt(0);
        unsigned nloc = b.st[0], nx = b.st[1];
        if (nloc == 0u) { xcd_barrier_complete(bar, b.x, nloc, nx); b.st[0] = nloc; b.st[1] = nx; }
        const unsigned old = xb_add(&bar[XB_XSUB(b.x)], 1u);
        const unsigned gen = old / nloc;
        if (old + 1u == (gen + 1u) * nloc) {
            __builtin_amdgcn_fence(__ATOMIC_RELEASE, "agent");
            asm volatile("s_waitcnt vmcnt(0)" ::: "memory");
            const unsigned og = xb_add(&bar[XB_TOP], 1u);
            const unsigned tg = og / nx;
            if (og + 1u == (tg + 1u) * nx) xb_add(&bar[XB_TOPGEN], 1u);
            else XB_SPIN(xb_ld(&bar[XB_TOPGEN]) == tg, bar);
            __builtin_amdgcn_fence(__ATOMIC_ACQUIRE, "agent");
            xb_add(&bar[XB_XGEN(b.x)], 1u);
            asm volatile("s_waitcnt vmcnt(0)" ::: "memory");
        } else {
            XB_SPIN(xb_ld(&bar[XB_XGEN(b.x)]) == gen, bar);
            __builtin_amdgcn_fence(__ATOMIC_ACQUIRE, "agent");
            asm volatile("s_waitcnt vmcnt(0)" ::: "memory");
        }
    }
    __syncthreads();
}


__global__ void __launch_bounds__(512) k_fwd(Params p) {
    __shared__ __attribute__((aligned(16))) unsigned char lds_raw[LDS_BYTES + 16];
    LAS unsigned char* lds = (LAS unsigned char*)lds_raw;
    const int tid = threadIdx.x, vb = blockIdx.x, nb = gridDim.x;
    volatile LAS unsigned* xbw = (volatile LAS unsigned*)(lds + LDS_BYTES);
    if (tid < 4) xbw[tid] = 0u;
    __syncthreads();
    XcdBarrier gb = xcd_barrier_post((unsigned*)p.bar, xbw);
    if (tid == 0) xbw[2] = xb_add(&((unsigned*)p.bar)[XCD_BAR_WORDS + 64 * gb.x], 1u);
    p0_prep(p, vb, nb, tid, lds);
    const bool early = vb >= 129 && vb < NTILES;
    if (early) p1_stage(p, vb, tid, lds);
    xcd_barrier(gb);
    for (int tile = vb; tile < NTILES; tile += nb) { if (!(early && tile == vb)) p1_stage(p, tile, tid, lds); p1_inproj(p, tile, tid, lds, vb, nb, tile == vb); __syncthreads(); }
    if ((tid >> 6) == 0) for (int mp = vb; mp < 32; mp += nb) p1_meta(p, mp, launder(tid) & 63);
    xcd_barrier(gb);
    for (int tile = vb; tile < NTILES; tile += nb) { p2_mix(p, tile, tid, lds); __syncthreads(); }
    xcd_barrier(gb);
    const int lane = launder(tid) & 63, wv = __builtin_amdgcn_readfirstlane(tid >> 6);
    int np = 0, mypos = 0, nloc = 1;
    {
        unsigned* bar = (unsigned*)p.bar;
        const int myx = (int)gb.x;
#pragma unroll
        for (int q = 0; q < 16; ++q) { const int c = (int)xb_ld(&bar[XB_XCNT(q)]); if (q == myx) { mypos = np; nloc = c > 0 ? c : 1; } np += (c > 0) ? 1 : 0; }
        if (np < 1) np = 1;
    }
    {
        const int rank = (int)xbw[2];
        LAS unsigned char* wl = lds + wv * P3W_BYTES;
#pragma unroll 1
        for (int k = rank; mypos + np * k < T / 32; k += 2 * nloc) {
            const int c0 = mypos + np * k, c1 = mypos + np * (k + nloc);
            p3_wave(p, 32 * c0 + 4 * wv, 32 * c1 + 4 * wv, c1 < T / 32 ? 3 : 2, mypos, lane, wl);
        }
    }
}
}

extern "C" void kernel_launch(void* const* d_in, const int* in_sizes, int n_in, void* d_out, int out_size, void* d_ws, size_t ws_size, hipStream_t stream) {
    static int grid_blocks = 0;
    if (n_in != 16 || out_size != T * D) { fprintf(stderr, "kernel_launch: unexpected sizes n_in %d out %d\n", n_in, out_size); return; }
    if (!grid_blocks) {
        int dev = 0, cus = 0, per_cu = 0;
        (void)hipGetDevice(&dev);
        (void)hipDeviceGetAttribute(&cus, hipDeviceAttributeMultiprocessorCount, dev);
        (void)hipOccupancyMaxActiveBlocksPerMultiprocessor(&per_cu, (const void*)k_fwd, 512, 0);
        if (per_cu < 1) { fprintf(stderr, "kernel_launch: occupancy query returned %d\n", per_cu); per_cu = 1; }
        grid_blocks = cus * 1;
    }
    Params p{};
    p.x = (const float*)d_in[0]; p.meta = (const float*)d_in[1]; p.g_mix = (const float*)d_in[2]; p.w_in = (const float*)d_in[3]; p.pool_w = (const float*)d_in[4];
    p.pool_scale = (const float*)d_in[5]; p.conv_w = (const float*)d_in[6]; p.g_a = (const float*)d_in[7]; p.g_b = (const float*)d_in[8]; p.w_out = (const float*)d_in[9];
    p.g_ffn = (const float*)d_in[10]; p.w_query = (const float*)d_in[11]; p.sub_keys = (const float*)d_in[12]; p.eu = (const float*)d_in[13]; p.ev = (const float*)d_in[14]; p.g_fin = (const float*)d_in[15];
    p.out = (float*)d_out;
    unsigned char* ws = (unsigned char*)d_ws;
    p.winf = ws; p.woutf = ws + (4u << 20); p.wqf = ws + (6u << 20); p.kf = ws + (10u << 20); p.pwf = p.kf + (512u << 10); p.metaf = p.pwf + (128u << 10); p.rsm = p.metaf + (64u << 10); p.bar = p.rsm + 256;
    p.eut = ws + (12u << 20); p.evt = p.eut + (32u << 20); p.proj = p.evt + (32u << 20); p.idx = p.proj + (size_t)TL * MIXIN * 2; p.gate = p.idx + (size_t)T * HK * 4; p.lst = p.gate + (size_t)T * HK * 4;
    p.su = p.lst + (size_t)T * NH * 32 * 4; p.sv = p.su + 65536; p.sx = p.sv + 65536; p.xq = p.sx + 65536; p.wsci = p.xq + (size_t)T * D; p.wscq = p.wsci + 8192; p.hb = p.wscq + 8192;
    if ((size_t)(p.hb - ws) + (size_t)T * D * 2 > ws_size) { fprintf(stderr, "kernel_launch: workspace too small\n"); return; }
    if (hipMemsetAsync(p.bar, 0, (XCD_BAR_WORDS + 64 * 16) * 4, stream) != hipSuccess) { fprintf(stderr, "kernel_launch: memset of the barrier words failed\n"); return; }
    hipLaunchKernelGGL(k_fwd, dim3(grid_blocks), dim3(512), 0, stream, p);
}
```

```cpp
#include <hip/hip_runtime.h>
#include <cstdio>
#include <cstdint>
#include <math.h>

namespace {
constexpr int D = 1024, BATCH = 4, SEQ = 4096, NMETA = 16, L = SEQ + NMETA;
constexpr int MIXA = 512, MIXB = 512, MIXIN = 2048;
constexpr int NH = 8, NKEYS = 128, DQH = 128, TOPK = 16, HK = 128;
constexpr int T = BATCH * SEQ;
constexpr int TL = BATCH * L;
constexpr float EPS = 1e-6f;

__device__ __forceinline__ float wave_sum(float v) {
#pragma unroll
    for (int o = 32; o > 0; o >>= 1) v += __shfl_xor(v, o);
    return v;
}
#define LAS __attribute__((address_space(3)))
typedef short bf16x8 __attribute__((ext_vector_type(8)));
typedef float f32x16 __attribute__((ext_vector_type(16)));
typedef float f32x4 __attribute__((ext_vector_type(4)));
typedef float f32x2 __attribute__((ext_vector_type(2)));
typedef __bf16 bf2_t __attribute__((ext_vector_type(2)));
typedef unsigned u32x4 __attribute__((ext_vector_type(4)));
typedef unsigned u32x2 __attribute__((ext_vector_type(2)));
typedef int i32x4 __attribute__((ext_vector_type(4)));
typedef int i32x16 __attribute__((ext_vector_type(16)));

constexpr int QCH = 2;
constexpr int NTILES = T / 64;
constexpr int TROW = 2064;
constexpr int TROWB = 1040;
constexpr int LDS_TILE = 64 * TROW;
constexpr int LDS_RS = LDS_TILE;
constexpr int LDS_SSA = LDS_RS + 256;
constexpr int LDS_LUT = LDS_SSA + 256;
constexpr int LDS_BYTES = LDS_LUT + 16384;

struct Params {
    const float* x; const float* meta; const float* g_mix; const float* w_in; const float* pool_w; const float* pool_scale; const float* conv_w;
    const float* g_a; const float* g_b; const float* w_out; const float* g_ffn; const float* w_query; const float* sub_keys; const float* eu; const float* ev; const float* g_fin;
    float* out;
    unsigned char *winf, *woutf, *wqf, *kf, *pwf, *metaf, *rsm, *eut, *evt, *proj, *idx, *gate, *bar, *lst, *su, *sv, *xq, *sx, *wsci, *wscq, *hb;
};

__device__ __forceinline__ unsigned pk_bf16(float lo, float hi) { f32x2 f = {lo, hi}; return __builtin_bit_cast(unsigned, __builtin_convertvector(f, bf2_t)); }
__device__ __forceinline__ float bf_lo(unsigned u) { return __builtin_bit_cast(float, u << 16); }
__device__ __forceinline__ float bf_hi(unsigned u) { return __builtin_bit_cast(float, u & 0xffff0000u); }
__device__ __forceinline__ f32x16 mfma32(u32x4 a, u32x4 b, f32x16 c) { return __builtin_amdgcn_mfma_f32_32x32x16_bf16(__builtin_bit_cast(bf16x8, a), __builtin_bit_cast(bf16x8, b), c, 0, 0, 0); }
__device__ __forceinline__ i32x16 mfma_i8(u32x4 a, u32x4 b, i32x16 c) { return __builtin_amdgcn_mfma_i32_32x32x32_i8(__builtin_bit_cast(i32x4, a), __builtin_bit_cast(i32x4, b), c, 0, 0, 0); }
__device__ __forceinline__ i32x16 izero16() { i32x16 z; for (int i = 0; i < 16; ++i) z[i] = 0; return z; }
__device__ __forceinline__ f32x16 zero16() { f32x16 z; for (int i = 0; i < 16; ++i) z[i] = 0.f; return z; }

__device__ __forceinline__ void wave_sync() { __builtin_amdgcn_fence(__ATOMIC_RELEASE, "wavefront"); __builtin_amdgcn_wave_barrier(); __builtin_amdgcn_fence(__ATOMIC_ACQUIRE, "wavefront"); }
__device__ __forceinline__ int launder(int x) { asm volatile("" : "+v"(x)); return x; }
template <class V> __device__ __forceinline__ V ldg(const void* base, unsigned off) { return *(const V*)((const unsigned char*)base + off); }
template <class V> __device__ __forceinline__ void stg(void* base, unsigned off, V v) { *(V*)((unsigned char*)base + off) = v; }

__device__ __forceinline__ void frag_from_kn(const float* __restrict__ W, int N, const float* __restrict__ g, int i, int s, int lane, u32x4* __restrict__ dst, int I8K = 0) {
    const int r = lane & 31, h = lane >> 5, k0 = 16 * s + 8 * h;
    const float* src = W + (size_t)k0 * N + 32 * i + r;
    float v[8];
#pragma unroll
    for (int j = 0; j < 8; ++j) v[j] = src[(size_t)j * N] * (g ? g[k0 + j] : 1.0f);
    u32x4 o; o.x = pk_bf16(v[0], v[1]); o.y = pk_bf16(v[2], v[3]); o.z = pk_bf16(v[4], v[5]); o.w = pk_bf16(v[6], v[7]);
    *dst = o;
}
__device__ __forceinline__ void frag2_from_kn(const float* __restrict__ W, int N, int i, int s, int lane, u32x4* __restrict__ dst) {
    const int r = lane & 31, h = lane >> 5, k0 = 16 * s + 8 * h;
    const float* src = W + (size_t)k0 * N + 32 * i + r;
    float v[16];
#pragma unroll
    for (int j = 0; j < 8; ++j) { v[j] = src[(size_t)j * N]; v[8 + j] = src[(size_t)(16 + j) * N]; }
    u32x4 o; o.x = pk_bf16(v[0], v[1]); o.y = pk_bf16(v[2], v[3]); o.z = pk_bf16(v[4], v[5]); o.w = pk_bf16(v[6], v[7]);
    u32x4 o2; o2.x = pk_bf16(v[8], v[9]); o2.y = pk_bf16(v[10], v[11]); o2.z = pk_bf16(v[12], v[13]); o2.w = pk_bf16(v[14], v[15]);
    dst[0] = o; dst[64] = o2;
}
constexpr int J_WOUT = 0, J_WQ = J_WOUT + 32 * 64, J_PW = J_WQ, J_KEY = J_PW + 128, J_END = J_KEY + 512;
__device__ __forceinline__ void mtile_i8_block(const float* __restrict__ W, const float* __restrict__ g, int i, int tid, LAS unsigned* lds_u, u32x4* __restrict__ dst, float* __restrict__ wsc) {
    const int lane = tid & 63, wv = tid >> 6, r = lane & 31, h = lane >> 5, col = 32 * i + r;
    if (tid < 32) lds_u[tid] = 0u;
    __syncthreads();
    {
        const int cg = lane & 7, ro = lane >> 3;
        f32x4 f[16];
#pragma unroll
        for (int q = 0; q < 16; ++q) f[q] = ldg<f32x4>(W, (unsigned)((128 * wv + 8 * q + ro) * 2048 + 32 * i + 4 * cg) * 4u);
        float m0 = 0.f, m1 = 0.f, m2 = 0.f, m3 = 0.f;
#pragma unroll
        for (int q = 0; q < 16; ++q) { const float gk = g ? g[128 * wv + 8 * q + ro] : 1.0f; m0 = fmaxf(m0, fabsf(f[q][0] * gk)); m1 = fmaxf(m1, fabsf(f[q][1] * gk)); m2 = fmaxf(m2, fabsf(f[q][2] * gk)); m3 = fmaxf(m3, fabsf(f[q][3] * gk)); }
#pragma unroll
        for (int o = 8; o < 64; o <<= 1) { m0 = fmaxf(m0, __shfl_xor(m0, o)); m1 = fmaxf(m1, __shfl_xor(m1, o)); m2 = fmaxf(m2, __shfl_xor(m2, o)); m3 = fmaxf(m3, __shfl_xor(m3, o)); }
        if (lane < 8) { atomicMax((unsigned*)(lds_u + 4 * cg), __builtin_bit_cast(unsigned, m0)); atomicMax((unsigned*)(lds_u + 4 * cg + 1), __builtin_bit_cast(unsigned, m1));
            atomicMax((unsigned*)(lds_u + 4 * cg + 2), __builtin_bit_cast(unsigned, m2)); atomicMax((unsigned*)(lds_u + 4 * cg + 3), __builtin_bit_cast(unsigned, m3)); }
    }
    __syncthreads();
    const float cm = __builtin_bit_cast(float, lds_u[r]);
    const float inv = cm > 0.f ? 127.0f / cm : 0.f;
    if (wv == 0 && h == 0) wsc[col] = cm * (1.0f / 127.0f);
#pragma unroll
    for (int sl = 0; sl < 4; ++sl) {
        const int s = 4 * wv + sl, k0 = 32 * s + 16 * h;
        u32x4 o;
#pragma unroll
        for (int q = 0; q < 4; ++q) {
            unsigned w = 0u;
#pragma unroll
            for (int e = 0; e < 4; ++e) { const int k = k0 + 4 * q + e; w |= ((unsigned)(int)rintf(ldg<float>(W, (unsigned)(k * 2048 + col) * 4u) * (g ? g[k] : 1.0f) * inv) & 255u) << (8 * e); }
            o[q] = w;
        }
        dst[(size_t)s * 64 + lane] = o;
    }
    __syncthreads();
}
__device__ __forceinline__ void meta_block(const Params& p, int tid, LAS float* lds_f) {
    const int lane = tid & 63, wv = tid >> 6;
#pragma unroll
    for (int q = 0; q < 2; ++q) {
        const int row = 2 * wv + q;
        float ss = 0.f, am = 0.f;
#pragma unroll
        for (int i = 0; i < 4; ++i) { const f32x4 f = *(const f32x4*)(p.meta + (size_t)row * D + i * 256 + 4 * lane); ss += f[0] * f[0] + f[1] * f[1] + f[2] * f[2] + f[3] * f[3];
            am = fmaxf(am, fmaxf(fmaxf(fabsf(f[0]), fabsf(f[1])), fmaxf(fabsf(f[2]), fabsf(f[3])))); }
        ss = wave_sum(ss);
#pragma unroll
        for (int o = 32; o > 0; o >>= 1) am = fmaxf(am, __shfl_xor(am, o));
        if (lane == 0) { ((float*)(p.rsm))[row] = rsqrtf(ss * (1.0f / D) + EPS) * am * (1.0f / 127.0f); lds_f[row] = am; }
    }
    __syncthreads();
    const int n = lane & 31, h = lane >> 5;
    const float am = n < NMETA ? lds_f[n] : 0.f;
    const float inv = am > 0.f ? 127.0f / am : 0.f;
#pragma unroll
    for (int sl = 0; sl < 4; ++sl) {
        const int s = 4 * wv + sl;
        u32x4 o = {0u, 0u, 0u, 0u};
        if (n < NMETA) {
            const float* row = p.meta + (size_t)n * D;
#pragma unroll
            for (int q = 0; q < 4; ++q) { const f32x4 f = *(const f32x4*)(row + 32 * s + 16 * h + 4 * q);
                o[q] = ((unsigned)(int)rintf(f[0] * inv) & 255u) | (((unsigned)(int)rintf(f[1] * inv) & 255u) << 8) | (((unsigned)(int)rintf(f[2] * inv) & 255u) << 16) | (((unsigned)(int)rintf(f[3] * inv) & 255u) << 24); }
        }
        ((u32x4*)(p.metaf))[(size_t)s * 64 + lane] = o;
    }
    __syncthreads();
}

__device__ __forceinline__ void p0_prep(const Params& p, int vb, int nb, int tid, LAS unsigned char* lds) {
    const int lane = tid & 63, wv = tid >> 6, gw = vb * 8 + wv, nw = nb * 8;
    for (int job = vb; job < 129; job += nb) {
        if (job < 64) mtile_i8_block(p.w_in, p.g_mix, job, tid, (LAS unsigned*)lds, (u32x4*)(p.winf) + (size_t)job * 32 * 64, (float*)p.wsci);
        else if (job < 128) mtile_i8_block(p.w_query, nullptr, job - 64, tid, (LAS unsigned*)lds, (u32x4*)(p.wqf) + (size_t)(job - 64) * 32 * 64, (float*)p.wscq);
        else meta_block(p, tid, (LAS float*)lds);
    }
    int jw = gw, jn = nw;
    if (nb >= 129 + 64) { jw = vb >= 129 ? (vb - 129) * 8 + wv : J_END; jn = (nb - 129) * 8; }
    for (int job = jw; job < J_END / 2; job += jn) {
        if (job < J_WQ / 2) { const int q = 2 * job, i = q >> 6, sA = q & 63; frag2_from_kn(p.w_out, 1024, i, sA, lane, (u32x4*)(p.woutf) + (size_t)q * 64 + lane); }
        else if (job < J_KEY / 2) { const int q = 2 * job - J_PW, g = q >> 5, mt = (q >> 3) & 3, sA = q & 7; frag2_from_kn(p.pool_w + (size_t)g * 128 * 128, 128, mt, sA, lane, (u32x4*)(p.pwf) + (size_t)q * 64 + lane); }
        else {
            const int q = 2 * job - J_KEY, hp = q >> 5, kt = (q >> 3) & 3, sA = q & 7, r = lane & 31, h = lane >> 5;
            const float* src = p.sub_keys + ((size_t)hp * 128 + 32 * kt + r) * 128 + 16 * sA + 4 * h;
            const f32x4 f0 = *(const f32x4*)src, f1 = *(const f32x4*)(src + 8), f2 = *(const f32x4*)(src + 16), f3 = *(const f32x4*)(src + 24);
            u32x4 o; o.x = pk_bf16(f0[0], f0[1]); o.y = pk_bf16(f0[2], f0[3]); o.z = pk_bf16(f1[0], f1[1]); o.w = pk_bf16(f1[2], f1[3]);
            u32x4 o2; o2.x = pk_bf16(f2[0], f2[1]); o2.y = pk_bf16(f2[2], f2[3]); o2.z = pk_bf16(f3[0], f3[1]); o2.w = pk_bf16(f3[2], f3[3]);
            ((u32x4*)(p.kf))[(size_t)q * 64 + lane] = o; ((u32x4*)(p.kf))[(size_t)(q + 1) * 64 + lane] = o2;
        }
    }
}

struct TabBatch { f32x4 f[4][4]; };
__device__ __forceinline__ int tab_rpb(int nb) { return ((2 * 16384 + nb - 1) / nb + 31) & ~31; }
__device__ __forceinline__ int tab_row(int vb, int nb, int wv, int i) { const int rpb = tab_rpb(nb), row = vb * rpb + 8 * i + wv; return (8 * i + wv < rpb && row < 2 * 16384) ? row : -1; }
__device__ __forceinline__ void tab_issue(const Params& p, int vb, int nb, int wv, int i0, int lane, TabBatch& t) {
#pragma unroll
    for (int q = 0; q < 4; ++q) {
        const int row = tab_row(vb, nb, wv, i0 + q);
        if (row >= 0) { const float* src = (row < 16384 ? p.eu : p.ev) + (size_t)(row & 16383) * D;
#pragma unroll
            for (int i = 0; i < 4; ++i) t.f[q][i] = ldg<f32x4>(src, (unsigned)(i * 256 + 4 * lane) * 4u); }
    }
}
__device__ __forceinline__ void tab_finish(const Params& p, int vb, int nb, int wv, int i0, int lane, const TabBatch& t) {
#pragma unroll
    for (int q = 0; q < 4; ++q) {
        const int row = tab_row(vb, nb, wv, i0 + q);
        if (row >= 0) {
            const bool isu = row < 16384; const int rr = row & 16383;
            float am = 0.f;
#pragma unroll
            for (int i = 0; i < 4; ++i) am = fmaxf(am, fmaxf(fmaxf(fabsf(t.f[q][i][0]), fabsf(t.f[q][i][1])), fmaxf(fabsf(t.f[q][i][2]), fabsf(t.f[q][i][3]))));
#pragma unroll
            for (int o = 32; o > 0; o >>= 1) am = fmaxf(am, __shfl_xor(am, o));
            if (isu) {
                const float inv = am > 0.f ? 127.0f / am : 0.f;
#pragma unroll
                for (int i = 0; i < 4; ++i) {
                    unsigned w = 0u;
#pragma unroll
                    for (int e = 0; e < 4; ++e) { const int qv = (int)rintf(t.f[q][i][e] * inv); w |= ((unsigned)qv & 255u) << (8 * e); }
                    const unsigned c = (unsigned)(i * 256 + 4 * lane);
                    stg<unsigned>(p.eut, (((c >> 7) * 16384u + (unsigned)rr) << 7) + (c & 127u), w);
                }
                if (lane == 0) ((float*)p.su)[rr] = am * (1.0f / 127.0f);
            } else {
                const float inv = am > 0.f ? 7.0f / am : 0.f;
#pragma unroll
                for (int i = 0; i < 4; ++i) {
                    const int q0 = (int)rintf(t.f[q][i][0] * inv) + 8, q1 = (int)rintf(t.f[q][i][1] * inv), q2 = (int)rintf(t.f[q][i][2] * inv) + 8, q3 = (int)rintf(t.f[q][i][3] * inv);
                    const unsigned w = ((unsigned)q0 & 15u) | (((unsigned)q1 & 15u) << 4) | (((unsigned)q2 & 15u) << 8) | (((unsigned)q3 & 15u) << 12);
                    stg<unsigned short>(p.evt, (((unsigned)i * 16384u + (unsigned)rr) << 7) + (unsigned)lane * 2u, (unsigned short)w);
                }
                if (lane == 0) ((float*)p.sv)[rr] = am * (1.0f / 7.0f);
            }
        }
    }
}


template <int CH>
__device__ __forceinline__ void gemm22_chunk(const u32x4 (&a)[2][CH], const LAS unsigned char* b, int s0, f32x16 (&acc)[2][2]) {
#pragma unroll
    for (int u = 0; u < CH; ++u) {
        const u32x4 b0 = *(const LAS u32x4*)(b + (s0 + u) * 32), b1 = *(const LAS u32x4*)(b + 32 * TROW + (s0 + u) * 32);
        acc[0][0] = mfma32(a[0][u], b0, acc[0][0]); acc[0][1] = mfma32(a[0][u], b1, acc[0][1]);
        acc[1][0] = mfma32(a[1][u], b0, acc[1][0]); acc[1][1] = mfma32(a[1][u], b1, acc[1][1]);
    }
}
template <int KS, int CH = 4>
__device__ __forceinline__ void gemm22(const u32x4* abase, unsigned lane, const LAS unsigned char* b, f32x16 (&acc)[2][2], int kofs = 0) {
    constexpr int NC = KS / CH;
    static_assert(NC % 2 == 0 && (NC & (NC - 1)) == 0, "chunk count: even power of two");
    u32x4 pa[2][CH], pb[2][CH];
    const unsigned lo = lane * 16u;
    {
        const unsigned o0 = lo + (unsigned)((kofs & (NC - 1)) * CH) * 1024u;
#pragma unroll
        for (int u = 0; u < CH; ++u) { pa[0][u] = ldg<u32x4>(abase, o0 + u * 1024u); pa[1][u] = ldg<u32x4>(abase, o0 + (KS + u) * 1024u); }
    }
#pragma unroll 1
    for (int c = 0; c < NC; c += 2) {
        const int c0 = (c + kofs) & (NC - 1), c1 = (c + 1 + kofs) & (NC - 1), c2 = (c + 2 + kofs) & (NC - 1);
        const unsigned o1 = lo + (unsigned)(c1 * CH) * 1024u, o2 = lo + (unsigned)(c2 * CH) * 1024u;
#pragma unroll
        for (int u = 0; u < CH; ++u) { pb[0][u] = ldg<u32x4>(abase, o1 + u * 1024u); pb[1][u] = ldg<u32x4>(abase, o1 + (KS + u) * 1024u); }
        __builtin_amdgcn_sched_barrier(0);
        gemm22_chunk<CH>(pa, b, c0 * CH, acc);
        __builtin_amdgcn_sched_barrier(0);
#pragma unroll
        for (int u = 0; u < CH; ++u) { pa[0][u] = ldg<u32x4>(abase, o2 + u * 1024u); pa[1][u] = ldg<u32x4>(abase, o2 + (KS + u) * 1024u); }
        __builtin_amdgcn_sched_barrier(0);
        gemm22_chunk<CH>(pb, b, c1 * CH, acc);
        __builtin_amdgcn_sched_barrier(0);
    }
}

template <int CH>
__device__ __forceinline__ void gemm22i_chunk(const u32x4 (&a)[2][CH], const LAS unsigned char* b, int s0, i32x16 (&acc)[2][2]) {
#pragma unroll
    for (int u = 0; u < CH; ++u) {
        const u32x4 b0 = *(const LAS u32x4*)(b + (s0 + u) * 32), b1 = *(const LAS u32x4*)(b + 32 * TROWB + (s0 + u) * 32);
        acc[0][0] = mfma_i8(a[0][u], b0, acc[0][0]); acc[0][1] = mfma_i8(a[0][u], b1, acc[0][1]);
        acc[1][0] = mfma_i8(a[1][u], b0, acc[1][0]); acc[1][1] = mfma_i8(a[1][u], b1, acc[1][1]);
    }
}
template <int KS, int CH = 4>
__device__ __forceinline__ void gemm22i(const u32x4* abase, unsigned lane, const LAS unsigned char* b, i32x16 (&acc)[2][2], int kofs = 0) {
    constexpr int NC = KS / CH;
    static_assert(NC % 2 == 0 && (NC & (NC - 1)) == 0, "chunk count: even power of two");
    u32x4 pa[2][CH], pb[2][CH];
    const unsigned lo = lane * 16u;
    {
        const unsigned o0 = lo + (unsigned)((kofs & (NC - 1)) * CH) * 1024u;
#pragma unroll
        for (int u = 0; u < CH; ++u) { pa[0][u] = ldg<u32x4>(abase, o0 + u * 1024u); pa[1][u] = ldg<u32x4>(abase, o0 + (KS + u) * 1024u); }
    }
#pragma unroll 1
    for (int c = 0; c < NC; c += 2) {
        const int c0 = (c + kofs) & (NC - 1), c1 = (c + 1 + kofs) & (NC - 1), c2 = (c + 2 + kofs) & (NC - 1);
        const unsigned o1 = lo + (unsigned)(c1 * CH) * 1024u, o2 = lo + (unsigned)(c2 * CH) * 1024u;
#pragma unroll
        for (int u = 0; u < CH; ++u) { pb[0][u] = ldg<u32x4>(abase, o1 + u * 1024u); pb[1][u] = ldg<u32x4>(abase, o1 + (KS + u) * 1024u); }
        __builtin_amdgcn_sched_barrier(0);
        gemm22i_chunk<CH>(pa, b, c0 * CH, acc);
        __builtin_amdgcn_sched_barrier(0);
#pragma unroll
        for (int u = 0; u < CH; ++u) { pa[0][u] = ldg<u32x4>(abase, o2 + u * 1024u); pa[1][u] = ldg<u32x4>(abase, o2 + (KS + u) * 1024u); }
        __builtin_amdgcn_sched_barrier(0);
        gemm22i_chunk<CH>(pb, b, c1 * CH, acc);
        __builtin_amdgcn_sched_barrier(0);
    }
}

__device__ __forceinline__ void p1_stage(const Params& p, int tile, int tid, LAS unsigned char* lds) {
    const int lane = tid & 63, wv = __builtin_amdgcn_readfirstlane(tid >> 6);
    LAS float* rs = (LAS float*)(lds + LDS_RS);
    const float* xt = p.x + (size_t)tile * 64 * D;
#pragma unroll 4
    for (int rr = 0; rr < 8; ++rr) {
        const int tk = 8 * wv + rr;
        f32x4 f[4]; float ss = 0.f, am = 0.f;
#pragma unroll
        for (int i = 0; i < 4; ++i) { f[i] = ldg<f32x4>(xt, (unsigned)(tk * D + i * 256 + 4 * lane) * 4u); ss += f[i][0] * f[i][0] + f[i][1] * f[i][1] + f[i][2] * f[i][2] + f[i][3] * f[i][3];
            am = fmaxf(am, fmaxf(fmaxf(fabsf(f[i][0]), fabsf(f[i][1])), fmaxf(fabsf(f[i][2]), fabsf(f[i][3])))); }
        ss = wave_sum(ss);
#pragma unroll
        for (int o = 32; o > 0; o >>= 1) am = fmaxf(am, __shfl_xor(am, o));
        const float inv = am > 0.f ? 127.0f / am : 0.f;
        if (lane == 0) rs[tk] = rsqrtf(ss * (1.0f / D) + EPS) * am * (1.0f / 127.0f);
#pragma unroll
        for (int i = 0; i < 4; ++i) {
            unsigned w = 0u;
#pragma unroll
            for (int e = 0; e < 4; ++e) w |= ((unsigned)(int)rintf(f[i][e] * inv) & 255u) << (8 * e);
            *(LAS unsigned*)(lds + tk * TROWB + i * 256 + 4 * lane) = w;
        }
    }
    __syncthreads();
}
__device__ __forceinline__ void p1_inproj(const Params& p, int tile, int tid, LAS unsigned char* lds, int vb, int nb, bool do_tab) {
    const int lane = launder(tid) & 63, wv = __builtin_amdgcn_readfirstlane(tid >> 6), r = lane & 31, h = lane >> 5;
    const int b = tile >> 6, s0 = (tile & 63) * 64;
    LAS float* rs = (LAS float*)(lds + LDS_RS);
    const u32x4* WF = (const u32x4*)(p.winf);
    unsigned char* prow0 = p.proj + ((size_t)b * L + NMETA + s0) * (MIXIN * 2);
    const LAS unsigned char* bp = lds + r * TROWB + h * 16;
    const float rs0 = rs[r], rs1 = rs[32 + r];
    const int stg_k = (tile >> 3) & 7, stg_r = (tile >> 6) & 3;
#pragma unroll 1
    for (int rdx = 0; rdx < 4; ++rdx) {
        const int rd = (rdx + stg_r) & 3;
        const int i0 = 8 * wv + 2 * rd;
        TabBatch tb;
        if (do_tab) tab_issue(p, vb, nb, wv, 4 * rdx, lane, tb);
        __builtin_amdgcn_sched_barrier(0);
        i32x16 acc[2][2]; acc[0][0] = izero16(); acc[0][1] = izero16(); acc[1][0] = izero16(); acc[1][1] = izero16();
        gemm22i<32, 4>(WF + (size_t)i0 * 32 * 64, lane, bp, acc, stg_k);
        f32x4 wsv[2][4];
#pragma unroll
        for (int mi = 0; mi < 2; ++mi)
#pragma unroll
            for (int q = 0; q < 4; ++q) wsv[mi][q] = ldg<f32x4>(p.wsci, (unsigned)(32 * (i0 + mi) + 8 * q + 4 * h) * 4u);
        LAS unsigned char* eb = lds + 64 * TROWB + wv * 8192;
#pragma unroll
        for (int mi = 0; mi < 2; ++mi)
#pragma unroll
            for (int q = 0; q < 4; ++q) {
                const f32x4 ws = wsv[mi][q];
#pragma unroll
                for (int nt = 0; nt < 2; ++nt) {
                    const float rv = nt ? rs1 : rs0;
                    u32x2 o; o.x = pk_bf16((float)acc[mi][nt][4 * q] * rv * ws[0], (float)acc[mi][nt][4 * q + 1] * rv * ws[1]); o.y = pk_bf16((float)acc[mi][nt][4 * q + 2] * rv * ws[2], (float)acc[mi][nt][4 * q + 3] * rv * ws[3]);
                    *(LAS u32x2*)(eb + (nt * 32 + r) * 128 + (((4 * mi + q) ^ (r & 7)) * 16) + 8 * h) = o;
                }
            }
        wave_sync();
        {
            u32x4 ov[8];
#pragma unroll
            for (int k = 0; k < 8; ++k) { const int row = 8 * k + (lane >> 3); ov[k] = *(const LAS u32x4*)(eb + row * 128 + (((lane & 7) ^ (row & 7)) * 16)); }
            wave_sync();
#pragma unroll
            for (int k = 0; k < 8; ++k) { const int row = 8 * k + (lane >> 3); stg<u32x4>(prow0, (unsigned)(row * MIXIN + 32 * i0) * 2u + (unsigned)(lane & 7) * 16u, ov[k]); }
        }
        if (do_tab) tab_finish(p, vb, nb, wv, 4 * rdx, lane, tb);
    }
    if (do_tab) for (int i0 = 16; 8 * i0 < tab_rpb(nb); i0 += 4) { TabBatch tb; tab_issue(p, vb, nb, wv, i0, lane, tb); tab_finish(p, vb, nb, wv, i0, lane, tb); }
}
__device__ __forceinline__ void p1_meta(const Params& p, int mp, int lane) {
    const int r = lane & 31, h = lane >> 5;
    const u32x4* A = (const u32x4*)(p.winf) + (size_t)(2 * mp) * 32 * 64;
    const u32x4* B = (const u32x4*)(p.metaf);
    i32x16 acc0 = izero16(), acc1 = izero16();
#pragma unroll 4
    for (int s = 0; s < 32; ++s) { const u32x4 bf = ldg<u32x4>(B, (unsigned)(s * 64 + lane) * 16u);
        acc0 = mfma_i8(ldg<u32x4>(A, (unsigned)(s * 64 + lane) * 16u), bf, acc0); acc1 = mfma_i8(ldg<u32x4>(A, (unsigned)((32 + s) * 64 + lane) * 16u), bf, acc1); }
    if (r < NMETA) {
        const float rv = ((const float*)(p.rsm))[r];
#pragma unroll
        for (int q = 0; q < 4; ++q) {
            const f32x4 w0 = ldg<f32x4>(p.wsci, (unsigned)(64 * mp + 8 * q + 4 * h) * 4u), w1 = ldg<f32x4>(p.wsci, (unsigned)(64 * mp + 32 + 8 * q + 4 * h) * 4u);
            u32x2 o0, o1;
            o0.x = pk_bf16((float)acc0[4 * q] * rv * w0[0], (float)acc0[4 * q + 1] * rv * w0[1]); o0.y = pk_bf16((float)acc0[4 * q + 2] * rv * w0[2], (float)acc0[4 * q + 3] * rv * w0[3]);
            o1.x = pk_bf16((float)acc1[4 * q] * rv * w1[0], (float)acc1[4 * q + 1] * rv * w1[1]); o1.y = pk_bf16((float)acc1[4 * q + 2] * rv * w1[2], (float)acc1[4 * q + 3] * rv * w1[3]);
#pragma unroll
            for (int bb = 0; bb < BATCH; ++bb) {
                const unsigned ro = (unsigned)((bb * L + r) * MIXIN + 64 * mp + 4 * h) * 2u;
                stg<u32x2>(p.proj, ro + 16u * q, o0); stg<u32x2>(p.proj, ro + 64u + 16u * q, o1);
            }
        }
    }
}

template <int LOGN> __device__ __forceinline__ void bitonic_sort_desc(float* v) {
    constexpr int N = 1 << LOGN;
#pragma unroll
    for (int lk = 1; lk <= LOGN; ++lk) {
#pragma unroll
        for (int lj = lk - 1; lj >= 0; --lj) {
#pragma unroll
            for (int i = 0; i < N; ++i) {
                const int k = 1 << lk, j = 1 << lj, l = i ^ j;
                if (l > i) { const bool up = ((i & k) == 0); const float a = v[i], c = v[l]; const float hi = fmaxf(a, c), lo = fminf(a, c); v[i] = up ? hi : lo; v[l] = up ? lo : hi; }
            }
        }
    }
}
__device__ __forceinline__ void bitonic_merge16_desc(float* v) {
#pragma unroll
    for (int lj = 3; lj >= 0; --lj) {
#pragma unroll
        for (int i = 0; i < 16; ++i) { const int j = 1 << lj, l = i ^ j; if (l > i) { const float a = v[i], c = v[l]; v[i] = fmaxf(a, c); v[l] = fminf(a, c); } }
    }
}
__device__ __forceinline__ void merge_top16(float* a, const float* c) {
#pragma unroll
    for (int i = 0; i < 16; ++i) a[i] = fmaxf(a[i], c[15 - i]);
    bitonic_merge16_desc(a);
}
__device__ __forceinline__ void top16_of_64(float* v) {
    bitonic_sort_desc<4>(v); bitonic_sort_desc<4>(v + 16); bitonic_sort_desc<4>(v + 32); bitonic_sort_desc<4>(v + 48);
    merge_top16(v, v + 16); merge_top16(v + 32, v + 48); merge_top16(v, v + 32);
}
__device__ __forceinline__ float embed_bits(float x, unsigned mask, unsigned code) { return __builtin_bit_cast(float, (__builtin_bit_cast(unsigned, x) & ~mask) | code); }

template <int W>
__device__ __forceinline__ void pool_window(const unsigned char* pbat, int p0, int cp, LAS unsigned char* dst) {
    unsigned u[31 + W];
#pragma unroll
    for (int i = 0; i < 31 + W; ++i) u[i] = ldg<unsigned>(pbat + (size_t)(p0 - (W - 1) + i) * 4096u, cp * 4u);
    float sx = 0.f, sy = 0.f;
#pragma unroll
    for (int i = 0; i < W - 1; ++i) { sx += bf_lo(u[i]); sy += bf_hi(u[i]); }
    const float invw = 1.0f / (float)W;
#pragma unroll
    for (int tk = 0; tk < 32; ++tk) {
        const float lo = bf_lo(u[W - 1 + tk]), hi = bf_hi(u[W - 1 + tk]);
        sx += lo; sy += hi;
        *(LAS unsigned*)(dst + tk * TROW) = pk_bf16(sx * invw - lo, sy * invw - hi);
        sx -= bf_lo(u[tk]); sy -= bf_hi(u[tk]);
    }
}

template <int RB>
__device__ __forceinline__ void p2_xf_batch(const Params& p, int tile, int wv, int lane, LAS unsigned char* lds, unsigned char* ht, f32x4 (&f)[4][4], const u32x2 (&hq)[8][4], const f32x4 (&gg)[4]) {
    unsigned char* xqt = p.xq + (size_t)tile * 64 * D;
#pragma unroll
    for (int rr = 0; rr < 4; ++rr) {
        const int tk = 8 * wv + RB + rr;
        float ss = 0.f;
#pragma unroll
        for (int i = 0; i < 4; ++i) {
            const u32x2 hw = hq[RB + rr][i];
            f[rr][i][0] += bf_lo(hw.x); f[rr][i][1] += bf_hi(hw.x); f[rr][i][2] += bf_lo(hw.y); f[rr][i][3] += bf_hi(hw.y);
            u32x2 ho; ho.x = pk_bf16(f[rr][i][0], f[rr][i][1]); ho.y = pk_bf16(f[rr][i][2], f[rr][i][3]);
            stg<u32x2>(ht, (unsigned)(tk * D + i * 256 + 4 * lane) * 2u, ho);
            ss += f[rr][i][0] * f[rr][i][0] + f[rr][i][1] * f[rr][i][1] + f[rr][i][2] * f[rr][i][2] + f[rr][i][3] * f[rr][i][3];
        }
        ss = wave_sum(ss);
        const float rv = rsqrtf(ss * (1.0f / D) + EPS);
        float am = 0.f;
#pragma unroll
        for (int i = 0; i < 4; ++i)
#pragma unroll
            for (int e = 0; e < 4; ++e) { f[rr][i][e] *= rv * gg[i][e]; am = fmaxf(am, fabsf(f[rr][i][e])); }
#pragma unroll
        for (int o = 32; o > 0; o >>= 1) am = fmaxf(am, __shfl_xor(am, o));
        const float inv = am > 0.f ? 127.0f / am : 0.f;
#pragma unroll
        for (int i = 0; i < 4; ++i) {
            unsigned w = 0u;
#pragma unroll
            for (int e = 0; e < 4; ++e) w |= ((unsigned)(int)rintf(f[rr][i][e] * inv) & 255u) << (8 * e);
            stg<unsigned>(xqt, (unsigned)(tk * D + i * 256 + 4 * lane), w);
            *(LAS unsigned*)(lds + tk * TROWB + i * 256 + 4 * lane) = w;
        }
        if (lane == 0) { ((LAS float*)(lds + LDS_RS))[tk] = am * (1.0f / 127.0f); ((float*)p.sx)[tile * 64 + tk] = am * (1.0f / 127.0f); }
    }
}

__device__ __forceinline__ void p2_mix(const Params& p, int tile, int tid, LAS unsigned char* lds) {
    const int wv = __builtin_amdgcn_readfirstlane(tid >> 6);
    const int b = tile >> 6, s0 = (tile & 63) * 64;
    LAS float* ssa = (LAS float*)(lds + LDS_SSA);
    const unsigned char* pbat = p.proj + (size_t)b * L * (MIXIN * 2);
    const float* xt = p.x + (size_t)tile * 64 * D;
    unsigned char* ht = p.hb + (size_t)tile * 64 * D * 2;
    if (tid < 64) ssa[tid] = 0.f;
    {
        const int lane = launder(tid) & 63, r = lane & 31, h = lane >> 5; (void)r; (void)h;
        float cw[3][8], gbv[8], u1[8], u2[8];
#pragma unroll
        for (int k = 0; k < 3; ++k) { const f32x4 a = ldg<f32x4>(p.conv_w, (unsigned)(k * MIXB + 8 * lane) * 4u), c = ldg<f32x4>(p.conv_w, (unsigned)(k * MIXB + 8 * lane + 4) * 4u);
#pragma unroll
            for (int e = 0; e < 4; ++e) { cw[k][e] = a[e]; cw[k][4 + e] = c[e]; } }
        { const f32x4 a = ldg<f32x4>(p.g_b, (unsigned)(8 * lane) * 4u), c = ldg<f32x4>(p.g_b, (unsigned)(8 * lane + 4) * 4u);
#pragma unroll
            for (int e = 0; e < 4; ++e) { gbv[e] = a[e]; gbv[4 + e] = c[e]; } }
        const int p0 = NMETA + s0 + 8 * wv;
        u32x4 bvv[8], cvv[10], vvv[10];
#pragma unroll
        for (int i = 0; i < 10; ++i) { const unsigned ro = (unsigned)(p0 - 2 + i) * 4096u + lane * 16u; cvv[i] = ldg<u32x4>(pbat, ro + 2048u); vvv[i] = ldg<u32x4>(pbat, ro + 3072u); if (i >= 2) bvv[i - 2] = ldg<u32x4>(pbat, ro + 1024u); }
    {
        const int cp = tid & 255, th = __builtin_amdgcn_readfirstlane(tid >> 8), g = __builtin_amdgcn_readfirstlane(cp >> 6);
        const int p0 = NMETA + s0 + 32 * th;
        LAS unsigned char* dst = lds + (32 * th) * TROW + cp * 4;
        if (g == 0) pool_window<2>(pbat, p0, cp, dst); else if (g == 1) pool_window<4>(pbat, p0, cp, dst); else if (g == 2) pool_window<8>(pbat, p0, cp, dst); else pool_window<16>(pbat, p0, cp, dst);
    }
#pragma unroll
        for (int e = 0; e < 4; ++e) { u2[2 * e] = bf_lo(cvv[0][e]) * bf_lo(vvv[0][e]); u2[2 * e + 1] = bf_hi(cvv[0][e]) * bf_hi(vvv[0][e]); u1[2 * e] = bf_lo(cvv[1][e]) * bf_lo(vvv[1][e]); u1[2 * e + 1] = bf_hi(cvv[1][e]) * bf_hi(vvv[1][e]); }
#pragma unroll
        for (int tk = 0; tk < 8; ++tk) {
            const u32x4 bv = bvv[tk], cv = cvv[tk + 2], vv = vvv[tk + 2];
            float z[8], ss = 0.f;
#pragma unroll
            for (int e = 0; e < 8; ++e) {
                const float bb = (e & 1) ? bf_hi(bv[e >> 1]) : bf_lo(bv[e >> 1]);
                const float u0 = ((e & 1) ? bf_hi(cv[e >> 1]) : bf_lo(cv[e >> 1])) * ((e & 1) ? bf_hi(vv[e >> 1]) : bf_lo(vv[e >> 1]));
                const float conv = u2[e] * cw[0][e] + u1[e] * cw[1][e] + u0 * cw[2][e];
                z[e] = bb * conv; ss += z[e] * z[e];
                u2[e] = u1[e]; u1[e] = u0;
            }
            ss = wave_sum(ss);
            const float rsb = rsqrtf(ss * (1.0f / MIXB) + EPS);
            u32x4 o; o.x = pk_bf16(z[0] * rsb * gbv[0], z[1] * rsb * gbv[1]); o.y = pk_bf16(z[2] * rsb * gbv[2], z[3] * rsb * gbv[3]);
            o.z = pk_bf16(z[4] * rsb * gbv[4], z[5] * rsb * gbv[5]); o.w = pk_bf16(z[6] * rsb * gbv[6], z[7] * rsb * gbv[7]);
            *(LAS u32x4*)(lds + (8 * wv + tk) * TROW + (MIXA + 8 * lane) * 2) = o;
        }
    }
    __syncthreads();
    {
        const int lane = launder(tid) & 63, r = lane & 31, h = lane >> 5; (void)r; (void)h;
        const int g = wv >> 1, dh = wv & 1;
        const u32x4* PWF = (const u32x4*)(p.pwf);
        f32x16 acc[2][2]; acc[0][0] = zero16(); acc[0][1] = zero16(); acc[1][0] = zero16(); acc[1][1] = zero16();
        gemm22<8>(PWF + (size_t)((g * 4 + 2 * dh) * 8) * 64, lane, lds + r * TROW + g * 256 + h * 16, acc);
        float ss0 = 0.f, ss1 = 0.f;
#pragma unroll
        for (int mi = 0; mi < 2; ++mi)
#pragma unroll
            for (int q = 0; q < 4; ++q) {
                const int d = g * 128 + 32 * (2 * dh + mi) + 8 * q + 4 * h;
                const f32x4 sc = ldg<f32x4>(p.pool_scale, (unsigned)d * 4u);
#pragma unroll
                for (int e = 0; e < 4; ++e) { acc[mi][0][4 * q + e] *= sc[e]; acc[mi][1][4 * q + e] *= sc[e]; ss0 += acc[mi][0][4 * q + e] * acc[mi][0][4 * q + e]; ss1 += acc[mi][1][4 * q + e] * acc[mi][1][4 * q + e]; }
            }
        ss0 += __shfl_xor(ss0, 32); ss1 += __shfl_xor(ss1, 32);
        if (h == 0) { atomicAdd((float*)(ssa + r), ss0); atomicAdd((float*)(ssa + 32 + r), ss1); }
        __syncthreads();
        const float ra0 = rsqrtf(ssa[r] * (1.0f / MIXA) + EPS), ra1 = rsqrtf(ssa[32 + r] * (1.0f / MIXA) + EPS);
#pragma unroll
        for (int mi = 0; mi < 2; ++mi)
#pragma unroll
            for (int q = 0; q < 4; ++q) {
                const int d = g * 128 + 32 * (2 * dh + mi) + 8 * q + 4 * h;
                const f32x4 gg = ldg<f32x4>(p.g_a, (unsigned)d * 4u);
                u32x2 o0, o1;
                o0.x = pk_bf16(acc[mi][0][4 * q] * ra0 * gg[0], acc[mi][0][4 * q + 1] * ra0 * gg[1]); o0.y = pk_bf16(acc[mi][0][4 * q + 2] * ra0 * gg[2], acc[mi][0][4 * q + 3] * ra0 * gg[3]);
                o1.x = pk_bf16(acc[mi][1][4 * q] * ra1 * gg[0], acc[mi][1][4 * q + 1] * ra1 * gg[1]); o1.y = pk_bf16(acc[mi][1][4 * q + 2] * ra1 * gg[2], acc[mi][1][4 * q + 3] * ra1 * gg[3]);
                *(LAS u32x2*)(lds + r * TROW + d * 2) = o0;
                *(LAS u32x2*)(lds + (32 + r) * TROW + d * 2) = o1;
            }
    }
    __syncthreads();
    f32x4 xa[4][4];
    {
        const int lane = launder(tid) & 63, r = lane & 31, h = lane >> 5; (void)r; (void)h;
#pragma unroll
        for (int rr = 0; rr < 4; ++rr)
#pragma unroll
            for (int i = 0; i < 4; ++i) xa[rr][i] = ldg<f32x4>(xt, (unsigned)((8 * wv + rr) * D + i * 256 + 4 * lane) * 4u);
        const u32x4* WF = (const u32x4*)(p.woutf);
        const LAS unsigned char* bp = lds + r * TROW + h * 16;
#pragma unroll 1
        for (int rdx = 0; rdx < 2; ++rdx) {
            const int rd = (rdx + (tile >> 7)) & 1;
            const int i0 = 4 * wv + 2 * rd;
            f32x16 acc[2][2]; acc[0][0] = zero16(); acc[0][1] = zero16(); acc[1][0] = zero16(); acc[1][1] = zero16();
            gemm22<64>(WF + (size_t)i0 * 64 * 64, lane, bp, acc, (tile >> 3) & 15);
            LAS unsigned char* eb = lds + LDS_LUT + wv * 2048;
#pragma unroll
            for (int nt = 0; nt < 2; ++nt)
#pragma unroll
                for (int hf = 0; hf < 2; ++hf) {
                    if ((r >> 4) == hf) {
#pragma unroll
                        for (int mi = 0; mi < 2; ++mi)
#pragma unroll
                            for (int q = 0; q < 4; ++q) {
                                u32x2 hw; hw.x = pk_bf16(acc[mi][nt][4 * q], acc[mi][nt][4 * q + 1]); hw.y = pk_bf16(acc[mi][nt][4 * q + 2], acc[mi][nt][4 * q + 3]);
                                *(LAS u32x2*)(eb + (r & 15) * 128 + (((4 * mi + q) ^ (r & 7)) * 16) + 8 * h) = hw;
                            }
                    }
                    wave_sync();
                    u32x4 ov[2];
#pragma unroll
                    for (int k = 0; k < 2; ++k) { const int row = 8 * k + (lane >> 3); ov[k] = *(const LAS u32x4*)(eb + row * 128 + (((lane & 7) ^ (row & 7)) * 16)); }
                    wave_sync();
#pragma unroll
                    for (int k = 0; k < 2; ++k) { const int row = 8 * k + (lane >> 3); stg<u32x4>(ht, (unsigned)((nt * 32 + hf * 16 + row) * D + 32 * i0) * 2u + (unsigned)(lane & 7) * 16u, ov[k]); }
                }
        }
    }
    __syncthreads();
    {
        const int lane = launder(tid) & 63;
        f32x4 gg[4];
#pragma unroll
        for (int i = 0; i < 4; ++i) gg[i] = ldg<f32x4>(p.g_ffn, (unsigned)(i * 256 + 4 * lane) * 4u);
        f32x4 xb[4][4];
#pragma unroll
        for (int rr = 0; rr < 4; ++rr)
#pragma unroll
            for (int i = 0; i < 4; ++i) xb[rr][i] = ldg<f32x4>(xt, (unsigned)((8 * wv + 4 + rr) * D + i * 256 + 4 * lane) * 4u);
        u32x2 hq[8][4];
#pragma unroll
        for (int rr = 0; rr < 4; ++rr)
#pragma unroll
            for (int i = 0; i < 4; ++i) hq[rr][i] = ldg<u32x2>(ht, (unsigned)((8 * wv + rr) * D + i * 256 + 4 * lane) * 2u);
        p2_xf_batch<0>(p, tile, wv, lane, lds, ht, xa, hq, gg);
#pragma unroll
        for (int rr = 4; rr < 8; ++rr)
#pragma unroll
            for (int i = 0; i < 4; ++i) hq[rr][i] = ldg<u32x2>(ht, (unsigned)((8 * wv + rr) * D + i * 256 + 4 * lane) * 2u);
        p2_xf_batch<4>(p, tile, wv, lane, lds, ht, xb, hq, gg);
    }
    __syncthreads();
    {
        const int lane = launder(tid) & 63, r = lane & 31, h = lane >> 5; (void)r; (void)h;
        const int hd = wv;
        const u32x4* WQF = (const u32x4*)(p.wqf);
        const u32x4* KF = (const u32x4*)(p.kf);
        unsigned char* lstt = p.lst + (size_t)tile * 64 * (NH * 32 * 4);
        const LAS unsigned char* bp = lds + r * TROWB + h * 16;
        const float sx0 = ((const LAS float*)(lds + LDS_RS))[r], sx1 = ((const LAS float*)(lds + LDS_RS))[32 + r];
        LAS unsigned char* lut = lds + LDS_LUT + wv * 2048;
#pragma unroll
        for (int pp = 0; pp < 2; ++pp) {
            const int hp = hd * 2 + pp;
            u32x4 qb[8];
            LAS u32x4* qpark = (LAS u32x4*)(lds + 64 * TROWB + wv * 8192) + lane;
#pragma unroll
            for (int mh = 0; mh < 2; ++mh) {
                const int mt0 = hp * 4 + mh * 2;
                i32x16 acc[2][2]; acc[0][0] = izero16(); acc[0][1] = izero16(); acc[1][0] = izero16(); acc[1][1] = izero16();
                gemm22i<32, QCH>(WQF + (size_t)mt0 * 32 * 64, lane, bp, acc, (tile >> 3));
#pragma unroll
                for (int mi = 0; mi < 2; ++mi)
#pragma unroll
                    for (int s2 = 0; s2 < 2; ++s2) {
                        const f32x4 w0 = ldg<f32x4>(p.wscq, (unsigned)(32 * (mt0 + mi) + 16 * s2 + 4 * h) * 4u), w1 = ldg<f32x4>(p.wscq, (unsigned)(32 * (mt0 + mi) + 16 * s2 + 8 + 4 * h) * 4u);
#pragma unroll
                        for (int nt = 0; nt < 2; ++nt) {
                            const float xs = nt ? sx1 : sx0;
                            u32x4 o; o.x = pk_bf16((float)acc[mi][nt][8 * s2] * xs * w0[0], (float)acc[mi][nt][8 * s2 + 1] * xs * w0[1]); o.y = pk_bf16((float)acc[mi][nt][8 * s2 + 2] * xs * w0[2], (float)acc[mi][nt][8 * s2 + 3] * xs * w0[3]);
                            o.z = pk_bf16((float)acc[mi][nt][8 * s2 + 4] * xs * w1[0], (float)acc[mi][nt][8 * s2 + 5] * xs * w1[1]); o.w = pk_bf16((float)acc[mi][nt][8 * s2 + 6] * xs * w1[2], (float)acc[mi][nt][8 * s2 + 7] * xs * w1[3]);
                            if (nt == 0) qb[2 * (mh * 2 + mi) + s2] = o; else qpark[(2 * (mh * 2 + mi) + s2) * 64] = o;
                        }
                    }
            }
#pragma unroll
            for (int nt = 0; nt < 2; ++nt) {
                float top[16];
#pragma unroll
                for (int i = 0; i < 16; ++i) top[i] = -INFINITY;
                if (nt == 1) {
#pragma unroll
                    for (int ks = 0; ks < 8; ++ks) qb[ks] = qpark[ks * 64];
                }
                const u32x4* kfp = KF + (size_t)(hp * 4 * 8) * 64;
                u32x4 kf[8];
#pragma unroll
                for (int ks = 0; ks < 8; ++ks) kf[ks] = ldg<u32x4>(kfp, (unsigned)(ks * 64 + lane) * 16u);
#pragma unroll 1
                for (int kt = 0; kt < 4; ++kt) {
                    f32x16 sa = zero16();
#pragma unroll
                    for (int ks = 0; ks < 8; ++ks) sa = mfma32(kf[ks], qb[ks], sa);
                    __builtin_amdgcn_sched_barrier(0);
                    const int ktn = (kt + 1) & 3;
#pragma unroll
                    for (int ks = 0; ks < 8; ++ks) kf[ks] = ldg<u32x4>(kfp, (unsigned)((ktn * 8 + ks) * 64 + lane) * 16u);
                    __builtin_amdgcn_sched_barrier(0);
                    float v[16];
#pragma unroll
                    for (int i = 0; i < 16; ++i) v[i] = embed_bits(sa[i], 127u, (unsigned)(32 * kt + (i & 3) + 8 * (i >> 2) + 4 * h));
                    bitonic_sort_desc<4>(v); merge_top16(top, v);
                    __builtin_amdgcn_sched_barrier(0);
                }
                float o[16];
#pragma unroll
                for (int i = 0; i < 16; ++i) o[i] = __shfl_xor(top[i], 32);
                merge_top16(top, o);
                if (h == 0) {
                    const unsigned lo = (unsigned)((((nt * 32 + r) * NH + hd) * 2 + pp) * 16) * 4u;
#pragma unroll
                    for (int w4 = 0; w4 < 4; ++w4) { f32x4 tv; tv[0] = top[4 * w4]; tv[1] = top[4 * w4 + 1]; tv[2] = top[4 * w4 + 2]; tv[3] = top[4 * w4 + 3]; stg<f32x4>(lstt, lo + 16u * w4, tv); }
                    u32x4 kb;
#pragma unroll
                    for (int w4 = 0; w4 < 4; ++w4) kb[w4] = (__builtin_bit_cast(unsigned, top[4 * w4]) & 127u) | ((__builtin_bit_cast(unsigned, top[4 * w4 + 1]) & 127u) << 8) | ((__builtin_bit_cast(unsigned, top[4 * w4 + 2]) & 127u) << 16) | ((__builtin_bit_cast(unsigned, top[4 * w4 + 3]) & 127u) << 24);
                    *(LAS u32x4*)(lut + ((nt * 32 + r) * 2 + pp) * 16) = kb;
                }
            }
        }
#pragma unroll
        for (int nt = 0; nt < 2; ++nt) {
            float s1[16], s2[16];
            {
                const unsigned lo = (unsigned)(((nt * 32 + r) * NH + hd) * 32) * 4u;
#pragma unroll
                for (int w4 = 0; w4 < 4; ++w4) { const f32x4 a = ldg<f32x4>(lstt, lo + 16u * w4), c = ldg<f32x4>(lstt, lo + 64u + 16u * w4);
#pragma unroll
                    for (int e4 = 0; e4 < 4; ++e4) { s1[4 * w4 + e4] = a[e4]; s2[4 * w4 + e4] = c[e4]; } }
            }
            float top[16];
#pragma unroll
            for (int i = 0; i < 16; ++i) top[i] = -INFINITY;
            { float v[16]; v[0] = embed_bits(s1[0] + s2[0], 255u, 0u); v[1] = embed_bits(s1[0] + s2[1], 255u, 1u); v[2] = embed_bits(s1[0] + s2[2], 255u, 2u); v[3] = embed_bits(s1[0] + s2[3], 255u, 3u); v[4] = embed_bits(s1[0] + s2[4], 255u, 4u); v[5] = embed_bits(s1[0] + s2[5], 255u, 5u); v[6] = embed_bits(s1[0] + s2[6], 255u, 6u); v[7] = embed_bits(s1[0] + s2[7], 255u, 7u); v[8] = embed_bits(s1[0] + s2[8], 255u, 8u); v[9] = embed_bits(s1[0] + s2[9], 255u, 9u); v[10] = embed_bits(s1[0] + s2[10], 255u, 10u); v[11] = embed_bits(s1[0] + s2[11], 255u, 11u); v[12] = embed_bits(s1[0] + s2[12], 255u, 12u); v[13] = embed_bits(s1[0] + s2[13], 255u, 13u); v[14] = embed_bits(s1[0] + s2[14], 255u, 14u); v[15] = embed_bits(s1[0] + s2[15], 255u, 15u);
              bitonic_sort_desc<4>(v); merge_top16(top, v); }
            { float v[16]; v[0] = embed_bits(s1[1] + s2[0], 255u, 16u); v[1] = embed_bits(s1[1] + s2[1], 255u, 17u); v[2] = embed_bits(s1[1] + s2[2], 255u, 18u); v[3] = embed_bits(s1[1] + s2[3], 255u, 19u); v[4] = embed_bits(s1[1] + s2[4], 255u, 20u); v[5] = embed_bits(s1[1] + s2[5], 255u, 21u); v[6] = embed_bits(s1[1] + s2[6], 255u, 22u); v[7] = embed_bits(s1[1] + s2[7], 255u, 23u); v[8] = embed_bits(s1[2] + s2[0], 255u, 32u); v[9] = embed_bits(s1[2] + s2[1], 255u, 33u); v[10] = embed_bits(s1[2] + s2[2], 255u, 34u); v[11] = embed_bits(s1[2] + s2[3], 255u, 35u); v[12] = embed_bits(s1[2] + s2[4], 255u, 36u); v[13] = embed_bits(s1[3] + s2[0], 255u, 48u); v[14] = embed_bits(s1[3] + s2[1], 255u, 49u); v[15] = embed_bits(s1[3] + s2[2], 255u, 50u);
              bitonic_sort_desc<4>(v); merge_top16(top, v); }
            { float v[16]; v[0] = embed_bits(s1[3] + s2[3], 255u, 51u); v[1] = embed_bits(s1[4] + s2[0], 255u, 64u); v[2] = embed_bits(s1[4] + s2[1], 255u, 65u); v[3] = embed_bits(s1[4] + s2[2], 255u, 66u); v[4] = embed_bits(s1[5] + s2[0], 255u, 80u); v[5] = embed_bits(s1[5] + s2[1], 255u, 81u); v[6] = embed_bits(s1[6] + s2[0], 255u, 96u); v[7] = embed_bits(s1[6] + s2[1], 255u, 97u); v[8] = embed_bits(s1[7] + s2[0], 255u, 112u); v[9] = embed_bits(s1[7] + s2[1], 255u, 113u); v[10] = embed_bits(s1[8] + s2[0], 255u, 128u); v[11] = embed_bits(s1[9] + s2[0], 255u, 144u); v[12] = embed_bits(s1[10] + s2[0], 255u, 160u); v[13] = embed_bits(s1[11] + s2[0], 255u, 176u); v[14] = embed_bits(s1[12] + s2[0], 255u, 192u); v[15] = embed_bits(s1[13] + s2[0], 255u, 208u);
              bitonic_sort_desc<4>(v); merge_top16(top, v); }
            { float v[16]; v[0] = embed_bits(s1[14] + s2[0], 255u, 224u); v[1] = embed_bits(s1[15] + s2[0], 255u, 240u); v[2] = -INFINITY; v[3] = -INFINITY; v[4] = -INFINITY; v[5] = -INFINITY; v[6] = -INFINITY; v[7] = -INFINITY; v[8] = -INFINITY; v[9] = -INFINITY; v[10] = -INFINITY; v[11] = -INFINITY; v[12] = -INFINITY; v[13] = -INFINITY; v[14] = -INFINITY; v[15] = -INFINITY;
              bitonic_sort_desc<4>(v); merge_top16(top, v); }
            float e[16], sum = 0.f;
#pragma unroll
            for (int i = 0; i < 16; ++i) { e[i] = __expf(top[i] - top[0]); sum += e[i]; }
            const float inv = 1.0f / sum;
            const LAS unsigned char* lt = lut + (nt * 32 + r) * 32;
            LAS unsigned char* slot = lds + 64 * TROWB + wv * 8192 + (nt * 32 + r) * 32;
            if (h == 0) {
                int ids[16];
#pragma unroll
                for (int i = 0; i < 16; ++i) { const unsigned code = __builtin_bit_cast(unsigned, top[i]) & 255u; ids[i] = (int)lt[code >> 4] * NKEYS + (int)lt[16 + (code & 15u)]; }
                u32x4 w0, w1;
#pragma unroll
                for (int i = 0; i < 4; ++i) { w0[i] = (unsigned)ids[i] | ((unsigned)ids[i + 8] << 16); w1[i] = (unsigned)ids[i + 4] | ((unsigned)ids[i + 12] << 16); }
                *(LAS u32x4*)(slot) = w0; *(LAS u32x4*)(slot + 16) = w1;
            } else {
#pragma unroll
                for (int i = 0; i < 4; ++i) { f32x4 gv; gv[0] = e[2 * i] * inv; gv[1] = e[2 * i + 8] * inv; gv[2] = e[2 * i + 1] * inv; gv[3] = e[2 * i + 9] * inv; *(LAS f32x4*)(slot + 2048 + (nt * 32 + r) * 32 + 16 * i) = gv; }
            }
        }
    }
    __syncthreads();
    {
        const LAS unsigned char* sl = lds + 64 * TROWB;
        unsigned char* idxt = p.idx + (size_t)tile * 64 * (HK * 2);
        unsigned char* gatet = p.gate + (size_t)tile * 64 * (HK * 4);
        u32x4 iv[2]; f32x4 gv[4];
#pragma unroll
        for (int k = 0; k < 2; ++k) { const int ci = tid + 512 * k, tok = ci >> 4, c = ci & 15;
#pragma unroll
            for (int q = 0; q < 4; ++q) iv[k][q] = *(const LAS unsigned*)(sl + (4 * (c & 1) + q) * 8192 + tok * 32 + (c >> 1) * 4); }
#pragma unroll
        for (int k = 0; k < 4; ++k) { const int ci = tid + 512 * k, tok = ci >> 5, c = ci & 31;
            const f32x2 a = *(const LAS f32x2*)(sl + (2 * (c & 3)) * 8192 + 2048 + tok * 64 + (c >> 2) * 8), b = *(const LAS f32x2*)(sl + (2 * (c & 3) + 1) * 8192 + 2048 + tok * 64 + (c >> 2) * 8);
            gv[k][0] = a[0]; gv[k][1] = a[1]; gv[k][2] = b[0]; gv[k][3] = b[1]; }
#pragma unroll
        for (int k = 0; k < 2; ++k) stg<u32x4>(idxt, (unsigned)(tid + 512 * k) * 16u, iv[k]);
#pragma unroll
        for (int k = 0; k < 4; ++k) stg<f32x4>(gatet, (unsigned)(tid + 512 * k) * 16u, gv[k]);
    }
}

__device__ __forceinline__ int dot16_i8(u32x4 a, u32x4 b) {
    int d = __builtin_amdgcn_sdot4((int)a[0], (int)b[0], 0, false);
    d = __builtin_amdgcn_sdot4((int)a[1], (int)b[1], d, false); d = __builtin_amdgcn_sdot4((int)a[2], (int)b[2], d, false); d = __builtin_amdgcn_sdot4((int)a[3], (int)b[3], d, false);
    return d;
}
__device__ __forceinline__ float gelu_exact(float z) { return 0.5f * z * (1.0f + erff(z * 0.70710678118654752f)); }

struct GMeta { int ids[16]; u32x4 x; };
struct GRows { u32x4 v[16]; };
__device__ __forceinline__ void g_rows(const unsigned char* slice, const GMeta& m, int lane, GRows& r) {
    const unsigned co = (unsigned)(lane & 7) * 16u;
#pragma unroll
    for (int i = 0; i < 16; ++i) r.v[i] = ldg<u32x4>(slice, (unsigned)m.ids[i] + co);
}

constexpr int P3W_Z = 0, P3W_CQ = 4096, P3W_SC = 5120, P3W_CS = 5152, P3W_ID = 5184, P3W_X = 9280, P3W_SSQ = 17472, P3W_BYTES = 19520;
constexpr int LDS_ALL = LDS_BYTES > 8 * P3W_BYTES ? LDS_BYTES : 8 * P3W_BYTES;
__device__ __forceinline__ void p3_wave(const Params& p, int tb0, int tb1, int lt, int pos, int lane, LAS unsigned char* wl) {
    const int ntok = 1 << lt;
    auto tokf = [&](int q) { return (q < 4 ? tb0 : tb1) + (q & 3); };
    const int grp = lane >> 3, ch = lane & 7, i0 = ((ch >> 2) & 1) * 8 + ((ch >> 1) & 1) * 4 + (ch & 1) * 2;
    LAS int* zl = (LAS int*)(wl + P3W_Z);
    LAS float* scl = (LAS float*)(wl + P3W_SC);
    LAS float* ssl = (LAS float*)(wl + P3W_SSQ);
#pragma unroll
    for (int q = 0; q < 8; ++q) if (q < ntok) {
        const int t = tokf(q);
        { const unsigned w = ldg<unsigned>(p.idx + (size_t)t * (HK * 2), (unsigned)lane * 4u); u32x2 o2; o2.x = (w & 0xffffu) << 7; o2.y = (w >> 16) << 7; *(LAS u32x2*)(wl + P3W_ID + q * 512 + lane * 8) = o2; }
        *(LAS u32x4*)(wl + P3W_X + q * 1024 + lane * 16) = ldg<u32x4>(p.xq + (size_t)t * D, (unsigned)lane * 16u);
    }
    wave_sync();
    auto ids_lds = [&](int q, GMeta& m) {
#pragma unroll
        for (int w = 0; w < 4; ++w) { const u32x4 a = *(const LAS u32x4*)(wl + P3W_ID + q * 512 + grp * 64 + 16 * w);
#pragma unroll
            for (int e = 0; e < 4; ++e) m.ids[4 * w + e] = (int)a[e]; }
    };
#pragma unroll 1
    for (int st = 0; st < 8; ++st) {
        const int j = (pos + st) & 7;
        const unsigned char* slice = p.eut + (size_t)j * (16384 * 128);
        const unsigned xo = (unsigned)(128 * j + 16 * ch);
#pragma unroll 1
        for (int q = 0; q < ntok; ++q) {
            const int t = tokf(q);
            GMeta m; GRows r; ids_lds(q, m); m.x = *(const LAS u32x4*)(wl + P3W_X + q * 1024 + xo); g_rows(slice, m, lane, r); (void)t;
            int part[16];
#pragma unroll
            for (int i = 0; i < 16; ++i) part[i] = dot16_i8(r.v[i], m.x);
#pragma unroll
            for (int lv = 2; lv >= 0; --lv) {
                const int n = 2 << lv, off = 1 << lv;
                const bool up = (lane & off) != 0;
#pragma unroll
                for (int i = 0; i < n; ++i) { const int a = part[i], c = part[i + n]; const int send = up ? a : c, keep = up ? c : a; part[i] = keep + __shfl_xor(send, off); }
            }
            LAS int* zp = zl + q * 128 + 2 * lane;
            if (st == 0) { zp[0] = part[0]; zp[1] = part[1]; } else { zp[0] += part[0]; zp[1] += part[1]; }
        }
    }
    {
        const unsigned po = (unsigned)(grp * 16 + i0) * 4u;
        u32x2 idw[8]; f32x2 g[8]; float sx[8];
#pragma unroll
        for (int q = 0; q < 8; ++q) { const int t = tokf(q < ntok ? q : 0); idw[q] = *(const LAS u32x2*)(wl + P3W_ID + (q < ntok ? q : 0) * 512 + po); g[q] = ldg<f32x2>(p.gate + (size_t)t * (HK * 4), po); sx[q] = ((const float*)p.sx)[t]; }
        float su0[8], su1[8], sv0[8], sv1[8];
#pragma unroll
        for (int q = 0; q < 8; ++q) { const int a = (int)(idw[q].x >> 7), c = (int)(idw[q].y >> 7); su0[q] = ((const float*)p.su)[a]; su1[q] = ((const float*)p.su)[c]; sv0[q] = ((const float*)p.sv)[a]; sv1[q] = ((const float*)p.sv)[c]; }
#pragma unroll
        for (int q = 0; q < 8; ++q) if (q < ntok) {
            const int z0 = zl[q * 128 + 2 * lane], z1 = zl[q * 128 + 2 * lane + 1];
            const float c0 = g[q][0] * gelu_exact((float)z0 * (sx[q] * su0[q])) * sv0[q];
            const float c1 = g[q][1] * gelu_exact((float)z1 * (sx[q] * su1[q])) * sv1[q];
            float am = fmaxf(fabsf(c0), fabsf(c1));
#pragma unroll
            for (int o = 32; o > 0; o >>= 1) am = fmaxf(am, __shfl_xor(am, o));
            const float inv = am > 0.f ? 127.0f / am : 0.f;
            const unsigned q0 = (unsigned)(int)rintf(c0 * inv) & 255u, q1 = (unsigned)(int)rintf(c1 * inv) & 255u;
            *(LAS unsigned short*)(wl + P3W_CQ + q * 128 + 16 * grp + i0) = (unsigned short)(q0 | (q1 << 8));
            int cs = (int)rintf(c0 * inv) + (int)rintf(c1 * inv);
#pragma unroll
            for (int o = 32; o > 0; o >>= 1) cs += __shfl_xor(cs, o);
            ssl[q * 64 + lane] = 0.f;
            if (lane == 0) { scl[q] = am * (1.0f / 127.0f); ((LAS int*)(wl + P3W_CS))[q] = cs; }
        }
    }
    wave_sync();
    {
        const int nvs = 4 << lt;
        auto meta = [&](int n, GMeta& m, float& sc, u32x2& hv) {
            const int nn = n < nvs ? n : nvs - 1, q = nn & (ntok - 1), j = (pos + (nn >> lt)) & 3, t = tokf(q);
            ids_lds(q, m);
            m.x = *(const LAS u32x4*)(wl + P3W_CQ + q * 128 + 16 * grp);
            sc = scl[q];
            hv = ldg<u32x2>(p.hb + (size_t)t * D * 2, (unsigned)(256 * j + 32 * ch + 4 * grp) * 2u);
        };
        auto rows = [&](int n, const GMeta& m, GRows& r) { const int nn = n < nvs ? n : nvs - 1; g_rows(p.evt + (size_t)((pos + (nn >> lt)) & 3) * (16384 * 128), m, lane, r); };
        auto finish = [&](int n, const GMeta& m, const GRows& r, float sc, u32x2 hv) {
            const int q = n & (ntok - 1), j = (pos + (n >> lt)) & 3, t = tokf(q);
            int acc[32];
#pragma unroll
            for (int e = 0; e < 32; ++e) acc[e] = 0;
#pragma unroll
            for (int g = 0; g < 4; ++g)
#pragma unroll
                for (int e = 0; e < 4; ++e) {
                    const int cq = (int)m.x[g];
                    const unsigned A = r.v[4 * g][e], B = r.v[4 * g + 1][e], C = r.v[4 * g + 2][e], Dd = r.v[4 * g + 3][e];
                    const unsigned t0 = __builtin_amdgcn_perm(B, A, 0x05010400u), t1 = __builtin_amdgcn_perm(B, A, 0x07030602u);
                    const unsigned t2 = __builtin_amdgcn_perm(Dd, C, 0x05010400u), t3 = __builtin_amdgcn_perm(Dd, C, 0x07030602u);
                    const unsigned r0 = __builtin_amdgcn_perm(t2, t0, 0x05040100u), r1 = __builtin_amdgcn_perm(t2, t0, 0x07060302u);
                    const unsigned r2 = __builtin_amdgcn_perm(t3, t1, 0x05040100u), r3 = __builtin_amdgcn_perm(t3, t1, 0x07060302u);
                    int* a4 = acc + 8 * e;
                    a4[0] = __builtin_amdgcn_sdot4((int)(r0 & 0x0f0f0f0fu), cq, a4[0], false); a4[2] = __builtin_amdgcn_sdot4((int)(r1 & 0x0f0f0f0fu), cq, a4[2], false);
                    a4[4] = __builtin_amdgcn_sdot4((int)(r2 & 0x0f0f0f0fu), cq, a4[4], false); a4[6] = __builtin_amdgcn_sdot4((int)(r3 & 0x0f0f0f0fu), cq, a4[6], false);
                    a4[1] = __builtin_amdgcn_sdot4((int)r0, cq, a4[1], false); a4[3] = __builtin_amdgcn_sdot4((int)r1, cq, a4[3], false);
                    a4[5] = __builtin_amdgcn_sdot4((int)r2, cq, a4[5], false); a4[7] = __builtin_amdgcn_sdot4((int)r3, cq, a4[7], false);
                }
#pragma unroll
            for (int i = 0; i < 16; ++i) { const auto sw = __builtin_amdgcn_permlane32_swap((unsigned)acc[i], (unsigned)acc[i + 16], false, false); acc[i] = (int)(sw[0] + sw[1]); }
#pragma unroll
            for (int i = 0; i < 8; ++i) { const auto sw = __builtin_amdgcn_permlane16_swap((unsigned)acc[i], (unsigned)acc[i + 8], false, false); acc[i] = (int)(sw[0] + sw[1]); }
            {
                const bool up = (lane & 8) != 0;
#pragma unroll
                for (int i = 0; i < 4; ++i) {
                    const int xs = acc[i] + __builtin_amdgcn_update_dpp(0, acc[i], 0x128, 0xf, 0xf, false), ys = acc[i + 4] + __builtin_amdgcn_update_dpp(0, acc[i + 4], 0x128, 0xf, 0xf, false);
                    acc[i] = up ? ys : xs;
                }
            }
            const int c8 = 8 * ((const LAS int*)(wl + P3W_CS))[q];
            f32x4 o; o[0] = (float)(acc[0] - c8) * sc + bf_lo(hv.x); o[1] = (float)((acc[1] - acc[0]) >> 4) * sc + bf_hi(hv.x); o[2] = (float)(acc[2] - c8) * sc + bf_lo(hv.y); o[3] = (float)((acc[3] - acc[2]) >> 4) * sc + bf_hi(hv.y);
            stg<f32x4>(p.out + (size_t)t * D, (unsigned)(256 * j + 32 * ch + 4 * grp) * 4u, o);
            atomicAdd((float*)(ssl + q * 64 + lane), o[0] * o[0] + o[1] * o[1] + o[2] * o[2] + o[3] * o[3]);
        };
        GMeta ma, mb; GRows ra, rb; float sa, sb; u32x2 ha, hb;
        meta(0, ma, sa, ha); meta(1, mb, sb, hb); rows(0, ma, ra);
#pragma unroll 1
        for (int n = 0; n < nvs; n += 2) {
            GMeta mc; float scc; u32x2 hc;
            meta(n + 2, mc, scc, hc); rows(n + 1, mb, rb);
            __builtin_amdgcn_sched_barrier(0);
            finish(n, ma, ra, sa, ha);
            __builtin_amdgcn_sched_barrier(0);
            meta(n + 3, ma, sa, ha); rows(n + 2, mc, ra);
            __builtin_amdgcn_sched_barrier(0);
            finish(n + 1, mb, rb, sb, hb);
            __builtin_amdgcn_sched_barrier(0);
            mb = ma; sb = sa; hb = ha; ma = mc; sa = scc; ha = hc;
        }
    }
    asm volatile("s_waitcnt vmcnt(0)" ::: "memory");
    __builtin_amdgcn_fence(__ATOMIC_ACQUIRE, "agent");
    {
        f32x4 gg[4];
#pragma unroll
        for (int i = 0; i < 4; ++i) gg[i] = ldg<f32x4>(p.g_fin, (unsigned)(i * 256 + 4 * lane) * 4u);
#pragma unroll 1
        for (int qb = 0; qb < ntok; qb += 4) {
            f32x4 a[4][4];
#pragma unroll
            for (int b = 0; b < 4; ++b)
#pragma unroll
                for (int i = 0; i < 4; ++i) a[b][i] = ldg<f32x4>(p.out + (size_t)tokf(qb + b) * D, (unsigned)(i * 256 + 4 * lane) * 4u);
#pragma unroll
            for (int b = 0; b < 4; ++b) {
                const float rv = rsqrtf(wave_sum(ssl[(qb + b) * 64 + lane]) * (1.0f / D) + EPS);
#pragma unroll
                for (int i = 0; i < 4; ++i) { f32x4 ov;
#pragma unroll
                    for (int e = 0; e < 4; ++e) ov[e] = a[b][i][e] * rv * gg[i][e];
                    stg<f32x4>(p.out + (size_t)tokf(qb + b) * D, (unsigned)(i * 256 + 4 * lane) * 4u, ov); }
            }
        }
    }
}

#define XB_TMO      128
#define XB_XCNT(j)  (256  + 64 * (j))
#define XB_XSUB(j)  (1280 + 64 * (j))
#define XB_XGEN(j)  (2304 + 64 * (j))
#define XB_TOP      3328
#define XB_TOPGEN   3392
#define XCD_BAR_WORDS 3456
#define XB_SPIN_CAP (1u << 18)

__device__ __forceinline__ unsigned xb_ld(unsigned* p)              { return __hip_atomic_load(p, __ATOMIC_RELAXED, __HIP_MEMORY_SCOPE_AGENT); }
__device__ __forceinline__ unsigned xb_add(unsigned* p, unsigned v) { return __hip_atomic_fetch_add(p, v, __ATOMIC_RELAXED, __HIP_MEMORY_SCOPE_AGENT); }
__device__ __forceinline__ unsigned xb_xcc_id() { return (unsigned)__builtin_amdgcn_s_getreg((3 << 11) | 20) & 0xFu; }
#define XB_SPIN(cond, bar) do { unsigned _sp = 0; while (cond) { __builtin_amdgcn_s_sleep(1); \
    if ((++_sp & 255u) == 0u) { if (xb_ld(&(bar)[XB_TMO])) break; if (_sp > XB_SPIN_CAP) { atomicAdd(&(bar)[XB_TMO], 1u); break; } } } } while (0)

struct XcdBarrier {
    unsigned* bar; unsigned x;
    volatile LAS unsigned* st;
};

__device__ __forceinline__ XcdBarrier xcd_barrier_post(unsigned* bar, volatile LAS unsigned* st) {
    XcdBarrier b; b.bar = bar; b.x = xb_xcc_id(); b.st = st;
    if (threadIdx.x == 0) (void)xb_add(&bar[XB_XCNT(b.x)], 1u);
    return b;
}
__device__ __forceinline__ void xcd_barrier_complete(unsigned* bar, unsigned x, unsigned& nloc, unsigned& nx) {
    const unsigned G = gridDim.x * gridDim.y * gridDim.z;
    unsigned sum, cnt, mine, sp = 0u;
    for (;;) {
        sum = 0u; cnt = 0u; mine = 0u;
#pragma unroll
        for (unsigned j = 0; j < 16; ++j) { const unsigned c = xb_ld(&bar[XB_XCNT(j)]); sum += c; cnt += (c > 0u) ? 1u : 0u; mine = (j == x) ? c : mine; }
        if (sum == G) break;
        __builtin_amdgcn_s_sleep(1);
        if ((++sp & 255u) == 0u) { if (xb_ld(&bar[XB_TMO])) break; if (sp > XB_SPIN_CAP) { atomicAdd(&bar[XB_TMO], 1u); break; } }
    }
    nloc = mine > 0u ? mine : 1u; nx = cnt > 0u ? cnt : 1u;
}

__device__ __forceinline__ void xcd_barrier(const XcdBarrier& b) {
    asm volatile("s_waitcnt vmcnt(0)" ::: "memory");
    __syncthreads();
    if (threadIdx.x == 0) {
        unsigned* bar = b.bar;
        __builtin_amdgcn_s_waitcnt(0);
        unsigned nloc = b.st[0], nx = b.st[1];
        if (nloc == 0u) { xcd_barrier_complete(bar, b.x, nloc, nx); b.st[0] = nloc; b.st[1] = nx; }
        const unsigned old = xb_add(&bar[XB_XSUB(b.x)], 1u);
        const unsigned gen = old / nloc;
        if (old + 1u == (gen + 1u) * nloc) {
            __builtin_amdgcn_fence(__ATOMIC_RELEASE, "agent");
            asm volatile("s_waitcnt vmcnt(0)" ::: "memory");
            const unsigned og = xb_add(&bar[XB_TOP], 1u);
            const unsigned tg = og / nx;
            if (og + 1u == (tg + 1u) * nx) xb_add(&bar[XB_TOPGEN], 1u);
            else XB_SPIN(xb_ld(&bar[XB_TOPGEN]) == tg, bar);
            __builtin_amdgcn_fence(__ATOMIC_ACQUIRE, "agent");
            xb_add(&bar[XB_XGEN(b.x)], 1u);
            asm volatile("s_waitcnt vmcnt(0)" ::: "memory");
        } else {
            XB_SPIN(xb_ld(&bar[XB_XGEN(b.x)]) == gen, bar);
            __builtin_amdgcn_fence(__ATOMIC_ACQUIRE, "agent");
            asm volatile("s_waitcnt vmcnt(0)" ::: "memory");
        }
    }
    __syncthreads();
}


__global__ void __launch_bounds__(512) k_fwd(Params p) {
    __shared__ __attribute__((aligned(16))) unsigned char lds_raw[LDS_ALL + 16];
    LAS unsigned char* lds = (LAS unsigned char*)lds_raw;
    const int tid = threadIdx.x, vb = blockIdx.x, nb = gridDim.x;
    volatile LAS unsigned* xbw = (volatile LAS unsigned*)(lds + LDS_ALL);
    if (tid < 4) xbw[tid] = 0u;
    __syncthreads();
    XcdBarrier gb = xcd_barrier_post((unsigned*)p.bar, xbw);
    if (tid == 0) xbw[2] = xb_add(&((unsigned*)p.bar)[XCD_BAR_WORDS + 64 * gb.x], 1u);
    p0_prep(p, vb, nb, tid, lds);
    const bool early = vb >= 129 && vb < NTILES;
    if (early) p1_stage(p, vb, tid, lds);
    xcd_barrier(gb);
    for (int tile = vb; tile < NTILES; tile += nb) { if (!(early && tile == vb)) p1_stage(p, tile, tid, lds); p1_inproj(p, tile, tid, lds, vb, nb, tile == vb); __syncthreads(); }
    if ((tid >> 6) == 0) for (int mp = vb; mp < 32; mp += nb) p1_meta(p, mp, launder(tid) & 63);
    xcd_barrier(gb);
    for (int tile = vb; tile < NTILES; tile += nb) { p2_mix(p, tile, tid, lds); __syncthreads(); }
    xcd_barrier(gb);
    const int lane = launder(tid) & 63, wv = __builtin_amdgcn_readfirstlane(tid >> 6);
    int np = 0, mypos = 0, nloc = 1;
    {
        unsigned* bar = (unsigned*)p.bar;
        const int myx = (int)gb.x;
#pragma unroll
        for (int q = 0; q < 16; ++q) { const int c = (int)xb_ld(&bar[XB_XCNT(q)]); if (q == myx) { mypos = np; nloc = c > 0 ? c : 1; } np += (c > 0) ? 1 : 0; }
        if (np < 1) np = 1;
    }
    {
        const int rank = (int)xbw[2];
        LAS unsigned char* wl = lds + wv * P3W_BYTES;
#pragma unroll 1
        for (int k = rank; mypos + np * k < T / 32; k += 2 * nloc) {
            const int c0 = mypos + np * k, c1 = mypos + np * (k + nloc);
            p3_wave(p, 32 * c0 + 4 * wv, 32 * c1 + 4 * wv, c1 < T / 32 ? 3 : 2, mypos, lane, wl);
        }
    }
}
}

extern "C" void kernel_launch(void* const* d_in, const int* in_sizes, int n_in, void* d_out, int out_size, void* d_ws, size_t ws_size, hipStream_t stream) {
    static int grid_blocks = 0;
    if (n_in != 16 || out_size != T * D) { fprintf(stderr, "kernel_launch: unexpected sizes n_in %d out %d\n", n_in, out_size); return; }
    if (!grid_blocks) {
        int dev = 0, cus = 0, per_cu = 0;
        (void)hipGetDevice(&dev);
        (void)hipDeviceGetAttribute(&cus, hipDeviceAttributeMultiprocessorCount, dev);
        (void)hipOccupancyMaxActiveBlocksPerMultiprocessor(&per_cu, (const void*)k_fwd, 512, 0);
        if (per_cu < 1) { fprintf(stderr, "kernel_launch: occupancy query returned %d\n", per_cu); per_cu = 1; }
        grid_blocks = cus * 1;
    }
    Params p{};
    p.x = (const float*)d_in[0]; p.meta = (const float*)d_in[1]; p.g_mix = (const float*)d_in[2]; p.w_in = (const float*)d_in[3]; p.pool_w = (const float*)d_in[4];
    p.pool_scale = (const float*)d_in[5]; p.conv_w = (const float*)d_in[6]; p.g_a = (const float*)d_in[7]; p.g_b = (const float*)d_in[8]; p.w_out = (const float*)d_in[9];
    p.g_ffn = (const float*)d_in[10]; p.w_query = (const float*)d_in[11]; p.sub_keys = (const float*)d_in[12]; p.eu = (const float*)d_in[13]; p.ev = (const float*)d_in[14]; p.g_fin = (const float*)d_in[15];
    p.out = (float*)d_out;
    unsigned char* ws = (unsigned char*)d_ws;
    p.winf = ws; p.woutf = ws + (4u << 20); p.wqf = ws + (6u << 20); p.kf = ws + (10u << 20); p.pwf = p.kf + (512u << 10); p.metaf = p.pwf + (128u << 10); p.rsm = p.metaf + (64u << 10); p.bar = p.rsm + 256;
    p.eut = ws + (12u << 20); p.evt = p.eut + (32u << 20); p.proj = p.evt + (32u << 20); p.idx = p.proj + (size_t)TL * MIXIN * 2; p.gate = p.idx + (size_t)T * HK * 4; p.lst = p.gate + (size_t)T * HK * 4;
    p.su = p.lst + (size_t)T * NH * 32 * 4; p.sv = p.su + 65536; p.sx = p.sv + 65536; p.xq = p.sx + 65536; p.wsci = p.xq + (size_t)T * D; p.wscq = p.wsci + 8192; p.hb = p.wscq + 8192;
    if ((size_t)(p.hb - ws) + (size_t)T * D * 2 > ws_size) { fprintf(stderr, "kernel_launch: workspace too small\n"); return; }
    if (hipMemsetAsync(p.bar, 0, (XCD_BAR_WORDS + 64 * 16) * 4, stream) != hipSuccess) { fprintf(stderr, "kernel_launch: memset of the barrier words failed\n"); return; }
    hipLaunchKernelGGL(k_fwd, dim3(grid_blocks), dim3(512), 0, stream, p);
}
```

```cpp
#include <hip/hip_runtime.h>
#include <cstdio>
#include <cstdint>
#include <math.h>

namespace {
constexpr int D = 1024, BATCH = 4, SEQ = 4096, NMETA = 16, L = SEQ + NMETA;
constexpr int MIXA = 512, MIXB = 512, MIXIN = 2048;
constexpr int NH = 8, NKEYS = 128, DQH = 128, TOPK = 16, HK = 128;
constexpr int T = BATCH * SEQ;
constexpr int TL = BATCH * L;
constexpr float EPS = 1e-6f;

__device__ __forceinline__ float wave_sum(float v) {
#pragma unroll
    for (int o = 32; o > 0; o >>= 1) v += __shfl_xor(v, o);
    return v;
}
#define LAS __attribute__((address_space(3)))
typedef short bf16x8 __attribute__((ext_vector_type(8)));
typedef float f32x16 __attribute__((ext_vector_type(16)));
typedef float f32x4 __attribute__((ext_vector_type(4)));
typedef float f32x2 __attribute__((ext_vector_type(2)));
typedef __bf16 bf2_t __attribute__((ext_vector_type(2)));
typedef unsigned u32x4 __attribute__((ext_vector_type(4)));
typedef unsigned u32x2 __attribute__((ext_vector_type(2)));
typedef int i32x4 __attribute__((ext_vector_type(4)));
typedef int i32x16 __attribute__((ext_vector_type(16)));

constexpr int QCH = 2;
constexpr int NTILES = T / 64;
constexpr int TROW = 2064;
constexpr int TROWB = 1040;
constexpr int LDS_TILE = 64 * TROW;
constexpr int LDS_RS = LDS_TILE;
constexpr int LDS_SSA = LDS_RS + 256;
constexpr int LDS_LUT = LDS_SSA + 256;
constexpr int LDS_BYTES = LDS_LUT + 16384;

struct Params {
    const float* x; const float* meta; const float* g_mix; const float* w_in; const float* pool_w; const float* pool_scale; const float* conv_w;
    const float* g_a; const float* g_b; const float* w_out; const float* g_ffn; const float* w_query; const float* sub_keys; const float* eu; const float* ev; const float* g_fin;
    float* out;
    unsigned char *winf, *woutf, *wqf, *kf, *pwf, *metaf, *rsm, *eut, *evt, *proj, *idx, *gate, *bar, *lst, *su, *sv, *xq, *sx, *wsci, *wscq, *hb;
};

__device__ __forceinline__ unsigned pk_bf16(float lo, float hi) { f32x2 f = {lo, hi}; return __builtin_bit_cast(unsigned, __builtin_convertvector(f, bf2_t)); }
__device__ __forceinline__ float bf_lo(unsigned u) { return __builtin_bit_cast(float, u << 16); }
__device__ __forceinline__ float bf_hi(unsigned u) { return __builtin_bit_cast(float, u & 0xffff0000u); }
__device__ __forceinline__ f32x16 mfma32(u32x4 a, u32x4 b, f32x16 c) { return __builtin_amdgcn_mfma_f32_32x32x16_bf16(__builtin_bit_cast(bf16x8, a), __builtin_bit_cast(bf16x8, b), c, 0, 0, 0); }
__device__ __forceinline__ i32x16 mfma_i8(u32x4 a, u32x4 b, i32x16 c) { return __builtin_amdgcn_mfma_i32_32x32x32_i8(__builtin_bit_cast(i32x4, a), __builtin_bit_cast(i32x4, b), c, 0, 0, 0); }
__device__ __forceinline__ i32x16 izero16() { i32x16 z; for (int i = 0; i < 16; ++i) z[i] = 0; return z; }
__device__ __forceinline__ f32x16 zero16() { f32x16 z; for (int i = 0; i < 16; ++i) z[i] = 0.f; return z; }

__device__ __forceinline__ void wave_sync() { __builtin_amdgcn_fence(__ATOMIC_RELEASE, "wavefront"); __builtin_amdgcn_wave_barrier(); __builtin_amdgcn_fence(__ATOMIC_ACQUIRE, "wavefront"); }
__device__ __forceinline__ int launder(int x) { asm volatile("" : "+v"(x)); return x; }
template <class V> __device__ __forceinline__ V ldg(const void* base, unsigned off) { return *(const V*)((const unsigned char*)base + off); }
template <class V> __device__ __forceinline__ void stg(void* base, unsigned off, V v) { *(V*)((unsigned char*)base + off) = v; }

__device__ __forceinline__ void frag_from_kn(const float* __restrict__ W, int N, const float* __restrict__ g, int i, int s, int lane, u32x4* __restrict__ dst, int I8K = 0) {
    const int r = lane & 31, h = lane >> 5, k0 = 16 * s + 8 * h;
    const float* src = W + (size_t)k0 * N + 32 * i + r;
    float v[8];
#pragma unroll
    for (int j = 0; j < 8; ++j) v[j] = src[(size_t)j * N] * (g ? g[k0 + j] : 1.0f);
    u32x4 o; o.x = pk_bf16(v[0], v[1]); o.y = pk_bf16(v[2], v[3]); o.z = pk_bf16(v[4], v[5]); o.w = pk_bf16(v[6], v[7]);
    *dst = o;
}
__device__ __forceinline__ void frag2_from_kn(const float* __restrict__ W, int N, int i, int s, int lane, u32x4* __restrict__ dst) {
    const int r = lane & 31, h = lane >> 5, k0 = 16 * s + 8 * h;
    const float* src = W + (size_t)k0 * N + 32 * i + r;
    float v[16];
#pragma unroll
    for (int j = 0; j < 8; ++j) { v[j] = src[(size_t)j * N]; v[8 + j] = src[(size_t)(16 + j) * N]; }
    u32x4 o; o.x = pk_bf16(v[0], v[1]); o.y = pk_bf16(v[2], v[3]); o.z = pk_bf16(v[4], v[5]); o.w = pk_bf16(v[6], v[7]);
    u32x4 o2; o2.x = pk_bf16(v[8], v[9]); o2.y = pk_bf16(v[10], v[11]); o2.z = pk_bf16(v[12], v[13]); o2.w = pk_bf16(v[14], v[15]);
    dst[0] = o; dst[64] = o2;
}
constexpr int J_WOUT = 0, J_WQ = J_WOUT + 32 * 64, J_PW = J_WQ, J_KEY = J_PW + 128, J_END = J_KEY + 512;
__device__ __forceinline__ void mtile_i8_block(const float* __restrict__ W, const float* __restrict__ g, int i, int tid, LAS unsigned* lds_u, u32x4* __restrict__ dst, float* __restrict__ wsc) {
    const int lane = tid & 63, wv = tid >> 6, r = lane & 31, h = lane >> 5, col = 32 * i + r;
    if (tid < 32) lds_u[tid] = 0u;
    __syncthreads();
    {
        const int cg = lane & 7, ro = lane >> 3;
        f32x4 f[16];
#pragma unroll
        for (int q = 0; q < 16; ++q) f[q] = ldg<f32x4>(W, (unsigned)((128 * wv + 8 * q + ro) * 2048 + 32 * i + 4 * cg) * 4u);
        float m0 = 0.f, m1 = 0.f, m2 = 0.f, m3 = 0.f;
#pragma unroll
        for (int q = 0; q < 16; ++q) { const float gk = g ? g[128 * wv + 8 * q + ro] : 1.0f; m0 = fmaxf(m0, fabsf(f[q][0] * gk)); m1 = fmaxf(m1, fabsf(f[q][1] * gk)); m2 = fmaxf(m2, fabsf(f[q][2] * gk)); m3 = fmaxf(m3, fabsf(f[q][3] * gk)); }
#pragma unroll
        for (int o = 8; o < 64; o <<= 1) { m0 = fmaxf(m0, __shfl_xor(m0, o)); m1 = fmaxf(m1, __shfl_xor(m1, o)); m2 = fmaxf(m2, __shfl_xor(m2, o)); m3 = fmaxf(m3, __shfl_xor(m3, o)); }
        if (lane < 8) { atomicMax((unsigned*)(lds_u + 4 * cg), __builtin_bit_cast(unsigned, m0)); atomicMax((unsigned*)(lds_u + 4 * cg + 1), __builtin_bit_cast(unsigned, m1));
            atomicMax((unsigned*)(lds_u + 4 * cg + 2), __builtin_bit_cast(unsigned, m2)); atomicMax((unsigned*)(lds_u + 4 * cg + 3), __builtin_bit_cast(unsigned, m3)); }
    }
    __syncthreads();
    const float cm = __builtin_bit_cast(float, lds_u[r]);
    const float inv = cm > 0.f ? 127.0f / cm : 0.f;
    if (wv == 0 && h == 0) wsc[col] = cm * (1.0f / 127.0f);
#pragma unroll
    for (int sl = 0; sl < 4; ++sl) {
        const int s = 4 * wv + sl, k0 = 32 * s + 16 * h;
        u32x4 o;
#pragma unroll
        for (int q = 0; q < 4; ++q) {
            unsigned w = 0u;
#pragma unroll
            for (int e = 0; e < 4; ++e) { const int k = k0 + 4 * q + e; w |= ((unsigned)(int)rintf(ldg<float>(W, (unsigned)(k * 2048 + col) * 4u) * (g ? g[k] : 1.0f) * inv) & 255u) << (8 * e); }
            o[q] = w;
        }
        dst[(size_t)s * 64 + lane] = o;
    }
    __syncthreads();
}
__device__ __forceinline__ void meta_block(const Params& p, int tid, LAS float* lds_f) {
    const int lane = tid & 63, wv = tid >> 6;
#pragma unroll
    for (int q = 0; q < 2; ++q) {
        const int row = 2 * wv + q;
        float ss = 0.f, am = 0.f;
#pragma unroll
        for (int i = 0; i < 4; ++i) { const f32x4 f = *(const f32x4*)(p.meta + (size_t)row * D + i * 256 + 4 * lane); ss += f[0] * f[0] + f[1] * f[1] + f[2] * f[2] + f[3] * f[3];
            am = fmaxf(am, fmaxf(fmaxf(fabsf(f[0]), fabsf(f[1])), fmaxf(fabsf(f[2]), fabsf(f[3])))); }
        ss = wave_sum(ss);
#pragma unroll
        for (int o = 32; o > 0; o >>= 1) am = fmaxf(am, __shfl_xor(am, o));
        if (lane == 0) { ((float*)(p.rsm))[row] = rsqrtf(ss * (1.0f / D) + EPS) * am * (1.0f / 127.0f); lds_f[row] = am; }
    }
    __syncthreads();
    const int n = lane & 31, h = lane >> 5;
    const float am = n < NMETA ? lds_f[n] : 0.f;
    const float inv = am > 0.f ? 127.0f / am : 0.f;
#pragma unroll
    for (int sl = 0; sl < 4; ++sl) {
        const int s = 4 * wv + sl;
        u32x4 o = {0u, 0u, 0u, 0u};
        if (n < NMETA) {
            const float* row = p.meta + (size_t)n * D;
#pragma unroll
            for (int q = 0; q < 4; ++q) { const f32x4 f = *(const f32x4*)(row + 32 * s + 16 * h + 4 * q);
                o[q] = ((unsigned)(int)rintf(f[0] * inv) & 255u) | (((unsigned)(int)rintf(f[1] * inv) & 255u) << 8) | (((unsigned)(int)rintf(f[2] * inv) & 255u) << 16) | (((unsigned)(int)rintf(f[3] * inv) & 255u) << 24); }
        }
        ((u32x4*)(p.metaf))[(size_t)s * 64 + lane] = o;
    }
    __syncthreads();
}

__device__ __forceinline__ void p0_prep(const Params& p, int vb, int nb, int tid, LAS unsigned char* lds) {
    const int lane = tid & 63, wv = tid >> 6, gw = vb * 8 + wv, nw = nb * 8;
    for (int job = vb; job < 129; job += nb) {
        if (job < 64) mtile_i8_block(p.w_in, p.g_mix, job, tid, (LAS unsigned*)lds, (u32x4*)(p.winf) + (size_t)job * 32 * 64, (float*)p.wsci);
        else if (job < 128) mtile_i8_block(p.w_query, nullptr, job - 64, tid, (LAS unsigned*)lds, (u32x4*)(p.wqf) + (size_t)(job - 64) * 32 * 64, (float*)p.wscq);
        else meta_block(p, tid, (LAS float*)lds);
    }
    int jw = gw, jn = nw;
    if (nb >= 129 + 64) { jw = vb >= 129 ? (vb - 129) * 8 + wv : J_END; jn = (nb - 129) * 8; }
    for (int job = jw; job < J_END / 2; job += jn) {
        if (job < J_WQ / 2) { const int q = 2 * job, i = q >> 6, sA = q & 63; frag2_from_kn(p.w_out, 1024, i, sA, lane, (u32x4*)(p.woutf) + (size_t)q * 64 + lane); }
        else if (job < J_KEY / 2) { const int q = 2 * job - J_PW, g = q >> 5, mt = (q >> 3) & 3, sA = q & 7; frag2_from_kn(p.pool_w + (size_t)g * 128 * 128, 128, mt, sA, lane, (u32x4*)(p.pwf) + (size_t)q * 64 + lane); }
        else {
            const int q = 2 * job - J_KEY, hp = q >> 5, kt = (q >> 3) & 3, sA = q & 7, r = lane & 31, h = lane >> 5;
            const float* src = p.sub_keys + ((size_t)hp * 128 + 32 * kt + r) * 128 + 16 * sA + 4 * h;
            const f32x4 f0 = *(const f32x4*)src, f1 = *(const f32x4*)(src + 8), f2 = *(const f32x4*)(src + 16), f3 = *(const f32x4*)(src + 24);
            u32x4 o; o.x = pk_bf16(f0[0], f0[1]); o.y = pk_bf16(f0[2], f0[3]); o.z = pk_bf16(f1[0], f1[1]); o.w = pk_bf16(f1[2], f1[3]);
            u32x4 o2; o2.x = pk_bf16(f2[0], f2[1]); o2.y = pk_bf16(f2[2], f2[3]); o2.z = pk_bf16(f3[0], f3[1]); o2.w = pk_bf16(f3[2], f3[3]);
            ((u32x4*)(p.kf))[(size_t)q * 64 + lane] = o; ((u32x4*)(p.kf))[(size_t)(q + 1) * 64 + lane] = o2;
        }
    }
}

struct TabBatch { f32x4 f[4][4]; };
__device__ __forceinline__ int tab_rpb(int nb) { return ((2 * 16384 + nb - 1) / nb + 31) & ~31; }
__device__ __forceinline__ int tab_row(int vb, int nb, int wv, int i) { const int rpb = tab_rpb(nb), row = vb * rpb + 8 * i + wv; return (8 * i + wv < rpb && row < 2 * 16384) ? row : -1; }
__device__ __forceinline__ void tab_issue(const Params& p, int vb, int nb, int wv, int i0, int lane, TabBatch& t) {
#pragma unroll
    for (int q = 0; q < 4; ++q) {
        const int row = tab_row(vb, nb, wv, i0 + q);
        if (row >= 0) { const float* src = (row < 16384 ? p.eu : p.ev) + (size_t)(row & 16383) * D;
#pragma unroll
            for (int i = 0; i < 4; ++i) t.f[q][i] = ldg<f32x4>(src, (unsigned)(i * 256 + 4 * lane) * 4u); }
    }
}
__device__ __forceinline__ void tab_finish(const Params& p, int vb, int nb, int wv, int i0, int lane, const TabBatch& t) {
#pragma unroll
    for (int q = 0; q < 4; ++q) {
        const int row = tab_row(vb, nb, wv, i0 + q);
        if (row >= 0) {
            const bool isu = row < 16384; const int rr = row & 16383;
            float ss = 0.f;
#pragma unroll
            for (int i = 0; i < 4; ++i) ss += t.f[q][i][0] * t.f[q][i][0] + t.f[q][i][1] * t.f[q][i][1] + t.f[q][i][2] * t.f[q][i][2] + t.f[q][i][3] * t.f[q][i][3];
            ss = wave_sum(ss);
            const float step = 0.355f * sqrtf(ss * (1.0f / D));
            const float inv = step > 0.f ? 1.0f / step : 0.f;
            auto q4 = [&](float f) { return (int)fminf(fmaxf(rintf(f * inv), -7.0f), 7.0f); };
            const int lo8 = isu ? 0 : 8;
            unsigned char* dstt = isu ? p.eut : p.evt;
#pragma unroll
            for (int i = 0; i < 4; ++i) {
                const int q0 = q4(t.f[q][i][0]) + lo8, q1 = q4(t.f[q][i][1]), q2 = q4(t.f[q][i][2]) + lo8, q3 = q4(t.f[q][i][3]);
                const unsigned w = ((unsigned)q0 & 15u) | (((unsigned)q1 & 15u) << 4) | (((unsigned)q2 & 15u) << 8) | (((unsigned)q3 & 15u) << 12);
                stg<unsigned short>(dstt, (((unsigned)i * 16384u + (unsigned)rr) << 7) + (unsigned)lane * 2u, (unsigned short)w);
            }
            if (lane == 0) ((float*)(isu ? p.su : p.sv))[rr] = step;
        }
    }
}


template <int CH>
__device__ __forceinline__ void gemm22_chunk(const u32x4 (&a)[2][CH], const LAS unsigned char* b, int s0, f32x16 (&acc)[2][2]) {
#pragma unroll
    for (int u = 0; u < CH; ++u) {
        const u32x4 b0 = *(const LAS u32x4*)(b + (s0 + u) * 32), b1 = *(const LAS u32x4*)(b + 32 * TROW + (s0 + u) * 32);
        acc[0][0] = mfma32(a[0][u], b0, acc[0][0]); acc[0][1] = mfma32(a[0][u], b1, acc[0][1]);
        acc[1][0] = mfma32(a[1][u], b0, acc[1][0]); acc[1][1] = mfma32(a[1][u], b1, acc[1][1]);
    }
}
template <int KS, int CH = 4>
__device__ __forceinline__ void gemm22(const u32x4* abase, unsigned lane, const LAS unsigned char* b, f32x16 (&acc)[2][2], int kofs = 0) {
    constexpr int NC = KS / CH;
    static_assert(NC % 2 == 0 && (NC & (NC - 1)) == 0, "chunk count: even power of two");
    u32x4 pa[2][CH], pb[2][CH];
    const unsigned lo = lane * 16u;
    {
        const unsigned o0 = lo + (unsigned)((kofs & (NC - 1)) * CH) * 1024u;
#pragma unroll
        for (int u = 0; u < CH; ++u) { pa[0][u] = ldg<u32x4>(abase, o0 + u * 1024u); pa[1][u] = ldg<u32x4>(abase, o0 + (KS + u) * 1024u); }
    }
#pragma unroll 1
    for (int c = 0; c < NC; c += 2) {
        const int c0 = (c + kofs) & (NC - 1), c1 = (c + 1 + kofs) & (NC - 1), c2 = (c + 2 + kofs) & (NC - 1);
        const unsigned o1 = lo + (unsigned)(c1 * CH) * 1024u, o2 = lo + (unsigned)(c2 * CH) * 1024u;
#pragma unroll
        for (int u = 0; u < CH; ++u) { pb[0][u] = ldg<u32x4>(abase, o1 + u * 1024u); pb[1][u] = ldg<u32x4>(abase, o1 + (KS + u) * 1024u); }
        __builtin_amdgcn_sched_barrier(0);
        gemm22_chunk<CH>(pa, b, c0 * CH, acc);
        __builtin_amdgcn_sched_barrier(0);
#pragma unroll
        for (int u = 0; u < CH; ++u) { pa[0][u] = ldg<u32x4>(abase, o2 + u * 1024u); pa[1][u] = ldg<u32x4>(abase, o2 + (KS + u) * 1024u); }
        __builtin_amdgcn_sched_barrier(0);
        gemm22_chunk<CH>(pb, b, c1 * CH, acc);
        __builtin_amdgcn_sched_barrier(0);
    }
}

template <int CH>
__device__ __forceinline__ void gemm22i_chunk(const u32x4 (&a)[2][CH], const LAS unsigned char* b, int s0, i32x16 (&acc)[2][2]) {
#pragma unroll
    for (int u = 0; u < CH; ++u) {
        const u32x4 b0 = *(const LAS u32x4*)(b + (s0 + u) * 32), b1 = *(const LAS u32x4*)(b + 32 * TROWB + (s0 + u) * 32);
        acc[0][0] = mfma_i8(a[0][u], b0, acc[0][0]); acc[0][1] = mfma_i8(a[0][u], b1, acc[0][1]);
        acc[1][0] = mfma_i8(a[1][u], b0, acc[1][0]); acc[1][1] = mfma_i8(a[1][u], b1, acc[1][1]);
    }
}
template <int KS, int CH = 4>
__device__ __forceinline__ void gemm22i(const u32x4* abase, unsigned lane, const LAS unsigned char* b, i32x16 (&acc)[2][2], int kofs = 0) {
    constexpr int NC = KS / CH;
    static_assert(NC % 2 == 0 && (NC & (NC - 1)) == 0, "chunk count: even power of two");
    u32x4 pa[2][CH], pb[2][CH];
    const unsigned lo = lane * 16u;
    {
        const unsigned o0 = lo + (unsigned)((kofs & (NC - 1)) * CH) * 1024u;
#pragma unroll
        for (int u = 0; u < CH; ++u) { pa[0][u] = ldg<u32x4>(abase, o0 + u * 1024u); pa[1][u] = ldg<u32x4>(abase, o0 + (KS + u) * 1024u); }
    }
#pragma unroll 1
    for (int c = 0; c < NC; c += 2) {
        const int c0 = (c + kofs) & (NC - 1), c1 = (c + 1 + kofs) & (NC - 1), c2 = (c + 2 + kofs) & (NC - 1);
        const unsigned o1 = lo + (unsigned)(c1 * CH) * 1024u, o2 = lo + (unsigned)(c2 * CH) * 1024u;
#pragma unroll
        for (int u = 0; u < CH; ++u) { pb[0][u] = ldg<u32x4>(abase, o1 + u * 1024u); pb[1][u] = ldg<u32x4>(abase, o1 + (KS + u) * 1024u); }
        __builtin_amdgcn_sched_barrier(0);
        gemm22i_chunk<CH>(pa, b, c0 * CH, acc);
        __builtin_amdgcn_sched_barrier(0);
#pragma unroll
        for (int u = 0; u < CH; ++u) { pa[0][u] = ldg<u32x4>(abase, o2 + u * 1024u); pa[1][u] = ldg<u32x4>(abase, o2 + (KS + u) * 1024u); }
        __builtin_amdgcn_sched_barrier(0);
        gemm22i_chunk<CH>(pb, b, c1 * CH, acc);
        __builtin_amdgcn_sched_barrier(0);
    }
}

__device__ __forceinline__ void p1_stage(const Params& p, int tile, int tid, LAS unsigned char* lds) {
    const int lane = tid & 63, wv = __builtin_amdgcn_readfirstlane(tid >> 6);
    LAS float* rs = (LAS float*)(lds + LDS_RS);
    const float* xt = p.x + (size_t)tile * 64 * D;
#pragma unroll 4
    for (int rr = 0; rr < 8; ++rr) {
        const int tk = 8 * wv + rr;
        f32x4 f[4]; float ss = 0.f, am = 0.f;
#pragma unroll
        for (int i = 0; i < 4; ++i) { f[i] = ldg<f32x4>(xt, (unsigned)(tk * D + i * 256 + 4 * lane) * 4u); ss += f[i][0] * f[i][0] + f[i][1] * f[i][1] + f[i][2] * f[i][2] + f[i][3] * f[i][3];
            am = fmaxf(am, fmaxf(fmaxf(fabsf(f[i][0]), fabsf(f[i][1])), fmaxf(fabsf(f[i][2]), fabsf(f[i][3])))); }
        ss = wave_sum(ss);
#pragma unroll
        for (int o = 32; o > 0; o >>= 1) am = fmaxf(am, __shfl_xor(am, o));
        const float inv = am > 0.f ? 127.0f / am : 0.f;
        if (lane == 0) rs[tk] = rsqrtf(ss * (1.0f / D) + EPS) * am * (1.0f / 127.0f);
#pragma unroll
        for (int i = 0; i < 4; ++i) {
            unsigned w = 0u;
#pragma unroll
            for (int e = 0; e < 4; ++e) w |= ((unsigned)(int)rintf(f[i][e] * inv) & 255u) << (8 * e);
            *(LAS unsigned*)(lds + tk * TROWB + i * 256 + 4 * lane) = w;
        }
    }
    __syncthreads();
}
__device__ __forceinline__ void p1_inproj(const Params& p, int tile, int tid, LAS unsigned char* lds, int vb, int nb, bool do_tab) {
    const int lane = launder(tid) & 63, wv = __builtin_amdgcn_readfirstlane(tid >> 6), r = lane & 31, h = lane >> 5;
    const int b = tile >> 6, s0 = (tile & 63) * 64;
    LAS float* rs = (LAS float*)(lds + LDS_RS);
    const u32x4* WF = (const u32x4*)(p.winf);
    unsigned char* prow0 = p.proj + ((size_t)b * L + NMETA + s0) * (MIXIN * 2);
    const LAS unsigned char* bp = lds + r * TROWB + h * 16;
    const float rs0 = rs[r], rs1 = rs[32 + r];
    const int stg_k = (tile >> 3) & 7, stg_r = (tile >> 6) & 3;
#pragma unroll 1
    for (int rdx = 0; rdx < 4; ++rdx) {
        const int rd = (rdx + stg_r) & 3;
        const int i0 = 8 * wv + 2 * rd;
        TabBatch tb;
        if (do_tab) tab_issue(p, vb, nb, wv, 4 * rdx, lane, tb);
        __builtin_amdgcn_sched_barrier(0);
        i32x16 acc[2][2]; acc[0][0] = izero16(); acc[0][1] = izero16(); acc[1][0] = izero16(); acc[1][1] = izero16();
        gemm22i<32, 4>(WF + (size_t)i0 * 32 * 64, lane, bp, acc, stg_k);
        f32x4 wsv[2][4];
#pragma unroll
        for (int mi = 0; mi < 2; ++mi)
#pragma unroll
            for (int q = 0; q < 4; ++q) wsv[mi][q] = ldg<f32x4>(p.wsci, (unsigned)(32 * (i0 + mi) + 8 * q + 4 * h) * 4u);
        LAS unsigned char* eb = lds + 64 * TROWB + wv * 8192;
#pragma unroll
        for (int mi = 0; mi < 2; ++mi)
#pragma unroll
            for (int q = 0; q < 4; ++q) {
                const f32x4 ws = wsv[mi][q];
#pragma unroll
                for (int nt = 0; nt < 2; ++nt) {
                    const float rv = nt ? rs1 : rs0;
                    u32x2 o; o.x = pk_bf16((float)acc[mi][nt][4 * q] * rv * ws[0], (float)acc[mi][nt][4 * q + 1] * rv * ws[1]); o.y = pk_bf16((float)acc[mi][nt][4 * q + 2] * rv * ws[2], (float)acc[mi][nt][4 * q + 3] * rv * ws[3]);
                    *(LAS u32x2*)(eb + (nt * 32 + r) * 128 + (((4 * mi + q) ^ (r & 7)) * 16) + 8 * h) = o;
                }
            }
        wave_sync();
        {
            u32x4 ov[8];
#pragma unroll
            for (int k = 0; k < 8; ++k) { const int row = 8 * k + (lane >> 3); ov[k] = *(const LAS u32x4*)(eb + row * 128 + (((lane & 7) ^ (row & 7)) * 16)); }
            wave_sync();
#pragma unroll
            for (int k = 0; k < 8; ++k) { const int row = 8 * k + (lane >> 3); stg<u32x4>(prow0, (unsigned)(row * MIXIN + 32 * i0) * 2u + (unsigned)(lane & 7) * 16u, ov[k]); }
        }
        if (do_tab) tab_finish(p, vb, nb, wv, 4 * rdx, lane, tb);
    }
    if (do_tab) for (int i0 = 16; 8 * i0 < tab_rpb(nb); i0 += 4) { TabBatch tb; tab_issue(p, vb, nb, wv, i0, lane, tb); tab_finish(p, vb, nb, wv, i0, lane, tb); }
}
__device__ __forceinline__ void p1_meta(const Params& p, int mp, int lane) {
    const int r = lane & 31, h = lane >> 5;
    const u32x4* A = (const u32x4*)(p.winf) + (size_t)(2 * mp) * 32 * 64;
    const u32x4* B = (const u32x4*)(p.metaf);
    i32x16 acc0 = izero16(), acc1 = izero16();
#pragma unroll 4
    for (int s = 0; s < 32; ++s) { const u32x4 bf = ldg<u32x4>(B, (unsigned)(s * 64 + lane) * 16u);
        acc0 = mfma_i8(ldg<u32x4>(A, (unsigned)(s * 64 + lane) * 16u), bf, acc0); acc1 = mfma_i8(ldg<u32x4>(A, (unsigned)((32 + s) * 64 + lane) * 16u), bf, acc1); }
    if (r < NMETA) {
        const float rv = ((const float*)(p.rsm))[r];
#pragma unroll
        for (int q = 0; q < 4; ++q) {
            const f32x4 w0 = ldg<f32x4>(p.wsci, (unsigned)(64 * mp + 8 * q + 4 * h) * 4u), w1 = ldg<f32x4>(p.wsci, (unsigned)(64 * mp + 32 + 8 * q + 4 * h) * 4u);
            u32x2 o0, o1;
            o0.x = pk_bf16((float)acc0[4 * q] * rv * w0[0], (float)acc0[4 * q + 1] * rv * w0[1]); o0.y = pk_bf16((float)acc0[4 * q + 2] * rv * w0[2], (float)acc0[4 * q + 3] * rv * w0[3]);
            o1.x = pk_bf16((float)acc1[4 * q] * rv * w1[0], (float)acc1[4 * q + 1] * rv * w1[1]); o1.y = pk_bf16((float)acc1[4 * q + 2] * rv * w1[2], (float)acc1[4 * q + 3] * rv * w1[3]);
#pragma unroll
            for (int bb = 0; bb < BATCH; ++bb) {
                const unsigned ro = (unsigned)((bb * L + r) * MIXIN + 64 * mp + 4 * h) * 2u;
                stg<u32x2>(p.proj, ro + 16u * q, o0); stg<u32x2>(p.proj, ro + 64u + 16u * q, o1);
            }
        }
    }
}

template <int LOGN> __device__ __forceinline__ void bitonic_sort_desc(float* v) {
    constexpr int N = 1 << LOGN;
#pragma unroll
    for (int lk = 1; lk <= LOGN; ++lk) {
#pragma unroll
        for (int lj = lk - 1; lj >= 0; --lj) {
#pragma unroll
            for (int i = 0; i < N; ++i) {
                const int k = 1 << lk, j = 1 << lj, l = i ^ j;
                if (l > i) { const bool up = ((i & k) == 0); const float a = v[i], c = v[l]; const float hi = fmaxf(a, c), lo = fminf(a, c); v[i] = up ? hi : lo; v[l] = up ? lo : hi; }
            }
        }
    }
}
__device__ __forceinline__ void bitonic_merge16_desc(float* v) {
#pragma unroll
    for (int lj = 3; lj >= 0; --lj) {
#pragma unroll
        for (int i = 0; i < 16; ++i) { const int j = 1 << lj, l = i ^ j; if (l > i) { const float a = v[i], c = v[l]; v[i] = fmaxf(a, c); v[l] = fminf(a, c); } }
    }
}
__device__ __forceinline__ void merge_top16(float* a, const float* c) {
#pragma unroll
    for (int i = 0; i < 16; ++i) a[i] = fmaxf(a[i], c[15 - i]);
    bitonic_merge16_desc(a);
}
__device__ __forceinline__ void top16_of_64(float* v) {
    bitonic_sort_desc<4>(v); bitonic_sort_desc<4>(v + 16); bitonic_sort_desc<4>(v + 32); bitonic_sort_desc<4>(v + 48);
    merge_top16(v, v + 16); merge_top16(v + 32, v + 48); merge_top16(v, v + 32);
}
__device__ __forceinline__ float embed_bits(float x, unsigned mask, unsigned code) { return __builtin_bit_cast(float, (__builtin_bit_cast(unsigned, x) & ~mask) | code); }

template <int W>
__device__ __forceinline__ void pool_window(const unsigned char* pbat, int p0, int cp, LAS unsigned char* dst) {
    unsigned u[31 + W];
#pragma unroll
    for (int i = 0; i < 31 + W; ++i) u[i] = ldg<unsigned>(pbat + (size_t)(p0 - (W - 1) + i) * 4096u, cp * 4u);
    float sx = 0.f, sy = 0.f;
#pragma unroll
    for (int i = 0; i < W - 1; ++i) { sx += bf_lo(u[i]); sy += bf_hi(u[i]); }
    const float invw = 1.0f / (float)W;
#pragma unroll
    for (int tk = 0; tk < 32; ++tk) {
        const float lo = bf_lo(u[W - 1 + tk]), hi = bf_hi(u[W - 1 + tk]);
        sx += lo; sy += hi;
        *(LAS unsigned*)(dst + tk * TROW) = pk_bf16(sx * invw - lo, sy * invw - hi);
        sx -= bf_lo(u[tk]); sy -= bf_hi(u[tk]);
    }
}

template <int RB>
__device__ __forceinline__ void p2_xf_batch(const Params& p, int tile, int wv, int lane, LAS unsigned char* lds, unsigned char* ht, f32x4 (&f)[4][4], const u32x2 (&hq)[8][4], const f32x4 (&gg)[4]) {
    unsigned char* xqt = p.xq + (size_t)tile * 64 * D;
#pragma unroll
    for (int rr = 0; rr < 4; ++rr) {
        const int tk = 8 * wv + RB + rr;
        float ss = 0.f;
#pragma unroll
        for (int i = 0; i < 4; ++i) {
            const u32x2 hw = hq[RB + rr][i];
            f[rr][i][0] += bf_lo(hw.x); f[rr][i][1] += bf_hi(hw.x); f[rr][i][2] += bf_lo(hw.y); f[rr][i][3] += bf_hi(hw.y);
            u32x2 ho; ho.x = pk_bf16(f[rr][i][0], f[rr][i][1]); ho.y = pk_bf16(f[rr][i][2], f[rr][i][3]);
            stg<u32x2>(ht, (unsigned)(tk * D + i * 256 + 4 * lane) * 2u, ho);
            ss += f[rr][i][0] * f[rr][i][0] + f[rr][i][1] * f[rr][i][1] + f[rr][i][2] * f[rr][i][2] + f[rr][i][3] * f[rr][i][3];
        }
        ss = wave_sum(ss);
        const float rv = rsqrtf(ss * (1.0f / D) + EPS);
        float am = 0.f;
#pragma unroll
        for (int i = 0; i < 4; ++i)
#pragma unroll
            for (int e = 0; e < 4; ++e) { f[rr][i][e] *= rv * gg[i][e]; am = fmaxf(am, fabsf(f[rr][i][e])); }
#pragma unroll
        for (int o = 32; o > 0; o >>= 1) am = fmaxf(am, __shfl_xor(am, o));
        const float inv = am > 0.f ? 127.0f / am : 0.f;
#pragma unroll
        for (int i = 0; i < 4; ++i) {
            unsigned w = 0u;
#pragma unroll
            for (int e = 0; e < 4; ++e) w |= ((unsigned)(int)fminf(rintf(f[rr][i][e] * inv), 119.0f) & 255u) << (8 * e);
            stg<unsigned>(xqt, (unsigned)(tk * D + i * 256 + 4 * lane), w);
            *(LAS unsigned*)(lds + tk * TROWB + i * 256 + 4 * lane) = w;
        }
        if (lane == 0) { ((LAS float*)(lds + LDS_RS))[tk] = am * (1.0f / 127.0f); ((float*)p.sx)[tile * 64 + tk] = am * (1.0f / 127.0f); }
    }
}

__device__ __forceinline__ void p2_mix(const Params& p, int tile, int tid, LAS unsigned char* lds) {
    const int wv = __builtin_amdgcn_readfirstlane(tid >> 6);
    const int b = tile >> 6, s0 = (tile & 63) * 64;
    LAS float* ssa = (LAS float*)(lds + LDS_SSA);
    const unsigned char* pbat = p.proj + (size_t)b * L * (MIXIN * 2);
    const float* xt = p.x + (size_t)tile * 64 * D;
    unsigned char* ht = p.hb + (size_t)tile * 64 * D * 2;
    if (tid < 64) ssa[tid] = 0.f;
    {
        const int lane = launder(tid) & 63, r = lane & 31, h = lane >> 5; (void)r; (void)h;
        float cw[3][8], gbv[8], u1[8], u2[8];
#pragma unroll
        for (int k = 0; k < 3; ++k) { const f32x4 a = ldg<f32x4>(p.conv_w, (unsigned)(k * MIXB + 8 * lane) * 4u), c = ldg<f32x4>(p.conv_w, (unsigned)(k * MIXB + 8 * lane + 4) * 4u);
#pragma unroll
            for (int e = 0; e < 4; ++e) { cw[k][e] = a[e]; cw[k][4 + e] = c[e]; } }
        { const f32x4 a = ldg<f32x4>(p.g_b, (unsigned)(8 * lane) * 4u), c = ldg<f32x4>(p.g_b, (unsigned)(8 * lane + 4) * 4u);
#pragma unroll
            for (int e = 0; e < 4; ++e) { gbv[e] = a[e]; gbv[4 + e] = c[e]; } }
        const int p0 = NMETA + s0 + 8 * wv;
        u32x4 bvv[8], cvv[10], vvv[10];
#pragma unroll
        for (int i = 0; i < 10; ++i) { const unsigned ro = (unsigned)(p0 - 2 + i) * 4096u + lane * 16u; cvv[i] = ldg<u32x4>(pbat, ro + 2048u); vvv[i] = ldg<u32x4>(pbat, ro + 3072u); if (i >= 2) bvv[i - 2] = ldg<u32x4>(pbat, ro + 1024u); }
    {
        const int cp = tid & 255, th = __builtin_amdgcn_readfirstlane(tid >> 8), g = __builtin_amdgcn_readfirstlane(cp >> 6);
        const int p0 = NMETA + s0 + 32 * th;
        LAS unsigned char* dst = lds + (32 * th) * TROW + cp * 4;
        if (g == 0) pool_window<2>(pbat, p0, cp, dst); else if (g == 1) pool_window<4>(pbat, p0, cp, dst); else if (g == 2) pool_window<8>(pbat, p0, cp, dst); else pool_window<16>(pbat, p0, cp, dst);
    }
#pragma unroll
        for (int e = 0; e < 4; ++e) { u2[2 * e] = bf_lo(cvv[0][e]) * bf_lo(vvv[0][e]); u2[2 * e + 1] = bf_hi(cvv[0][e]) * bf_hi(vvv[0][e]); u1[2 * e] = bf_lo(cvv[1][e]) * bf_lo(vvv[1][e]); u1[2 * e + 1] = bf_hi(cvv[1][e]) * bf_hi(vvv[1][e]); }
#pragma unroll
        for (int tk = 0; tk < 8; ++tk) {
            const u32x4 bv = bvv[tk], cv = cvv[tk + 2], vv = vvv[tk + 2];
            float z[8], ss = 0.f;
#pragma unroll
            for (int e = 0; e < 8; ++e) {
                const float bb = (e & 1) ? bf_hi(bv[e >> 1]) : bf_lo(bv[e >> 1]);
                const float u0 = ((e & 1) ? bf_hi(cv[e >> 1]) : bf_lo(cv[e >> 1])) * ((e & 1) ? bf_hi(vv[e >> 1]) : bf_lo(vv[e >> 1]));
                const float conv = u2[e] * cw[0][e] + u1[e] * cw[1][e] + u0 * cw[2][e];
                z[e] = bb * conv; ss += z[e] * z[e];
                u2[e] = u1[e]; u1[e] = u0;
            }
            ss = wave_sum(ss);
            const float rsb = rsqrtf(ss * (1.0f / MIXB) + EPS);
            u32x4 o; o.x = pk_bf16(z[0] * rsb * gbv[0], z[1] * rsb * gbv[1]); o.y = pk_bf16(z[2] * rsb * gbv[2], z[3] * rsb * gbv[3]);
            o.z = pk_bf16(z[4] * rsb * gbv[4], z[5] * rsb * gbv[5]); o.w = pk_bf16(z[6] * rsb * gbv[6], z[7] * rsb * gbv[7]);
            *(LAS u32x4*)(lds + (8 * wv + tk) * TROW + (MIXA + 8 * lane) * 2) = o;
        }
    }
    __syncthreads();
    {
        const int lane = launder(tid) & 63, r = lane & 31, h = lane >> 5; (void)r; (void)h;
        const int g = wv >> 1, dh = wv & 1;
        const u32x4* PWF = (const u32x4*)(p.pwf);
        f32x16 acc[2][2]; acc[0][0] = zero16(); acc[0][1] = zero16(); acc[1][0] = zero16(); acc[1][1] = zero16();
        gemm22<8>(PWF + (size_t)((g * 4 + 2 * dh) * 8) * 64, lane, lds + r * TROW + g * 256 + h * 16, acc);
        float ss0 = 0.f, ss1 = 0.f;
#pragma unroll
        for (int mi = 0; mi < 2; ++mi)
#pragma unroll
            for (int q = 0; q < 4; ++q) {
                const int d = g * 128 + 32 * (2 * dh + mi) + 8 * q + 4 * h;
                const f32x4 sc = ldg<f32x4>(p.pool_scale, (unsigned)d * 4u);
#pragma unroll
                for (int e = 0; e < 4; ++e) { acc[mi][0][4 * q + e] *= sc[e]; acc[mi][1][4 * q + e] *= sc[e]; ss0 += acc[mi][0][4 * q + e] * acc[mi][0][4 * q + e]; ss1 += acc[mi][1][4 * q + e] * acc[mi][1][4 * q + e]; }
            }
        ss0 += __shfl_xor(ss0, 32); ss1 += __shfl_xor(ss1, 32);
        if (h == 0) { atomicAdd((float*)(ssa + r), ss0); atomicAdd((float*)(ssa + 32 + r), ss1); }
        __syncthreads();
        const float ra0 = rsqrtf(ssa[r] * (1.0f / MIXA) + EPS), ra1 = rsqrtf(ssa[32 + r] * (1.0f / MIXA) + EPS);
#pragma unroll
        for (int mi = 0; mi < 2; ++mi)
#pragma unroll
            for (int q = 0; q < 4; ++q) {
                const int d = g * 128 + 32 * (2 * dh + mi) + 8 * q + 4 * h;
                const f32x4 gg = ldg<f32x4>(p.g_a, (unsigned)d * 4u);
                u32x2 o0, o1;
                o0.x = pk_bf16(acc[mi][0][4 * q] * ra0 * gg[0], acc[mi][0][4 * q + 1] * ra0 * gg[1]); o0.y = pk_bf16(acc[mi][0][4 * q + 2] * ra0 * gg[2], acc[mi][0][4 * q + 3] * ra0 * gg[3]);
                o1.x = pk_bf16(acc[mi][1][4 * q] * ra1 * gg[0], acc[mi][1][4 * q + 1] * ra1 * gg[1]); o1.y = pk_bf16(acc[mi][1][4 * q + 2] * ra1 * gg[2], acc[mi][1][4 * q + 3] * ra1 * gg[3]);
                *(LAS u32x2*)(lds + r * TROW + d * 2) = o0;
                *(LAS u32x2*)(lds + (32 + r) * TROW + d * 2) = o1;
            }
    }
    __syncthreads();
    f32x4 xa[4][4];
    {
        const int lane = launder(tid) & 63, r = lane & 31, h = lane >> 5; (void)r; (void)h;
#pragma unroll
        for (int rr = 0; rr < 4; ++rr)
#pragma unroll
            for (int i = 0; i < 4; ++i) xa[rr][i] = ldg<f32x4>(xt, (unsigned)((8 * wv + rr) * D + i * 256 + 4 * lane) * 4u);
        const u32x4* WF = (const u32x4*)(p.woutf);
        const LAS unsigned char* bp = lds + r * TROW + h * 16;
#pragma unroll 1
        for (int rdx = 0; rdx < 2; ++rdx) {
            const int rd = (rdx + (tile >> 7)) & 1;
            const int i0 = 4 * wv + 2 * rd;
            f32x16 acc[2][2]; acc[0][0] = zero16(); acc[0][1] = zero16(); acc[1][0] = zero16(); acc[1][1] = zero16();
            gemm22<64>(WF + (size_t)i0 * 64 * 64, lane, bp, acc, (tile >> 3) & 15);
            LAS unsigned char* eb = lds + LDS_LUT + wv * 2048;
#pragma unroll
            for (int nt = 0; nt < 2; ++nt)
#pragma unroll
                for (int hf = 0; hf < 2; ++hf) {
                    if ((r >> 4) == hf) {
#pragma unroll
                        for (int mi = 0; mi < 2; ++mi)
#pragma unroll
                            for (int q = 0; q < 4; ++q) {
                                u32x2 hw; hw.x = pk_bf16(acc[mi][nt][4 * q], acc[mi][nt][4 * q + 1]); hw.y = pk_bf16(acc[mi][nt][4 * q + 2], acc[mi][nt][4 * q + 3]);
                                *(LAS u32x2*)(eb + (r & 15) * 128 + (((4 * mi + q) ^ (r & 7)) * 16) + 8 * h) = hw;
                            }
                    }
                    wave_sync();
                    u32x4 ov[2];
#pragma unroll
                    for (int k = 0; k < 2; ++k) { const int row = 8 * k + (lane >> 3); ov[k] = *(const LAS u32x4*)(eb + row * 128 + (((lane & 7) ^ (row & 7)) * 16)); }
                    wave_sync();
#pragma unroll
                    for (int k = 0; k < 2; ++k) { const int row = 8 * k + (lane >> 3); stg<u32x4>(ht, (unsigned)((nt * 32 + hf * 16 + row) * D + 32 * i0) * 2u + (unsigned)(lane & 7) * 16u, ov[k]); }
                }
        }
    }
    __syncthreads();
    {
        const int lane = launder(tid) & 63;
        f32x4 gg[4];
#pragma unroll
        for (int i = 0; i < 4; ++i) gg[i] = ldg<f32x4>(p.g_ffn, (unsigned)(i * 256 + 4 * lane) * 4u);
        f32x4 xb[4][4];
#pragma unroll
        for (int rr = 0; rr < 4; ++rr)
#pragma unroll
            for (int i = 0; i < 4; ++i) xb[rr][i] = ldg<f32x4>(xt, (unsigned)((8 * wv + 4 + rr) * D + i * 256 + 4 * lane) * 4u);
        u32x2 hq[8][4];
#pragma unroll
        for (int rr = 0; rr < 4; ++rr)
#pragma unroll
            for (int i = 0; i < 4; ++i) hq[rr][i] = ldg<u32x2>(ht, (unsigned)((8 * wv + rr) * D + i * 256 + 4 * lane) * 2u);
        p2_xf_batch<0>(p, tile, wv, lane, lds, ht, xa, hq, gg);
#pragma unroll
        for (int rr = 4; rr < 8; ++rr)
#pragma unroll
            for (int i = 0; i < 4; ++i) hq[rr][i] = ldg<u32x2>(ht, (unsigned)((8 * wv + rr) * D + i * 256 + 4 * lane) * 2u);
        p2_xf_batch<4>(p, tile, wv, lane, lds, ht, xb, hq, gg);
    }
    __syncthreads();
    {
        const int lane = launder(tid) & 63, r = lane & 31, h = lane >> 5; (void)r; (void)h;
        const int hd = wv;
        const u32x4* WQF = (const u32x4*)(p.wqf);
        const u32x4* KF = (const u32x4*)(p.kf);
        unsigned char* lstt = p.lst + (size_t)tile * 64 * (NH * 32 * 4);
        const LAS unsigned char* bp = lds + r * TROWB + h * 16;
        const float sx0 = ((const LAS float*)(lds + LDS_RS))[r], sx1 = ((const LAS float*)(lds + LDS_RS))[32 + r];
        LAS unsigned char* lut = lds + LDS_LUT + wv * 2048;
#pragma unroll
        for (int pp = 0; pp < 2; ++pp) {
            const int hp = hd * 2 + pp;
            u32x4 qb[8];
            LAS u32x4* qpark = (LAS u32x4*)(lds + 64 * TROWB + wv * 8192) + lane;
#pragma unroll
            for (int mh = 0; mh < 2; ++mh) {
                const int mt0 = hp * 4 + mh * 2;
                i32x16 acc[2][2]; acc[0][0] = izero16(); acc[0][1] = izero16(); acc[1][0] = izero16(); acc[1][1] = izero16();
                gemm22i<32, QCH>(WQF + (size_t)mt0 * 32 * 64, lane, bp, acc, (tile >> 3));
#pragma unroll
                for (int mi = 0; mi < 2; ++mi)
#pragma unroll
                    for (int s2 = 0; s2 < 2; ++s2) {
                        const f32x4 w0 = ldg<f32x4>(p.wscq, (unsigned)(32 * (mt0 + mi) + 16 * s2 + 4 * h) * 4u), w1 = ldg<f32x4>(p.wscq, (unsigned)(32 * (mt0 + mi) + 16 * s2 + 8 + 4 * h) * 4u);
#pragma unroll
                        for (int nt = 0; nt < 2; ++nt) {
                            const float xs = nt ? sx1 : sx0;
                            u32x4 o; o.x = pk_bf16((float)acc[mi][nt][8 * s2] * xs * w0[0], (float)acc[mi][nt][8 * s2 + 1] * xs * w0[1]); o.y = pk_bf16((float)acc[mi][nt][8 * s2 + 2] * xs * w0[2], (float)acc[mi][nt][8 * s2 + 3] * xs * w0[3]);
                            o.z = pk_bf16((float)acc[mi][nt][8 * s2 + 4] * xs * w1[0], (float)acc[mi][nt][8 * s2 + 5] * xs * w1[1]); o.w = pk_bf16((float)acc[mi][nt][8 * s2 + 6] * xs * w1[2], (float)acc[mi][nt][8 * s2 + 7] * xs * w1[3]);
                            if (nt == 0) qb[2 * (mh * 2 + mi) + s2] = o; else qpark[(2 * (mh * 2 + mi) + s2) * 64] = o;
                        }
                    }
            }
#pragma unroll
            for (int nt = 0; nt < 2; ++nt) {
                float top[16];
#pragma unroll
                for (int i = 0; i < 16; ++i) top[i] = -INFINITY;
                if (nt == 1) {
#pragma unroll
                    for (int ks = 0; ks < 8; ++ks) qb[ks] = qpark[ks * 64];
                }
                const u32x4* kfp = KF + (size_t)(hp * 4 * 8) * 64;
                u32x4 kf[8];
#pragma unroll
                for (int ks = 0; ks < 8; ++ks) kf[ks] = ldg<u32x4>(kfp, (unsigned)(ks * 64 + lane) * 16u);
#pragma unroll 1
                for (int kt = 0; kt < 4; ++kt) {
                    f32x16 sa = zero16();
#pragma unroll
                    for (int ks = 0; ks < 8; ++ks) sa = mfma32(kf[ks], qb[ks], sa);
                    __builtin_amdgcn_sched_barrier(0);
                    const int ktn = (kt + 1) & 3;
#pragma unroll
                    for (int ks = 0; ks < 8; ++ks) kf[ks] = ldg<u32x4>(kfp, (unsigned)((ktn * 8 + ks) * 64 + lane) * 16u);
                    __builtin_amdgcn_sched_barrier(0);
                    float v[16];
#pragma unroll
                    for (int i = 0; i < 16; ++i) v[i] = embed_bits(sa[i], 127u, (unsigned)(32 * kt + (i & 3) + 8 * (i >> 2) + 4 * h));
                    bitonic_sort_desc<4>(v); merge_top16(top, v);
                    __builtin_amdgcn_sched_barrier(0);
                }
                float o[16];
#pragma unroll
                for (int i = 0; i < 16; ++i) o[i] = __shfl_xor(top[i], 32);
                merge_top16(top, o);
                if (h == 0) {
                    const unsigned lo = (unsigned)((((nt * 32 + r) * NH + hd) * 2 + pp) * 16) * 4u;
#pragma unroll
                    for (int w4 = 0; w4 < 4; ++w4) { f32x4 tv; tv[0] = top[4 * w4]; tv[1] = top[4 * w4 + 1]; tv[2] = top[4 * w4 + 2]; tv[3] = top[4 * w4 + 3]; stg<f32x4>(lstt, lo + 16u * w4, tv); }
                    u32x4 kb;
#pragma unroll
                    for (int w4 = 0; w4 < 4; ++w4) kb[w4] = (__builtin_bit_cast(unsigned, top[4 * w4]) & 127u) | ((__builtin_bit_cast(unsigned, top[4 * w4 + 1]) & 127u) << 8) | ((__builtin_bit_cast(unsigned, top[4 * w4 + 2]) & 127u) << 16) | ((__builtin_bit_cast(unsigned, top[4 * w4 + 3]) & 127u) << 24);
                    *(LAS u32x4*)(lut + ((nt * 32 + r) * 2 + pp) * 16) = kb;
                }
            }
        }
#pragma unroll
        for (int nt = 0; nt < 2; ++nt) {
            float s1[16], s2[16];
            {
                const unsigned lo = (unsigned)(((nt * 32 + r) * NH + hd) * 32) * 4u;
#pragma unroll
                for (int w4 = 0; w4 < 4; ++w4) { const f32x4 a = ldg<f32x4>(lstt, lo + 16u * w4), c = ldg<f32x4>(lstt, lo + 64u + 16u * w4);
#pragma unroll
                    for (int e4 = 0; e4 < 4; ++e4) { s1[4 * w4 + e4] = a[e4]; s2[4 * w4 + e4] = c[e4]; } }
            }
            float top[16];
#pragma unroll
            for (int i = 0; i < 16; ++i) top[i] = -INFINITY;
            { float v[16]; v[0] = embed_bits(s1[0] + s2[0], 255u, 0u); v[1] = embed_bits(s1[0] + s2[1], 255u, 1u); v[2] = embed_bits(s1[0] + s2[2], 255u, 2u); v[3] = embed_bits(s1[0] + s2[3], 255u, 3u); v[4] = embed_bits(s1[0] + s2[4], 255u, 4u); v[5] = embed_bits(s1[0] + s2[5], 255u, 5u); v[6] = embed_bits(s1[0] + s2[6], 255u, 6u); v[7] = embed_bits(s1[0] + s2[7], 255u, 7u); v[8] = embed_bits(s1[0] + s2[8], 255u, 8u); v[9] = embed_bits(s1[0] + s2[9], 255u, 9u); v[10] = embed_bits(s1[0] + s2[10], 255u, 10u); v[11] = embed_bits(s1[0] + s2[11], 255u, 11u); v[12] = embed_bits(s1[0] + s2[12], 255u, 12u); v[13] = embed_bits(s1[0] + s2[13], 255u, 13u); v[14] = embed_bits(s1[0] + s2[14], 255u, 14u); v[15] = embed_bits(s1[0] + s2[15], 255u, 15u);
              bitonic_sort_desc<4>(v); merge_top16(top, v); }
            { float v[16]; v[0] = embed_bits(s1[1] + s2[0], 255u, 16u); v[1] = embed_bits(s1[1] + s2[1], 255u, 17u); v[2] = embed_bits(s1[1] + s2[2], 255u, 18u); v[3] = embed_bits(s1[1] + s2[3], 255u, 19u); v[4] = embed_bits(s1[1] + s2[4], 255u, 20u); v[5] = embed_bits(s1[1] + s2[5], 255u, 21u); v[6] = embed_bits(s1[1] + s2[6], 255u, 22u); v[7] = embed_bits(s1[1] + s2[7], 255u, 23u); v[8] = embed_bits(s1[2] + s2[0], 255u, 32u); v[9] = embed_bits(s1[2] + s2[1], 255u, 33u); v[10] = embed_bits(s1[2] + s2[2], 255u, 34u); v[11] = embed_bits(s1[2] + s2[3], 255u, 35u); v[12] = embed_bits(s1[2] + s2[4], 255u, 36u); v[13] = embed_bits(s1[3] + s2[0], 255u, 48u); v[14] = embed_bits(s1[3] + s2[1], 255u, 49u); v[15] = embed_bits(s1[3] + s2[2], 255u, 50u);
              bitonic_sort_desc<4>(v); merge_top16(top, v); }
            { float v[16]; v[0] = embed_bits(s1[3] + s2[3], 255u, 51u); v[1] = embed_bits(s1[4] + s2[0], 255u, 64u); v[2] = embed_bits(s1[4] + s2[1], 255u, 65u); v[3] = embed_bits(s1[4] + s2[2], 255u, 66u); v[4] = embed_bits(s1[5] + s2[0], 255u, 80u); v[5] = embed_bits(s1[5] + s2[1], 255u, 81u); v[6] = embed_bits(s1[6] + s2[0], 255u, 96u); v[7] = embed_bits(s1[6] + s2[1], 255u, 97u); v[8] = embed_bits(s1[7] + s2[0], 255u, 112u); v[9] = embed_bits(s1[7] + s2[1], 255u, 113u); v[10] = embed_bits(s1[8] + s2[0], 255u, 128u); v[11] = embed_bits(s1[9] + s2[0], 255u, 144u); v[12] = embed_bits(s1[10] + s2[0], 255u, 160u); v[13] = embed_bits(s1[11] + s2[0], 255u, 176u); v[14] = embed_bits(s1[12] + s2[0], 255u, 192u); v[15] = embed_bits(s1[13] + s2[0], 255u, 208u);
              bitonic_sort_desc<4>(v); merge_top16(top, v); }
            { float v[16]; v[0] = embed_bits(s1[14] + s2[0], 255u, 224u); v[1] = embed_bits(s1[15] + s2[0], 255u, 240u); v[2] = -INFINITY; v[3] = -INFINITY; v[4] = -INFINITY; v[5] = -INFINITY; v[6] = -INFINITY; v[7] = -INFINITY; v[8] = -INFINITY; v[9] = -INFINITY; v[10] = -INFINITY; v[11] = -INFINITY; v[12] = -INFINITY; v[13] = -INFINITY; v[14] = -INFINITY; v[15] = -INFINITY;
              bitonic_sort_desc<4>(v); merge_top16(top, v); }
            float e[16], sum = 0.f;
#pragma unroll
            for (int i = 0; i < 16; ++i) { e[i] = __expf(top[i] - top[0]); sum += e[i]; }
            const float inv = 1.0f / sum;
            const LAS unsigned char* lt = lut + (nt * 32 + r) * 32;
            LAS unsigned char* slot = lds + 64 * TROWB + wv * 8192 + (nt * 32 + r) * 32;
            if (h == 0) {
                int ids[16];
#pragma unroll
                for (int i = 0; i < 16; ++i) { const unsigned code = __builtin_bit_cast(unsigned, top[i]) & 255u; ids[i] = (int)lt[code >> 4] * NKEYS + (int)lt[16 + (code & 15u)]; }
                u32x4 w0, w1;
#pragma unroll
                for (int i = 0; i < 4; ++i) { w0[i] = (unsigned)ids[i] | ((unsigned)ids[i + 8] << 16); w1[i] = (unsigned)ids[i + 4] | ((unsigned)ids[i + 12] << 16); }
                *(LAS u32x4*)(slot) = w0; *(LAS u32x4*)(slot + 16) = w1;
            } else {
#pragma unroll
                for (int i = 0; i < 4; ++i) { f32x4 gv; gv[0] = e[2 * i] * inv; gv[1] = e[2 * i + 8] * inv; gv[2] = e[2 * i + 1] * inv; gv[3] = e[2 * i + 9] * inv; *(LAS f32x4*)(slot + 2048 + (nt * 32 + r) * 32 + 16 * i) = gv; }
            }
        }
    }
    __syncthreads();
    {
        const LAS unsigned char* sl = lds + 64 * TROWB;
        unsigned char* idxt = p.idx + (size_t)tile * 64 * (HK * 2);
        unsigned char* gatet = p.gate + (size_t)tile * 64 * (HK * 4);
        u32x4 iv[2]; f32x4 gv[4];
#pragma unroll
        for (int k = 0; k < 2; ++k) { const int ci = tid + 512 * k, tok = ci >> 4, c = ci & 15;
#pragma unroll
            for (int q = 0; q < 4; ++q) iv[k][q] = *(const LAS unsigned*)(sl + (4 * (c & 1) + q) * 8192 + tok * 32 + (c >> 1) * 4); }
#pragma unroll
        for (int k = 0; k < 4; ++k) { const int ci = tid + 512 * k, tok = ci >> 5, c = ci & 31;
            const f32x2 a = *(const LAS f32x2*)(sl + (2 * (c & 3)) * 8192 + 2048 + tok * 64 + (c >> 2) * 8), b = *(const LAS f32x2*)(sl + (2 * (c & 3) + 1) * 8192 + 2048 + tok * 64 + (c >> 2) * 8);
            gv[k][0] = a[0]; gv[k][1] = a[1]; gv[k][2] = b[0]; gv[k][3] = b[1]; }
#pragma unroll
        for (int k = 0; k < 2; ++k) stg<u32x4>(idxt, (unsigned)(tid + 512 * k) * 16u, iv[k]);
#pragma unroll
        for (int k = 0; k < 4; ++k) stg<f32x4>(gatet, (unsigned)(tid + 512 * k) * 16u, gv[k]);
    }
}

__device__ __forceinline__ int dot16_i8(u32x4 a, u32x4 b) {
    int d = __builtin_amdgcn_sdot4((int)a[0], (int)b[0], 0, false);
    d = __builtin_amdgcn_sdot4((int)a[1], (int)b[1], d, false); d = __builtin_amdgcn_sdot4((int)a[2], (int)b[2], d, false); d = __builtin_amdgcn_sdot4((int)a[3], (int)b[3], d, false);
    return d;
}
__device__ __forceinline__ float gelu_exact(float z) { return 0.5f * z * (1.0f + erff(z * 0.70710678118654752f)); }

struct GMeta { int ids[16]; u32x4 x; };
struct GRows { u32x4 v[16]; };
__device__ __forceinline__ void g_rows(const unsigned char* slice, const GMeta& m, int lane, GRows& r) {
    const unsigned co = (unsigned)(lane & 7) * 16u;
#pragma unroll
    for (int i = 0; i < 16; ++i) r.v[i] = ldg<u32x4>(slice, (unsigned)m.ids[i] + co);
}

constexpr int P3W_Z = 0, P3W_CQ = 4096, P3W_SC = 5120, P3W_CS = 5152, P3W_ID = 5184, P3W_X = 9280, P3W_SSQ = 17472, P3W_BYTES = 19520;
constexpr int LDS_ALL = LDS_BYTES > 8 * P3W_BYTES ? LDS_BYTES : 8 * P3W_BYTES;
__device__ __forceinline__ void p3_wave(const Params& p, int tb0, int tb1, int lt, int pos, int lane, LAS unsigned char* wl) {
    const int ntok = 1 << lt;
    auto tokf = [&](int q) { return (q < 4 ? tb0 : tb1) + (q & 3); };
    const int grp = lane >> 3, ch = lane & 7, i0 = ((ch >> 2) & 1) * 8 + ((ch >> 1) & 1) * 4 + (ch & 1) * 2;
    LAS int* zl = (LAS int*)(wl + P3W_Z);
    LAS float* scl = (LAS float*)(wl + P3W_SC);
    LAS float* ssl = (LAS float*)(wl + P3W_SSQ);
#pragma unroll
    for (int q = 0; q < 8; ++q) if (q < ntok) {
        const int t = tokf(q);
        { const unsigned w = ldg<unsigned>(p.idx + (size_t)t * (HK * 2), (unsigned)lane * 4u); u32x2 o2; o2.x = (w & 0xffffu) << 7; o2.y = (w >> 16) << 7; *(LAS u32x2*)(wl + P3W_ID + q * 512 + lane * 8) = o2; }
        {
            const u32x4 xw = ldg<u32x4>(p.xq + (size_t)t * D, (unsigned)lane * 16u);
            unsigned lo[4], hi[4];
#pragma unroll
            for (int d = 0; d < 4; ++d) { const unsigned L = xw[d] & 0x0f0f0f0fu, H = (((((xw[d] ^ 0x80808080u) + 0x08080808u) >> 4) & 0x0f0f0f0fu) ^ 0x08080808u); lo[d] = L | (L >> 4); hi[d] = H | (H >> 4); }
            u32x2 xl, xh;
            xl.x = __builtin_amdgcn_perm(lo[1], lo[0], 0x06040200u); xl.y = __builtin_amdgcn_perm(lo[3], lo[2], 0x06040200u);
            xh.x = __builtin_amdgcn_perm(hi[1], hi[0], 0x06040200u); xh.y = __builtin_amdgcn_perm(hi[3], hi[2], 0x06040200u);
            LAS unsigned char* xd = wl + P3W_X + q * 1024 + (lane >> 4) * 256 + ((lane >> 1) & 7) * 32 + (lane & 1) * 8;
            *(LAS u32x2*)(xd) = xl; *(LAS u32x2*)(xd + 16) = xh;
        }
    }
    wave_sync();
    auto ids_lds = [&](int q, GMeta& m) {
#pragma unroll
        for (int w = 0; w < 4; ++w) { const u32x4 a = *(const LAS u32x4*)(wl + P3W_ID + q * 512 + grp * 64 + 16 * w);
#pragma unroll
            for (int e = 0; e < 4; ++e) m.ids[4 * w + e] = (int)a[e]; }
    };
#pragma unroll 1
    for (int st = 0; st < 4; ++st) {
        const int j = (pos + st) & 3;
        const unsigned char* slice = p.eut + (size_t)j * (16384 * 128);
        const unsigned xo = (unsigned)(256 * j + 32 * ch);
#pragma unroll 1
        for (int q = 0; q < ntok; ++q) {
            GMeta m; GRows r; ids_lds(q, m); m.x = *(const LAS u32x4*)(wl + P3W_X + q * 1024 + xo); const u32x4 xh = *(const LAS u32x4*)(wl + P3W_X + q * 1024 + xo + 16); g_rows(slice, m, lane, r);
            int part[16];
#pragma unroll
            for (int i = 0; i < 16; ++i) {
                int al = __builtin_amdgcn_sdot8((int)r.v[i][0], (int)m.x[0], 0, false), ah = __builtin_amdgcn_sdot8((int)r.v[i][0], (int)xh[0], 0, false);
#pragma unroll
                for (int d = 1; d < 4; ++d) { al = __builtin_amdgcn_sdot8((int)r.v[i][d], (int)m.x[d], al, false); ah = __builtin_amdgcn_sdot8((int)r.v[i][d], (int)xh[d], ah, false); }
                part[i] = al + 16 * ah;
            }
#pragma unroll
            for (int lv = 2; lv >= 0; --lv) {
                const int n = 2 << lv, off = 1 << lv;
                const bool up = (lane & off) != 0;
#pragma unroll
                for (int i = 0; i < n; ++i) { const int a = part[i], c = part[i + n]; const int send = up ? a : c, keep = up ? c : a; part[i] = keep + __shfl_xor(send, off); }
            }
            LAS int* zp = zl + q * 128 + 2 * lane;
            if (st == 0) { zp[0] = part[0]; zp[1] = part[1]; } else { zp[0] += part[0]; zp[1] += part[1]; }
        }
    }
    {
        const unsigned po = (unsigned)(grp * 16 + i0) * 4u;
        u32x2 idw[8]; f32x2 g[8]; float sx[8];
#pragma unroll
        for (int q = 0; q < 8; ++q) { const int t = tokf(q < ntok ? q : 0); idw[q] = *(const LAS u32x2*)(wl + P3W_ID + (q < ntok ? q : 0) * 512 + po); g[q] = ldg<f32x2>(p.gate + (size_t)t * (HK * 4), po); sx[q] = ((const float*)p.sx)[t]; }
        float su0[8], su1[8], sv0[8], sv1[8];
#pragma unroll
        for (int q = 0; q < 8; ++q) { const int a = (int)(idw[q].x >> 7), c = (int)(idw[q].y >> 7); su0[q] = ((const float*)p.su)[a]; su1[q] = ((const float*)p.su)[c]; sv0[q] = ((const float*)p.sv)[a]; sv1[q] = ((const float*)p.sv)[c]; }
#pragma unroll
        for (int q = 0; q < 8; ++q) if (q < ntok) {
            const int z0 = zl[q * 128 + 2 * lane], z1 = zl[q * 128 + 2 * lane + 1];
            const float c0 = g[q][0] * gelu_exact((float)z0 * (sx[q] * su0[q])) * sv0[q];
            const float c1 = g[q][1] * gelu_exact((float)z1 * (sx[q] * su1[q])) * sv1[q];
            float am = fmaxf(fabsf(c0), fabsf(c1));
#pragma unroll
            for (int o = 32; o > 0; o >>= 1) am = fmaxf(am, __shfl_xor(am, o));
            const float inv = am > 0.f ? 127.0f / am : 0.f;
            const unsigned q0 = (unsigned)(int)rintf(c0 * inv) & 255u, q1 = (unsigned)(int)rintf(c1 * inv) & 255u;
            *(LAS unsigned short*)(wl + P3W_CQ + q * 128 + 16 * grp + i0) = (unsigned short)(q0 | (q1 << 8));
            int cs = (int)rintf(c0 * inv) + (int)rintf(c1 * inv);
#pragma unroll
            for (int o = 32; o > 0; o >>= 1) cs += __shfl_xor(cs, o);
            ssl[q * 64 + lane] = 0.f;
            if (lane == 0) { scl[q] = am * (1.0f / 127.0f); ((LAS int*)(wl + P3W_CS))[q] = cs; }
        }
    }
    wave_sync();
    {
        const int nvs = 4 << lt;
        auto meta = [&](int n, GMeta& m, float& sc, u32x2& hv) {
            const int nn = n < nvs ? n : nvs - 1, q = nn & (ntok - 1), j = (pos + (nn >> lt)) & 3, t = tokf(q);
            ids_lds(q, m);
            m.x = *(const LAS u32x4*)(wl + P3W_CQ + q * 128 + 16 * grp);
            sc = scl[q];
            hv = ldg<u32x2>(p.hb + (size_t)t * D * 2, (unsigned)(256 * j + 32 * ch + 4 * grp) * 2u);
        };
        auto rows = [&](int n, const GMeta& m, GRows& r) { const int nn = n < nvs ? n : nvs - 1; g_rows(p.evt + (size_t)((pos + (nn >> lt)) & 3) * (16384 * 128), m, lane, r); };
        auto finish = [&](int n, const GMeta& m, const GRows& r, float sc, u32x2 hv) {
            const int q = n & (ntok - 1), j = (pos + (n >> lt)) & 3, t = tokf(q);
            int acc[32];
#pragma unroll
            for (int e = 0; e < 32; ++e) acc[e] = 0;
#pragma unroll
            for (int g = 0; g < 4; ++g)
#pragma unroll
                for (int e = 0; e < 4; ++e) {
                    const int cq = (int)m.x[g];
                    const unsigned A = r.v[4 * g][e], B = r.v[4 * g + 1][e], C = r.v[4 * g + 2][e], Dd = r.v[4 * g + 3][e];
                    const unsigned t0 = __builtin_amdgcn_perm(B, A, 0x05010400u), t1 = __builtin_amdgcn_perm(B, A, 0x07030602u);
                    const unsigned t2 = __builtin_amdgcn_perm(Dd, C, 0x05010400u), t3 = __builtin_amdgcn_perm(Dd, C, 0x07030602u);
                    const unsigned r0 = __builtin_amdgcn_perm(t2, t0, 0x05040100u), r1 = __builtin_amdgcn_perm(t2, t0, 0x07060302u);
                    const unsigned r2 = __builtin_amdgcn_perm(t3, t1, 0x05040100u), r3 = __builtin_amdgcn_perm(t3, t1, 0x07060302u);
                    int* a4 = acc + 8 * e;
                    a4[0] = __builtin_amdgcn_sdot4((int)(r0 & 0x0f0f0f0fu), cq, a4[0], false); a4[2] = __builtin_amdgcn_sdot4((int)(r1 & 0x0f0f0f0fu), cq, a4[2], false);
                    a4[4] = __builtin_amdgcn_sdot4((int)(r2 & 0x0f0f0f0fu), cq, a4[4], false); a4[6] = __builtin_amdgcn_sdot4((int)(r3 & 0x0f0f0f0fu), cq, a4[6], false);
                    a4[1] = __builtin_amdgcn_sdot4((int)r0, cq, a4[1], false); a4[3] = __builtin_amdgcn_sdot4((int)r1, cq, a4[3], false);
                    a4[5] = __builtin_amdgcn_sdot4((int)r2, cq, a4[5], false); a4[7] = __builtin_amdgcn_sdot4((int)r3, cq, a4[7], false);
                }
#pragma unroll
            for (int i = 0; i < 16; ++i) { const auto sw = __builtin_amdgcn_permlane32_swap((unsigned)acc[i], (unsigned)acc[i + 16], false, false); acc[i] = (int)(sw[0] + sw[1]); }
#pragma unroll
            for (int i = 0; i < 8; ++i) { const auto sw = __builtin_amdgcn_permlane16_swap((unsigned)acc[i], (unsigned)acc[i + 8], false, false); acc[i] = (int)(sw[0] + sw[1]); }
            {
                const bool up = (lane & 8) != 0;
#pragma unroll
                for (int i = 0; i < 4; ++i) {
                    const int xs = acc[i] + __builtin_amdgcn_update_dpp(0, acc[i], 0x128, 0xf, 0xf, false), ys = acc[i + 4] + __builtin_amdgcn_update_dpp(0, acc[i + 4], 0x128, 0xf, 0xf, false);
                    acc[i] = up ? ys : xs;
                }
            }
            const int c8 = 8 * ((const LAS int*)(wl + P3W_CS))[q];
            f32x4 o; o[0] = (float)(acc[0] - c8) * sc + bf_lo(hv.x); o[1] = (float)((acc[1] - acc[0]) >> 4) * sc + bf_hi(hv.x); o[2] = (float)(acc[2] - c8) * sc + bf_lo(hv.y); o[3] = (float)((acc[3] - acc[2]) >> 4) * sc + bf_hi(hv.y);
            stg<f32x4>(p.out + (size_t)t * D, (unsigned)(256 * j + 32 * ch + 4 * grp) * 4u, o);
            atomicAdd((float*)(ssl + q * 64 + lane), o[0] * o[0] + o[1] * o[1] + o[2] * o[2] + o[3] * o[3]);
        };
        GMeta ma, mb; GRows ra, rb; float sa, sb; u32x2 ha, hb;
        meta(0, ma, sa, ha); meta(1, mb, sb, hb); rows(0, ma, ra);
#pragma unroll 1
        for (int n = 0; n < nvs; n += 2) {
            GMeta mc; float scc; u32x2 hc;
            meta(n + 2, mc, scc, hc); rows(n + 1, mb, rb);
            __builtin_amdgcn_sched_barrier(0);
            finish(n, ma, ra, sa, ha);
            __builtin_amdgcn_sched_barrier(0);
            meta(n + 3, ma, sa, ha); rows(n + 2, mc, ra);
            __builtin_amdgcn_sched_barrier(0);
            finish(n + 1, mb, rb, sb, hb);
            __builtin_amdgcn_sched_barrier(0);
            mb = ma; sb = sa; hb = ha; ma = mc; sa = scc; ha = hc;
        }
    }
    asm volatile("s_waitcnt vmcnt(0)" ::: "memory");
    __builtin_amdgcn_fence(__ATOMIC_ACQUIRE, "agent");
    {
        f32x4 gg[4];
#pragma unroll
        for (int i = 0; i < 4; ++i) gg[i] = ldg<f32x4>(p.g_fin, (unsigned)(i * 256 + 4 * lane) * 4u);
#pragma unroll 1
        for (int qb = 0; qb < ntok; qb += 4) {
            f32x4 a[4][4];
#pragma unroll
            for (int b = 0; b < 4; ++b)
#pragma unroll
                for (int i = 0; i < 4; ++i) a[b][i] = ldg<f32x4>(p.out + (size_t)tokf(qb + b) * D, (unsigned)(i * 256 + 4 * lane) * 4u);
#pragma unroll
            for (int b = 0; b < 4; ++b) {
                const float rv = rsqrtf(wave_sum(ssl[(qb + b) * 64 + lane]) * (1.0f / D) + EPS);
#pragma unroll
                for (int i = 0; i < 4; ++i) { f32x4 ov;
#pragma unroll
                    for (int e = 0; e < 4; ++e) ov[e] = a[b][i][e] * rv * gg[i][e];
                    stg<f32x4>(p.out + (size_t)tokf(qb + b) * D, (unsigned)(i * 256 + 4 * lane) * 4u, ov); }
            }
        }
    }
}

#define XB_TMO      128
#define XB_XCNT(j)  (256  + 64 * (j))
#define XB_XSUB(j)  (1280 + 64 * (j))
#define XB_XGEN(j)  (2304 + 64 * (j))
#define XB_TOP      3328
#define XB_TOPGEN   3392
#define XCD_BAR_WORDS 3456
#define XB_SPIN_CAP (1u << 18)

__device__ __forceinline__ unsigned xb_ld(unsigned* p)              { return __hip_atomic_load(p, __ATOMIC_RELAXED, __HIP_MEMORY_SCOPE_AGENT); }
__device__ __forceinline__ unsigned xb_add(unsigned* p, unsigned v) { return __hip_atomic_fetch_add(p, v, __ATOMIC_RELAXED, __HIP_MEMORY_SCOPE_AGENT); }
__device__ __forceinline__ unsigned xb_xcc_id() { return (unsigned)__builtin_amdgcn_s_getreg((3 << 11) | 20) & 0xFu; }
#define XB_SPIN(cond, bar) do { unsigned _sp = 0; while (cond) { __builtin_amdgcn_s_sleep(1); \
    if ((++_sp & 255u) == 0u) { if (xb_ld(&(bar)[XB_TMO])) break; if (_sp > XB_SPIN_CAP) { atomicAdd(&(bar)[XB_TMO], 1u); break; } } } } while (0)

struct XcdBarrier {
    unsigned* bar; unsigned x;
    volatile LAS unsigned* st;
};

__device__ __forceinline__ XcdBarrier xcd_barrier_post(unsigned* bar, volatile LAS unsigned* st) {
    XcdBarrier b; b.bar = bar; b.x = xb_xcc_id(); b.st = st;
    if (threadIdx.x == 0) (void)xb_add(&bar[XB_XCNT(b.x)], 1u);
    return b;
}
__device__ __forceinline__ void xcd_barrier_complete(unsigned* bar, unsigned x, unsigned& nloc, unsigned& nx) {
    const unsigned G = gridDim.x * gridDim.y * gridDim.z;
    unsigned sum, cnt, mine, sp = 0u;
    for (;;) {
        sum = 0u; cnt = 0u; mine = 0u;
#pragma unroll
        for (unsigned j = 0; j < 16; ++j) { const unsigned c = xb_ld(&bar[XB_XCNT(j)]); sum += c; cnt += (c > 0u) ? 1u : 0u; mine = (j == x) ? c : mine; }
        if (sum == G) break;
        __builtin_amdgcn_s_sleep(1);
        if ((++sp & 255u) == 0u) { if (xb_ld(&bar[XB_TMO])) break; if (sp > XB_SPIN_CAP) { atomicAdd(&bar[XB_TMO], 1u); break; } }
    }
    nloc = mine > 0u ? mine : 1u; nx = cnt > 0u ? cnt : 1u;
}

__device__ __forceinline__ void xcd_barrier(const XcdBarrier& b) {
    asm volatile("s_waitcnt vmcnt(0)" ::: "memory");
    __syncthreads();
    if (threadIdx.x == 0) {
        unsigned* bar = b.bar;
        __builtin_amdgcn_s_waitcnt(0);
        unsigned nloc = b.st[0], nx = b.st[1];
        if (nloc == 0u) { xcd_barrier_complete(bar, b.x, nloc, nx); b.st[0] = nloc; b.st[1] = nx; }
        const unsigned old = xb_add(&bar[XB_XSUB(b.x)], 1u);
        const unsigned gen = old / nloc;
        if (old + 1u == (gen + 1u) * nloc) {
            __builtin_amdgcn_fence(__ATOMIC_RELEASE, "agent");
            asm volatile("s_waitcnt vmcnt(0)" ::: "memory");
            const unsigned og = xb_add(&bar[XB_TOP], 1u);
            const unsigned tg = og / nx;
            if (og + 1u == (tg + 1u) * nx) xb_add(&bar[XB_TOPGEN], 1u);
            else XB_SPIN(xb_ld(&bar[XB_TOPGEN]) == tg, bar);
            __builtin_amdgcn_fence(__ATOMIC_ACQUIRE, "agent");
            xb_add(&bar[XB_XGEN(b.x)], 1u);
            asm volatile("s_waitcnt vmcnt(0)" ::: "memory");
        } else {
            XB_SPIN(xb_ld(&bar[XB_XGEN(b.x)]) == gen, bar);
            __builtin_amdgcn_fence(__ATOMIC_ACQUIRE, "agent");
            asm volatile("s_waitcnt vmcnt(0)" ::: "memory");
        }
    }
    __syncthreads();
}


__global__ void __launch_bounds__(512) k_fwd(Params p) {
    __shared__ __attribute__((aligned(16))) unsigned char lds_raw[LDS_ALL + 16];
    LAS unsigned char* lds = (LAS unsigned char*)lds_raw;
    const int tid = threadIdx.x, vb = blockIdx.x, nb = gridDim.x;
    volatile LAS unsigned* xbw = (volatile LAS unsigned*)(lds + LDS_ALL);
    if (tid < 4) xbw[tid] = 0u;
    __syncthreads();
    XcdBarrier gb = xcd_barrier_post((unsigned*)p.bar, xbw);
    if (tid == 0) xbw[2] = xb_add(&((unsigned*)p.bar)[XCD_BAR_WORDS + 64 * gb.x], 1u);
    p0_prep(p, vb, nb, tid, lds);
    const bool early = vb >= 129 && vb < NTILES;
    if (early) p1_stage(p, vb, tid, lds);
    xcd_barrier(gb);
    for (int tile = vb; tile < NTILES; tile += nb) { if (!(early && tile == vb)) p1_stage(p, tile, tid, lds); p1_inproj(p, tile, tid, lds, vb, nb, tile == vb); __syncthreads(); }
    if ((tid >> 6) == 0) for (int mp = vb; mp < 32; mp += nb) p1_meta(p, mp, launder(tid) & 63);
    xcd_barrier(gb);
    for (int tile = vb; tile < NTILES; tile += nb) { p2_mix(p, tile, tid, lds); __syncthreads(); }
    xcd_barrier(gb);
    const int lane = launder(tid) & 63, wv = __builtin_amdgcn_readfirstlane(tid >> 6);
    int np = 0, mypos = 0, nloc = 1;
    {
        unsigned* bar = (unsigned*)p.bar;
        const int myx = (int)gb.x;
#pragma unroll
        for (int q = 0; q < 16; ++q) { const int c = (int)xb_ld(&bar[XB_XCNT(q)]); if (q == myx) { mypos = np; nloc = c > 0 ? c : 1; } np += (c > 0) ? 1 : 0; }
        if (np < 1) np = 1;
    }
    {
        const int rank = (int)xbw[2];
        LAS unsigned char* wl = lds + wv * P3W_BYTES;
#pragma unroll 1
        for (int k = rank; mypos + np * k < T / 32; k += 2 * nloc) {
            const int c0 = mypos + np * k, c1 = mypos + np * (k + nloc);
            p3_wave(p, 32 * c0 + 4 * wv, 32 * c1 + 4 * wv, c1 < T / 32 ? 3 : 2, mypos, lane, wl);
        }
    }
}
}

extern "C" void kernel_launch(void* const* d_in, const int* in_sizes, int n_in, void* d_out, int out_size, void* d_ws, size_t ws_size, hipStream_t stream) {
    static int grid_blocks = 0;
    if (n_in != 16 || out_size != T * D) { fprintf(stderr, "kernel_launch: unexpected sizes n_in %d out %d\n", n_in, out_size); return; }
    if (!grid_blocks) {
        int dev = 0, cus = 0, per_cu = 0;
        (void)hipGetDevice(&dev);
        (void)hipDeviceGetAttribute(&cus, hipDeviceAttributeMultiprocessorCount, dev);
        (void)hipOccupancyMaxActiveBlocksPerMultiprocessor(&per_cu, (const void*)k_fwd, 512, 0);
        if (per_cu < 1) { fprintf(stderr, "kernel_launch: occupancy query returned %d\n", per_cu); per_cu = 1; }
        grid_blocks = cus * 1;
    }
    Params p{};
    p.x = (const float*)d_in[0]; p.meta = (const float*)d_in[1]; p.g_mix = (const float*)d_in[2]; p.w_in = (const float*)d_in[3]; p.pool_w = (const float*)d_in[4];
    p.pool_scale = (const float*)d_in[5]; p.conv_w = (const float*)d_in[6]; p.g_a = (const float*)d_in[7]; p.g_b = (const float*)d_in[8]; p.w_out = (const float*)d_in[9];
    p.g_ffn = (const float*)d_in[10]; p.w_query = (const float*)d_in[11]; p.sub_keys = (const float*)d_in[12]; p.eu = (const float*)d_in[13]; p.ev = (const float*)d_in[14]; p.g_fin = (const float*)d_in[15];
    p.out = (float*)d_out;
    unsigned char* ws = (unsigned char*)d_ws;
    p.winf = ws; p.woutf = ws + (4u << 20); p.wqf = ws + (6u << 20); p.kf = ws + (10u << 20); p.pwf = p.kf + (512u << 10); p.metaf = p.pwf + (128u << 10); p.rsm = p.metaf + (64u << 10); p.bar = p.rsm + 256;
    p.eut = ws + (12u << 20); p.evt = p.eut + (32u << 20); p.proj = p.evt + (32u << 20); p.idx = p.proj + (size_t)TL * MIXIN * 2; p.gate = p.idx + (size_t)T * HK * 4; p.lst = p.gate + (size_t)T * HK * 4;
    p.su = p.lst + (size_t)T * NH * 32 * 4; p.sv = p.su + 65536; p.sx = p.sv + 65536; p.xq = p.sx + 65536; p.wsci = p.xq + (size_t)T * D; p.wscq = p.wsci + 8192; p.hb = p.wscq + 8192;
    if ((size_t)(p.hb - ws) + (size_t)T * D * 2 > ws_size) { fprintf(stderr, "kernel_launch: workspace too small\n"); return; }
    if (hipMemsetAsync(p.bar, 0, (XCD_BAR_WORDS + 64 * 16) * 4, stream) != hipSuccess) { fprintf(stderr, "kernel_launch: memset of the barrier words failed\n"); return; }
    hipLaunchKernelGGL(k_fwd, dim3(grid_blocks), dim3(512), 0, stream, p);
}
```

```cpp
#include <hip/hip_runtime.h>
#include <cstdio>
#include <cstdint>
#include <math.h>

namespace {
constexpr int D = 1024, BATCH = 4, SEQ = 4096, NMETA = 16, L = SEQ + NMETA;
constexpr int MIXA = 512, MIXB = 512, MIXIN = 2048;
constexpr int PW = 1536;
constexpr int NH = 8, NKEYS = 128, DQH = 128, TOPK = 16, HK = 128;
constexpr int T = BATCH * SEQ;
constexpr int TL = BATCH * L;
constexpr float EPS = 1e-6f;

struct U2_ { unsigned a, b; };
__device__ __forceinline__ U2_ swap16_self(unsigned x) { unsigned y = x; asm volatile("" : "+v"(y)); const auto s_ = __builtin_amdgcn_permlane16_swap(x, y, false, false); U2_ r; r.a = s_[0]; r.b = s_[1]; return r; }
__device__ __forceinline__ U2_ swap32_self(unsigned x) { unsigned y = x; asm volatile("" : "+v"(y)); const auto s_ = __builtin_amdgcn_permlane32_swap(x, y, false, false); U2_ r; r.a = s_[0]; r.b = s_[1]; return r; }
#define WAVE_ALL_(NAME, T, OP, TOI, FROMI) \
__device__ __forceinline__ T NAME(T v) { \
    v = OP(v, FROMI(__builtin_amdgcn_update_dpp(0, TOI(v), 0xb1, 0xf, 0xf, false))); \
    v = OP(v, FROMI(__builtin_amdgcn_update_dpp(0, TOI(v), 0x4e, 0xf, 0xf, false))); \
    v = OP(v, FROMI(__builtin_amdgcn_update_dpp(0, TOI(v), 0x141, 0xf, 0xf, false))); \
    v = OP(v, FROMI(__builtin_amdgcn_update_dpp(0, TOI(v), 0x140, 0xf, 0xf, false))); \
    { const U2_ s_ = swap16_self((unsigned)TOI(v)); v = OP(FROMI((int)s_.a), FROMI((int)s_.b)); } \
    { const U2_ s_ = swap32_self((unsigned)TOI(v)); v = OP(FROMI((int)s_.a), FROMI((int)s_.b)); } \
    return v; \
}
__device__ __forceinline__ int f2i_(float x) { return __builtin_bit_cast(int, x); }
__device__ __forceinline__ float i2f_(int x) { return __builtin_bit_cast(float, x); }
__device__ __forceinline__ int idi_(int x) { return x; }
__device__ __forceinline__ float addf_(float a, float b) { return a + b; }
__device__ __forceinline__ int addi_(int a, int b) { return a + b; }
WAVE_ALL_(wave_sum, float, addf_, f2i_, i2f_)
WAVE_ALL_(wave_max, float, fmaxf, f2i_, i2f_)
WAVE_ALL_(wave_sum_i, int, addi_, idi_, idi_)
#undef WAVE_ALL_
#define LAS __attribute__((address_space(3)))
typedef short bf16x8 __attribute__((ext_vector_type(8)));
typedef float f32x16 __attribute__((ext_vector_type(16)));
typedef float f32x4 __attribute__((ext_vector_type(4)));
typedef float f32x2 __attribute__((ext_vector_type(2)));
typedef __bf16 bf2_t __attribute__((ext_vector_type(2)));
typedef unsigned u32x4 __attribute__((ext_vector_type(4)));
typedef unsigned u32x2 __attribute__((ext_vector_type(2)));
typedef int i32x4 __attribute__((ext_vector_type(4)));
typedef int i32x16 __attribute__((ext_vector_type(16)));

constexpr int QCH = 2;
constexpr int NTILES = T / 64;
constexpr int TROW = 2064;
constexpr int TROWB = 1040;
constexpr int LDS_TILE = 64 * TROW;
constexpr int LDS_RS = LDS_TILE;
constexpr int LDS_SSA = LDS_RS + 256;
constexpr int LDS_LUT = LDS_SSA + 256;
constexpr int LDS_BYTES = LDS_LUT + 16384;

struct Params {
    const float* x; const float* meta; const float* g_mix; const float* w_in; const float* pool_w; const float* pool_scale; const float* conv_w;
    const float* g_a; const float* g_b; const float* w_out; const float* g_ffn; const float* w_query; const float* sub_keys; const float* eu; const float* ev; const float* g_fin;
    float* out;
    unsigned char *winf, *woutf, *wqf, *kf, *pwf, *metaf, *rsm, *eut, *evt, *proj, *idx, *gate, *bar, *lst, *su, *sv, *xq, *sx, *wsci, *wscq, *hb;
};

__device__ __forceinline__ unsigned pk_bf16(float lo, float hi) { f32x2 f = {lo, hi}; return __builtin_bit_cast(unsigned, __builtin_convertvector(f, bf2_t)); }
__device__ __forceinline__ float bf_lo(unsigned u) { return __builtin_bit_cast(float, u << 16); }
__device__ __forceinline__ float bf_hi(unsigned u) { return __builtin_bit_cast(float, u & 0xffff0000u); }
__device__ __forceinline__ f32x16 mfma32(u32x4 a, u32x4 b, f32x16 c) { return __builtin_amdgcn_mfma_f32_32x32x16_bf16(__builtin_bit_cast(bf16x8, a), __builtin_bit_cast(bf16x8, b), c, 0, 0, 0); }
__device__ __forceinline__ i32x16 mfma_i8(u32x4 a, u32x4 b, i32x16 c) { return __builtin_amdgcn_mfma_i32_32x32x32_i8(__builtin_bit_cast(i32x4, a), __builtin_bit_cast(i32x4, b), c, 0, 0, 0); }
__device__ __forceinline__ i32x16 izero16() { i32x16 z; for (int i = 0; i < 16; ++i) z[i] = 0; return z; }
__device__ __forceinline__ f32x16 zero16() { f32x16 z; for (int i = 0; i < 16; ++i) z[i] = 0.f; return z; }

__device__ __forceinline__ void wave_sync() { __builtin_amdgcn_fence(__ATOMIC_RELEASE, "wavefront"); __builtin_amdgcn_wave_barrier(); __builtin_amdgcn_fence(__ATOMIC_ACQUIRE, "wavefront"); }
__device__ __forceinline__ int launder(int x) { asm volatile("" : "+v"(x)); return x; }
template <class V> __device__ __forceinline__ V ldg(const void* base, unsigned off) { return *(const V*)((const unsigned char*)base + off); }
template <class V> __device__ __forceinline__ void stg(void* base, unsigned off, V v) { *(V*)((unsigned char*)base + off) = v; }

__device__ __forceinline__ void frag_from_kn(const float* __restrict__ W, int N, const float* __restrict__ g, int i, int s, int lane, u32x4* __restrict__ dst, int I8K = 0) {
    const int r = lane & 31, h = lane >> 5, k0 = 16 * s + 8 * h;
    const float* src = W + (size_t)k0 * N + 32 * i + r;
    float v[8];
#pragma unroll
    for (int j = 0; j < 8; ++j) v[j] = src[(size_t)j * N] * (g ? g[k0 + j] : 1.0f);
    u32x4 o; o.x = pk_bf16(v[0], v[1]); o.y = pk_bf16(v[2], v[3]); o.z = pk_bf16(v[4], v[5]); o.w = pk_bf16(v[6], v[7]);
    *dst = o;
}
__device__ __forceinline__ void frag2_from_kn(const float* __restrict__ W, int N, int i, int s, int lane, u32x4* __restrict__ dst) {
    const int r = lane & 31, h = lane >> 5, k0 = 16 * s + 8 * h;
    const float* src = W + (size_t)k0 * N + 32 * i + r;
    float v[16];
#pragma unroll
    for (int j = 0; j < 8; ++j) { v[j] = __builtin_nontemporal_load(src + (size_t)j * N); v[8 + j] = __builtin_nontemporal_load(src + (size_t)(16 + j) * N); }
    u32x4 o; o.x = pk_bf16(v[0], v[1]); o.y = pk_bf16(v[2], v[3]); o.z = pk_bf16(v[4], v[5]); o.w = pk_bf16(v[6], v[7]);
    u32x4 o2; o2.x = pk_bf16(v[8], v[9]); o2.y = pk_bf16(v[10], v[11]); o2.z = pk_bf16(v[12], v[13]); o2.w = pk_bf16(v[14], v[15]);
    dst[0] = o; dst[64] = o2;
}
constexpr int J_WOUT = 0, J_WQ = J_WOUT + 32 * 64, J_PW = J_WQ, J_KEY = J_PW + 128, J_END = J_KEY + 512;
__device__ __forceinline__ void mtile_i8_block(const float* __restrict__ W, const float* __restrict__ g, int i, int tid, LAS unsigned* lds_u, u32x4* __restrict__ dst, float* __restrict__ wsc) {
    const int lane = tid & 63, wv = tid >> 6, r = lane & 31, h = lane >> 5, col = 32 * i + r;
    LAS float* ldsw = (LAS float*)(lds_u + 64);
    if (tid < 32) lds_u[tid] = 0u;
    __syncthreads();
    {
        const int cg = lane & 7, ro = lane >> 3;
        f32x4 f[16];
#pragma unroll
        for (int q = 0; q < 16; ++q) f[q] = __builtin_nontemporal_load((const f32x4*)((const unsigned char*)W + (unsigned)((128 * wv + 8 * q + ro) * 2048 + 32 * i + 4 * cg) * 4u));
        float m0 = 0.f, m1 = 0.f, m2 = 0.f, m3 = 0.f;
#pragma unroll
        for (int q = 0; q < 16; ++q) { const float gk = g ? g[128 * wv + 8 * q + ro] : 1.0f; f32x4 t = f[q]; t[0] *= gk; t[1] *= gk; t[2] *= gk; t[3] *= gk;
            *(LAS f32x4*)(ldsw + (128 * wv + 8 * q + ro) * 32 + 4 * cg) = t;
            m0 = fmaxf(m0, fabsf(t[0])); m1 = fmaxf(m1, fabsf(t[1])); m2 = fmaxf(m2, fabsf(t[2])); m3 = fmaxf(m3, fabsf(t[3])); }
#pragma unroll
        for (int o = 8; o < 64; o <<= 1) { m0 = fmaxf(m0, __shfl_xor(m0, o)); m1 = fmaxf(m1, __shfl_xor(m1, o)); m2 = fmaxf(m2, __shfl_xor(m2, o)); m3 = fmaxf(m3, __shfl_xor(m3, o)); }
        if (lane < 8) { atomicMax((unsigned*)(lds_u + 4 * cg), __builtin_bit_cast(unsigned, m0)); atomicMax((unsigned*)(lds_u + 4 * cg + 1), __builtin_bit_cast(unsigned, m1));
            atomicMax((unsigned*)(lds_u + 4 * cg + 2), __builtin_bit_cast(unsigned, m2)); atomicMax((unsigned*)(lds_u + 4 * cg + 3), __builtin_bit_cast(unsigned, m3)); }
    }
    __syncthreads();
    const float cm = __builtin_bit_cast(float, lds_u[r]);
    const float inv = cm > 0.f ? 127.0f / cm : 0.f;
    if (wv == 0 && h == 0) wsc[col] = cm * (1.0f / 127.0f);
#pragma unroll
    for (int sl = 0; sl < 4; ++sl) {
        const int s = 4 * wv + sl, k0 = 32 * s + 16 * h;
        u32x4 o;
#pragma unroll
        for (int q = 0; q < 4; ++q) {
            unsigned w = 0u;
#pragma unroll
            for (int e = 0; e < 4; ++e) { const int k = k0 + 4 * q + e; w |= ((unsigned)(int)rintf(ldsw[k * 32 + r] * inv) & 255u) << (8 * e); }
            o[q] = w;
        }
        dst[(size_t)s * 64 + lane] = o;
    }
    __syncthreads();
}
__device__ __forceinline__ void meta_block(const Params& p, int tid, LAS float* lds_f) {
    const int lane = tid & 63, wv = tid >> 6;
#pragma unroll
    for (int q = 0; q < 2; ++q) {
        const int row = 2 * wv + q;
        float ss = 0.f, am = 0.f;
#pragma unroll
        for (int i = 0; i < 4; ++i) { const f32x4 f = *(const f32x4*)(p.meta + (size_t)row * D + i * 256 + 4 * lane); ss += f[0] * f[0] + f[1] * f[1] + f[2] * f[2] + f[3] * f[3];
            am = fmaxf(am, fmaxf(fmaxf(fabsf(f[0]), fabsf(f[1])), fmaxf(fabsf(f[2]), fabsf(f[3])))); }
        ss = wave_sum(ss);
        am = wave_max(am);
        if (lane == 0) { ((float*)(p.rsm))[row] = rsqrtf(ss * (1.0f / D) + EPS) * am * (1.0f / 127.0f); lds_f[row] = am; }
    }
    __syncthreads();
    const int n = lane & 31, h = lane >> 5;
    const float am = n < NMETA ? lds_f[n] : 0.f;
    const float inv = am > 0.f ? 127.0f / am : 0.f;
#pragma unroll
    for (int sl = 0; sl < 4; ++sl) {
        const int s = 4 * wv + sl;
        u32x4 o = {0u, 0u, 0u, 0u};
        if (n < NMETA) {
            const float* row = p.meta + (size_t)n * D;
#pragma unroll
            for (int q = 0; q < 4; ++q) { const f32x4 f = *(const f32x4*)(row + 32 * s + 16 * h + 4 * q);
                o[q] = ((unsigned)(int)rintf(f[0] * inv) & 255u) | (((unsigned)(int)rintf(f[1] * inv) & 255u) << 8) | (((unsigned)(int)rintf(f[2] * inv) & 255u) << 16) | (((unsigned)(int)rintf(f[3] * inv) & 255u) << 24); }
        }
        ((u32x4*)(p.metaf))[(size_t)s * 64 + lane] = o;
    }
    __syncthreads();
}

__device__ __forceinline__ void p0_prep(const Params& p, int vb, int nb, int tid, LAS unsigned char* lds) {
    const int lane = tid & 63, wv = tid >> 6, gw = vb * 8 + wv, nw = nb * 8;
    for (int job = vb; job < 129; job += nb) {
        if (job < 64) mtile_i8_block(p.w_in, p.g_mix, job, tid, (LAS unsigned*)lds, (u32x4*)(p.winf) + (size_t)job * 32 * 64, (float*)p.wsci);
        else if (job < 128) mtile_i8_block(p.w_query, nullptr, job - 64, tid, (LAS unsigned*)lds, (u32x4*)(p.wqf) + (size_t)(job - 64) * 32 * 64, (float*)p.wscq);
        else meta_block(p, tid, (LAS float*)lds);
    }
    int jw = gw, jn = nw;
    if (nb >= 129 + 64) { jw = vb >= 129 ? (vb - 129) * 8 + wv : J_END; jn = (nb - 129) * 8; }
    for (int job = jw; job < J_END / 2; job += jn) {
        if (job < J_WQ / 2) { const int q = 2 * job, i = q >> 6, sA = q & 63; frag2_from_kn(p.w_out, 1024, i, sA, lane, (u32x4*)(p.woutf) + (size_t)q * 64 + lane); }
        else if (job < J_KEY / 2) { const int q = 2 * job - J_PW, g = q >> 5, mt = (q >> 3) & 3, sA = q & 7; frag2_from_kn(p.pool_w + (size_t)g * 128 * 128, 128, mt, sA, lane, (u32x4*)(p.pwf) + (size_t)q * 64 + lane); }
        else {
            const int q = 2 * job - J_KEY, hp = q >> 5, kt = (q >> 3) & 3, sA = q & 7, r = lane & 31, h = lane >> 5;
            const float* src = p.sub_keys + ((size_t)hp * 128 + 32 * kt + r) * 128 + 16 * sA + 4 * h;
            const f32x4 f0 = *(const f32x4*)src, f1 = *(const f32x4*)(src + 8), f2 = *(const f32x4*)(src + 16), f3 = *(const f32x4*)(src + 24);
            u32x4 o; o.x = pk_bf16(f0[0], f0[1]); o.y = pk_bf16(f0[2], f0[3]); o.z = pk_bf16(f1[0], f1[1]); o.w = pk_bf16(f1[2], f1[3]);
            u32x4 o2; o2.x = pk_bf16(f2[0], f2[1]); o2.y = pk_bf16(f2[2], f2[3]); o2.z = pk_bf16(f3[0], f3[1]); o2.w = pk_bf16(f3[2], f3[3]);
            ((u32x4*)(p.kf))[(size_t)q * 64 + lane] = o; ((u32x4*)(p.kf))[(size_t)(q + 1) * 64 + lane] = o2;
        }
    }
}

template <int NR> struct TabBatchN { f32x4 f[NR][4]; };
typedef TabBatchN<4> TabBatch;
__device__ __forceinline__ int tab_rpb(int nb) { return ((2 * 16384 + nb - 1) / nb + 31) & ~31; }
__device__ __forceinline__ int tab_row(int vb, int nb, int wv, int i) { const int rpb = tab_rpb(nb), row = vb * rpb + 8 * i + wv; return (8 * i + wv < rpb && row < 2 * 16384) ? row : -1; }
template <int NR> __device__ __forceinline__ void tab_issue(const Params& p, int vb, int nb, int wv, int i0, int lane, TabBatchN<NR>& t) {
#pragma unroll
    for (int q = 0; q < NR; ++q) {
        const int row = tab_row(vb, nb, wv, i0 + q);
        if (row >= 0) { const float* src = (row < 16384 ? p.eu : p.ev) + (size_t)(row & 16383) * D;
#pragma unroll
            for (int i = 0; i < 4; ++i) t.f[q][i] = __builtin_nontemporal_load((const f32x4*)((const unsigned char*)src + (unsigned)(i * 256 + 4 * lane) * 4u)); }
    }
}
template <int NR> __device__ __forceinline__ void tab_finish(const Params& p, int vb, int nb, int wv, int i0, int lane, const TabBatchN<NR>& t) {
#pragma unroll
    for (int q = 0; q < NR; ++q) {
        const int row = tab_row(vb, nb, wv, i0 + q);
        if (row >= 0) {
            const bool isu = row < 16384; const int rr = row & 16383;
            float ss = 0.f;
#pragma unroll
            for (int i = 0; i < 4; ++i) ss += t.f[q][i][0] * t.f[q][i][0] + t.f[q][i][1] * t.f[q][i][1] + t.f[q][i][2] * t.f[q][i][2] + t.f[q][i][3] * t.f[q][i][3];
            ss = wave_sum(ss);
            const float step = 0.355f * sqrtf(ss * (1.0f / D));
            const float inv = step > 0.f ? 1.0f / step : 0.f;
            auto q4 = [&](float f) { return (int)fminf(fmaxf(rintf(f * inv), -7.0f), 7.0f); };
            const int lo8 = isu ? 0 : 8;
            unsigned char* dstt = isu ? p.eut : p.evt;
#pragma unroll
            for (int i = 0; i < 4; ++i) {
                const int q0 = q4(t.f[q][i][0]) + lo8, q1 = q4(t.f[q][i][1]), q2 = q4(t.f[q][i][2]) + lo8, q3 = q4(t.f[q][i][3]);
                const unsigned w = ((unsigned)q0 & 15u) | (((unsigned)q1 & 15u) << 4) | (((unsigned)q2 & 15u) << 8) | (((unsigned)q3 & 15u) << 12);
                stg<unsigned short>(dstt, (((unsigned)i * 16384u + (unsigned)rr) << 7) + (unsigned)lane * 2u, (unsigned short)w);
            }
            if (lane == 0) ((float*)(isu ? p.su : p.sv))[rr] = step;
        }
    }
}


template <int CH>
__device__ __forceinline__ void gemm22_chunk(const u32x4 (&a)[2][CH], const LAS unsigned char* b, int s0, int snext, f32x16 (&acc)[2][2], u32x4& bc0, u32x4& bc1) {
    const unsigned ba = (unsigned)(uintptr_t)(b + s0 * 32), bn = (unsigned)(uintptr_t)(b + snext * 32);
#pragma unroll
    for (int u = 0; u < CH; ++u) {
        u32x4 n0, n1;
        if (u + 1 < CH) asm volatile("ds_read_b128 %0, %2 offset:%4\n\tds_read_b128 %1, %3 offset:%4" : "=&v"(n0), "=&v"(n1) : "v"(ba), "v"(ba + 32u * TROW), "n"((u + 1) * 32));
        else            asm volatile("ds_read_b128 %0, %2\n\tds_read_b128 %1, %3" : "=&v"(n0), "=&v"(n1) : "v"(bn), "v"(bn + 32u * TROW));
        __builtin_amdgcn_sched_barrier(0);
        acc[0][0] = mfma32(a[0][u], bc0, acc[0][0]); acc[0][1] = mfma32(a[0][u], bc1, acc[0][1]);
        acc[1][0] = mfma32(a[1][u], bc0, acc[1][0]); acc[1][1] = mfma32(a[1][u], bc1, acc[1][1]);
        __builtin_amdgcn_sched_barrier(0);
        asm volatile("s_waitcnt lgkmcnt(0)" : "+v"(n0), "+v"(n1));
        bc0 = n0; bc1 = n1;
    }
}
template <int KS, int CH = 4>
__device__ __forceinline__ void gemm22(const u32x4* abase, unsigned lane, const LAS unsigned char* b, f32x16 (&acc)[2][2], int kofs = 0) {
    constexpr int NC = KS / CH;
    static_assert(NC % 2 == 0 && (NC & (NC - 1)) == 0, "chunk count: even power of two");
    u32x4 pa[2][CH], pb[2][CH];
    const unsigned lo = lane * 16u;
    {
        const unsigned o0 = lo + (unsigned)((kofs & (NC - 1)) * CH) * 1024u;
#pragma unroll
        for (int u = 0; u < CH; ++u) { pa[0][u] = ldg<u32x4>(abase, o0 + u * 1024u); pa[1][u] = ldg<u32x4>(abase, o0 + (KS + u) * 1024u); }
    }
    u32x4 bc0 = *(const LAS u32x4*)(b + ((kofs & (NC - 1)) * CH) * 32), bc1 = *(const LAS u32x4*)(b + 32 * TROW + ((kofs & (NC - 1)) * CH) * 32);
#pragma unroll 1
    for (int c = 0; c < NC; c += 2) {
        const int c0 = (c + kofs) & (NC - 1), c1 = (c + 1 + kofs) & (NC - 1), c2 = (c + 2 + kofs) & (NC - 1);
        const unsigned o1 = lo + (unsigned)(c1 * CH) * 1024u, o2 = lo + (unsigned)(c2 * CH) * 1024u;
#pragma unroll
        for (int u = 0; u < CH; ++u) { pb[0][u] = ldg<u32x4>(abase, o1 + u * 1024u); pb[1][u] = ldg<u32x4>(abase, o1 + (KS + u) * 1024u); }
        __builtin_amdgcn_sched_barrier(0);
        gemm22_chunk<CH>(pa, b, c0 * CH, c1 * CH, acc, bc0, bc1);
        __builtin_amdgcn_sched_barrier(0);
#pragma unroll
        for (int u = 0; u < CH; ++u) { pa[0][u] = ldg<u32x4>(abase, o2 + u * 1024u); pa[1][u] = ldg<u32x4>(abase, o2 + (KS + u) * 1024u); }
        __builtin_amdgcn_sched_barrier(0);
        gemm22_chunk<CH>(pb, b, c1 * CH, c2 * CH, acc, bc0, bc1);
        __builtin_amdgcn_sched_barrier(0);
    }
}

template <int CH>
__device__ __forceinline__ void gemm22i_chunk(const u32x4 (&a)[2][CH], const LAS unsigned char* b, int s0, int snext, i32x16 (&acc)[2][2], u32x4& bc0, u32x4& bc1) {
    const unsigned ba = (unsigned)(uintptr_t)(b + s0 * 32), bn = (unsigned)(uintptr_t)(b + snext * 32);
#pragma unroll
    for (int u = 0; u < CH; ++u) {
        u32x4 n0, n1;
        if (u + 1 < CH) asm volatile("ds_read_b128 %0, %2 offset:%4\n\tds_read_b128 %1, %3 offset:%4" : "=&v"(n0), "=&v"(n1) : "v"(ba), "v"(ba + 32u * TROWB), "n"((u + 1) * 32));
        else            asm volatile("ds_read_b128 %0, %2\n\tds_read_b128 %1, %3" : "=&v"(n0), "=&v"(n1) : "v"(bn), "v"(bn + 32u * TROWB));
        __builtin_amdgcn_sched_barrier(0);
        acc[0][0] = mfma_i8(a[0][u], bc0, acc[0][0]); acc[0][1] = mfma_i8(a[0][u], bc1, acc[0][1]);
        acc[1][0] = mfma_i8(a[1][u], bc0, acc[1][0]); acc[1][1] = mfma_i8(a[1][u], bc1, acc[1][1]);
        __builtin_amdgcn_sched_barrier(0);
        asm volatile("s_waitcnt lgkmcnt(0)" : "+v"(n0), "+v"(n1));
        bc0 = n0; bc1 = n1;
    }
}
template <int KS, int CH = 4>
__device__ __forceinline__ void gemm22i(const u32x4* abase, unsigned lane, const LAS unsigned char* b, i32x16 (&acc)[2][2], int kofs = 0) {
    constexpr int NC = KS / CH;
    static_assert(NC % 2 == 0 && (NC & (NC - 1)) == 0, "chunk count: even power of two");
    u32x4 pa[2][CH], pb[2][CH];
    const unsigned lo = lane * 16u;
    {
        const unsigned o0 = lo + (unsigned)((kofs & (NC - 1)) * CH) * 1024u;
#pragma unroll
        for (int u = 0; u < CH; ++u) { pa[0][u] = ldg<u32x4>(abase, o0 + u * 1024u); pa[1][u] = ldg<u32x4>(abase, o0 + (KS + u) * 1024u); }
    }
    u32x4 bc0 = *(const LAS u32x4*)(b + ((kofs & (NC - 1)) * CH) * 32), bc1 = *(const LAS u32x4*)(b + 32 * TROWB + ((kofs & (NC - 1)) * CH) * 32);
#pragma unroll 1
    for (int c = 0; c < NC; c += 2) {
        const int c0 = (c + kofs) & (NC - 1), c1 = (c + 1 + kofs) & (NC - 1), c2 = (c + 2 + kofs) & (NC - 1);
        const unsigned o1 = lo + (unsigned)(c1 * CH) * 1024u, o2 = lo + (unsigned)(c2 * CH) * 1024u;
#pragma unroll
        for (int u = 0; u < CH; ++u) { pb[0][u] = ldg<u32x4>(abase, o1 + u * 1024u); pb[1][u] = ldg<u32x4>(abase, o1 + (KS + u) * 1024u); }
        __builtin_amdgcn_sched_barrier(0);
        gemm22i_chunk<CH>(pa, b, c0 * CH, c1 * CH, acc, bc0, bc1);
        __builtin_amdgcn_sched_barrier(0);
#pragma unroll
        for (int u = 0; u < CH; ++u) { pa[0][u] = ldg<u32x4>(abase, o2 + u * 1024u); pa[1][u] = ldg<u32x4>(abase, o2 + (KS + u) * 1024u); }
        __builtin_amdgcn_sched_barrier(0);
        gemm22i_chunk<CH>(pb, b, c1 * CH, c2 * CH, acc, bc0, bc1);
        __builtin_amdgcn_sched_barrier(0);
    }
}

template <int KS, int CH = 4>
__device__ __forceinline__ void gemm22_pre(const u32x4* abase, const u32x4* anext, unsigned lane, const LAS unsigned char* b, f32x16 (&acc)[2][2], u32x4 (&pa)[2][CH], int kofs = 0) {
    constexpr int NC = KS / CH;
    static_assert(NC % 2 == 0 && (NC & (NC - 1)) == 0, "chunk count: even power of two");
    u32x4 pb[2][CH];
    const unsigned lo = lane * 16u;
    u32x4 bc0 = *(const LAS u32x4*)(b + ((kofs & (NC - 1)) * CH) * 32), bc1 = *(const LAS u32x4*)(b + 32 * TROW + ((kofs & (NC - 1)) * CH) * 32);
#pragma unroll 1
    for (int c = 0; c < NC; c += 2) {
        const int c0 = (c + kofs) & (NC - 1), c1 = (c + 1 + kofs) & (NC - 1), c2 = (c + 2 + kofs) & (NC - 1);
        const unsigned o1 = lo + (unsigned)(c1 * CH) * 1024u, o2 = lo + (unsigned)(c2 * CH) * 1024u;
        const u32x4* a2 = (c + 2 < NC) ? abase : anext;
#pragma unroll
        for (int u = 0; u < CH; ++u) { pb[0][u] = ldg<u32x4>(abase, o1 + u * 1024u); pb[1][u] = ldg<u32x4>(abase, o1 + (KS + u) * 1024u); }
        __builtin_amdgcn_sched_barrier(0);
        gemm22_chunk<CH>(pa, b, c0 * CH, c1 * CH, acc, bc0, bc1);
        __builtin_amdgcn_sched_barrier(0);
#pragma unroll
        for (int u = 0; u < CH; ++u) { pa[0][u] = ldg<u32x4>(a2, o2 + u * 1024u); pa[1][u] = ldg<u32x4>(a2, o2 + (KS + u) * 1024u); }
        __builtin_amdgcn_sched_barrier(0);
        gemm22_chunk<CH>(pb, b, c1 * CH, c2 * CH, acc, bc0, bc1);
        __builtin_amdgcn_sched_barrier(0);
    }
}
template <int KS, int CH = 4>
__device__ __forceinline__ void gemm22_first(const u32x4* abase, unsigned lane, u32x4 (&pa)[2][CH], int kofs = 0) {
    const unsigned o0 = lane * 16u + (unsigned)((kofs & (KS / CH - 1)) * CH) * 1024u;
#pragma unroll
    for (int u = 0; u < CH; ++u) { pa[0][u] = ldg<u32x4>(abase, o0 + u * 1024u); pa[1][u] = ldg<u32x4>(abase, o0 + (KS + u) * 1024u); }
}

template <int KS, int CH = 4>
__device__ __forceinline__ void gemm22i_pre(const u32x4* abase, const u32x4* anext, unsigned lane, const LAS unsigned char* b, i32x16 (&acc)[2][2], u32x4 (&pa)[2][CH], int kofs = 0) {
    constexpr int NC = KS / CH;
    static_assert(NC % 2 == 0 && (NC & (NC - 1)) == 0, "chunk count: even power of two");
    u32x4 pb[2][CH];
    const unsigned lo = lane * 16u;
    u32x4 bc0 = *(const LAS u32x4*)(b + ((kofs & (NC - 1)) * CH) * 32), bc1 = *(const LAS u32x4*)(b + 32 * TROWB + ((kofs & (NC - 1)) * CH) * 32);
#pragma unroll 1
    for (int c = 0; c < NC; c += 2) {
        const int c0 = (c + kofs) & (NC - 1), c1 = (c + 1 + kofs) & (NC - 1), c2 = (c + 2 + kofs) & (NC - 1);
        const unsigned o1 = lo + (unsigned)(c1 * CH) * 1024u, o2 = lo + (unsigned)(c2 * CH) * 1024u;
        const u32x4* a2 = (c + 2 < NC) ? abase : anext;
#pragma unroll
        for (int u = 0; u < CH; ++u) { pb[0][u] = ldg<u32x4>(abase, o1 + u * 1024u); pb[1][u] = ldg<u32x4>(abase, o1 + (KS + u) * 1024u); }
        __builtin_amdgcn_sched_barrier(0);
        gemm22i_chunk<CH>(pa, b, c0 * CH, c1 * CH, acc, bc0, bc1);
        __builtin_amdgcn_sched_barrier(0);
#pragma unroll
        for (int u = 0; u < CH; ++u) { pa[0][u] = ldg<u32x4>(a2, o2 + u * 1024u); pa[1][u] = ldg<u32x4>(a2, o2 + (KS + u) * 1024u); }
        __builtin_amdgcn_sched_barrier(0);
        gemm22i_chunk<CH>(pb, b, c1 * CH, c2 * CH, acc, bc0, bc1);
        __builtin_amdgcn_sched_barrier(0);
    }
}
template <int KS, int CH = 4>
__device__ __forceinline__ void gemm22i_first(const u32x4* abase, unsigned lane, u32x4 (&pa)[2][CH], int kofs = 0) {
    const unsigned o0 = lane * 16u + (unsigned)((kofs & (KS / CH - 1)) * CH) * 1024u;
#pragma unroll
    for (int u = 0; u < CH; ++u) { pa[0][u] = ldg<u32x4>(abase, o0 + u * 1024u); pa[1][u] = ldg<u32x4>(abase, o0 + (KS + u) * 1024u); }
}

__device__ __forceinline__ void p1_stage(const Params& p, int tile, int tid, LAS unsigned char* lds) {
    const int lane = tid & 63, wv = __builtin_amdgcn_readfirstlane(tid >> 6);
    LAS float* rs = (LAS float*)(lds + LDS_RS);
    const float* xt = p.x + (size_t)tile * 64 * D;
#pragma unroll 4
    for (int rr = 0; rr < 8; ++rr) {
        const int tk = 8 * wv + rr;
        f32x4 f[4]; float ss = 0.f, am = 0.f;
#pragma unroll
        for (int i = 0; i < 4; ++i) { f[i] = __builtin_nontemporal_load((const f32x4*)((const unsigned char*)xt + (unsigned)(tk * D + i * 256 + 4 * lane) * 4u)); ss += f[i][0] * f[i][0] + f[i][1] * f[i][1] + f[i][2] * f[i][2] + f[i][3] * f[i][3];
            am = fmaxf(am, fmaxf(fmaxf(fabsf(f[i][0]), fabsf(f[i][1])), fmaxf(fabsf(f[i][2]), fabsf(f[i][3])))); }
        ss = wave_sum(ss);
        am = wave_max(am);
        const float inv = am > 0.f ? 127.0f / am : 0.f;
        if (lane == 0) rs[tk] = rsqrtf(ss * (1.0f / D) + EPS) * am * (1.0f / 127.0f);
#pragma unroll
        for (int i = 0; i < 4; ++i) {
            unsigned w = 0u;
#pragma unroll
            for (int e = 0; e < 4; ++e) w |= ((unsigned)(int)rintf(f[i][e] * inv) & 255u) << (8 * e);
            *(LAS unsigned*)(lds + tk * TROWB + i * 256 + 4 * lane) = w;
        }
    }
    __syncthreads();
}
__device__ __forceinline__ void p1_inproj(const Params& p, int tile, int tid, LAS unsigned char* lds, int vb, int nb, bool do_tab) {
    const int lane = launder(tid) & 63, wv = __builtin_amdgcn_readfirstlane(tid >> 6), r = lane & 31, h = lane >> 5;
    const int b = tile >> 6, s0 = (tile & 63) * 64;
    LAS float* rs = (LAS float*)(lds + LDS_RS);
    const u32x4* WF = (const u32x4*)(p.winf);
    unsigned char* prow0 = p.proj + ((size_t)b * L + NMETA + s0) * (PW * 2);
    const LAS unsigned char* bp = lds + r * TROWB + h * 16;
    const float rs0 = rs[r], rs1 = rs[32 + r];
    const int stg_k = (tile >> 3) & 7;
    u32x4 pch[2][4];
    gemm22i_first<32, 4>(WF + (size_t)(2 * wv) * 32 * 64, lane, pch, stg_k);
#pragma unroll 1
    for (int rdx = 0; rdx < 4; ++rdx) {
        const int i0 = 16 * rdx + 2 * wv, i0n = 16 * (rdx < 3 ? rdx + 1 : rdx) + 2 * wv;
        TabBatch tb;
        if (do_tab) tab_issue(p, vb, nb, wv, 4 * rdx, lane, tb);
        __builtin_amdgcn_sched_barrier(0);
        i32x16 acc[2][2]; acc[0][0] = izero16(); acc[0][1] = izero16(); acc[1][0] = izero16(); acc[1][1] = izero16();
        gemm22i_pre<32, 4>(WF + (size_t)i0 * 32 * 64, WF + (size_t)i0n * 32 * 64, lane, bp, acc, pch, stg_k);
        f32x4 wsv[2][4];
#pragma unroll
        for (int mi = 0; mi < 2; ++mi)
#pragma unroll
            for (int q = 0; q < 4; ++q) wsv[mi][q] = ldg<f32x4>(p.wsci, (unsigned)(32 * (i0 + mi) + 8 * q + 4 * h) * 4u);
        LAS unsigned char* eb = lds + 64 * TROWB + wv * 8192;
#pragma unroll
        for (int mi = 0; mi < 2; ++mi)
#pragma unroll
            for (int q = 0; q < 4; ++q) {
                const f32x4 ws = wsv[mi][q];
#pragma unroll
                for (int nt = 0; nt < 2; ++nt) {
                    const float rv = nt ? rs1 : rs0;
                    u32x2 o; o.x = pk_bf16((float)acc[mi][nt][4 * q] * rv * ws[0], (float)acc[mi][nt][4 * q + 1] * rv * ws[1]); o.y = pk_bf16((float)acc[mi][nt][4 * q + 2] * rv * ws[2], (float)acc[mi][nt][4 * q + 3] * rv * ws[3]);
                    LAS u32x2* ep = (LAS u32x2*)(eb + (nt * 32 + r) * 128 + (((4 * mi + q) ^ (r & 7)) * 16) + 8 * h);
                    if (rdx == 3) {
                        const u32x2 cw = *ep;
                        o.x = pk_bf16(bf_lo(cw.x) * ((float)acc[mi][nt][4 * q] * rv * ws[0]), bf_hi(cw.x) * ((float)acc[mi][nt][4 * q + 1] * rv * ws[1]));
                        o.y = pk_bf16(bf_lo(cw.y) * ((float)acc[mi][nt][4 * q + 2] * rv * ws[2]), bf_hi(cw.y) * ((float)acc[mi][nt][4 * q + 3] * rv * ws[3]));
                    }
                    *ep = o;
                }
            }
        wave_sync();
        if (rdx != 2) {
            u32x4 ov[8];
#pragma unroll
            for (int k = 0; k < 8; ++k) { const int row = 8 * k + (lane >> 3); ov[k] = *(const LAS u32x4*)(eb + row * 128 + (((lane & 7) ^ (row & 7)) * 16)); }
            wave_sync();
#pragma unroll
            for (int k = 0; k < 8; ++k) { const int row = 8 * k + (lane >> 3); stg<u32x4>(prow0, (unsigned)(row * PW + 32 * (rdx == 3 ? 32 + 2 * wv : i0)) * 2u + (unsigned)(lane & 7) * 16u, ov[k]); }
        }
        if (do_tab) tab_finish(p, vb, nb, wv, 4 * rdx, lane, tb);
    }
    if (do_tab) for (int i0 = 16; 8 * i0 < tab_rpb(nb); i0 += 4) { TabBatch tb; tab_issue(p, vb, nb, wv, i0, lane, tb); tab_finish(p, vb, nb, wv, i0, lane, tb); }
}
__device__ __forceinline__ void p1_meta(const Params& p, int mp, int lane) {
    const int r = lane & 31, h = lane >> 5;
    const bool cv = mp >= 16;
    const int mt0 = cv ? 32 + (mp - 16) : 2 * mp, mt1 = cv ? 48 + (mp - 16) : 2 * mp + 1;
    const u32x4* A0 = (const u32x4*)(p.winf) + (size_t)mt0 * 32 * 64;
    const u32x4* A1 = (const u32x4*)(p.winf) + (size_t)mt1 * 32 * 64;
    const u32x4* B = (const u32x4*)(p.metaf);
    i32x16 acc0 = izero16(), acc1 = izero16();
#pragma unroll 4
    for (int s = 0; s < 32; ++s) { const u32x4 bf = ldg<u32x4>(B, (unsigned)(s * 64 + lane) * 16u);
        acc0 = mfma_i8(ldg<u32x4>(A0, (unsigned)(s * 64 + lane) * 16u), bf, acc0); acc1 = mfma_i8(ldg<u32x4>(A1, (unsigned)(s * 64 + lane) * 16u), bf, acc1); }
    if (r < NMETA) {
        const float rv = ((const float*)(p.rsm))[r];
#pragma unroll
        for (int q = 0; q < 4; ++q) {
            const f32x4 w0 = ldg<f32x4>(p.wsci, (unsigned)(32 * mt0 + 8 * q + 4 * h) * 4u), w1 = ldg<f32x4>(p.wsci, (unsigned)(32 * mt1 + 8 * q + 4 * h) * 4u);
            float v0[4], v1[4];
#pragma unroll
            for (int e = 0; e < 4; ++e) { v0[e] = (float)acc0[4 * q + e] * rv * w0[e]; v1[e] = (float)acc1[4 * q + e] * rv * w1[e]; }
            u32x2 o0, o1;
            o0.x = pk_bf16(v0[0], v0[1]); o0.y = pk_bf16(v0[2], v0[3]); o1.x = pk_bf16(v1[0], v1[1]); o1.y = pk_bf16(v1[2], v1[3]);
            if (cv) {
                o0.x = pk_bf16(bf_lo(o0.x) * v1[0], bf_hi(o0.x) * v1[1]); o0.y = pk_bf16(bf_lo(o0.y) * v1[2], bf_hi(o0.y) * v1[3]);
            }
#pragma unroll
            for (int bb = 0; bb < BATCH; ++bb) {
                if (!cv) { const unsigned ro = (unsigned)((bb * L + r) * PW + 64 * mp + 4 * h) * 2u; stg<u32x2>(p.proj, ro + 16u * q, o0); stg<u32x2>(p.proj, ro + 64u + 16u * q, o1); }
                else     { const unsigned ro = (unsigned)((bb * L + r) * PW + 1024 + 32 * (mp - 16) + 4 * h) * 2u; stg<u32x2>(p.proj, ro + 16u * q, o0); }
            }
        }
    }
}

template <int LOGN> __device__ __forceinline__ void bitonic_sort_desc(float* v) {
    constexpr int N = 1 << LOGN;
#pragma unroll
    for (int lk = 1; lk <= LOGN; ++lk) {
#pragma unroll
        for (int lj = lk - 1; lj >= 0; --lj) {
#pragma unroll
            for (int i = 0; i < N; ++i) {
                const int k = 1 << lk, j = 1 << lj, l = i ^ j;
                if (l > i) { const bool up = ((i & k) == 0); const float a = v[i], c = v[l]; const float hi = fmaxf(a, c), lo = fminf(a, c); v[i] = up ? hi : lo; v[l] = up ? lo : hi; }
            }
        }
    }
}
__device__ __forceinline__ void sort16_desc(float* v) {
#define CE_(i, j) { const float a_ = v[i], c_ = v[j]; v[i] = fmaxf(a_, c_); v[j] = fminf(a_, c_); }
    CE_(0,13) CE_(1,12) CE_(2,15) CE_(3,14) CE_(4,8) CE_(5,6) CE_(7,11) CE_(9,10)
    CE_(0,5) CE_(1,7) CE_(2,9) CE_(3,4) CE_(6,13) CE_(8,14) CE_(10,15) CE_(11,12)
    CE_(0,1) CE_(2,3) CE_(4,5) CE_(6,8) CE_(7,9) CE_(10,11) CE_(12,13) CE_(14,15)
    CE_(0,2) CE_(1,3) CE_(4,10) CE_(5,11) CE_(6,7) CE_(8,9) CE_(12,14) CE_(13,15)
    CE_(1,2) CE_(3,12) CE_(4,6) CE_(5,7) CE_(8,10) CE_(9,11) CE_(13,14)
    CE_(1,4) CE_(2,6) CE_(5,8) CE_(7,10) CE_(9,13) CE_(11,14)
    CE_(2,4) CE_(3,6) CE_(9,12) CE_(11,13)
    CE_(3,5) CE_(6,8) CE_(7,9) CE_(10,12)
    CE_(3,4) CE_(5,6) CE_(7,8) CE_(9,10) CE_(11,12)
    CE_(6,7) CE_(8,9)
#undef CE_
}
__device__ __forceinline__ void bitonic_merge16_desc(float* v) {
#pragma unroll
    for (int lj = 3; lj >= 0; --lj) {
#pragma unroll
        for (int i = 0; i < 16; ++i) { const int j = 1 << lj, l = i ^ j; if (l > i) { const float a = v[i], c = v[l]; v[i] = fmaxf(a, c); v[l] = fminf(a, c); } }
    }
}
__device__ __forceinline__ void merge_top16(float* a, const float* c) {
#pragma unroll
    for (int i = 0; i < 16; ++i) a[i] = fmaxf(a[i], c[15 - i]);
    bitonic_merge16_desc(a);
}
__device__ __forceinline__ void top16_of_64(float* v) {
    sort16_desc(v); bitonic_sort_desc<4>(v + 16); bitonic_sort_desc<4>(v + 32); bitonic_sort_desc<4>(v + 48);
    merge_top16(v, v + 16); merge_top16(v + 32, v + 48); merge_top16(v, v + 32);
}
__device__ __forceinline__ float embed_bits(float x, unsigned mask, unsigned code) { return __builtin_bit_cast(float, (__builtin_bit_cast(unsigned, x) & ~mask) | code); }

template <int W>
__device__ __forceinline__ void pool_window(const unsigned char* pbat, int p0, int cp, LAS unsigned char* dst) {
    unsigned u[31 + W];
#pragma unroll
    for (int i = 0; i < 31 + W; ++i) u[i] = ldg<unsigned>(pbat + (size_t)(p0 - (W - 1) + i) * (PW * 2u), cp * 4u);
    float sx = 0.f, sy = 0.f;
#pragma unroll
    for (int i = 0; i < W - 1; ++i) { sx += bf_lo(u[i]); sy += bf_hi(u[i]); }
    const float invw = 1.0f / (float)W;
#pragma unroll
    for (int tk = 0; tk < 32; ++tk) {
        const float lo = bf_lo(u[W - 1 + tk]), hi = bf_hi(u[W - 1 + tk]);
        sx += lo; sy += hi;
        *(LAS unsigned*)(dst + tk * TROW) = pk_bf16(sx * invw - lo, sy * invw - hi);
        sx -= bf_lo(u[tk]); sy -= bf_hi(u[tk]);
    }
}

template <int RB>
__device__ __forceinline__ void p2_xf_batch(const Params& p, int tile, int wv, int lane, LAS unsigned char* lds, unsigned char* ht, f32x4 (&f)[4][4], const u32x2 (&hq)[8][4], const f32x4 (&gg)[4], bool wr) {
    unsigned char* xqt = p.xq + (size_t)tile * 64 * D;
#pragma unroll
    for (int rr = 0; rr < 4; ++rr) {
        const int tk = 8 * wv + RB + rr;
        float ss = 0.f;
#pragma unroll
        for (int i = 0; i < 4; ++i) {
            const u32x2 hw = hq[RB + rr][i];
            f[rr][i][0] += bf_lo(hw.x); f[rr][i][1] += bf_hi(hw.x); f[rr][i][2] += bf_lo(hw.y); f[rr][i][3] += bf_hi(hw.y);
            u32x2 ho; ho.x = pk_bf16(f[rr][i][0], f[rr][i][1]); ho.y = pk_bf16(f[rr][i][2], f[rr][i][3]);
            stg<u32x2>(ht, (unsigned)(tk * D + i * 256 + 4 * lane) * 2u, ho);
            ss += f[rr][i][0] * f[rr][i][0] + f[rr][i][1] * f[rr][i][1] + f[rr][i][2] * f[rr][i][2] + f[rr][i][3] * f[rr][i][3];
        }
        ss = wave_sum(ss);
        const float rv = rsqrtf(ss * (1.0f / D) + EPS);
        float am = 0.f;
#pragma unroll
        for (int i = 0; i < 4; ++i)
#pragma unroll
            for (int e = 0; e < 4; ++e) { f[rr][i][e] *= rv * gg[i][e]; am = fmaxf(am, fabsf(f[rr][i][e])); }
        am = wave_max(am);
        const float inv = am > 0.f ? 127.0f / am : 0.f;
#pragma unroll
        for (int i = 0; i < 4; ++i) {
            unsigned w = 0u;
#pragma unroll
            for (int e = 0; e < 4; ++e) w |= ((unsigned)(int)fminf(rintf(f[rr][i][e] * inv), 119.0f) & 255u) << (8 * e);
            if (wr) stg<unsigned>(xqt, (unsigned)(tk * D + i * 256 + 4 * lane), w);
            *(LAS unsigned*)(lds + tk * TROWB + i * 256 + 4 * lane) = w;
        }
        if (lane == 0) { ((LAS float*)(lds + LDS_RS))[tk] = am * (1.0f / 127.0f); ((float*)p.sx)[tile * 64 + tk] = am * (1.0f / 127.0f); }
    }
}

__device__ __forceinline__ void p2_mix(const Params& p, int tile, int tid, LAS unsigned char* lds, int vb, int nb, bool do_tab) {
    const int wv = __builtin_amdgcn_readfirstlane(tid >> 6), lane0 = tid & 63;
    const int b = tile >> 6, s0 = (tile & 63) * 64;
    LAS float* ssa = (LAS float*)(lds + LDS_SSA);
    const unsigned char* pbat = p.proj + (size_t)b * L * (PW * 2);
    const float* xt = p.x + (size_t)tile * 64 * D;
    unsigned char* ht = p.hb + (size_t)tile * 64 * D * 2;
    if (tid < 64) ssa[tid] = 0.f;
    {
        const int lane = launder(tid) & 63, r = lane & 31, h = lane >> 5; (void)r; (void)h;
        float cw[3][8], gbv[8], u1[8], u2[8];
#pragma unroll
        for (int k = 0; k < 3; ++k) { const f32x4 a = ldg<f32x4>(p.conv_w, (unsigned)(k * MIXB + 8 * lane) * 4u), c = ldg<f32x4>(p.conv_w, (unsigned)(k * MIXB + 8 * lane + 4) * 4u);
#pragma unroll
            for (int e = 0; e < 4; ++e) { cw[k][e] = a[e]; cw[k][4 + e] = c[e]; } }
        { const f32x4 a = ldg<f32x4>(p.g_b, (unsigned)(8 * lane) * 4u), c = ldg<f32x4>(p.g_b, (unsigned)(8 * lane + 4) * 4u);
#pragma unroll
            for (int e = 0; e < 4; ++e) { gbv[e] = a[e]; gbv[4 + e] = c[e]; } }
        const int p0 = NMETA + s0 + 8 * wv;
        u32x4 bvv[8], cvv[10];
#pragma unroll
        for (int i = 0; i < 10; ++i) { const unsigned ro = (unsigned)(p0 - 2 + i) * (PW * 2u) + lane * 16u; cvv[i] = ldg<u32x4>(pbat, ro + 2048u); if (i >= 2) bvv[i - 2] = ldg<u32x4>(pbat, ro + 1024u); }
    {
        const int cp = tid & 255, th = __builtin_amdgcn_readfirstlane(tid >> 8), g = __builtin_amdgcn_readfirstlane(cp >> 6);
        const int p0 = NMETA + s0 + 32 * th;
        LAS unsigned char* dst = lds + (32 * th) * TROW + cp * 4;
        if (g == 0) pool_window<2>(pbat, p0, cp, dst); else if (g == 1) pool_window<4>(pbat, p0, cp, dst); else if (g == 2) pool_window<8>(pbat, p0, cp, dst); else pool_window<16>(pbat, p0, cp, dst);
    }
#pragma unroll
        for (int e = 0; e < 4; ++e) { u2[2 * e] = bf_lo(cvv[0][e]); u2[2 * e + 1] = bf_hi(cvv[0][e]); u1[2 * e] = bf_lo(cvv[1][e]); u1[2 * e + 1] = bf_hi(cvv[1][e]); }
#pragma unroll
        for (int tk = 0; tk < 8; ++tk) {
            const u32x4 bv = bvv[tk], cv = cvv[tk + 2];
            float z[8], ss = 0.f;
#pragma unroll
            for (int e = 0; e < 8; ++e) {
                const float bb = (e & 1) ? bf_hi(bv[e >> 1]) : bf_lo(bv[e >> 1]);
                const float u0 = (e & 1) ? bf_hi(cv[e >> 1]) : bf_lo(cv[e >> 1]);
                const float conv = u2[e] * cw[0][e] + u1[e] * cw[1][e] + u0 * cw[2][e];
                z[e] = bb * conv; ss += z[e] * z[e];
                u2[e] = u1[e]; u1[e] = u0;
            }
            ss = wave_sum(ss);
            const float rsb = rsqrtf(ss * (1.0f / MIXB) + EPS);
            u32x4 o; o.x = pk_bf16(z[0] * rsb * gbv[0], z[1] * rsb * gbv[1]); o.y = pk_bf16(z[2] * rsb * gbv[2], z[3] * rsb * gbv[3]);
            o.z = pk_bf16(z[4] * rsb * gbv[4], z[5] * rsb * gbv[5]); o.w = pk_bf16(z[6] * rsb * gbv[6], z[7] * rsb * gbv[7]);
            *(LAS u32x4*)(lds + (8 * wv + tk) * TROW + (MIXA + 8 * lane) * 2) = o;
        }
    }
    __syncthreads();
    {
        const int lane = launder(tid) & 63, r = lane & 31, h = lane >> 5; (void)r; (void)h;
        const int g = wv >> 1, dh = wv & 1;
        const u32x4* PWF = (const u32x4*)(p.pwf);
        f32x4 psc[2][4], pga[2][4];
#pragma unroll
        for (int mi = 0; mi < 2; ++mi)
#pragma unroll
            for (int q = 0; q < 4; ++q) { const int d = g * 128 + 32 * (2 * dh + mi) + 8 * q + 4 * h; psc[mi][q] = ldg<f32x4>(p.pool_scale, (unsigned)d * 4u); pga[mi][q] = ldg<f32x4>(p.g_a, (unsigned)d * 4u); }
        __builtin_amdgcn_sched_barrier(0);
        f32x16 acc[2][2]; acc[0][0] = zero16(); acc[0][1] = zero16(); acc[1][0] = zero16(); acc[1][1] = zero16();
        gemm22<8>(PWF + (size_t)((g * 4 + 2 * dh) * 8) * 64, lane, lds + r * TROW + g * 256 + h * 16, acc);
        float ss0 = 0.f, ss1 = 0.f;
#pragma unroll
        for (int mi = 0; mi < 2; ++mi)
#pragma unroll
            for (int q = 0; q < 4; ++q) {
                const int d = g * 128 + 32 * (2 * dh + mi) + 8 * q + 4 * h;
                const f32x4 sc = psc[mi][q]; (void)d;
#pragma unroll
                for (int e = 0; e < 4; ++e) { acc[mi][0][4 * q + e] *= sc[e]; acc[mi][1][4 * q + e] *= sc[e]; ss0 += acc[mi][0][4 * q + e] * acc[mi][0][4 * q + e]; ss1 += acc[mi][1][4 * q + e] * acc[mi][1][4 * q + e]; }
            }
        ss0 += __shfl_xor(ss0, 32); ss1 += __shfl_xor(ss1, 32);
        if (h == 0) { atomicAdd((float*)(ssa + r), ss0); atomicAdd((float*)(ssa + 32 + r), ss1); }
        __syncthreads();
        const float ra0 = rsqrtf(ssa[r] * (1.0f / MIXA) + EPS), ra1 = rsqrtf(ssa[32 + r] * (1.0f / MIXA) + EPS);
#pragma unroll
        for (int mi = 0; mi < 2; ++mi)
#pragma unroll
            for (int q = 0; q < 4; ++q) {
                const int d = g * 128 + 32 * (2 * dh + mi) + 8 * q + 4 * h;
                const f32x4 gg = pga[mi][q];
                u32x2 o0, o1;
                o0.x = pk_bf16(acc[mi][0][4 * q] * ra0 * gg[0], acc[mi][0][4 * q + 1] * ra0 * gg[1]); o0.y = pk_bf16(acc[mi][0][4 * q + 2] * ra0 * gg[2], acc[mi][0][4 * q + 3] * ra0 * gg[3]);
                o1.x = pk_bf16(acc[mi][1][4 * q] * ra1 * gg[0], acc[mi][1][4 * q + 1] * ra1 * gg[1]); o1.y = pk_bf16(acc[mi][1][4 * q + 2] * ra1 * gg[2], acc[mi][1][4 * q + 3] * ra1 * gg[3]);
                *(LAS u32x2*)(lds + r * TROW + d * 2) = o0;
                *(LAS u32x2*)(lds + (32 + r) * TROW + d * 2) = o1;
            }
    }
    __syncthreads();
    f32x4 xa[4][4];
    {
        const int lane = launder(tid) & 63, r = lane & 31, h = lane >> 5; (void)r; (void)h;
#pragma unroll
        for (int rr = 0; rr < 4; ++rr)
#pragma unroll
            for (int i = 0; i < 4; ++i) xa[rr][i] = __builtin_nontemporal_load((const f32x4*)((const unsigned char*)xt + (unsigned)((8 * wv + rr) * D + i * 256 + 4 * lane) * 4u));
        const u32x4* WF = (const u32x4*)(p.woutf);
        const LAS unsigned char* bp = lds + r * TROW + h * 16;
        u32x4 pch[2][4];
        gemm22_first<64, 4>(WF + (size_t)(4 * wv + 2 * ((tile >> 7) & 1)) * 64 * 64, lane, pch, (tile >> 3) & 15);
#pragma unroll 1
        for (int rdx = 0; rdx < 2; ++rdx) {
            const int rd = (rdx + (tile >> 7)) & 1;
            const int i0 = 4 * wv + 2 * rd, i0n = 4 * wv + 2 * (rdx < 1 ? rd ^ 1 : rd);
            f32x16 acc[2][2]; acc[0][0] = zero16(); acc[0][1] = zero16(); acc[1][0] = zero16(); acc[1][1] = zero16();
            gemm22_pre<64, 4>(WF + (size_t)i0 * 64 * 64, WF + (size_t)i0n * 64 * 64, lane, bp, acc, pch, (tile >> 3) & 15);
            LAS unsigned char* eb = lds + LDS_LUT + wv * 2048;
#pragma unroll
            for (int nt = 0; nt < 2; ++nt)
#pragma unroll
                for (int hf = 0; hf < 2; ++hf) {
                    if ((r >> 4) == hf) {
#pragma unroll
                        for (int mi = 0; mi < 2; ++mi)
#pragma unroll
                            for (int q = 0; q < 4; ++q) {
                                u32x2 hw; hw.x = pk_bf16(acc[mi][nt][4 * q], acc[mi][nt][4 * q + 1]); hw.y = pk_bf16(acc[mi][nt][4 * q + 2], acc[mi][nt][4 * q + 3]);
                                *(LAS u32x2*)(eb + (r & 15) * 128 + (((4 * mi + q) ^ (r & 7)) * 16) + 8 * h) = hw;
                            }
                    }
                    wave_sync();
                    u32x4 ov[2];
#pragma unroll
                    for (int k = 0; k < 2; ++k) { const int row = 8 * k + (lane >> 3); ov[k] = *(const LAS u32x4*)(eb + row * 128 + (((lane & 7) ^ (row & 7)) * 16)); }
                    wave_sync();
#pragma unroll
                    for (int k = 0; k < 2; ++k) { const int row = 8 * k + (lane >> 3); stg<u32x4>(ht, (unsigned)((nt * 32 + hf * 16 + row) * D + 32 * i0) * 2u + (unsigned)(lane & 7) * 16u, ov[k]); }
                }
        }
    }
    __syncthreads();
    {
        const int lane = launder(tid) & 63;
        f32x4 gg[4];
#pragma unroll
        for (int i = 0; i < 4; ++i) gg[i] = ldg<f32x4>(p.g_ffn, (unsigned)(i * 256 + 4 * lane) * 4u);
        f32x4 xb[4][4];
#pragma unroll
        for (int rr = 0; rr < 4; ++rr)
#pragma unroll
            for (int i = 0; i < 4; ++i) xb[rr][i] = __builtin_nontemporal_load((const f32x4*)((const unsigned char*)xt + (unsigned)((8 * wv + 4 + rr) * D + i * 256 + 4 * lane) * 4u));
        u32x2 hq[8][4];
#pragma unroll
        for (int rr = 0; rr < 4; ++rr)
#pragma unroll
            for (int i = 0; i < 4; ++i) hq[rr][i] = ldg<u32x2>(ht, (unsigned)((8 * wv + rr) * D + i * 256 + 4 * lane) * 2u);
        p2_xf_batch<0>(p, tile, wv, lane, lds, ht, xa, hq, gg, nb < NTILES);
#pragma unroll
        for (int rr = 4; rr < 8; ++rr)
#pragma unroll
            for (int i = 0; i < 4; ++i) hq[rr][i] = ldg<u32x2>(ht, (unsigned)((8 * wv + rr) * D + i * 256 + 4 * lane) * 2u);
        p2_xf_batch<4>(p, tile, wv, lane, lds, ht, xb, hq, gg, nb < NTILES);
    }
    __syncthreads();
    {
        const int lane = launder(tid) & 63, r = lane & 31, h = lane >> 5; (void)r; (void)h;
        const int hd = wv;
        const u32x4* WQF = (const u32x4*)(p.wqf);
        const u32x4* KF = (const u32x4*)(p.kf);
        unsigned char* lstt = p.lst + (size_t)tile * 64 * (NH * 32 * 4);
        const LAS unsigned char* bp = lds + r * TROWB + h * 16;
        const float sx0 = ((const LAS float*)(lds + LDS_RS))[r], sx1 = ((const LAS float*)(lds + LDS_RS))[32 + r];
        LAS unsigned char* lut = lds + LDS_LUT + wv * 2048;
        float L1[2][16];
#pragma unroll
        for (int pp = 0; pp < 2; ++pp) {
            const int hp = hd * 2 + pp;
            u32x4 qb[8];
            LAS u32x4* qpark = (LAS u32x4*)(lds + 64 * TROWB + wv * 8192) + lane;
            LAS float* wsl = (LAS float*)(lds + LDS_BYTES + wv * 512);
            const f32x4 wq4 = ldg<f32x4>(p.wscq, (unsigned)(hp * 128 + 4 * (lane & 31)) * 4u);
#pragma unroll
            for (int mh = 0; mh < 2; ++mh) {
                const int mt0 = hp * 4 + mh * 2;
                i32x16 acc[2][2]; acc[0][0] = izero16(); acc[0][1] = izero16(); acc[1][0] = izero16(); acc[1][1] = izero16();
                __builtin_amdgcn_sched_barrier(0);
                gemm22i<32, QCH>(WQF + (size_t)mt0 * 32 * 64, lane, bp, acc, (tile >> 3));
                if (mh == 0) { if (lane < 32) *(LAS f32x4*)(wsl + 4 * lane) = wq4; wave_sync(); }
#pragma unroll
                for (int mi = 0; mi < 2; ++mi)
#pragma unroll
                    for (int s2 = 0; s2 < 2; ++s2) {
                        const f32x4 w0 = *(const LAS f32x4*)(wsl + 32 * (2 * mh + mi) + 16 * s2 + 4 * h), w1 = *(const LAS f32x4*)(wsl + 32 * (2 * mh + mi) + 16 * s2 + 8 + 4 * h);
#pragma unroll
                        for (int nt = 0; nt < 2; ++nt) {
                            const float xs = nt ? sx1 : sx0;
                            u32x4 o; o.x = pk_bf16((float)acc[mi][nt][8 * s2] * xs * w0[0], (float)acc[mi][nt][8 * s2 + 1] * xs * w0[1]); o.y = pk_bf16((float)acc[mi][nt][8 * s2 + 2] * xs * w0[2], (float)acc[mi][nt][8 * s2 + 3] * xs * w0[3]);
                            o.z = pk_bf16((float)acc[mi][nt][8 * s2 + 4] * xs * w1[0], (float)acc[mi][nt][8 * s2 + 5] * xs * w1[1]); o.w = pk_bf16((float)acc[mi][nt][8 * s2 + 6] * xs * w1[2], (float)acc[mi][nt][8 * s2 + 7] * xs * w1[3]);
                            if (nt == 0) qb[2 * (mh * 2 + mi) + s2] = o; else qpark[(2 * (mh * 2 + mi) + s2) * 64] = o;
                        }
                    }
            }
            {
                float top0[16], top1[16];
#pragma unroll
                for (int i = 0; i < 16; ++i) { top0[i] = -INFINITY; top1[i] = -INFINITY; }
                const u32x4* kfp = KF + (size_t)(hp * 4 * 8) * 64;
                u32x4 kf[8];
#pragma unroll
                for (int ks = 0; ks < 8; ++ks) kf[ks] = ldg<u32x4>(kfp, (unsigned)(ks * 64 + lane) * 16u);
#pragma unroll 1
                for (int kt = 0; kt < 4; ++kt) {
                    f32x16 sa0 = zero16(), sa1 = zero16();
#pragma unroll
                    for (int ks = 0; ks < 8; ++ks) sa0 = mfma32(kf[ks], qb[ks], sa0);
                    __builtin_amdgcn_sched_barrier(0);
#pragma unroll
                    for (int ks = 0; ks < 8; ++ks) sa1 = mfma32(kf[ks], qpark[ks * 64], sa1);
                    __builtin_amdgcn_sched_barrier(0);
                    const int ktn = (kt + 1) & 3;
#pragma unroll
                    for (int ks = 0; ks < 8; ++ks) kf[ks] = ldg<u32x4>(kfp, (unsigned)((ktn * 8 + ks) * 64 + lane) * 16u);
                    __builtin_amdgcn_sched_barrier(0);
                    {
                        float v[16];
#pragma unroll
                        for (int i = 0; i < 16; ++i) v[i] = embed_bits(sa0[i], 127u, (unsigned)(32 * kt + (i & 3) + 8 * (i >> 2) + 4 * h));
                        sort16_desc(v); merge_top16(top0, v);
                    }
                    {
                        float v[16];
#pragma unroll
                        for (int i = 0; i < 16; ++i) v[i] = embed_bits(sa1[i], 127u, (unsigned)(32 * kt + (i & 3) + 8 * (i >> 2) + 4 * h));
                        sort16_desc(v); merge_top16(top1, v);
                    }
                    __builtin_amdgcn_sched_barrier(0);
                }
#pragma unroll
                for (int nt = 0; nt < 2; ++nt) {
                    float* top = nt ? top1 : top0;
                    float o[16];
#pragma unroll
                    for (int i = 0; i < 16; ++i) o[i] = __shfl_xor(top[i], 32);
                    merge_top16(top, o);
                    if (pp == 1) {
#pragma unroll
                        for (int i = 0; i < 16; ++i) L1[nt][i] = top[i];
                    }
                    if (h == 0) {
                        const unsigned lo = (unsigned)((((nt * 32 + r) * NH + hd) * 2 + pp) * 16) * 4u;
                        if (pp == 0)
#pragma unroll
                        for (int w4 = 0; w4 < 4; ++w4) { f32x4 tv; tv[0] = top[4 * w4]; tv[1] = top[4 * w4 + 1]; tv[2] = top[4 * w4 + 2]; tv[3] = top[4 * w4 + 3]; stg<f32x4>(lstt, lo + 16u * w4, tv); }
                        u32x4 kb;
#pragma unroll
                        for (int w4 = 0; w4 < 4; ++w4) kb[w4] = (__builtin_bit_cast(unsigned, top[4 * w4]) & 127u) | ((__builtin_bit_cast(unsigned, top[4 * w4 + 1]) & 127u) << 8) | ((__builtin_bit_cast(unsigned, top[4 * w4 + 2]) & 127u) << 16) | ((__builtin_bit_cast(unsigned, top[4 * w4 + 3]) & 127u) << 24);
                        *(LAS u32x4*)(lut + ((nt * 32 + r) * 2 + pp) * 16) = kb;
                    }
                }
            }
        }
#pragma unroll
        for (int nt = 0; nt < 2; ++nt) {
            float s1[16], s2[16];
            {
                const unsigned lo = (unsigned)(((nt * 32 + r) * NH + hd) * 32) * 4u;
#pragma unroll
                for (int w4 = 0; w4 < 4; ++w4) { const f32x4 a = ldg<f32x4>(lstt, lo + 16u * w4);
#pragma unroll
                    for (int e4 = 0; e4 < 4; ++e4) { s1[4 * w4 + e4] = a[e4]; s2[4 * w4 + e4] = L1[nt][4 * w4 + e4]; } }
            }
            float top[16];
#pragma unroll
            for (int i = 0; i < 16; ++i) top[i] = -INFINITY;
            { float v[16]; v[0] = embed_bits(s1[0] + s2[0], 255u, 0u); v[1] = embed_bits(s1[0] + s2[1], 255u, 1u); v[2] = embed_bits(s1[0] + s2[2], 255u, 2u); v[3] = embed_bits(s1[0] + s2[3], 255u, 3u); v[4] = embed_bits(s1[0] + s2[4], 255u, 4u); v[5] = embed_bits(s1[0] + s2[5], 255u, 5u); v[6] = embed_bits(s1[0] + s2[6], 255u, 6u); v[7] = embed_bits(s1[0] + s2[7], 255u, 7u); v[8] = embed_bits(s1[0] + s2[8], 255u, 8u); v[9] = embed_bits(s1[0] + s2[9], 255u, 9u); v[10] = embed_bits(s1[0] + s2[10], 255u, 10u); v[11] = embed_bits(s1[0] + s2[11], 255u, 11u); v[12] = embed_bits(s1[0] + s2[12], 255u, 12u); v[13] = embed_bits(s1[0] + s2[13], 255u, 13u); v[14] = embed_bits(s1[0] + s2[14], 255u, 14u); v[15] = embed_bits(s1[0] + s2[15], 255u, 15u);
              sort16_desc(v); merge_top16(top, v); }
            { float v[16]; v[0] = embed_bits(s1[1] + s2[0], 255u, 16u); v[1] = embed_bits(s1[1] + s2[1], 255u, 17u); v[2] = embed_bits(s1[1] + s2[2], 255u, 18u); v[3] = embed_bits(s1[1] + s2[3], 255u, 19u); v[4] = embed_bits(s1[1] + s2[4], 255u, 20u); v[5] = embed_bits(s1[1] + s2[5], 255u, 21u); v[6] = embed_bits(s1[1] + s2[6], 255u, 22u); v[7] = embed_bits(s1[1] + s2[7], 255u, 23u); v[8] = embed_bits(s1[2] + s2[0], 255u, 32u); v[9] = embed_bits(s1[2] + s2[1], 255u, 33u); v[10] = embed_bits(s1[2] + s2[2], 255u, 34u); v[11] = embed_bits(s1[2] + s2[3], 255u, 35u); v[12] = embed_bits(s1[2] + s2[4], 255u, 36u); v[13] = embed_bits(s1[3] + s2[0], 255u, 48u); v[14] = embed_bits(s1[3] + s2[1], 255u, 49u); v[15] = embed_bits(s1[3] + s2[2], 255u, 50u);
              sort16_desc(v); merge_top16(top, v); }
            { float v[16]; v[0] = embed_bits(s1[3] + s2[3], 255u, 51u); v[1] = embed_bits(s1[4] + s2[0], 255u, 64u); v[2] = embed_bits(s1[4] + s2[1], 255u, 65u); v[3] = embed_bits(s1[4] + s2[2], 255u, 66u); v[4] = embed_bits(s1[5] + s2[0], 255u, 80u); v[5] = embed_bits(s1[5] + s2[1], 255u, 81u); v[6] = embed_bits(s1[6] + s2[0], 255u, 96u); v[7] = embed_bits(s1[6] + s2[1], 255u, 97u); v[8] = embed_bits(s1[7] + s2[0], 255u, 112u); v[9] = embed_bits(s1[7] + s2[1], 255u, 113u); v[10] = embed_bits(s1[8] + s2[0], 255u, 128u); v[11] = embed_bits(s1[9] + s2[0], 255u, 144u); v[12] = embed_bits(s1[10] + s2[0], 255u, 160u); v[13] = embed_bits(s1[11] + s2[0], 255u, 176u); v[14] = embed_bits(s1[12] + s2[0], 255u, 192u); v[15] = embed_bits(s1[13] + s2[0], 255u, 208u);
              sort16_desc(v); merge_top16(top, v); }
            {
                float c0 = embed_bits(s1[14] + s2[0], 255u, 224u), c1 = embed_bits(s1[15] + s2[0], 255u, 240u);
#pragma unroll
                for (int i = 0; i < 16; ++i) { const float t0 = top[i]; top[i] = fmaxf(t0, c0); c0 = fminf(t0, c0); const float t1 = top[i]; top[i] = fmaxf(t1, c1); c1 = fminf(t1, c1); }
            }
            float e[16], sum = 0.f;
#pragma unroll
            for (int i = 0; i < 16; ++i) { e[i] = __expf(top[i] - top[0]); sum += e[i]; }
            const float inv = 1.0f / sum;
            const LAS unsigned char* lt = lut + (nt * 32 + r) * 32;
            LAS unsigned char* slot = lds + 64 * TROWB + wv * 8192 + (nt * 32 + r) * 32;
            if (h == 0) {
                int ids[16];
#pragma unroll
                for (int i = 0; i < 16; ++i) { const unsigned code = __builtin_bit_cast(unsigned, top[i]) & 255u; ids[i] = (int)lt[code >> 4] * NKEYS + (int)lt[16 + (code & 15u)]; }
                u32x4 w0, w1;
#pragma unroll
                for (int i = 0; i < 4; ++i) { w0[i] = (unsigned)ids[i] | ((unsigned)ids[i + 8] << 16); w1[i] = (unsigned)ids[i + 4] | ((unsigned)ids[i + 12] << 16); }
                *(LAS u32x4*)(slot) = w0; *(LAS u32x4*)(slot + 16) = w1;
            } else {
#pragma unroll
                for (int i = 0; i < 4; ++i) { f32x4 gv; gv[0] = e[2 * i] * inv; gv[1] = e[2 * i + 8] * inv; gv[2] = e[2 * i + 1] * inv; gv[3] = e[2 * i + 9] * inv; *(LAS f32x4*)(slot + 2048 + (nt * 32 + r) * 32 + 16 * i) = gv; }
            }
        }
    }
    __syncthreads();
    {
        const int t7 = launder(tid);
        const LAS unsigned char* sl = lds + 64 * TROWB;
        unsigned char* idxt = p.idx + (size_t)tile * 64 * (HK * 2);
        unsigned char* gatet = p.gate + (size_t)tile * 64 * (HK * 4);
        u32x4 iv[2]; f32x4 gv[4];
#pragma unroll
        for (int k = 0; k < 2; ++k) { const int ci = t7 + 512 * k, tok = ci >> 4, c = ci & 15;
#pragma unroll
            for (int q = 0; q < 4; ++q) iv[k][q] = *(const LAS unsigned*)(sl + (4 * (c & 1) + q) * 8192 + tok * 32 + (c >> 1) * 4); }
#pragma unroll
        for (int k = 0; k < 4; ++k) { const int ci = t7 + 512 * k, tok = ci >> 5, c = ci & 31;
            const f32x2 a = *(const LAS f32x2*)(sl + (2 * (c & 3)) * 8192 + 2048 + tok * 64 + (c >> 2) * 8), b = *(const LAS f32x2*)(sl + (2 * (c & 3) + 1) * 8192 + 2048 + tok * 64 + (c >> 2) * 8);
            gv[k][0] = a[0]; gv[k][1] = a[1]; gv[k][2] = b[0]; gv[k][3] = b[1]; }
#pragma unroll
        for (int k = 0; k < 2; ++k) if (nb < NTILES) stg<u32x4>(idxt, (unsigned)(t7 + 512 * k) * 16u, iv[k]);
#pragma unroll
        for (int k = 0; k < 4; ++k) stg<f32x4>(gatet, (unsigned)(t7 + 512 * k) * 16u, gv[k]);
    }
}

__device__ __forceinline__ int dot16_i8(u32x4 a, u32x4 b) {
    int d = __builtin_amdgcn_sdot4((int)a[0], (int)b[0], 0, false);
    d = __builtin_amdgcn_sdot4((int)a[1], (int)b[1], d, false); d = __builtin_amdgcn_sdot4((int)a[2], (int)b[2], d, false); d = __builtin_amdgcn_sdot4((int)a[3], (int)b[3], d, false);
    return d;
}
__device__ __forceinline__ float gelu_exact(float z) { return 0.5f * z * (1.0f + erff(z * 0.70710678118654752f)); }

struct GMeta { int ids[16]; u32x4 x; };
struct GRows { u32x4 v[16]; };
__device__ __forceinline__ void g_rows(const unsigned char* slice, const GMeta& m, int lane, GRows& r) {
    const unsigned co = (unsigned)(lane & 7) * 16u;
#pragma unroll
    for (int i = 0; i < 16; ++i) r.v[i] = ldg<u32x4>(slice, (unsigned)m.ids[i] + co);
}

constexpr int P3W_Z = 0, P3W_CQ = 4096, P3W_SC = 5120, P3W_CS = 5152, P3W_ID = 5184, P3W_X = 9280, P3W_SSQ = 17472, P3W_BYTES = 19520;
constexpr int LDS_ALL = LDS_BYTES > 8 * P3W_BYTES ? LDS_BYTES : 8 * P3W_BYTES;
__device__ __forceinline__ void p3_stage_tok(LAS unsigned char* wl, int q, int lane, unsigned w, u32x4 xw) {
    { u32x2 o2; o2.x = (w & 0xffffu) << 7; o2.y = (w >> 16) << 7; *(LAS u32x2*)(wl + P3W_ID + q * 512 + lane * 8) = o2; }
    unsigned lo[4], hi[4];
#pragma unroll
    for (int d = 0; d < 4; ++d) { const unsigned L = xw[d] & 0x0f0f0f0fu, H = (((((xw[d] ^ 0x80808080u) + 0x08080808u) >> 4) & 0x0f0f0f0fu) ^ 0x08080808u); lo[d] = L | (L >> 4); hi[d] = H | (H >> 4); }
    u32x2 xl, xh;
    xl.x = __builtin_amdgcn_perm(lo[1], lo[0], 0x06040200u); xl.y = __builtin_amdgcn_perm(lo[3], lo[2], 0x06040200u);
    xh.x = __builtin_amdgcn_perm(hi[1], hi[0], 0x06040200u); xh.y = __builtin_amdgcn_perm(hi[3], hi[2], 0x06040200u);
    LAS unsigned char* xd = wl + P3W_X + q * 1024 + (lane >> 4) * 256 + ((lane >> 1) & 7) * 32 + (lane & 1) * 8;
    *(LAS u32x2*)(xd) = xl; *(LAS u32x2*)(xd + 16) = xh;
}
__device__ __forceinline__ void p3_wave(const Params& p, int tb0, int tb1, int lt, int pos, int lane, LAS unsigned char* wl, bool pre) {
    const int ntok = 1 << lt;
    auto tokf = [&](int q) { return (q < 4 ? tb0 : tb1) + (q & 3); };
    const int grp = lane >> 3, ch = lane & 7, i0 = ((ch >> 2) & 1) * 8 + ((ch >> 1) & 1) * 4 + (ch & 1) * 2;
    LAS int* zl = (LAS int*)(wl + P3W_Z);
    LAS float* scl = (LAS float*)(wl + P3W_SC);
    LAS float* ssl = (LAS float*)(wl + P3W_SSQ);
    if (!pre) {
#pragma unroll
        for (int q = 0; q < 8; ++q) if (q < ntok) {
            const int t = tokf(q);
            p3_stage_tok(wl, q, lane, ldg<unsigned>(p.idx + (size_t)t * (HK * 2), (unsigned)lane * 4u), ldg<u32x4>(p.xq + (size_t)t * D, (unsigned)lane * 16u));
        }
    }
    wave_sync();
    auto ids_lds = [&](int q, GMeta& m) {
#pragma unroll
        for (int w = 0; w < 4; ++w) { const u32x4 a = *(const LAS u32x4*)(wl + P3W_ID + q * 512 + grp * 64 + 16 * w);
#pragma unroll
            for (int e = 0; e < 4; ++e) m.ids[4 * w + e] = (int)a[e]; }
    };
    {
        const int nus = 4 << lt;
        auto umeta = [&](int n, GMeta& m, u32x4& xh) {
            const int nn = n < nus ? n : nus - 1, q = nn & (ntok - 1), j = (pos + (nn >> lt)) & 3;
            ids_lds(q, m);
            m.x = *(const LAS u32x4*)(wl + P3W_X + q * 1024 + 256 * j + 32 * ch); xh = *(const LAS u32x4*)(wl + P3W_X + q * 1024 + 256 * j + 32 * ch + 16);
        };
        auto urows = [&](int n, const GMeta& m, GRows& r) { const int nn = n < nus ? n : nus - 1; g_rows(p.eut + (size_t)((pos + (nn >> lt)) & 3) * (16384 * 128), m, lane, r); };
        auto ufinish = [&](int n, const GMeta& m, const u32x4 xh, const GRows& r) {
            const int q = n & (ntok - 1);
            int part[16];
#pragma unroll
            for (int i = 0; i < 16; ++i) {
                int al = __builtin_amdgcn_sdot8((int)r.v[i][0], (int)m.x[0], 0, false), ah = __builtin_amdgcn_sdot8((int)r.v[i][0], (int)xh[0], 0, false);
#pragma unroll
                for (int d = 1; d < 4; ++d) { al = __builtin_amdgcn_sdot8((int)r.v[i][d], (int)m.x[d], al, false); ah = __builtin_amdgcn_sdot8((int)r.v[i][d], (int)xh[d], ah, false); }
                part[i] = al + 16 * ah;
            }
#pragma unroll
            for (int lv = 2; lv >= 0; --lv) {
                const int n2 = 2 << lv, off = 1 << lv;
                const bool up = (lane & off) != 0;
#pragma unroll
                for (int i = 0; i < n2; ++i) { const int a = part[i], c = part[i + n2]; const int send = up ? a : c, keep = up ? c : a; part[i] = keep + __shfl_xor(send, off); }
            }
            LAS int* zp = zl + q * 128 + 2 * lane;
            if (n < ntok) { zp[0] = part[0]; zp[1] = part[1]; } else { zp[0] += part[0]; zp[1] += part[1]; }
        };
        GMeta ma, mb; GRows ra, rb; u32x4 xa, xb;
        umeta(0, ma, xa); umeta(1, mb, xb); urows(0, ma, ra);
#pragma unroll 1
        for (int n = 0; n < nus; n += 2) {
            GMeta mc; u32x4 xc;
            umeta(n + 2, mc, xc); urows(n + 1, mb, rb);
            __builtin_amdgcn_sched_barrier(0);
            ufinish(n, ma, xa, ra);
            __builtin_amdgcn_sched_barrier(0);
            umeta(n + 3, ma, xa); urows(n + 2, mc, ra);
            __builtin_amdgcn_sched_barrier(0);
            ufinish(n + 1, mb, xb, rb);
            __builtin_amdgcn_sched_barrier(0);
            mb = ma; xb = xa; ma = mc; xa = xc;
        }
    }
    {
        const unsigned po = (unsigned)(grp * 16 + i0) * 4u;
        u32x2 idw[8]; f32x2 g[8]; float sx[8];
#pragma unroll
        for (int q = 0; q < 8; ++q) { const int t = tokf(q < ntok ? q : 0); idw[q] = *(const LAS u32x2*)(wl + P3W_ID + (q < ntok ? q : 0) * 512 + po); g[q] = ldg<f32x2>(p.gate + (size_t)t * (HK * 4), po); sx[q] = ((const float*)p.sx)[t]; }
        float su0[8], su1[8], sv0[8], sv1[8];
#pragma unroll
        for (int q = 0; q < 8; ++q) { const int a = (int)(idw[q].x >> 7), c = (int)(idw[q].y >> 7); su0[q] = ((const float*)p.su)[a]; su1[q] = ((const float*)p.su)[c]; sv0[q] = ((const float*)p.sv)[a]; sv1[q] = ((const float*)p.sv)[c]; }
#pragma unroll
        for (int q = 0; q < 8; ++q) if (q < ntok) {
            const int z0 = zl[q * 128 + 2 * lane], z1 = zl[q * 128 + 2 * lane + 1];
            const float c0 = g[q][0] * gelu_exact((float)z0 * (sx[q] * su0[q])) * sv0[q];
            const float c1 = g[q][1] * gelu_exact((float)z1 * (sx[q] * su1[q])) * sv1[q];
            float am = fmaxf(fabsf(c0), fabsf(c1));
            am = wave_max(am);
            const float inv = am > 0.f ? 127.0f / am : 0.f;
            const unsigned q0 = (unsigned)(int)rintf(c0 * inv) & 255u, q1 = (unsigned)(int)rintf(c1 * inv) & 255u;
            *(LAS unsigned short*)(wl + P3W_CQ + q * 128 + 16 * grp + i0) = (unsigned short)(q0 | (q1 << 8));
            int cs = (int)rintf(c0 * inv) + (int)rintf(c1 * inv);
            cs = wave_sum_i(cs);
            ssl[q * 64 + lane] = 0.f;
            if (lane == 0) { scl[q] = am * (1.0f / 127.0f); ((LAS int*)(wl + P3W_CS))[q] = cs; }
        }
    }
    wave_sync();
    {
        const int nvs = 4 << lt;
        auto meta = [&](int n, GMeta& m, float& sc, u32x2& hv) {
            const int nn = n < nvs ? n : nvs - 1, q = nn & (ntok - 1), j = (pos + (nn >> lt)) & 3, t = tokf(q);
            ids_lds(q, m);
            m.x = *(const LAS u32x4*)(wl + P3W_CQ + q * 128 + 16 * grp);
            sc = scl[q];
            hv = ldg<u32x2>(p.hb + (size_t)t * D * 2, (unsigned)(256 * j + 32 * ch + 4 * grp) * 2u);
        };
        auto rows = [&](int n, const GMeta& m, GRows& r) { const int nn = n < nvs ? n : nvs - 1; g_rows(p.evt + (size_t)((pos + (nn >> lt)) & 3) * (16384 * 128), m, lane, r); };
        auto finish = [&](int n, const GMeta& m, const GRows& r, float sc, u32x2 hv) {
            const int q = n & (ntok - 1), j = (pos + (n >> lt)) & 3, t = tokf(q);
            const bool last = (n >> lt) == 3;
            unsigned long long sw0 = 0ull, sw1 = 0ull, sw2 = 0ull;
            f32x4 gfa[4] = {};
            if (last) {
#pragma unroll
                for (int k = 0; k < 4; ++k) gfa[k] = ldg<f32x4>(p.g_fin, (unsigned)(256 * ((j + k) & 3) + 32 * ch + 4 * grp) * 4u);
                const unsigned char* hrow = p.hb + (size_t)t * D * 2;
                sw0 = __hip_atomic_load((const unsigned long long*)(hrow + (unsigned)(256 * ((j + 1) & 3) + 32 * ch + 4 * grp) * 2u), __ATOMIC_RELAXED, __HIP_MEMORY_SCOPE_AGENT);
                sw1 = __hip_atomic_load((const unsigned long long*)(hrow + (unsigned)(256 * ((j + 2) & 3) + 32 * ch + 4 * grp) * 2u), __ATOMIC_RELAXED, __HIP_MEMORY_SCOPE_AGENT);
                sw2 = __hip_atomic_load((const unsigned long long*)(hrow + (unsigned)(256 * ((j + 3) & 3) + 32 * ch + 4 * grp) * 2u), __ATOMIC_RELAXED, __HIP_MEMORY_SCOPE_AGENT);
            }
            int acc[32];
#pragma unroll
            for (int e = 0; e < 32; ++e) acc[e] = 0;
#pragma unroll
            for (int g = 0; g < 4; ++g)
#pragma unroll
                for (int e = 0; e < 4; ++e) {
                    const int cq = (int)m.x[g];
                    const unsigned A = r.v[4 * g][e], B = r.v[4 * g + 1][e], C = r.v[4 * g + 2][e], Dd = r.v[4 * g + 3][e];
                    const unsigned t0 = __builtin_amdgcn_perm(B, A, 0x05010400u), t1 = __builtin_amdgcn_perm(B, A, 0x07030602u);
                    const unsigned t2 = __builtin_amdgcn_perm(Dd, C, 0x05010400u), t3 = __builtin_amdgcn_perm(Dd, C, 0x07030602u);
                    const unsigned r0 = __builtin_amdgcn_perm(t2, t0, 0x05040100u), r1 = __builtin_amdgcn_perm(t2, t0, 0x07060302u);
                    const unsigned r2 = __builtin_amdgcn_perm(t3, t1, 0x05040100u), r3 = __builtin_amdgcn_perm(t3, t1, 0x07060302u);
                    int* a4 = acc + 8 * e;
                    a4[0] = __builtin_amdgcn_sdot4((int)(r0 & 0x0f0f0f0fu), cq, a4[0], false); a4[2] = __builtin_amdgcn_sdot4((int)(r1 & 0x0f0f0f0fu), cq, a4[2], false);
                    a4[4] = __builtin_amdgcn_sdot4((int)(r2 & 0x0f0f0f0fu), cq, a4[4], false); a4[6] = __builtin_amdgcn_sdot4((int)(r3 & 0x0f0f0f0fu), cq, a4[6], false);
                    a4[1] = __builtin_amdgcn_sdot4((int)r0, cq, a4[1], false); a4[3] = __builtin_amdgcn_sdot4((int)r1, cq, a4[3], false);
                    a4[5] = __builtin_amdgcn_sdot4((int)r2, cq, a4[5], false); a4[7] = __builtin_amdgcn_sdot4((int)r3, cq, a4[7], false);
                }
#pragma unroll
            for (int i = 0; i < 16; ++i) { const auto sw = __builtin_amdgcn_permlane32_swap((unsigned)acc[i], (unsigned)acc[i + 16], false, false); acc[i] = (int)(sw[0] + sw[1]); }
#pragma unroll
            for (int i = 0; i < 8; ++i) { const auto sw = __builtin_amdgcn_permlane16_swap((unsigned)acc[i], (unsigned)acc[i + 8], false, false); acc[i] = (int)(sw[0] + sw[1]); }
            {
                const bool up = (lane & 8) != 0;
#pragma unroll
                for (int i = 0; i < 4; ++i) {
                    const int xs = acc[i] + __builtin_amdgcn_update_dpp(0, acc[i], 0x128, 0xf, 0xf, false), ys = acc[i + 4] + __builtin_amdgcn_update_dpp(0, acc[i + 4], 0x128, 0xf, 0xf, false);
                    acc[i] = up ? ys : xs;
                }
            }
            const int c8 = 8 * ((const LAS int*)(wl + P3W_CS))[q];
            f32x4 o; o[0] = (float)(acc[0] - c8) * sc + bf_lo(hv.x); o[1] = (float)((acc[1] - acc[0]) >> 4) * sc + bf_hi(hv.x); o[2] = (float)(acc[2] - c8) * sc + bf_lo(hv.y); o[3] = (float)((acc[3] - acc[2]) >> 4) * sc + bf_hi(hv.y);
            const float sq = o[0] * o[0] + o[1] * o[1] + o[2] * o[2] + o[3] * o[3];
            if (!last) {
                { u32x2 ob; ob.x = pk_bf16(o[0], o[1]); ob.y = pk_bf16(o[2], o[3]); stg<u32x2>(p.hb + (size_t)t * D * 2, (unsigned)(256 * j + 32 * ch + 4 * grp) * 2u, ob); }
                atomicAdd((float*)(ssl + q * 64 + lane), sq);
            } else {
                const float rv = rsqrtf(wave_sum(ssl[q * 64 + lane] + sq) * (1.0f / D) + EPS);
                float* orow = p.out + (size_t)t * D;
                { const unsigned cb = (unsigned)(256 * j + 32 * ch + 4 * grp); const f32x4 gf = gfa[0]; f32x4 ov; ov[0] = o[0] * rv * gf[0]; ov[1] = o[1] * rv * gf[1]; ov[2] = o[2] * rv * gf[2]; ov[3] = o[3] * rv * gf[3]; __builtin_nontemporal_store(ov, (f32x4*)((unsigned char*)orow + cb * 4u)); }
#pragma unroll
                for (int k = 0; k < 3; ++k) {
                    const unsigned long long w = k == 0 ? sw0 : (k == 1 ? sw1 : sw2);
                    const unsigned wl0 = (unsigned)w, wh0 = (unsigned)(w >> 32);
                    const unsigned cb = (unsigned)(256 * ((j + 1 + k) & 3) + 32 * ch + 4 * grp);
                    const f32x4 gf = gfa[k + 1];
                    f32x4 ov; ov[0] = bf_lo(wl0) * rv * gf[0]; ov[1] = bf_hi(wl0) * rv * gf[1]; ov[2] = bf_lo(wh0) * rv * gf[2]; ov[3] = bf_hi(wh0) * rv * gf[3];
                    __builtin_nontemporal_store(ov, (f32x4*)((unsigned char*)orow + cb * 4u));
                }
            }
        };
        GMeta ma, mb; GRows ra, rb; float sa, sb; u32x2 ha, hb;
        meta(0, ma, sa, ha); meta(1, mb, sb, hb); rows(0, ma, ra);
#pragma unroll 1
        for (int n = 0; n < nvs; n += 2) {
            GMeta mc; float scc; u32x2 hc;
            meta(n + 2, mc, scc, hc); rows(n + 1, mb, rb);
            __builtin_amdgcn_sched_barrier(0);
            finish(n, ma, ra, sa, ha);
            __builtin_amdgcn_sched_barrier(0);
            meta(n + 3, ma, sa, ha); rows(n + 2, mc, ra);
            __builtin_amdgcn_sched_barrier(0);
            finish(n + 1, mb, rb, sb, hb);
            __builtin_amdgcn_sched_barrier(0);
            mb = ma; sb = sa; hb = ha; ma = mc; sa = scc; ha = hc;
        }
    }
}

#define XB_TMO      128
#define XB_XCNT(j)  (256  + 64 * (j))
#define XB_XSUB(j)  (1280 + 64 * (j))
#define XB_XGEN(j)  (2304 + 64 * (j))
#define XB_TOP      3328
#define XB_TOPGEN   3392
#define XCD_BAR_WORDS 3456
#define XB_SPIN_CAP (1u << 18)

__device__ __forceinline__ unsigned xb_ld(unsigned* p)              { return __hip_atomic_load(p, __ATOMIC_RELAXED, __HIP_MEMORY_SCOPE_AGENT); }
__device__ __forceinline__ unsigned xb_add(unsigned* p, unsigned v) { return __hip_atomic_fetch_add(p, v, __ATOMIC_RELAXED, __HIP_MEMORY_SCOPE_AGENT); }
__device__ __forceinline__ unsigned xb_xcc_id() { return (unsigned)__builtin_amdgcn_s_getreg((3 << 11) | 20) & 0xFu; }
#define XB_SPIN(cond, bar) do { unsigned _sp = 0; while (cond) { __builtin_amdgcn_s_sleep(1); \
    if ((++_sp & 255u) == 0u) { if (xb_ld(&(bar)[XB_TMO])) break; if (_sp > XB_SPIN_CAP) { atomicAdd(&(bar)[XB_TMO], 1u); break; } } } } while (0)

struct XcdBarrier {
    unsigned* bar; unsigned x;
    volatile LAS unsigned* st;
};

__device__ __forceinline__ XcdBarrier xcd_barrier_post(unsigned* bar, volatile LAS unsigned* st) {
    XcdBarrier b; b.bar = bar; b.x = xb_xcc_id(); b.st = st;
    if (threadIdx.x == 0) (void)xb_add(&bar[XB_XCNT(b.x)], 1u);
    return b;
}
__device__ __forceinline__ void xcd_barrier_complete(unsigned* bar, unsigned x, unsigned& nloc, unsigned& nx) {
    const unsigned G = gridDim.x * gridDim.y * gridDim.z;
    unsigned sum, cnt, mine, sp = 0u;
    for (;;) {
        sum = 0u; cnt = 0u; mine = 0u;
#pragma unroll
        for (unsigned j = 0; j < 16; ++j) { const unsigned c = xb_ld(&bar[XB_XCNT(j)]); sum += c; cnt += (c > 0u) ? 1u : 0u; mine = (j == x) ? c : mine; }
        if (sum == G) break;
        __builtin_amdgcn_s_sleep(1);
        if ((++sp & 255u) == 0u) { if (xb_ld(&bar[XB_TMO])) break; if (sp > XB_SPIN_CAP) { atomicAdd(&bar[XB_TMO], 1u); break; } }
    }
    nloc = mine > 0u ? mine : 1u; nx = cnt > 0u ? cnt : 1u;
}

__device__ __forceinline__ void xcd_barrier(const XcdBarrier& b) {
    asm volatile("s_waitcnt vmcnt(0)" ::: "memory");
    __syncthreads();
    if (threadIdx.x == 0) {
        unsigned* bar = b.bar;
        __builtin_amdgcn_s_waitcnt(0);
        unsigned nloc = b.st[0], nx = b.st[1];
        if (nloc == 0u) { xcd_barrier_complete(bar, b.x, nloc, nx); b.st[0] = nloc; b.st[1] = nx; }
        const unsigned old = xb_add(&bar[XB_XSUB(b.x)], 1u);
        const unsigned gen = old / nloc;
        if (old + 1u == (gen + 1u) * nloc) {
            __builtin_amdgcn_fence(__ATOMIC_RELEASE, "agent");
            asm volatile("s_waitcnt vmcnt(0)" ::: "memory");
            const unsigned og = xb_add(&bar[XB_TOP], 1u);
            const unsigned tg = og / nx;
            if (og + 1u == (tg + 1u) * nx) xb_add(&bar[XB_TOPGEN], 1u);
            else XB_SPIN(xb_ld(&bar[XB_TOPGEN]) == tg, bar);
            __builtin_amdgcn_fence(__ATOMIC_ACQUIRE, "agent");
            xb_add(&bar[XB_XGEN(b.x)], 1u);
            asm volatile("s_waitcnt vmcnt(0)" ::: "memory");
        } else {
            XB_SPIN(xb_ld(&bar[XB_XGEN(b.x)]) == gen, bar);
            __builtin_amdgcn_fence(__ATOMIC_ACQUIRE, "agent");
            asm volatile("s_waitcnt vmcnt(0)" ::: "memory");
        }
    }
    __syncthreads();
}


__global__ void __launch_bounds__(512) k_fwd(Params p) {
    __shared__ __attribute__((aligned(16))) unsigned char lds_raw[LDS_ALL + 16];
    LAS unsigned char* lds = (LAS unsigned char*)lds_raw;
    const int tid = threadIdx.x, vb = blockIdx.x, nb = gridDim.x;
    volatile LAS unsigned* xbw = (volatile LAS unsigned*)(lds + LDS_ALL);
    if (tid < 4) xbw[tid] = 0u;
    __syncthreads();
    XcdBarrier gb = xcd_barrier_post((unsigned*)p.bar, xbw);
    if (tid == 0) xbw[2] = xb_add(&((unsigned*)p.bar)[XCD_BAR_WORDS + 64 * gb.x], 1u);
    p0_prep(p, vb, nb, tid, lds);
    const bool early = vb >= 129 && vb < NTILES;
    if (early) p1_stage(p, vb, tid, lds);
    xcd_barrier(gb);
    for (int tile = vb; tile < NTILES; tile += nb) { if (!(early && tile == vb)) p1_stage(p, tile, tid, lds); p1_inproj(p, tile, tid, lds, vb, nb, tile == vb); __syncthreads(); }
    if ((tid >> 6) == 0) for (int mp = vb; mp < 32; mp += nb) p1_meta(p, mp, launder(tid) & 63);
    xcd_barrier(gb);
    for (int tile = vb; tile < NTILES; tile += nb) { p2_mix(p, tile, tid, lds, vb, nb, tile == vb); __syncthreads(); }
    asm volatile("s_waitcnt vmcnt(0)" ::: "memory");
    __syncthreads();
    __builtin_amdgcn_fence(__ATOMIC_ACQUIRE, "agent");
    const int tid3 = launder(tid), lane = tid3 & 63, wv = __builtin_amdgcn_readfirstlane(tid3 >> 6);
    int np = 0, mypos = 0, nloc = 1;
    {
        unsigned* bar = (unsigned*)p.bar;
        const int myx = (int)gb.x;
#pragma unroll
        for (int q = 0; q < 16; ++q) { const int c = (int)xb_ld(&bar[XB_XCNT(q)]); if (q == myx) { mypos = np; nloc = c > 0 ? c : 1; } np += (c > 0) ? 1 : 0; }
        if (np < 1) np = 1;
    }
    {
        LAS unsigned char* wl = lds + wv * P3W_BYTES;
        (void)nloc;
        const bool single = nb >= NTILES;
        u32x4 hx[8]; unsigned hid[8];
#pragma unroll
        for (int q = 0; q < 8; ++q) { hx[q] = u32x4{0u, 0u, 0u, 0u}; hid[q] = 0u; }
        if (single) {
#pragma unroll
            for (int q = 0; q < 8; ++q) {
                const int tok = 4 * wv + (q & 3) + 32 * (q >> 2);
                hx[q] = *(const LAS u32x4*)(lds + tok * TROWB + lane * 16);
                hid[q] = *(const LAS unsigned*)(lds + 64 * TROWB + (lane & 7) * 8192 + tok * 32 + (lane >> 3) * 4);
            }
        }
        __syncthreads();
        if (single) {
#pragma unroll
            for (int q = 0; q < 8; ++q) p3_stage_tok(wl, q, lane, hid[q], hx[q]);
        }
#pragma unroll 1
        for (int tile = vb; tile < NTILES; tile += nb) p3_wave(p, 64 * tile + 4 * wv, 64 * tile + 32 + 4 * wv, 3, mypos, lane, wl, single);
    }
}
}

extern "C" void kernel_launch(void* const* d_in, const int* in_sizes, int n_in, void* d_out, int out_size, void* d_ws, size_t ws_size, hipStream_t stream) {
    static int grid_blocks = 0;
    if (n_in != 16 || out_size != T * D) { fprintf(stderr, "kernel_launch: unexpected sizes n_in %d out %d\n", n_in, out_size); return; }
    if (!grid_blocks) {
        int dev = 0, cus = 0, per_cu = 0;
        (void)hipGetDevice(&dev);
        (void)hipDeviceGetAttribute(&cus, hipDeviceAttributeMultiprocessorCount, dev);
        (void)hipOccupancyMaxActiveBlocksPerMultiprocessor(&per_cu, (const void*)k_fwd, 512, 0);
        if (per_cu < 1) { fprintf(stderr, "kernel_launch: occupancy query returned %d\n", per_cu); per_cu = 1; }
        grid_blocks = cus * 1;
    }
    Params p{};
    p.x = (const float*)d_in[0]; p.meta = (const float*)d_in[1]; p.g_mix = (const float*)d_in[2]; p.w_in = (const float*)d_in[3]; p.pool_w = (const float*)d_in[4];
    p.pool_scale = (const float*)d_in[5]; p.conv_w = (const float*)d_in[6]; p.g_a = (const float*)d_in[7]; p.g_b = (const float*)d_in[8]; p.w_out = (const float*)d_in[9];
    p.g_ffn = (const float*)d_in[10]; p.w_query = (const float*)d_in[11]; p.sub_keys = (const float*)d_in[12]; p.eu = (const float*)d_in[13]; p.ev = (const float*)d_in[14]; p.g_fin = (const float*)d_in[15];
    p.out = (float*)d_out;
    unsigned char* ws = (unsigned char*)d_ws;
    p.winf = ws; p.woutf = ws + (4u << 20); p.wqf = ws + (6u << 20); p.kf = ws + (10u << 20); p.pwf = p.kf + (512u << 10); p.metaf = p.pwf + (128u << 10); p.rsm = p.metaf + (64u << 10); p.bar = p.rsm + 256;
    p.eut = ws + (12u << 20); p.evt = p.eut + (32u << 20); p.proj = p.evt + (32u << 20); p.idx = p.proj + (size_t)TL * MIXIN * 2; p.gate = p.idx + (size_t)T * HK * 4; p.lst = p.gate + (size_t)T * HK * 4;
    p.su = p.lst + (size_t)T * NH * 32 * 4; p.sv = p.su + 65536; p.sx = p.sv + 65536; p.xq = p.sx + 65536; p.wsci = p.xq + (size_t)T * D; p.wscq = p.wsci + 8192; p.hb = p.wscq + 8192;
    if ((size_t)(p.hb - ws) + (size_t)T * D * 2 > ws_size) { fprintf(stderr, "kernel_launch: workspace too small\n"); return; }
    if (hipMemsetAsync(p.bar, 0, (XCD_BAR_WORDS + 64 * 16) * 4, stream) != hipSuccess) { fprintf(stderr, "kernel_launch: memset of the barrier words failed\n"); return; }
    hipLaunchKernelGGL(k_fwd, dim3(grid_blocks), dim3(512), 0, stream, p);
}
```
